# Optimizing an MI355X kernel written in HIP

```python
import jax, jax.numpy as jnp
from jax import lax
import numpy as np

D_MODEL = 2048
BATCH = 16
SEQ = 2048
DEPTH = 1

HEAD_DIM = 128
ATTN_PATTERNS = ((128, 1), (512, 4), (2048, 16))
N_GROUPS = len(ATTN_PATTERNS)
HEADS_PER_GROUP = 4
ATTN_QKV = N_GROUPS * HEADS_PER_GROUP * HEAD_DIM
ATTN_OUT = HEADS_PER_GROUP * HEAD_DIM
BLK = 128
CONV_WIDTH = 1024
CONV_K = 3
MEM_LEN = 256
MEM_HEADS = 4
MEM_HEAD_DIM = 256
MEM_W = MEM_HEADS * MEM_HEAD_DIM
N_BRANCH = 3
EPS = 1e-6

SPLIT_SIZES = (ATTN_QKV, ATTN_QKV, ATTN_QKV, ATTN_OUT,
               CONV_WIDTH, CONV_WIDTH, CONV_WIDTH, CONV_WIDTH,
               MEM_W, MEM_W, N_BRANCH * D_MODEL)
IN_COLS = int(sum(SPLIT_SIZES))
SPLIT_IDX = [int(i) for i in np.cumsum(SPLIT_SIZES)[:-1]]

kernel_name = "hybrid_dilated_attn_shortconv_memory_gated_merge"


def rms_norm(t, g):
    tf = t.astype(jnp.float32)
    y = tf * lax.rsqrt(jnp.mean(tf * tf, axis=-1, keepdims=True) + EPS) * g.astype(jnp.float32)
    return y.astype(t.dtype)


def banded_causal_attn(q, k, v, span):
    N, L, H, E = q.shape
    nb = -(-L // BLK)
    pad = nb * BLK - L
    q = jnp.pad(q, ((0, 0), (0, pad), (0, 0), (0, 0)))
    k = jnp.pad(k, ((0, 0), (BLK, pad), (0, 0), (0, 0)))
    v = jnp.pad(v, ((0, 0), (BLK, pad), (0, 0), (0, 0)))
    qb = q.reshape(N, nb, BLK, H, E)

    def two_blocks(t):
        t = t.reshape(N, nb + 1, BLK, H, E)
        return jnp.concatenate([t[:, :-1], t[:, 1:]], axis=2)

    kb, vb = two_blocks(k), two_blocks(v)
    s = jnp.einsum('nbqhe,nbkhe->nbhqk', qb.astype(jnp.float32), kb.astype(jnp.float32)) * (E ** -0.5)
    qpos = jnp.arange(BLK)[:, None] + BLK
    kpos = jnp.arange(2 * BLK)[None, :]
    rel = qpos - kpos
    band = (rel >= 0) & (rel <= span)
    valid = (jnp.arange(nb)[:, None] * BLK + kpos - BLK) >= 0
    mask = band[None] & valid[:, None, :]
    s = jnp.where(mask[None, :, None], s, -jnp.inf)
    m = jnp.max(s, axis=-1, keepdims=True)
    p = jnp.exp(s - m)
    den = jnp.sum(p, axis=-1, keepdims=True)
    o = jnp.einsum('nbhqk,nbkhe->nbqhe', p / den, vb.astype(jnp.float32))
    lse = (m + jnp.log(den))[..., 0]
    o = o.reshape(N, nb * BLK, H, E)[:, :L]
    lse = lse.transpose(0, 1, 3, 2).reshape(N, nb * BLK, H)[:, :L]
    return o, lse


def dilated_causal_attn(q, k, v, window, dilation):
    B, S, H, E = q.shape
    L = S // dilation

    def to_classes(t):
        return t.reshape(B, L, dilation, H, E).transpose(0, 2, 1, 3, 4).reshape(B * dilation, L, H, E)

    o, lse = banded_causal_attn(to_classes(q), to_classes(k), to_classes(v), window // dilation)
    o = o.reshape(B, dilation, L, H, E).transpose(0, 2, 1, 3, 4).reshape(B, S, H, E)
    lse = lse.reshape(B, dilation, L, H).transpose(0, 2, 1, 3).reshape(B, S, H)
    return o, lse


def setup_inputs(seed: int = 0) -> dict:
    key = jax.random.key(seed)
    ks = jax.random.split(key, 16)
    f32 = jnp.float32

    def w(k, shape, fan_in):
        return jax.random.normal(k, shape, f32) * (fan_in ** -0.5)

    def gain(k, shape):
        return 1.0 + 0.02 * jax.random.normal(k, shape, f32)

    return {
        "x": jax.random.normal(ks[0], (BATCH, SEQ, D_MODEL), f32),
        "mem": jax.random.normal(ks[1], (BATCH, MEM_LEN, D_MODEL), f32),
        "norm_g": gain(ks[2], (D_MODEL,)),
        "mem_norm_g": gain(ks[3], (D_MODEL,)),
        "w_in": w(ks[4], (D_MODEL, IN_COLS), D_MODEL),
        "attn_q_norm": gain(ks[5], (N_GROUPS, HEAD_DIM)),
        "attn_k_norm": gain(ks[6], (N_GROUPS, HEAD_DIM)),
        "conv_w": w(ks[7], (CONV_K, CONV_WIDTH), CONV_K),
        "mem_w_kv": w(ks[8], (D_MODEL, 2 * MEM_W), D_MODEL),
        "mem_q_norm": gain(ks[9], (MEM_HEAD_DIM,)),
        "mem_k_norm": gain(ks[10], (MEM_HEAD_DIM,)),
        "w_br_attn": w(ks[11], (ATTN_OUT, D_MODEL), ATTN_OUT),
        "w_br_conv": w(ks[12], (CONV_WIDTH, D_MODEL), CONV_WIDTH),
        "w_br_mem": w(ks[13], (MEM_W, D_MODEL), MEM_W),
        "w_out": w(ks[14], (D_MODEL, D_MODEL), D_MODEL),
    }


def reference(x, mem, norm_g, mem_norm_g, w_in, attn_q_norm, attn_k_norm, conv_w,
              mem_w_kv, mem_q_norm, mem_k_norm, w_br_attn, w_br_conv, w_br_mem, w_out):
    B, S, D = x.shape
    for _layer in range(DEPTH):
        h = rms_norm(x, norm_g)
        proj = jnp.einsum('bsd,dc->bsc', h, w_in)
        (q, k, v, z_attn, conv_b, conv_c, conv_v, z_conv,
         mem_q, z_mem, gates) = jnp.split(proj, SPLIT_IDX, axis=-1)

        q = q.reshape(B, S, N_GROUPS, HEADS_PER_GROUP, HEAD_DIM)
        k = k.reshape(B, S, N_GROUPS, HEADS_PER_GROUP, HEAD_DIM)
        v = v.reshape(B, S, N_GROUPS, HEADS_PER_GROUP, HEAD_DIM)
        outs, lses = [], []
        for g, (window, dilation) in enumerate(ATTN_PATTERNS):
            qg = rms_norm(q[:, :, g], attn_q_norm[g])
            kg = rms_norm(k[:, :, g], attn_k_norm[g])
            o, lse = dilated_causal_attn(qg, kg, v[:, :, g], window, dilation)
            outs.append(o)
            lses.append(lse)
        alpha = jax.nn.softmax(jnp.stack(lses, axis=0), axis=0)
        a = jnp.sum(alpha[..., None] * jnp.stack(outs, axis=0), axis=0)
        a = a.reshape(B, S, ATTN_OUT).astype(x.dtype) * jax.nn.silu(z_attn)

        u = conv_c * conv_v
        y = sum(conv_w[j] * jnp.pad(u, ((0, 0), (j, 0), (0, 0)))[:, :S] for j in range(CONV_K))
        c = conv_b * y * jax.nn.silu(z_conv)

        mh = rms_norm(mem, mem_norm_g)
        mkv = jnp.einsum('bmd,dc->bmc', mh, mem_w_kv)
        mk, mv = jnp.split(mkv, 2, axis=-1)
        M = mem.shape[1]
        mq = rms_norm(mem_q.reshape(B, S, MEM_HEADS, MEM_HEAD_DIM), mem_q_norm)
        mk = rms_norm(mk.reshape(B, M, MEM_HEADS, MEM_HEAD_DIM), mem_k_norm)
        mv = mv.reshape(B, M, MEM_HEADS, MEM_HEAD_DIM)
        ms = jnp.einsum('bshe,bmhe->bhsm', mq.astype(jnp.float32), mk.astype(jnp.float32)) * (MEM_HEAD_DIM ** -0.5)
        mp = jax.nn.softmax(ms, axis=-1)
        mo = jnp.einsum('bhsm,bmhe->bshe', mp, mv.astype(jnp.float32))
        mo = mo.reshape(B, S, MEM_W).astype(x.dtype) * jax.nn.silu(z_mem)

        gt = jax.nn.sigmoid(gates.astype(jnp.float32).reshape(B, S, N_BRANCH, D)).astype(x.dtype)
        merged = (gt[:, :, 0] * jnp.einsum('bsc,cd->bsd', a, w_br_attn)
                  + gt[:, :, 1] * jnp.einsum('bsc,cd->bsd', c, w_br_conv)
                  + gt[:, :, 2] * jnp.einsum('bsc,cd->bsd', mo, w_br_mem))
        x = x + jnp.einsum('bsd,de->bse', merged, w_out)
    return x
```

```cpp
#include <hip/hip_runtime.h>
#include <hip/hip_cooperative_groups.h>
#include <cstdio>
namespace cg = cooperative_groups;

#ifndef ONE_LAUNCH
#define ONE_LAUNCH 1
#endif

#define LAS __attribute__((address_space(3)))
typedef unsigned short bf16_t;
typedef short bf16x8 __attribute__((ext_vector_type(8)));
typedef short s16x4 __attribute__((ext_vector_type(4)));
typedef float f32x4 __attribute__((ext_vector_type(4)));
typedef unsigned u32x4 __attribute__((ext_vector_type(4)));
typedef unsigned u32x2 __attribute__((ext_vector_type(2)));

constexpr int DM = 2048, SEQ = 2048, NB = 16, NTOK = NB * SEQ;
constexpr int PC = 17408;
constexpr int HT = NTOK / 2;
constexpr int C_Q = 0, C_K = 1536, C_V = 3072, C_ZA = 4608, C_CB = 5120, C_CC = 6144, C_CV = 7168, C_ZC = 8192, C_MQ = 9216, C_ZM = 10240, C_G = 11264;
constexpr int ACTW = 2560;
constexpr float EPSF = 1e-6f;
constexpr int NTHR = 512;
constexpr int LDS_BYTES = 149504;

constexpr size_t WS_WIN = 0;
constexpr size_t WS_WKV = WS_WIN + (size_t)PC * DM * 2;
constexpr size_t WS_WBR = WS_WKV + (size_t)DM * DM * 2;
constexpr size_t WS_WOUT = WS_WBR + (size_t)DM * ACTW * 2;
constexpr size_t WS_MH = WS_WOUT + (size_t)DM * DM * 2;
constexpr size_t WS_MKV = WS_MH + (size_t)4096 * DM * 2;
constexpr size_t WS_PROJ = WS_MKV + (size_t)4096 * DM * 2;
constexpr size_t WS_OG = WS_PROJ + (size_t)HT * PC * 2;
constexpr size_t WS_LSE = WS_OG + (size_t)HT * 1536 * 2;
constexpr size_t WS_ACT = WS_LSE + (size_t)HT * 12 * 4;
constexpr size_t WS_MF = WS_ACT + (size_t)HT * ACTW * 2;
constexpr size_t WS_MB = WS_MF + (size_t)HT * DM * 4;
constexpr size_t WS_END = WS_MB + (size_t)HT * DM * 2;
constexpr size_t OUT_H_OFF = (size_t)HT * DM * 4;

__device__ __forceinline__ float bflo(unsigned w) { return __uint_as_float(w << 16); }
__device__ __forceinline__ float bfhi(unsigned w) { return __uint_as_float(w & 0xffff0000u); }
__device__ __forceinline__ unsigned cvt_pk_bf16(float lo, float hi) { unsigned r; asm volatile("v_cvt_pk_bf16_f32 %0, %1, %2" : "=v"(r) : "v"(lo), "v"(hi)); return r; }
__device__ __forceinline__ float sigmoidf_(float x) { return 1.0f / (1.0f + __expf(-x)); }
__device__ __forceinline__ float siluf_(float x) { return x / (1.0f + __expf(-x)); }

namespace pg8 {
constexpr int BM = 256, BK = 64, HALF = 128, HTB = HALF * BK * 2, STAGE_BYTES = 8 * HTB, NXCD = 8, WGM = 8;
__host__ __device__ __forceinline__ int lds_byte(int r, int c) { const int st = (r >> 4) * 2 + (c >> 5), rr = r & 15, cc = c & 31, ob = rr * 64 + cc * 2; return st * 1024 + (ob ^ (((ob >> 9) & 1) << 5)); }
__host__ __device__ __forceinline__ void stage_rc(int b, int& R, int& C) { const int st = b / 1024, sb = b % 1024, swz = sb ^ (((sb >> 9) & 1) << 5); R = (st >> 1) * 16 + swz / 64; C = (st & 1) * 32 + (swz % 64) / 2; }
__host__ __device__ __forceinline__ int perm32(int rho) { const int n = rho >> 4, i = rho & 15; return 8 * (i >> 2) + 4 * n + (i & 3); }
struct Unit { int pm, pn; };
struct Gemm { const bf16_t* A; const bf16_t* Bt; int M, N, K, lda, ldb; };
struct StaticOrder {
    int nM, nN, nwg, G, c;
    __device__ void init(int M, int N, int G_, int c_) { nM = M / BM; nN = N / BM; nwg = nM * nN; G = G_; c = c_; }
    __device__ bool next(int i, Unit& u) const {
        const long L = (long)i * G + c; if (L >= nwg) return false;
        int wgid = (int)L; { const int q = nwg / NXCD, r = nwg % NXCD, xcd = wgid % NXCD, off = wgid / NXCD; wgid = (xcd < r ? xcd * (q + 1) : r * (q + 1) + (xcd - r) * q) + off; }
        const int nig = WGM * nN, gid = wgid / nig, fm = gid * WGM, gsz = (nM - fm) < WGM ? (nM - fm) : WGM;
        u.pm = fm + ((wgid % nig) % gsz); u.pn = (wgid % nig) / gsz; return true;
    }
};

struct Epi;
template <class Epi, class Sched>
__device__ __forceinline__ void gemm_phase(LAS unsigned char* lds, const Gemm g, const Sched& S, const Epi& E, const int tid) {
    const int wid = __builtin_amdgcn_readfirstlane(tid >> 6), lane = tid & 63, wr = wid >> 2, wc = wid & 3, fr = lane & 15, fq = lane >> 4;
    const int K = g.K, nt = K / BK;
    unsigned voffA[2], voffB[2];
#pragma unroll
    for (int i = 0; i < 2; ++i) { int R, C; stage_rc(tid * 16 + i * 8192, R, C); const int Rb = E.perm() ? ((R & ~31) + perm32(R & 31)) : R;
        voffA[i] = (unsigned)(R * g.lda + C) * 2u; voffB[i] = (unsigned)(Rb * g.ldb + C) * 2u; }
    const size_t kstep = (size_t)(BK * 2);
    const size_t hstepA = (size_t)HALF * g.lda * 2, hstepB = (size_t)HALF * g.ldb * 2;
    const size_t tstepA = 2 * hstepA, tstepB = 2 * hstepB;
    const unsigned ldsw = (unsigned)wid * 1024u;
    const int aoff = lds_byte(wr * 64 + fr, fq * 8), boff = lds_byte(wc * 32 + fr, fq * 8);
#define PG8_SA(b, h) (((b) * 2 + (h)) * HTB)
#define PG8_SB(b, h) ((4 + (b) * 2 + (h)) * HTB)
#define PG8_STAGE(bufoff, gbase, voff) do { _Pragma("unroll") for (int _i = 0; _i < 2; ++_i) \
        __builtin_amdgcn_global_load_lds((const unsigned*)((const char*)(gbase) + (voff)[_i]), (LAS unsigned*)(lds + (bufoff) + ldsw + _i * 8192), 16, 0, 0); } while (0)
#define PG8_LDA(dst, b, h) do { _Pragma("unroll") for (int m = 0; m < 4; ++m) _Pragma("unroll") for (int k = 0; k < 2; ++k) dst[m][k] = *(const LAS bf16x8*)(lds + PG8_SA(b, h) + aoff + m * 2048 + k * 1024); } while (0)
#define PG8_LDB(dst, b, h) do { _Pragma("unroll") for (int n = 0; n < 2; ++n) _Pragma("unroll") for (int k = 0; k < 2; ++k) dst[n][k] = *(const LAS bf16x8*)(lds + PG8_SB(b, h) + boff + n * 2048 + k * 1024); } while (0)
#define PG8_MMA(ai, bj, At, Bt) do { __builtin_amdgcn_s_setprio(1); _Pragma("unroll") for (int m = 0; m < 4; ++m) _Pragma("unroll") for (int n = 0; n < 2; ++n) _Pragma("unroll") for (int k = 0; k < 2; ++k) \
        acc[ai][bj][m][n] = __builtin_amdgcn_mfma_f32_16x16x32_bf16(Bt[n][k], At[m][k], acc[ai][bj][m][n], 0, 0, 0); __builtin_amdgcn_s_setprio(0); } while (0)
#define PG8_WAIT_V(n) asm volatile("s_waitcnt vmcnt(" #n ")" ::: "memory")
#define PG8_WAIT_L(n) asm volatile("s_waitcnt lgkmcnt(" #n ")" ::: "memory")
#define PG8_BAR __builtin_amdgcn_s_barrier()
#define PG8_SCHED __builtin_amdgcn_sched_barrier(0)
    Unit cur, nxt; int ui = 0;
    if (!S.next(0, cur)) return;
    f32x4 acc[2][2][4][2];
#pragma unroll
    for (int a = 0; a < 2; ++a)
#pragma unroll
        for (int b = 0; b < 2; ++b)
#pragma unroll
            for (int m = 0; m < 4; ++m)
#pragma unroll
                for (int n = 0; n < 2; ++n) acc[a][b][m][n] = (f32x4){0.f, 0.f, 0.f, 0.f};
    bf16x8 At[4][2], B0[2][2], B1[2][2];
    const char* cA = (const char*)g.A + (size_t)cur.pm * tstepA; const char* cB = (const char*)g.Bt + (size_t)cur.pn * tstepB;
    PG8_STAGE(PG8_SB(0, 0), cB, voffB); PG8_STAGE(PG8_SA(0, 0), cA, voffA); PG8_STAGE(PG8_SB(0, 1), cB + hstepB, voffB); PG8_STAGE(PG8_SA(0, 1), cA + hstepA, voffA);
    if (wr == 1) PG8_BAR;
    PG8_WAIT_V(4); PG8_BAR;
    PG8_STAGE(PG8_SB(1, 0), cB + kstep, voffB); PG8_STAGE(PG8_SA(1, 0), cA + kstep, voffA); PG8_STAGE(PG8_SB(1, 1), cB + hstepB + kstep, voffB);
    PG8_WAIT_V(6); PG8_BAR;
    for (;;) {
        const bool has_next = S.next(ui + 1, nxt);
        const char* nA = has_next ? (const char*)g.A + (size_t)nxt.pm * tstepA : cA; const char* nB = has_next ? (const char*)g.Bt + (size_t)nxt.pn * tstepB : cB;
        for (int t = 0; t < nt; t += 2) {
            const bool last = (t == nt - 2);
            const char* a1 = cA + (size_t)(t + 1) * kstep;
            const char* a2 = last ? nA : cA + (size_t)(t + 2) * kstep; const char* b2 = last ? nB : cB + (size_t)(t + 2) * kstep;
            const char* a3 = a2 + kstep; const char* b3 = b2 + kstep;
            PG8_LDB(B0, 0, 0); PG8_SCHED; PG8_LDA(At, 0, 0); PG8_STAGE(PG8_SA(1, 1), a1 + hstepA, voffA);
            PG8_WAIT_L(8); PG8_BAR; PG8_WAIT_L(0); PG8_MMA(0, 0, At, B0); PG8_BAR; PG8_SCHED;
            PG8_LDB(B1, 0, 1); PG8_STAGE(PG8_SB(0, 0), b2, voffB);
            PG8_BAR; PG8_WAIT_L(0); PG8_MMA(0, 1, At, B1); PG8_BAR;
            PG8_LDA(At, 0, 1); PG8_STAGE(PG8_SA(0, 0), a2, voffA);
            PG8_BAR; PG8_WAIT_L(0); PG8_MMA(1, 0, At, B0); PG8_BAR; PG8_SCHED;
            PG8_STAGE(PG8_SB(0, 1), b2 + hstepB, voffB);
            PG8_WAIT_V(6); PG8_BAR; PG8_MMA(1, 1, At, B1); PG8_BAR;
            PG8_LDB(B0, 1, 0); PG8_SCHED; PG8_LDA(At, 1, 0); PG8_STAGE(PG8_SA(0, 1), a2 + hstepA, voffA);
            PG8_WAIT_L(8); PG8_BAR; PG8_WAIT_L(0); PG8_MMA(0, 0, At, B0); PG8_BAR; PG8_SCHED;
            PG8_LDB(B1, 1, 1); PG8_STAGE(PG8_SB(1, 0), b3, voffB);
            PG8_BAR; PG8_WAIT_L(0); PG8_MMA(0, 1, At, B1); PG8_BAR;
            PG8_LDA(At, 1, 1); PG8_STAGE(PG8_SA(1, 0), a3, voffA);
            PG8_BAR; PG8_WAIT_L(0); PG8_MMA(1, 0, At, B0); PG8_BAR; PG8_SCHED;
            PG8_STAGE(PG8_SB(1, 1), b3 + hstepB, voffB);
            PG8_WAIT_V(6); PG8_BAR; PG8_MMA(1, 1, At, B1); PG8_BAR;
        }
        E(acc, cur, wr, wc, fr, fq);
        if (!has_next) break;
#pragma unroll
        for (int a = 0; a < 2; ++a)
#pragma unroll
            for (int b = 0; b < 2; ++b)
#pragma unroll
                for (int m = 0; m < 4; ++m)
#pragma unroll
                    for (int n = 0; n < 2; ++n) acc[a][b][m][n] = (f32x4){0.f, 0.f, 0.f, 0.f};
        cur = nxt; cA = nA; cB = nB; ++ui;
    }
    PG8_WAIT_V(0);
    if (wr == 0) PG8_BAR;
    PG8_BAR;
#undef PG8_SA
#undef PG8_SB
#undef PG8_STAGE
#undef PG8_LDA
#undef PG8_LDB
#undef PG8_MMA
#undef PG8_WAIT_V
#undef PG8_WAIT_L
#undef PG8_BAR
#undef PG8_SCHED
}

struct Epi {
    int kind; void* p0; const void* p1; void* p2; int ldc;
    __device__ __forceinline__ bool perm() const { return kind == 0; }
    __device__ __forceinline__ void operator()(const f32x4 (&acc)[2][2][4][2], const Unit& u, int wr, int wc, int fr, int fq) const {
        const int row0 = u.pm * BM + wr * 64 + fr;
        if (kind == 0) {
            bf16_t* O = (bf16_t*)p0; const int col0 = u.pn * BM + wc * 32 + 8 * fq;
#pragma unroll
            for (int ai = 0; ai < 2; ++ai)
#pragma unroll
                for (int m = 0; m < 4; ++m) { bf16_t* rowp = O + (size_t)(row0 + ai * HALF + m * 16) * ldc + col0;
#pragma unroll
                    for (int bj = 0; bj < 2; ++bj) { const f32x4 v0 = acc[ai][bj][m][0], v1 = acc[ai][bj][m][1];
                        u32x4 w; w.x = cvt_pk_bf16(v0[0], v0[1]); w.y = cvt_pk_bf16(v0[2], v0[3]); w.z = cvt_pk_bf16(v1[0], v1[1]); w.w = cvt_pk_bf16(v1[2], v1[3]);
                        *(u32x4*)(rowp + bj * HALF) = w; } }
        } else if (kind == 4) {
            const float* x = (const float*)p1; float* out = (float*)p0; const int col0 = u.pn * BM + wc * 32 + 4 * fq;
#pragma unroll
            for (int ai = 0; ai < 2; ++ai)
#pragma unroll
                for (int m = 0; m < 4; ++m) { const size_t off = (size_t)(row0 + ai * HALF + m * 16) * DM + col0;
#pragma unroll
                    for (int bj = 0; bj < 2; ++bj)
#pragma unroll
                        for (int n = 0; n < 2; ++n) *(f32x4*)(out + off + bj * HALF + n * 16) = *(const f32x4*)(x + off + bj * HALF + n * 16) + acc[ai][bj][m][n]; }
        } else {
            const bf16_t* gates = (const bf16_t*)p1; float* mf = (float*)p0; bf16_t* mb = (bf16_t*)p2; const int col0 = u.pn * BM + wc * 32 + 4 * fq;
#pragma unroll
            for (int ai = 0; ai < 2; ++ai)
#pragma unroll
                for (int m = 0; m < 4; ++m) { const int row = row0 + ai * HALF + m * 16;
#pragma unroll
                    for (int bj = 0; bj < 2; ++bj)
#pragma unroll
                        for (int n = 0; n < 2; ++n) { const int col = col0 + bj * HALF + n * 16;
                            const u32x2 gw = *(const u32x2*)(gates + (size_t)row * PC + col);
                            f32x4 gv; gv[0] = sigmoidf_(bflo(gw.x)); gv[1] = sigmoidf_(bfhi(gw.x)); gv[2] = sigmoidf_(bflo(gw.y)); gv[3] = sigmoidf_(bfhi(gw.y));
                            f32x4 v = acc[ai][bj][m][n] * gv; const size_t off = (size_t)row * DM + col;
                            if (kind != 1) v += *(const f32x4*)(mf + off);
                            if (kind != 3) *(f32x4*)(mf + off) = v;
                            else { u32x2 w; w.x = cvt_pk_bf16(v[0], v[1]); w.y = cvt_pk_bf16(v[2], v[3]); *(u32x2*)(mb + off) = w; } } }
        }
    }
};
}

__device__ __forceinline__ void rmsnorm_rows(const float* __restrict__ x, const float* __restrict__ g, bf16_t* __restrict__ out, int nrows, int gw, int nw, int lane) {
    for (int row = gw; row < nrows; row += nw) {
        const float4* xr = (const float4*)(x + (size_t)row * DM);
        float4 v[8]; float ss = 0.f;
#pragma unroll
        for (int i = 0; i < 4; ++i) { const int c = lane + 64 * i; v[2 * i] = xr[2 * c]; v[2 * i + 1] = xr[2 * c + 1]; }
#pragma unroll
        for (int i = 0; i < 8; ++i) ss += v[i].x * v[i].x + v[i].y * v[i].y + v[i].z * v[i].z + v[i].w * v[i].w;
#pragma unroll
        for (int o = 32; o >= 1; o >>= 1) ss += __shfl_xor(ss, o);
        const float rstd = rsqrtf(ss * (1.0f / DM) + EPSF);
#pragma unroll
        for (int i = 0; i < 4; ++i) { const int c = lane + 64 * i; const float4 ga = ((const float4*)g)[2 * c], gb = ((const float4*)g)[2 * c + 1]; const float4 a = v[2 * i], b = v[2 * i + 1];
            u32x4 w; w.x = cvt_pk_bf16(a.x * rstd * ga.x, a.y * rstd * ga.y); w.y = cvt_pk_bf16(a.z * rstd * ga.z, a.w * rstd * ga.w);
            w.z = cvt_pk_bf16(b.x * rstd * gb.x, b.y * rstd * gb.y); w.w = cvt_pk_bf16(b.z * rstd * gb.z, b.w * rstd * gb.w);
            *(u32x4*)(out + (size_t)row * DM + c * 8) = w; }
    }
}
__device__ __forceinline__ void transpose_tile(LAS float* t, const float* __restrict__ src, int ldsrc, int r0, int c0, bf16_t* __restrict__ dst, int lddst, int koff, int tid) {
#pragma unroll
    for (int pass = 0; pass < 2; ++pass) { const int r = pass * 32 + (tid >> 4), c4 = (tid & 15) * 4; const float4 v = *(const float4*)(src + (size_t)(r0 + r) * ldsrc + c0 + c4);
        t[r * 65 + c4 + 0] = v.x; t[r * 65 + c4 + 1] = v.y; t[r * 65 + c4 + 2] = v.z; t[r * 65 + c4 + 3] = v.w; }
    __syncthreads();
    { const int c = tid >> 3, rc = (tid & 7) * 8; float f[8];
#pragma unroll
        for (int j = 0; j < 8; ++j) f[j] = t[(rc + j) * 65 + c];
        u32x4 w; w.x = cvt_pk_bf16(f[0], f[1]); w.y = cvt_pk_bf16(f[2], f[3]); w.z = cvt_pk_bf16(f[4], f[5]); w.w = cvt_pk_bf16(f[6], f[7]);
        *(u32x4*)(dst + (size_t)(c0 + c) * lddst + koff + r0 + rc) = w; }
    __syncthreads();
}

template <int HD> struct AttnGeo { static constexpr int KSTR = HD * 2 + 16, VSTR = HD * 2 + 32, PPR = HD / 8, NKS = HD / 32, NDT = HD / 16; };

template <int HD, bool BANDED>
__device__ __forceinline__ void stage_k(LAS unsigned char* kl, const bf16_t* __restrict__ kp, size_t kvstride, int jbase, const float* __restrict__ wk, int tid) {
    typedef AttnGeo<HD> G;
#pragma unroll 4
    for (int p = tid; p < 256 * G::PPR; p += NTHR) {
        const int row = p / G::PPR, pc = p % G::PPR; const int j = jbase + row;
        u32x4 w = (u32x4){0u, 0u, 0u, 0u};
        if (!BANDED || j >= 0) w = *(const u32x4*)(kp + (size_t)j * kvstride + pc * 8);
        float f[8] = {bflo(w.x), bfhi(w.x), bflo(w.y), bfhi(w.y), bflo(w.z), bfhi(w.z), bflo(w.w), bfhi(w.w)};
        float ss = 0.f;
#pragma unroll
        for (int i = 0; i < 8; ++i) ss += f[i] * f[i];
#pragma unroll
        for (int o = 1; o < G::PPR; o <<= 1) ss += __shfl_xor(ss, o);
        const float rstd = rsqrtf(ss * (1.0f / HD) + EPSF);
        const float4 wa = *(const float4*)(wk + pc * 8), wb = *(const float4*)(wk + pc * 8 + 4);
        u32x4 o4; o4.x = cvt_pk_bf16(f[0] * rstd * wa.x, f[1] * rstd * wa.y); o4.y = cvt_pk_bf16(f[2] * rstd * wa.z, f[3] * rstd * wa.w);
        o4.z = cvt_pk_bf16(f[4] * rstd * wb.x, f[5] * rstd * wb.y); o4.w = cvt_pk_bf16(f[6] * rstd * wb.z, f[7] * rstd * wb.w);
        *(LAS u32x4*)(kl + row * G::KSTR + pc * 16) = o4;
    }
}
template <int HD, bool BANDED>
__device__ __forceinline__ void stage_v(LAS unsigned char* vl, const bf16_t* __restrict__ vp, size_t kvstride, int jbase, int tid) {
    typedef AttnGeo<HD> G;
#pragma unroll 4
    for (int p = tid; p < 256 * G::PPR; p += NTHR) {
        const int row = p / G::PPR, pc = p % G::PPR; const int j = jbase + row;
        u32x4 w = (u32x4){0u, 0u, 0u, 0u};
        if (!BANDED || j >= 0) w = *(const u32x4*)(vp + (size_t)j * kvstride + pc * 8);
        *(LAS u32x4*)(vl + row * G::VSTR + pc * 16) = w;
    }
    if (BANDED) { for (int p = tid; p < 16 * G::PPR; p += NTHR) { const int row = 256 + p / G::PPR, pc = p % G::PPR; *(LAS u32x4*)(vl + row * G::VSTR + pc * 16) = (u32x4){0u, 0u, 0u, 0u}; } }
}

__device__ __forceinline__ void attn_banded_item(LAS unsigned char* lds, const bf16_t* __restrict__ qp, size_t rstride, int qb, const float* __restrict__ wq, const float* __restrict__ wk,
                                                 bf16_t* __restrict__ og, size_t ogstride, float* __restrict__ lsep, size_t lsestride, const int tid) {
    constexpr int HD = 128; typedef AttnGeo<HD> G;
    const int w = __builtin_amdgcn_readfirstlane(tid >> 6), lane = tid & 63, lq = lane & 15, g4 = lane >> 4;
    LAS unsigned char* kl = lds; LAS unsigned char* vl = lds + 256 * G::KSTR;
    const int q0 = qb * 128, jbase = q0 - 128;
    const int qi = q0 + 16 * w + lq;
    const bf16_t* qrow = qp + (size_t)qi * rstride;
    u32x4 qw[G::NKS];
#pragma unroll
    for (int ks = 0; ks < G::NKS; ++ks) qw[ks] = *(const u32x4*)(qrow + ks * 32 + g4 * 8);
    stage_k<HD, true>(kl, qp + C_K, rstride, jbase, wk, tid);
    stage_v<HD, true>(vl, qp + C_V, rstride, jbase, tid);
    bf16x8 qf[G::NKS];
    {
        float ss = 0.f;
#pragma unroll
        for (int ks = 0; ks < G::NKS; ++ks) { const u32x4 x = qw[ks]; const float a0 = bflo(x.x), a1 = bfhi(x.x), a2 = bflo(x.y), a3 = bfhi(x.y), a4 = bflo(x.z), a5 = bfhi(x.z), a6 = bflo(x.w), a7 = bfhi(x.w);
            ss += a0 * a0 + a1 * a1 + a2 * a2 + a3 * a3 + a4 * a4 + a5 * a5 + a6 * a6 + a7 * a7; }
        ss += __shfl_xor(ss, 16); ss += __shfl_xor(ss, 32);
        const float sc = rsqrtf(ss * (1.0f / HD) + EPSF) * 0.08838834764831845f * 1.4426950408889634f;
#pragma unroll
        for (int ks = 0; ks < G::NKS; ++ks) { const u32x4 x = qw[ks]; const float4 wa = *(const float4*)(wq + ks * 32 + g4 * 8), wb = *(const float4*)(wq + ks * 32 + g4 * 8 + 4);
            u32x4 o; o.x = cvt_pk_bf16(bflo(x.x) * sc * wa.x, bfhi(x.x) * sc * wa.y); o.y = cvt_pk_bf16(bflo(x.y) * sc * wa.z, bfhi(x.y) * sc * wa.w);
            o.z = cvt_pk_bf16(bflo(x.z) * sc * wb.x, bfhi(x.z) * sc * wb.y); o.w = cvt_pk_bf16(bflo(x.w) * sc * wb.z, bfhi(x.w) * sc * wb.w);
            qf[ks] = __builtin_bit_cast(bf16x8, o); }
    }
    __syncthreads();
    f32x4 S[10];
    const float NEG = -__builtin_inff();
#pragma unroll
    for (int t = 0; t < 9; ++t) {
        const int kt = w + t;
        if (jbase + kt * 16 >= 0) {
            f32x4 s = (f32x4){0.f, 0.f, 0.f, 0.f};
#pragma unroll
            for (int ks = 0; ks < G::NKS; ++ks) { const bf16x8 kf = *(const LAS bf16x8*)(kl + (kt * 16 + lq) * G::KSTR + ks * 64 + g4 * 16); s = __builtin_amdgcn_mfma_f32_16x16x32_bf16(kf, qf[ks], s, 0, 0, 0); }
            if (t == 0) {
#pragma unroll
                for (int r = 0; r < 4; ++r) s[r] = (4 * g4 + r >= lq) ? s[r] : NEG; }
            if (t == 8) {
#pragma unroll
                for (int r = 0; r < 4; ++r) s[r] = (4 * g4 + r <= lq) ? s[r] : NEG; }
            S[t] = s;
        } else S[t] = (f32x4){NEG, NEG, NEG, NEG};
    }
    S[9] = (f32x4){NEG, NEG, NEG, NEG};
    float mx = NEG;
#pragma unroll
    for (int t = 0; t < 9; ++t)
#pragma unroll
        for (int r = 0; r < 4; ++r) mx = fmaxf(mx, S[t][r]);
    mx = fmaxf(mx, __shfl_xor(mx, 16)); mx = fmaxf(mx, __shfl_xor(mx, 32));
    float l = 0.f;
#pragma unroll
    for (int t = 0; t < 10; ++t)
#pragma unroll
        for (int r = 0; r < 4; ++r) { const float p = __builtin_amdgcn_exp2f(S[t][r] - mx); l += p; S[t][r] = p; }
    l += __shfl_xor(l, 16); l += __shfl_xor(l, 32);
    f32x4 O[G::NDT];
#pragma unroll
    for (int dt = 0; dt < G::NDT; ++dt) O[dt] = (f32x4){0.f, 0.f, 0.f, 0.f};
#pragma unroll
    for (int u = 0; u < 5; ++u) {
        u32x4 pw; pw.x = cvt_pk_bf16(S[2 * u][0], S[2 * u][1]); pw.y = cvt_pk_bf16(S[2 * u][2], S[2 * u][3]); pw.z = cvt_pk_bf16(S[2 * u + 1][0], S[2 * u + 1][1]); pw.w = cvt_pk_bf16(S[2 * u + 1][2], S[2 * u + 1][3]);
        const bf16x8 pb = __builtin_bit_cast(bf16x8, pw);
        const int ka = (w + 2 * u) * 16 + 4 * g4 + (lq >> 2), kb = ka + 16;
        LAS unsigned char* va = vl + ka * G::VSTR + (lane & 3) * 8; LAS unsigned char* vb = vl + kb * G::VSTR + (lane & 3) * 8;
#pragma unroll
        for (int dt = 0; dt < G::NDT; ++dt) {
            const s16x4 x = __builtin_amdgcn_ds_read_tr16_b64_v4i16((LAS s16x4*)(va + dt * 32));
            const s16x4 y = __builtin_amdgcn_ds_read_tr16_b64_v4i16((LAS s16x4*)(vb + dt * 32));
            const bf16x8 a = (bf16x8){x[0], x[1], x[2], x[3], y[0], y[1], y[2], y[3]};
            O[dt] = __builtin_amdgcn_mfma_f32_16x16x32_bf16(a, pb, O[dt], 0, 0, 0);
        }
    }
    const float inv = 1.0f / l;
    bf16_t* orow = og + (size_t)qi * ogstride;
#pragma unroll
    for (int dt = 0; dt < G::NDT; ++dt) { u32x2 o; o.x = cvt_pk_bf16(O[dt][0] * inv, O[dt][1] * inv); o.y = cvt_pk_bf16(O[dt][2] * inv, O[dt][3] * inv); *(u32x2*)(orow + dt * 16 + 4 * g4) = o; }
    if (g4 == 0) lsep[(size_t)qi * lsestride] = (mx + __builtin_amdgcn_logf(l)) * 0.6931471805599453f;
    __syncthreads();
}

__device__ __forceinline__ void attn_mem_item(LAS unsigned char* lds, const bf16_t* __restrict__ qp  , const bf16_t* __restrict__ kp, const bf16_t* __restrict__ vp,
                                              const float* __restrict__ wq, const float* __restrict__ wk, const bf16_t* __restrict__ zp  , bf16_t* __restrict__ ap  , const int tid) {
    constexpr int HD = 256; typedef AttnGeo<HD> G;
    const int w = __builtin_amdgcn_readfirstlane(tid >> 6), lane = tid & 63, lq = lane & 15, g4 = lane >> 4;
    const int qi = 16 * w + lq;
    const bf16_t* qrow = qp + (size_t)qi * PC;
    u32x4 qw[G::NKS];
#pragma unroll
    for (int ks = 0; ks < G::NKS; ++ks) qw[ks] = *(const u32x4*)(qrow + ks * 32 + g4 * 8);
    stage_k<HD, false>(lds, kp, DM, 0, wk, tid);
    bf16x8 qf[G::NKS];
    {
        float ss = 0.f;
#pragma unroll
        for (int ks = 0; ks < G::NKS; ++ks) { const u32x4 x = qw[ks]; const float a0 = bflo(x.x), a1 = bfhi(x.x), a2 = bflo(x.y), a3 = bfhi(x.y), a4 = bflo(x.z), a5 = bfhi(x.z), a6 = bflo(x.w), a7 = bfhi(x.w);
            ss += a0 * a0 + a1 * a1 + a2 * a2 + a3 * a3 + a4 * a4 + a5 * a5 + a6 * a6 + a7 * a7; }
        ss += __shfl_xor(ss, 16); ss += __shfl_xor(ss, 32);
        const float sc = rsqrtf(ss * (1.0f / HD) + EPSF) * 0.0625f * 1.4426950408889634f;
#pragma unroll
        for (int ks = 0; ks < G::NKS; ++ks) { const u32x4 x = qw[ks]; const float4 wa = *(const float4*)(wq + ks * 32 + g4 * 8), wb = *(const float4*)(wq + ks * 32 + g4 * 8 + 4);
            u32x4 o; o.x = cvt_pk_bf16(bflo(x.x) * sc * wa.x, bfhi(x.x) * sc * wa.y); o.y = cvt_pk_bf16(bflo(x.y) * sc * wa.z, bfhi(x.y) * sc * wa.w);
            o.z = cvt_pk_bf16(bflo(x.z) * sc * wb.x, bfhi(x.z) * sc * wb.y); o.w = cvt_pk_bf16(bflo(x.w) * sc * wb.z, bfhi(x.w) * sc * wb.w);
            qf[ks] = __builtin_bit_cast(bf16x8, o); }
    }
    __syncthreads();
    f32x4 S[16];
#pragma unroll
    for (int t = 0; t < 16; ++t) {
        f32x4 s = (f32x4){0.f, 0.f, 0.f, 0.f};
#pragma unroll
        for (int ks = 0; ks < G::NKS; ++ks) { const bf16x8 kf = *(const LAS bf16x8*)(lds + (t * 16 + lq) * G::KSTR + ks * 64 + g4 * 16); s = __builtin_amdgcn_mfma_f32_16x16x32_bf16(kf, qf[ks], s, 0, 0, 0); }
        S[t] = s;
    }
    float mx = -__builtin_inff();
#pragma unroll
    for (int t = 0; t < 16; ++t)
#pragma unroll
        for (int r = 0; r < 4; ++r) mx = fmaxf(mx, S[t][r]);
    mx = fmaxf(mx, __shfl_xor(mx, 16)); mx = fmaxf(mx, __shfl_xor(mx, 32));
    float l = 0.f; u32x2 P[16];
#pragma unroll
    for (int t = 0; t < 16; ++t) { const float p0 = __builtin_amdgcn_exp2f(S[t][0] - mx), p1 = __builtin_amdgcn_exp2f(S[t][1] - mx), p2 = __builtin_amdgcn_exp2f(S[t][2] - mx), p3 = __builtin_amdgcn_exp2f(S[t][3] - mx);
        l += (p0 + p1) + (p2 + p3); P[t].x = cvt_pk_bf16(p0, p1); P[t].y = cvt_pk_bf16(p2, p3); }
    l += __shfl_xor(l, 16); l += __shfl_xor(l, 32);
    __syncthreads();
    stage_v<HD, false>(lds, vp, DM, 0, tid);
    __syncthreads();
    f32x4 O[G::NDT];
#pragma unroll
    for (int dt = 0; dt < G::NDT; ++dt) O[dt] = (f32x4){0.f, 0.f, 0.f, 0.f};
#pragma unroll
    for (int u = 0; u < 8; ++u) {
        u32x4 pw; pw.x = P[2 * u].x; pw.y = P[2 * u].y; pw.z = P[2 * u + 1].x; pw.w = P[2 * u + 1].y;
        const bf16x8 pb = __builtin_bit_cast(bf16x8, pw);
        const int ka = (2 * u) * 16 + 4 * g4 + (lq >> 2), kb = ka + 16;
        LAS unsigned char* va = lds + ka * G::VSTR + (lane & 3) * 8; LAS unsigned char* vb = lds + kb * G::VSTR + (lane & 3) * 8;
#pragma unroll
        for (int dt = 0; dt < G::NDT; ++dt) {
            const s16x4 x = __builtin_amdgcn_ds_read_tr16_b64_v4i16((LAS s16x4*)(va + dt * 32));
            const s16x4 y = __builtin_amdgcn_ds_read_tr16_b64_v4i16((LAS s16x4*)(vb + dt * 32));
            const bf16x8 a = (bf16x8){x[0], x[1], x[2], x[3], y[0], y[1], y[2], y[3]};
            O[dt] = __builtin_amdgcn_mfma_f32_16x16x32_bf16(a, pb, O[dt], 0, 0, 0);
        }
    }
    const float inv = 1.0f / l;
    const bf16_t* zrow = zp + (size_t)qi * PC; bf16_t* arow = ap + (size_t)qi * ACTW;
#pragma unroll
    for (int dt = 0; dt < G::NDT; ++dt) { const u32x2 z = *(const u32x2*)(zrow + dt * 16 + 4 * g4);
        u32x2 o; o.x = cvt_pk_bf16(O[dt][0] * inv * siluf_(bflo(z.x)), O[dt][1] * inv * siluf_(bfhi(z.x))); o.y = cvt_pk_bf16(O[dt][2] * inv * siluf_(bflo(z.y)), O[dt][3] * inv * siluf_(bfhi(z.y)));
        *(u32x2*)(arow + dt * 16 + 4 * g4) = o; }
    __syncthreads();
}

struct Args { const float* in[15]; float* out; unsigned char* ws; int lo, hi; };
enum { I_X = 0, I_MEM, I_NG, I_MNG, I_WIN, I_AQN, I_AKN, I_CW, I_WKV, I_MQN, I_MKN, I_WBA, I_WBC, I_WBM, I_WOUT };
constexpr int NPHASE = 10;

__global__ void __launch_bounds__(NTHR, 2) mega(Args a) {
    extern __shared__ __attribute__((aligned(16))) unsigned char lds_raw[];
    LAS unsigned char* lds = (LAS unsigned char*)lds_raw;
    const int G = gridDim.x, bx = blockIdx.x;
    unsigned char* ws = a.ws;
    bf16_t* WIN = (bf16_t*)(ws + WS_WIN); bf16_t* WKV = (bf16_t*)(ws + WS_WKV); bf16_t* WBR = (bf16_t*)(ws + WS_WBR); bf16_t* WOUT = (bf16_t*)(ws + WS_WOUT);
    bf16_t* MH = (bf16_t*)(ws + WS_MH); bf16_t* MKV = (bf16_t*)(ws + WS_MKV); bf16_t* PROJ = (bf16_t*)(ws + WS_PROJ); bf16_t* OG = (bf16_t*)(ws + WS_OG);
    float* LSE = (float*)(ws + WS_LSE); bf16_t* ACT = (bf16_t*)(ws + WS_ACT); float* MF = (float*)(ws + WS_MF); bf16_t* MB = (bf16_t*)(ws + WS_MB);
    bf16_t* H = (bf16_t*)((unsigned char*)a.out + OUT_H_OFF);

    for (int ph = a.lo; ph < a.hi; ++ph) {
        int tid = threadIdx.x; asm volatile("" : "+v"(tid));
        const int lane = tid & 63, wave = tid >> 6;
        if (ph == 0) {
            rmsnorm_rows(a.in[I_X], a.in[I_NG], H, NTOK, bx * 8 + wave, G * 8, lane);
            rmsnorm_rows(a.in[I_MEM], a.in[I_MNG], MH, 4096, bx * 8 + wave, G * 8, lane);
            constexpr int T0 = 32 * 272, T1 = T0 + 1024, T2 = T1 + 256, T3 = T2 + 512, T4 = T3 + 512, T5 = T4 + 1024;
            for (int t = bx; t < T5; t += G) {
                const float* src; int C, ld, koff, ti; bf16_t* dst;
                if (t < T0) { src = a.in[I_WIN]; C = PC; dst = WIN; ld = DM; koff = 0; ti = t; }
                else if (t < T1) { src = a.in[I_WKV]; C = DM; dst = WKV; ld = DM; koff = 0; ti = t - T0; }
                else if (t < T2) { src = a.in[I_WBA]; C = DM; dst = WBR; ld = ACTW; koff = 0; ti = t - T1; }
                else if (t < T3) { src = a.in[I_WBC]; C = DM; dst = WBR; ld = ACTW; koff = 512; ti = t - T2; }
                else if (t < T4) { src = a.in[I_WBM]; C = DM; dst = WBR; ld = ACTW; koff = 1536; ti = t - T3; }
                else { src = a.in[I_WOUT]; C = DM; dst = WOUT; ld = DM; koff = 0; ti = t - T4; }
                const int nct = C / 64, tr = ti / nct, tc = ti % nct;
                transpose_tile((LAS float*)lds, src, C, tr * 64, tc * 64, dst, ld, koff, tid);
            }
        } else if (ph == 1 || ph == 5 || ph == 4 || ph == 8 || ph == 9) {
            const int nj = (ph == 9) ? 1 : ((ph == 4 || ph == 8) ? 3 : 2);
#pragma unroll 1
            for (int j = 0; j < nj; ++j) {
                pg8::Gemm g; pg8::Epi E;
                if (ph == 4 || ph == 8) {
                    const int ko = (j == 0) ? 0 : (j == 1 ? 512 : 1536);
                    g = pg8::Gemm{ACT + ko, WBR + ko, HT, DM, (j == 0) ? 512 : 1024, ACTW, ACTW};
                    E = pg8::Epi{1 + j, MF, PROJ + C_G + j * DM, MB, DM};
                } else if (ph == 1 && j == 0) {
                    g = pg8::Gemm{MH, WKV, 4096, DM, DM, DM, DM}; E = pg8::Epi{0, MKV, nullptr, nullptr, DM};
                } else if ((ph == 5 && j == 0) || ph == 9) {
                    const size_t ro = (ph == 9) ? (size_t)HT * DM : 0;
                    g = pg8::Gemm{MB, WOUT, HT, DM, DM, DM, DM}; E = pg8::Epi{4, a.out + ro, a.in[I_X] + ro, nullptr, DM};
                } else {
                    const int half = (ph == 1) ? 0 : 1;
                    g = pg8::Gemm{H + (size_t)half * HT * DM, WIN, HT, PC, DM, DM, DM}; E = pg8::Epi{0, PROJ, nullptr, nullptr, PC};
                }
                pg8::StaticOrder S; S.init(g.M, g.N, G, bx);
                pg8::gemm_phase(lds, g, S, E, tid);
            }
        } else if (ph == 2 || ph == 6) {
            const int half = (ph == 2) ? 0 : 1;
            for (int it = bx; it < 2048; it += G) {
                const int type = it >> 9, idx = it & 511;
                if (type < 3) {
                    const int g = type, dsh = 2 * g, d = 1 << dsh, nqb = 16 >> dsh;
                    const int qb = idx % nqb; int rest = idx / nqb; const int r = rest % d; rest /= d; const int h = rest & 3, bl = rest >> 2;
                    const size_t row0 = (size_t)bl * SEQ + r;
                    attn_banded_item(lds, PROJ + row0 * PC + g * 512 + h * 128, (size_t)d * PC, qb, a.in[I_AQN] + g * 128, a.in[I_AKN] + g * 128,
                                     OG + row0 * 1536 + g * 512 + h * 128, (size_t)d * 1536, LSE + row0 * 12 + g * 4 + h, (size_t)d * 12, tid);
                } else {
                    const int qb = idx & 15, h = (idx >> 4) & 3, bl = idx >> 6, b = half * 8 + bl;
                    const size_t row0 = (size_t)bl * SEQ + qb * 128;
                    attn_mem_item(lds, PROJ + row0 * PC + C_MQ + h * 256, MKV + (size_t)b * 256 * DM + h * 256, MKV + (size_t)b * 256 * DM + 1024 + h * 256,
                                  a.in[I_MQN], a.in[I_MKN], PROJ + row0 * PC + C_ZM + h * 256, ACT + row0 * ACTW + 1536 + h * 256, tid);
                }
            }
        } else if (ph == 3 || ph == 7) {
            const int gt = bx * NTHR + tid, nth = G * NTHR;
            for (int idx = gt; idx < HT * 64; idx += nth) {
                const int row = idx >> 6, c8 = (idx & 63) * 8, h = c8 >> 7;
                const float l0 = LSE[(size_t)row * 12 + h], l1 = LSE[(size_t)row * 12 + 4 + h], l2 = LSE[(size_t)row * 12 + 8 + h];
                const float m = fmaxf(l0, fmaxf(l1, l2)); float w0 = __expf(l0 - m), w1 = __expf(l1 - m), w2 = __expf(l2 - m); const float inv = 1.0f / (w0 + w1 + w2); w0 *= inv; w1 *= inv; w2 *= inv;
                const u32x4 o0 = *(const u32x4*)(OG + (size_t)row * 1536 + c8), o1 = *(const u32x4*)(OG + (size_t)row * 1536 + 512 + c8), o2 = *(const u32x4*)(OG + (size_t)row * 1536 + 1024 + c8);
                const u32x4 z = *(const u32x4*)(PROJ + (size_t)row * PC + C_ZA + c8);
                u32x4 o;
#define CMB(k) o.k = cvt_pk_bf16((w0 * bflo(o0.k) + w1 * bflo(o1.k) + w2 * bflo(o2.k)) * siluf_(bflo(z.k)), (w0 * bfhi(o0.k) + w1 * bfhi(o1.k) + w2 * bfhi(o2.k)) * siluf_(bfhi(z.k)))
                CMB(x); CMB(y); CMB(z); CMB(w);
#undef CMB
                *(u32x4*)(ACT + (size_t)row * ACTW + c8) = o;
            }
            const float* cw = a.in[I_CW];
            for (int idx = gt; idx < HT * 128; idx += nth) {
                const int row = idx >> 7, c8 = (idx & 127) * 8, t = row & (SEQ - 1);
                const bf16_t* pr = PROJ + (size_t)row * PC;
                const u32x4 z4 = (u32x4){0u, 0u, 0u, 0u};
                const u32x4 c0 = *(const u32x4*)(pr + C_CC + c8), v0 = *(const u32x4*)(pr + C_CV + c8);
                const u32x4 c1 = t >= 1 ? *(const u32x4*)(pr - PC + C_CC + c8) : z4, v1 = t >= 1 ? *(const u32x4*)(pr - PC + C_CV + c8) : z4;
                const u32x4 c2 = t >= 2 ? *(const u32x4*)(pr - 2 * PC + C_CC + c8) : z4, v2 = t >= 2 ? *(const u32x4*)(pr - 2 * PC + C_CV + c8) : z4;
                const u32x4 bb = *(const u32x4*)(pr + C_CB + c8), zz = *(const u32x4*)(pr + C_ZC + c8);
                const float4 wa0 = *(const float4*)(cw + c8), wb0 = *(const float4*)(cw + c8 + 4), wa1 = *(const float4*)(cw + 1024 + c8), wb1 = *(const float4*)(cw + 1024 + c8 + 4), wa2 = *(const float4*)(cw + 2048 + c8), wb2 = *(const float4*)(cw + 2048 + c8 + 4);
                u32x4 o;
#define CV1(f, k, W0, W1, W2) ((W0 * (f(c0.k) * f(v0.k)) + W1 * (f(c1.k) * f(v1.k)) + W2 * (f(c2.k) * f(v2.k))) * f(bb.k) * siluf_(f(zz.k)))
                o.x = cvt_pk_bf16(CV1(bflo, x, wa0.x, wa1.x, wa2.x), CV1(bfhi, x, wa0.y, wa1.y, wa2.y));
                o.y = cvt_pk_bf16(CV1(bflo, y, wa0.z, wa1.z, wa2.z), CV1(bfhi, y, wa0.w, wa1.w, wa2.w));
                o.z = cvt_pk_bf16(CV1(bflo, z, wb0.x, wb1.x, wb2.x), CV1(bfhi, z, wb0.y, wb1.y, wb2.y));
                o.w = cvt_pk_bf16(CV1(bflo, w, wb0.z, wb1.z, wb2.z), CV1(bfhi, w, wb0.w, wb1.w, wb2.w));
#undef CV1
                *(u32x4*)(ACT + (size_t)row * ACTW + 512 + c8) = o;
            }
        }
        if (ph + 1 < a.hi) cg::this_grid().sync();
    }
}

extern "C" void kernel_launch(void* const* d_in, const int* in_sizes, int n_in, void* d_out, int out_size, void* d_ws, size_t ws_size, hipStream_t stream) {
    static int grid = 0;
    if (grid == 0) {
        if (n_in != 15 || ws_size < WS_END) { fprintf(stderr, "kernel_launch: unexpected inputs (n_in %d, ws %zu < %zu)\n", n_in, ws_size, (size_t)WS_END); grid = -1; return; }
        int dev = 0, cus = 0, per_cu = 0;
        hipGetDevice(&dev); hipDeviceGetAttribute(&cus, hipDeviceAttributeMultiprocessorCount, dev);
        if (hipFuncSetAttribute((const void*)mega, hipFuncAttributeMaxDynamicSharedMemorySize, LDS_BYTES) != hipSuccess) { fprintf(stderr, "kernel_launch: hipFuncSetAttribute failed\n"); grid = -1; return; }
        hipOccupancyMaxActiveBlocksPerMultiprocessor(&per_cu, (const void*)mega, NTHR, LDS_BYTES);
        if (per_cu < 1) per_cu = 1;
        grid = cus * 1;
        (void)hipGetLastError();
    }
    if (grid < 0) return;
    Args a{};
    for (int i = 0; i < 15; ++i) a.in[i] = (const float*)d_in[i];
    a.out = (float*)d_out; a.ws = (unsigned char*)d_ws;
#if ONE_LAUNCH
    a.lo = 0; a.hi = NPHASE;
    void* args[] = {&a};
    hipError_t e = hipLaunchCooperativeKernel((const void*)mega, dim3(grid), dim3(NTHR), args, LDS_BYTES, stream);
    if (e != hipSuccess) fprintf(stderr, "cooperative launch failed: %s (grid %d)\n", hipGetErrorString(e), grid);
#else
    for (int ph = 0; ph < NPHASE; ++ph) { a.lo = ph; a.hi = ph + 1; hipLaunchKernelGGL(mega, dim3(grid), dim3(NTHR), LDS_BYTES, stream, a); }
#endif
}
```

```cpp
#include <hip/hip_runtime.h>
#include <hip/hip_cooperative_groups.h>
#include <cstdio>
namespace cg = cooperative_groups;

#ifndef ONE_LAUNCH
#define ONE_LAUNCH 1
#endif

#ifndef REP_MASK
#define REP_MASK 0
#endif
#define LAS __attribute__((address_space(3)))
typedef unsigned short bf16_t;
typedef short bf16x8 __attribute__((ext_vector_type(8)));
typedef short s16x4 __attribute__((ext_vector_type(4)));
typedef float f32x4 __attribute__((ext_vector_type(4)));
typedef unsigned u32x4 __attribute__((ext_vector_type(4)));
typedef unsigned u32x2 __attribute__((ext_vector_type(2)));

constexpr int DM = 2048, SEQ = 2048, NB = 16, NTOK = NB * SEQ;
constexpr int PC = 17408;
constexpr int PS = 11264;
constexpr int HT = NTOK / 2;
constexpr int C_Q = 0, C_K = 1536, C_V = 3072, C_ZA = 4608, C_CB = 5120, C_CC = 6144, C_CV = 7168, C_ZC = 8192, C_MQ = 9216, C_ZM = 10240, C_G = 11264;
constexpr int ACTW = 2560;
constexpr float EPSF = 1e-6f;
constexpr int NTHR = 512;
constexpr int LDS_BYTES = 149504;

constexpr size_t WS_WIN = 0;
constexpr size_t WS_WKV = WS_WIN + (size_t)PC * DM * 2;
constexpr size_t WS_WBR = WS_WKV + (size_t)DM * DM * 2;
constexpr size_t WS_WOUT = WS_WBR + (size_t)DM * ACTW * 2;
constexpr size_t WS_MH = WS_WOUT + (size_t)DM * DM * 2;
constexpr size_t WS_MKV = WS_MH + (size_t)4096 * DM * 2;
constexpr size_t WS_PROJ = WS_MKV + (size_t)4096 * DM * 2;
constexpr size_t WS_OG = WS_PROJ + (size_t)HT * PS * 2;
constexpr size_t WS_LSE = WS_OG + (size_t)HT * 1536 * 2;
constexpr size_t WS_ACT = WS_LSE + (size_t)HT * 12 * 4;
constexpr size_t WS_GF = WS_ACT + (size_t)HT * ACTW * 2;
constexpr size_t WS_MB = WS_GF + (size_t)HT * 6144 * 2;
constexpr size_t WS_END = WS_MB + (size_t)HT * DM * 2;
constexpr size_t OUT_H_OFF = (size_t)HT * DM * 4;

__device__ __forceinline__ float bflo(unsigned w) { return __uint_as_float(w << 16); }
__device__ __forceinline__ float bfhi(unsigned w) { return __uint_as_float(w & 0xffff0000u); }
__device__ __forceinline__ unsigned cvt_pk_bf16(float lo, float hi) { unsigned r; asm volatile("v_cvt_pk_bf16_f32 %0, %1, %2" : "=v"(r) : "v"(lo), "v"(hi)); return r; }
__device__ __forceinline__ float sigmoidf_(float x) { return 1.0f / (1.0f + __expf(-x)); }
__device__ __forceinline__ float siluf_(float x) { return x / (1.0f + __expf(-x)); }

namespace pg8 {
constexpr int BM = 256, BK = 64, HALF = 128, HTB = HALF * BK * 2, STAGE_BYTES = 8 * HTB, NXCD = 8, WGM = 8;
__host__ __device__ __forceinline__ int lds_byte(int r, int c) { const int st = (r >> 4) * 2 + (c >> 5), rr = r & 15, cc = c & 31, ob = rr * 64 + cc * 2; return st * 1024 + (ob ^ (((ob >> 9) & 1) << 5)); }
__host__ __device__ __forceinline__ void stage_rc(int b, int& R, int& C) { const int st = b / 1024, sb = b % 1024, swz = sb ^ (((sb >> 9) & 1) << 5); R = (st >> 1) * 16 + swz / 64; C = (st & 1) * 32 + (swz % 64) / 2; }
__host__ __device__ __forceinline__ int perm32(int rho) { const int n = rho >> 4, i = rho & 15; return 8 * (i >> 2) + 4 * n + (i & 3); }
struct Unit { int pm, pn; };
struct Gemm { const bf16_t* A; const bf16_t* Bt; int M, N, K, lda, ldb; };
struct StaticOrder {
    int nM, nN, nwg, G, c;
    __device__ void init(int M, int N, int G_, int c_) { nM = M / BM; nN = N / BM; nwg = nM * nN; G = G_; c = c_; }
    __device__ bool next(int i, Unit& u) const {
        const long L = (long)i * G + c; if (L >= nwg) return false;
        int wgid = (int)L; { const int q = nwg / NXCD, r = nwg % NXCD, xcd = wgid % NXCD, off = wgid / NXCD; wgid = (xcd < r ? xcd * (q + 1) : r * (q + 1) + (xcd - r) * q) + off; }
        const int nig = WGM * nN, gid = wgid / nig, fm = gid * WGM, gsz = (nM - fm) < WGM ? (nM - fm) : WGM;
        u.pm = fm + ((wgid % nig) % gsz); u.pn = (wgid % nig) / gsz; return true;
    }
};

struct Epi;
template <class Epi, class Sched>
__device__ __forceinline__ void gemm_phase(LAS unsigned char* lds, const Gemm g, const Sched& S, const Epi& E, const int tid) {
    const int wid = __builtin_amdgcn_readfirstlane(tid >> 6), lane = tid & 63, wr = wid >> 2, wc = wid & 3, fr = lane & 15, fq = lane >> 4;
    const int K = g.K, nt = K / BK;
    unsigned voffA[2], voffB[2];
#pragma unroll
    for (int i = 0; i < 2; ++i) { int R, C; stage_rc(tid * 16 + i * 8192, R, C); const int Rb = E.perm() ? ((R & ~31) + perm32(R & 31)) : R;
        voffA[i] = (unsigned)(R * g.lda + C) * 2u; voffB[i] = (unsigned)(Rb * g.ldb + C) * 2u; }
    const size_t kstep = (size_t)(BK * 2);
    const size_t hstepA = (size_t)HALF * g.lda * 2, hstepB = (size_t)HALF * g.ldb * 2;
    const size_t tstepA = 2 * hstepA, tstepB = 2 * hstepB;
    const unsigned ldsw = (unsigned)wid * 1024u;
    const int aoff = lds_byte(wr * 64 + fr, fq * 8), boff = lds_byte(wc * 32 + fr, fq * 8);
#define PG8_SA(b, h) (((b) * 2 + (h)) * HTB)
#define PG8_SB(b, h) ((4 + (b) * 2 + (h)) * HTB)
#define PG8_STAGE(bufoff, gbase, voff) do { _Pragma("unroll") for (int _i = 0; _i < 2; ++_i) \
        __builtin_amdgcn_global_load_lds((const unsigned*)((const char*)(gbase) + (voff)[_i]), (LAS unsigned*)(lds + (bufoff) + ldsw + _i * 8192), 16, 0, 0); } while (0)
#define PG8_LDA(dst, b, h) do { _Pragma("unroll") for (int m = 0; m < 4; ++m) _Pragma("unroll") for (int k = 0; k < 2; ++k) dst[m][k] = *(const LAS bf16x8*)(lds + PG8_SA(b, h) + aoff + m * 2048 + k * 1024); } while (0)
#define PG8_LDB(dst, b, h) do { _Pragma("unroll") for (int n = 0; n < 2; ++n) _Pragma("unroll") for (int k = 0; k < 2; ++k) dst[n][k] = *(const LAS bf16x8*)(lds + PG8_SB(b, h) + boff + n * 2048 + k * 1024); } while (0)
#define PG8_MMA(ai, bj, At, Bt) do { __builtin_amdgcn_s_setprio(1); _Pragma("unroll") for (int m = 0; m < 4; ++m) _Pragma("unroll") for (int n = 0; n < 2; ++n) _Pragma("unroll") for (int k = 0; k < 2; ++k) \
        acc[ai][bj][m][n] = __builtin_amdgcn_mfma_f32_16x16x32_bf16(Bt[n][k], At[m][k], acc[ai][bj][m][n], 0, 0, 0); __builtin_amdgcn_s_setprio(0); } while (0)
#define PG8_WAIT_V(n) asm volatile("s_waitcnt vmcnt(" #n ")" ::: "memory")
#define PG8_WAIT_L(n) asm volatile("s_waitcnt lgkmcnt(" #n ")" ::: "memory")
#define PG8_BAR __builtin_amdgcn_s_barrier()
#define PG8_SCHED __builtin_amdgcn_sched_barrier(0)
    Unit cur, nxt; int ui = 0;
    if (!S.next(0, cur)) return;
    f32x4 acc[2][2][4][2];
#pragma unroll
    for (int a = 0; a < 2; ++a)
#pragma unroll
        for (int b = 0; b < 2; ++b)
#pragma unroll
            for (int m = 0; m < 4; ++m)
#pragma unroll
                for (int n = 0; n < 2; ++n) acc[a][b][m][n] = (f32x4){0.f, 0.f, 0.f, 0.f};
    bf16x8 At[4][2], B0[2][2], B1[2][2];
    const char* cA = (const char*)g.A + (size_t)cur.pm * tstepA; const char* cB = (const char*)g.Bt + (size_t)cur.pn * tstepB;
    PG8_STAGE(PG8_SB(0, 0), cB, voffB); PG8_STAGE(PG8_SA(0, 0), cA, voffA); PG8_STAGE(PG8_SB(0, 1), cB + hstepB, voffB); PG8_STAGE(PG8_SA(0, 1), cA + hstepA, voffA);
    if (wr == 1) PG8_BAR;
    PG8_WAIT_V(4); PG8_BAR;
    PG8_STAGE(PG8_SB(1, 0), cB + kstep, voffB); PG8_STAGE(PG8_SA(1, 0), cA + kstep, voffA); PG8_STAGE(PG8_SB(1, 1), cB + hstepB + kstep, voffB);
    PG8_WAIT_V(6); PG8_BAR;
    for (;;) {
        const bool has_next = S.next(ui + 1, nxt);
        const char* nA = has_next ? (const char*)g.A + (size_t)nxt.pm * tstepA : cA; const char* nB = has_next ? (const char*)g.Bt + (size_t)nxt.pn * tstepB : cB;
        for (int t = 0; t < nt; t += 2) {
            const bool last = (t == nt - 2);
            const char* a1 = cA + (size_t)(t + 1) * kstep;
            const char* a2 = last ? nA : cA + (size_t)(t + 2) * kstep; const char* b2 = last ? nB : cB + (size_t)(t + 2) * kstep;
            const char* a3 = a2 + kstep; const char* b3 = b2 + kstep;
            if (E.has_mid() && (t == 8 || t == 24)) E.mid(acc, cur, tid, t == 8 ? 0 : 1);
            PG8_LDB(B0, 0, 0); PG8_SCHED; PG8_LDA(At, 0, 0); PG8_STAGE(PG8_SA(1, 1), a1 + hstepA, voffA);
            PG8_WAIT_L(8); PG8_BAR; PG8_WAIT_L(0); PG8_MMA(0, 0, At, B0); PG8_BAR; PG8_SCHED;
            PG8_LDB(B1, 0, 1); PG8_STAGE(PG8_SB(0, 0), b2, voffB);
            PG8_BAR; PG8_WAIT_L(0); PG8_MMA(0, 1, At, B1); PG8_BAR;
            PG8_LDA(At, 0, 1); PG8_STAGE(PG8_SA(0, 0), a2, voffA);
            PG8_BAR; PG8_WAIT_L(0); PG8_MMA(1, 0, At, B0); PG8_BAR; PG8_SCHED;
            PG8_STAGE(PG8_SB(0, 1), b2 + hstepB, voffB);
            PG8_WAIT_V(6); PG8_BAR; PG8_MMA(1, 1, At, B1); PG8_BAR;
            PG8_LDB(B0, 1, 0); PG8_SCHED; PG8_LDA(At, 1, 0); PG8_STAGE(PG8_SA(0, 1), a2 + hstepA, voffA);
            PG8_WAIT_L(8); PG8_BAR; PG8_WAIT_L(0); PG8_MMA(0, 0, At, B0); PG8_BAR; PG8_SCHED;
            PG8_LDB(B1, 1, 1); PG8_STAGE(PG8_SB(1, 0), b3, voffB);
            PG8_BAR; PG8_WAIT_L(0); PG8_MMA(0, 1, At, B1); PG8_BAR;
            PG8_LDA(At, 1, 1); PG8_STAGE(PG8_SA(1, 0), a3, voffA);
            PG8_BAR; PG8_WAIT_L(0); PG8_MMA(1, 0, At, B0); PG8_BAR; PG8_SCHED;
            PG8_STAGE(PG8_SB(1, 1), b3 + hstepB, voffB);
            PG8_WAIT_V(6); PG8_BAR; PG8_MMA(1, 1, At, B1); PG8_BAR;
        }
        E(acc, cur, wr, wc, fr, fq, tid);
        if (!has_next) break;
#pragma unroll
        for (int a = 0; a < 2; ++a)
#pragma unroll
            for (int b = 0; b < 2; ++b)
#pragma unroll
                for (int m = 0; m < 4; ++m)
#pragma unroll
                    for (int n = 0; n < 2; ++n) acc[a][b][m][n] = (f32x4){0.f, 0.f, 0.f, 0.f};
        cur = nxt; cA = nA; cB = nB; ++ui;
    }
    PG8_WAIT_V(0);
    if (wr == 0) PG8_BAR;
    PG8_BAR;
#undef PG8_SA
#undef PG8_SB
#undef PG8_STAGE
#undef PG8_LDA
#undef PG8_LDB
#undef PG8_MMA
#undef PG8_WAIT_V
#undef PG8_WAIT_L
#undef PG8_BAR
#undef PG8_SCHED
}

struct Epi {
    int kind; void* p0; const void* p1; void* p2; int ldc, gpn0;
    __device__ __forceinline__ bool perm() const { return kind != 4; }
    __device__ __forceinline__ bool has_mid() const { return kind == 5; }
    __device__ __forceinline__ void mid(f32x4 (&acc)[2][2][4][2], const Unit& u, int tid, int which) const {
        const u32x4* ga = (const u32x4*)p1 + ((size_t)(u.pm * 24 + 8 * which + u.pn) * 16) * 512 + tid; const u32x4* gb = ga + (size_t)8 * 16 * 512;
#pragma unroll
        for (int ai = 0; ai < 2; ++ai)
#pragma unroll
            for (int m = 0; m < 4; ++m)
#pragma unroll
                for (int bj = 0; bj < 2; ++bj) { const int idx = ((ai * 4 + m) * 2 + bj) * 512; const u32x4 x = ga[idx], y = gb[idx];
                    f32x4 r0, r1;
                    r0[0] = bflo(x.x) * __builtin_amdgcn_rcpf(bflo(y.x)); r0[1] = bfhi(x.x) * __builtin_amdgcn_rcpf(bfhi(y.x)); r0[2] = bflo(x.y) * __builtin_amdgcn_rcpf(bflo(y.y)); r0[3] = bfhi(x.y) * __builtin_amdgcn_rcpf(bfhi(y.y));
                    r1[0] = bflo(x.z) * __builtin_amdgcn_rcpf(bflo(y.z)); r1[1] = bfhi(x.z) * __builtin_amdgcn_rcpf(bfhi(y.z)); r1[2] = bflo(x.w) * __builtin_amdgcn_rcpf(bflo(y.w)); r1[3] = bfhi(x.w) * __builtin_amdgcn_rcpf(bfhi(y.w));
                    acc[ai][bj][m][0] *= r0; acc[ai][bj][m][1] *= r1; }
    }
    __device__ __forceinline__ void operator()(const f32x4 (&acc)[2][2][4][2], const Unit& u, int wr, int wc, int fr, int fq, int tid) const {
        const int row0 = u.pm * BM + wr * 64 + fr;
        if (kind == 0 && u.pn >= gpn0) {
            u32x4* gf = (u32x4*)p2 + ((size_t)(u.pm * 24 + (u.pn - gpn0)) * 16) * 512 + tid;
#pragma unroll
            for (int ai = 0; ai < 2; ++ai)
#pragma unroll
                for (int m = 0; m < 4; ++m)
#pragma unroll
                    for (int bj = 0; bj < 2; ++bj) { const f32x4 v0 = acc[ai][bj][m][0], v1 = acc[ai][bj][m][1];
                        u32x4 w; w.x = cvt_pk_bf16(sigmoidf_(v0[0]), sigmoidf_(v0[1])); w.y = cvt_pk_bf16(sigmoidf_(v0[2]), sigmoidf_(v0[3])); w.z = cvt_pk_bf16(sigmoidf_(v1[0]), sigmoidf_(v1[1])); w.w = cvt_pk_bf16(sigmoidf_(v1[2]), sigmoidf_(v1[3]));
                        gf[((ai * 4 + m) * 2 + bj) * 512] = w; }
        } else if (kind == 0) {
            bf16_t* O = (bf16_t*)p0; const int col0 = u.pn * BM + wc * 32 + 8 * fq;
#pragma unroll
            for (int ai = 0; ai < 2; ++ai)
#pragma unroll
                for (int m = 0; m < 4; ++m) { bf16_t* rowp = O + (size_t)(row0 + ai * HALF + m * 16) * ldc + col0;
#pragma unroll
                    for (int bj = 0; bj < 2; ++bj) { const f32x4 v0 = acc[ai][bj][m][0], v1 = acc[ai][bj][m][1];
                        u32x4 w; w.x = cvt_pk_bf16(v0[0], v0[1]); w.y = cvt_pk_bf16(v0[2], v0[3]); w.z = cvt_pk_bf16(v1[0], v1[1]); w.w = cvt_pk_bf16(v1[2], v1[3]);
                        *(u32x4*)(rowp + bj * HALF) = w; } }
        } else if (kind == 4) {
            const float* x = (const float*)p1; float* out = (float*)p0; const int col0 = u.pn * BM + wc * 32 + 4 * fq;
#pragma unroll
            for (int ai = 0; ai < 2; ++ai)
#pragma unroll
                for (int m = 0; m < 4; ++m) { const size_t off = (size_t)(row0 + ai * HALF + m * 16) * DM + col0;
#pragma unroll
                    for (int bj = 0; bj < 2; ++bj)
#pragma unroll
                        for (int n = 0; n < 2; ++n) *(f32x4*)(out + off + bj * HALF + n * 16) = *(const f32x4*)(x + off + bj * HALF + n * 16) + acc[ai][bj][m][n]; }
        } else {
            bf16_t* O = (bf16_t*)p0; const int col0 = u.pn * BM + wc * 32 + 8 * fq;
            const u32x4* gc = (const u32x4*)p1 + ((size_t)(u.pm * 24 + 16 + u.pn) * 16) * 512 + tid;
#pragma unroll
            for (int ai = 0; ai < 2; ++ai)
#pragma unroll
                for (int m = 0; m < 4; ++m) { bf16_t* rowp = O + (size_t)(row0 + ai * HALF + m * 16) * ldc + col0;
#pragma unroll
                    for (int bj = 0; bj < 2; ++bj) { const f32x4 v0 = acc[ai][bj][m][0], v1 = acc[ai][bj][m][1]; const u32x4 y = gc[((ai * 4 + m) * 2 + bj) * 512];
                        u32x4 w; w.x = cvt_pk_bf16(v0[0] * bflo(y.x), v0[1] * bfhi(y.x)); w.y = cvt_pk_bf16(v0[2] * bflo(y.y), v0[3] * bfhi(y.y)); w.z = cvt_pk_bf16(v1[0] * bflo(y.z), v1[1] * bfhi(y.z)); w.w = cvt_pk_bf16(v1[2] * bflo(y.w), v1[3] * bfhi(y.w));
                        *(u32x4*)(rowp + bj * HALF) = w; } }
        }
    }
};
}

__device__ __forceinline__ void rmsnorm_rows(const float* __restrict__ x, const float* __restrict__ g, bf16_t* __restrict__ out, int nrows, int gw, int nw, int lane) {
    for (int row = gw; row < nrows; row += nw) {
        const float4* xr = (const float4*)(x + (size_t)row * DM);
        float4 v[8]; float ss = 0.f;
#pragma unroll
        for (int i = 0; i < 4; ++i) { const int c = lane + 64 * i; v[2 * i] = xr[2 * c]; v[2 * i + 1] = xr[2 * c + 1]; }
#pragma unroll
        for (int i = 0; i < 8; ++i) ss += v[i].x * v[i].x + v[i].y * v[i].y + v[i].z * v[i].z + v[i].w * v[i].w;
#pragma unroll
        for (int o = 32; o >= 1; o >>= 1) ss += __shfl_xor(ss, o);
        const float rstd = rsqrtf(ss * (1.0f / DM) + EPSF);
#pragma unroll
        for (int i = 0; i < 4; ++i) { const int c = lane + 64 * i; const float4 ga = ((const float4*)g)[2 * c], gb = ((const float4*)g)[2 * c + 1]; const float4 a = v[2 * i], b = v[2 * i + 1];
            u32x4 w; w.x = cvt_pk_bf16(a.x * rstd * ga.x, a.y * rstd * ga.y); w.y = cvt_pk_bf16(a.z * rstd * ga.z, a.w * rstd * ga.w);
            w.z = cvt_pk_bf16(b.x * rstd * gb.x, b.y * rstd * gb.y); w.w = cvt_pk_bf16(b.z * rstd * gb.z, b.w * rstd * gb.w);
            *(u32x4*)(out + (size_t)row * DM + c * 8) = w; }
    }
}
__device__ __forceinline__ void transpose_tile(LAS float* t, const float* __restrict__ src, int ldsrc, int r0, int c0, bf16_t* __restrict__ dst, int lddst, int koff, int tid) {
#pragma unroll
    for (int pass = 0; pass < 2; ++pass) { const int r = pass * 32 + (tid >> 4), c4 = (tid & 15) * 4; const float4 v = *(const float4*)(src + (size_t)(r0 + r) * ldsrc + c0 + c4);
        t[r * 65 + c4 + 0] = v.x; t[r * 65 + c4 + 1] = v.y; t[r * 65 + c4 + 2] = v.z; t[r * 65 + c4 + 3] = v.w; }
    __syncthreads();
    { const int c = tid >> 3, rc = (tid & 7) * 8; float f[8];
#pragma unroll
        for (int j = 0; j < 8; ++j) f[j] = t[(rc + j) * 65 + c];
        u32x4 w; w.x = cvt_pk_bf16(f[0], f[1]); w.y = cvt_pk_bf16(f[2], f[3]); w.z = cvt_pk_bf16(f[4], f[5]); w.w = cvt_pk_bf16(f[6], f[7]);
        *(u32x4*)(dst + (size_t)(c0 + c) * lddst + koff + r0 + rc) = w; }
    __syncthreads();
}

template <int HD> struct AttnGeo { static constexpr int KSTR = HD * 2 + 16, VSTR = HD * 2 + 32, PPR = HD / 8, NKS = HD / 32, NDT = HD / 16; };

template <int HD, bool BANDED>
__device__ __forceinline__ void stage_k(LAS unsigned char* kl, const bf16_t* __restrict__ kp, size_t kvstride, int jbase, const float* __restrict__ wk, int tid) {
    typedef AttnGeo<HD> G;
#pragma unroll 4
    for (int p = tid; p < 256 * G::PPR; p += NTHR) {
        const int row = p / G::PPR, pc = p % G::PPR; const int j = jbase + row;
        u32x4 w = (u32x4){0u, 0u, 0u, 0u};
        if (!BANDED || j >= 0) w = *(const u32x4*)(kp + (size_t)j * kvstride + pc * 8);
        float f[8] = {bflo(w.x), bfhi(w.x), bflo(w.y), bfhi(w.y), bflo(w.z), bfhi(w.z), bflo(w.w), bfhi(w.w)};
        float ss = 0.f;
#pragma unroll
        for (int i = 0; i < 8; ++i) ss += f[i] * f[i];
#pragma unroll
        for (int o = 1; o < G::PPR; o <<= 1) ss += __shfl_xor(ss, o);
        const float rstd = rsqrtf(ss * (1.0f / HD) + EPSF);
        const float4 wa = *(const float4*)(wk + pc * 8), wb = *(const float4*)(wk + pc * 8 + 4);
        u32x4 o4; o4.x = cvt_pk_bf16(f[0] * rstd * wa.x, f[1] * rstd * wa.y); o4.y = cvt_pk_bf16(f[2] * rstd * wa.z, f[3] * rstd * wa.w);
        o4.z = cvt_pk_bf16(f[4] * rstd * wb.x, f[5] * rstd * wb.y); o4.w = cvt_pk_bf16(f[6] * rstd * wb.z, f[7] * rstd * wb.w);
        *(LAS u32x4*)(kl + row * G::KSTR + pc * 16) = o4;
    }
}
template <int HD, bool BANDED>
__device__ __forceinline__ void stage_v(LAS unsigned char* vl, const bf16_t* __restrict__ vp, size_t kvstride, int jbase, int tid) {
    typedef AttnGeo<HD> G;
#pragma unroll 4
    for (int p = tid; p < 256 * G::PPR; p += NTHR) {
        const int row = p / G::PPR, pc = p % G::PPR; const int j = jbase + row;
        u32x4 w = (u32x4){0u, 0u, 0u, 0u};
        if (!BANDED || j >= 0) w = *(const u32x4*)(vp + (size_t)j * kvstride + pc * 8);
        *(LAS u32x4*)(vl + row * G::VSTR + pc * 16) = w;
    }
    if (BANDED) { for (int p = tid; p < 16 * G::PPR; p += NTHR) { const int row = 256 + p / G::PPR, pc = p % G::PPR; *(LAS u32x4*)(vl + row * G::VSTR + pc * 16) = (u32x4){0u, 0u, 0u, 0u}; } }
}

__device__ __forceinline__ void attn_banded_item(LAS unsigned char* lds, const bf16_t* __restrict__ qp, size_t rstride, int qb, const float* __restrict__ wq, const float* __restrict__ wk,
                                                 bf16_t* __restrict__ og, size_t ogstride, float* __restrict__ lsep, size_t lsestride, const int tid) {
    constexpr int HD = 128; typedef AttnGeo<HD> G;
    const int w = __builtin_amdgcn_readfirstlane(tid >> 6), lane = tid & 63, lq = lane & 15, g4 = lane >> 4;
    LAS unsigned char* kl = lds; LAS unsigned char* vl = lds + 256 * G::KSTR;
    const int q0 = qb * 128, jbase = q0 - 128;
    const int qi = q0 + 16 * w + lq;
    const bf16_t* qrow = qp + (size_t)qi * rstride;
    u32x4 qw[G::NKS];
#pragma unroll
    for (int ks = 0; ks < G::NKS; ++ks) qw[ks] = *(const u32x4*)(qrow + ks * 32 + g4 * 8);
    stage_k<HD, true>(kl, qp + C_K, rstride, jbase, wk, tid);
    stage_v<HD, true>(vl, qp + C_V, rstride, jbase, tid);
    bf16x8 qf[G::NKS];
    {
        float ss = 0.f;
#pragma unroll
        for (int ks = 0; ks < G::NKS; ++ks) { const u32x4 x = qw[ks]; const float a0 = bflo(x.x), a1 = bfhi(x.x), a2 = bflo(x.y), a3 = bfhi(x.y), a4 = bflo(x.z), a5 = bfhi(x.z), a6 = bflo(x.w), a7 = bfhi(x.w);
            ss += a0 * a0 + a1 * a1 + a2 * a2 + a3 * a3 + a4 * a4 + a5 * a5 + a6 * a6 + a7 * a7; }
        ss += __shfl_xor(ss, 16); ss += __shfl_xor(ss, 32);
        const float sc = rsqrtf(ss * (1.0f / HD) + EPSF) * 0.08838834764831845f * 1.4426950408889634f;
#pragma unroll
        for (int ks = 0; ks < G::NKS; ++ks) { const u32x4 x = qw[ks]; const float4 wa = *(const float4*)(wq + ks * 32 + g4 * 8), wb = *(const float4*)(wq + ks * 32 + g4 * 8 + 4);
            u32x4 o; o.x = cvt_pk_bf16(bflo(x.x) * sc * wa.x, bfhi(x.x) * sc * wa.y); o.y = cvt_pk_bf16(bflo(x.y) * sc * wa.z, bfhi(x.y) * sc * wa.w);
            o.z = cvt_pk_bf16(bflo(x.z) * sc * wb.x, bfhi(x.z) * sc * wb.y); o.w = cvt_pk_bf16(bflo(x.w) * sc * wb.z, bfhi(x.w) * sc * wb.w);
            qf[ks] = __builtin_bit_cast(bf16x8, o); }
    }
    __syncthreads();
    f32x4 S[10];
    const float NEG = -__builtin_inff();
#pragma unroll
    for (int t = 0; t < 9; ++t) {
        const int kt = w + t;
        if (jbase + kt * 16 >= 0) {
            f32x4 s = (f32x4){0.f, 0.f, 0.f, 0.f};
#pragma unroll
            for (int ks = 0; ks < G::NKS; ++ks) { const bf16x8 kf = *(const LAS bf16x8*)(kl + (kt * 16 + lq) * G::KSTR + ks * 64 + g4 * 16); s = __builtin_amdgcn_mfma_f32_16x16x32_bf16(kf, qf[ks], s, 0, 0, 0); }
            if (t == 0) {
#pragma unroll
                for (int r = 0; r < 4; ++r) s[r] = (4 * g4 + r >= lq) ? s[r] : NEG; }
            if (t == 8) {
#pragma unroll
                for (int r = 0; r < 4; ++r) s[r] = (4 * g4 + r <= lq) ? s[r] : NEG; }
            S[t] = s;
        } else S[t] = (f32x4){NEG, NEG, NEG, NEG};
    }
    S[9] = (f32x4){NEG, NEG, NEG, NEG};
    float mx = NEG;
#pragma unroll
    for (int t = 0; t < 9; ++t)
#pragma unroll
        for (int r = 0; r < 4; ++r) mx = fmaxf(mx, S[t][r]);
    mx = fmaxf(mx, __shfl_xor(mx, 16)); mx = fmaxf(mx, __shfl_xor(mx, 32));
    float l = 0.f;
#pragma unroll
    for (int t = 0; t < 10; ++t)
#pragma unroll
        for (int r = 0; r < 4; ++r) { const float p = __builtin_amdgcn_exp2f(S[t][r] - mx); l += p; S[t][r] = p; }
    l += __shfl_xor(l, 16); l += __shfl_xor(l, 32);
    f32x4 O[G::NDT];
#pragma unroll
    for (int dt = 0; dt < G::NDT; ++dt) O[dt] = (f32x4){0.f, 0.f, 0.f, 0.f};
#pragma unroll
    for (int u = 0; u < 5; ++u) {
        u32x4 pw; pw.x = cvt_pk_bf16(S[2 * u][0], S[2 * u][1]); pw.y = cvt_pk_bf16(S[2 * u][2], S[2 * u][3]); pw.z = cvt_pk_bf16(S[2 * u + 1][0], S[2 * u + 1][1]); pw.w = cvt_pk_bf16(S[2 * u + 1][2], S[2 * u + 1][3]);
        const bf16x8 pb = __builtin_bit_cast(bf16x8, pw);
        const int ka = (w + 2 * u) * 16 + 4 * g4 + (lq >> 2), kb = ka + 16;
        LAS unsigned char* va = vl + ka * G::VSTR + (lane & 3) * 8; LAS unsigned char* vb = vl + kb * G::VSTR + (lane & 3) * 8;
#pragma unroll
        for (int dt = 0; dt < G::NDT; ++dt) {
            const s16x4 x = __builtin_amdgcn_ds_read_tr16_b64_v4i16((LAS s16x4*)(va + dt * 32));
            const s16x4 y = __builtin_amdgcn_ds_read_tr16_b64_v4i16((LAS s16x4*)(vb + dt * 32));
            const bf16x8 a = (bf16x8){x[0], x[1], x[2], x[3], y[0], y[1], y[2], y[3]};
            O[dt] = __builtin_amdgcn_mfma_f32_16x16x32_bf16(a, pb, O[dt], 0, 0, 0);
        }
    }
    const float inv = 1.0f / l;
    bf16_t* orow = og + (size_t)qi * ogstride;
#pragma unroll
    for (int dt = 0; dt < G::NDT; ++dt) { u32x2 o; o.x = cvt_pk_bf16(O[dt][0] * inv, O[dt][1] * inv); o.y = cvt_pk_bf16(O[dt][2] * inv, O[dt][3] * inv); *(u32x2*)(orow + dt * 16 + 4 * g4) = o; }
    if (g4 == 0) lsep[(size_t)qi * lsestride] = (mx + __builtin_amdgcn_logf(l)) * 0.6931471805599453f;
    __syncthreads();
}

__device__ __forceinline__ void attn_mem_item(LAS unsigned char* lds, const bf16_t* __restrict__ qp  , const bf16_t* __restrict__ kp, const bf16_t* __restrict__ vp,
                                              const float* __restrict__ wq, const float* __restrict__ wk, const bf16_t* __restrict__ zp  , bf16_t* __restrict__ ap  , const int tid) {
    constexpr int HD = 256; typedef AttnGeo<HD> G;
    const int w = __builtin_amdgcn_readfirstlane(tid >> 6), lane = tid & 63, lq = lane & 15, g4 = lane >> 4;
    const int qi = 16 * w + lq;
    const bf16_t* qrow = qp + (size_t)qi * PS;
    u32x4 qw[G::NKS];
#pragma unroll
    for (int ks = 0; ks < G::NKS; ++ks) qw[ks] = *(const u32x4*)(qrow + ks * 32 + g4 * 8);
    stage_k<HD, false>(lds, kp, DM, 0, wk, tid);
    bf16x8 qf[G::NKS];
    {
        float ss = 0.f;
#pragma unroll
        for (int ks = 0; ks < G::NKS; ++ks) { const u32x4 x = qw[ks]; const float a0 = bflo(x.x), a1 = bfhi(x.x), a2 = bflo(x.y), a3 = bfhi(x.y), a4 = bflo(x.z), a5 = bfhi(x.z), a6 = bflo(x.w), a7 = bfhi(x.w);
            ss += a0 * a0 + a1 * a1 + a2 * a2 + a3 * a3 + a4 * a4 + a5 * a5 + a6 * a6 + a7 * a7; }
        ss += __shfl_xor(ss, 16); ss += __shfl_xor(ss, 32);
        const float sc = rsqrtf(ss * (1.0f / HD) + EPSF) * 0.0625f * 1.4426950408889634f;
#pragma unroll
        for (int ks = 0; ks < G::NKS; ++ks) { const u32x4 x = qw[ks]; const float4 wa = *(const float4*)(wq + ks * 32 + g4 * 8), wb = *(const float4*)(wq + ks * 32 + g4 * 8 + 4);
            u32x4 o; o.x = cvt_pk_bf16(bflo(x.x) * sc * wa.x, bfhi(x.x) * sc * wa.y); o.y = cvt_pk_bf16(bflo(x.y) * sc * wa.z, bfhi(x.y) * sc * wa.w);
            o.z = cvt_pk_bf16(bflo(x.z) * sc * wb.x, bfhi(x.z) * sc * wb.y); o.w = cvt_pk_bf16(bflo(x.w) * sc * wb.z, bfhi(x.w) * sc * wb.w);
            qf[ks] = __builtin_bit_cast(bf16x8, o); }
    }
    __syncthreads();
    f32x4 S[16];
#pragma unroll
    for (int t = 0; t < 16; ++t) {
        f32x4 s = (f32x4){0.f, 0.f, 0.f, 0.f};
#pragma unroll
        for (int ks = 0; ks < G::NKS; ++ks) { const bf16x8 kf = *(const LAS bf16x8*)(lds + (t * 16 + lq) * G::KSTR + ks * 64 + g4 * 16); s = __builtin_amdgcn_mfma_f32_16x16x32_bf16(kf, qf[ks], s, 0, 0, 0); }
        S[t] = s;
    }
    float mx = -__builtin_inff();
#pragma unroll
    for (int t = 0; t < 16; ++t)
#pragma unroll
        for (int r = 0; r < 4; ++r) mx = fmaxf(mx, S[t][r]);
    mx = fmaxf(mx, __shfl_xor(mx, 16)); mx = fmaxf(mx, __shfl_xor(mx, 32));
    float l = 0.f; u32x2 P[16];
#pragma unroll
    for (int t = 0; t < 16; ++t) { const float p0 = __builtin_amdgcn_exp2f(S[t][0] - mx), p1 = __builtin_amdgcn_exp2f(S[t][1] - mx), p2 = __builtin_amdgcn_exp2f(S[t][2] - mx), p3 = __builtin_amdgcn_exp2f(S[t][3] - mx);
        l += (p0 + p1) + (p2 + p3); P[t].x = cvt_pk_bf16(p0, p1); P[t].y = cvt_pk_bf16(p2, p3); }
    l += __shfl_xor(l, 16); l += __shfl_xor(l, 32);
    __syncthreads();
    stage_v<HD, false>(lds, vp, DM, 0, tid);
    __syncthreads();
    f32x4 O[G::NDT];
#pragma unroll
    for (int dt = 0; dt < G::NDT; ++dt) O[dt] = (f32x4){0.f, 0.f, 0.f, 0.f};
#pragma unroll
    for (int u = 0; u < 8; ++u) {
        u32x4 pw; pw.x = P[2 * u].x; pw.y = P[2 * u].y; pw.z = P[2 * u + 1].x; pw.w = P[2 * u + 1].y;
        const bf16x8 pb = __builtin_bit_cast(bf16x8, pw);
        const int ka = (2 * u) * 16 + 4 * g4 + (lq >> 2), kb = ka + 16;
        LAS unsigned char* va = lds + ka * G::VSTR + (lane & 3) * 8; LAS unsigned char* vb = lds + kb * G::VSTR + (lane & 3) * 8;
#pragma unroll
        for (int dt = 0; dt < G::NDT; ++dt) {
            const s16x4 x = __builtin_amdgcn_ds_read_tr16_b64_v4i16((LAS s16x4*)(va + dt * 32));
            const s16x4 y = __builtin_amdgcn_ds_read_tr16_b64_v4i16((LAS s16x4*)(vb + dt * 32));
            const bf16x8 a = (bf16x8){x[0], x[1], x[2], x[3], y[0], y[1], y[2], y[3]};
            O[dt] = __builtin_amdgcn_mfma_f32_16x16x32_bf16(a, pb, O[dt], 0, 0, 0);
        }
    }
    const float inv = 1.0f / l;
    const bf16_t* zrow = zp + (size_t)qi * PS; bf16_t* arow = ap + (size_t)qi * ACTW;
#pragma unroll
    for (int dt = 0; dt < G::NDT; ++dt) { const u32x2 z = *(const u32x2*)(zrow + dt * 16 + 4 * g4);
        u32x2 o; o.x = cvt_pk_bf16(O[dt][0] * inv * siluf_(bflo(z.x)), O[dt][1] * inv * siluf_(bfhi(z.x))); o.y = cvt_pk_bf16(O[dt][2] * inv * siluf_(bflo(z.y)), O[dt][3] * inv * siluf_(bfhi(z.y)));
        *(u32x2*)(arow + dt * 16 + 4 * g4) = o; }
    __syncthreads();
}

struct Args { const float* in[15]; float* out; unsigned char* ws; int lo, hi; };
enum { I_X = 0, I_MEM, I_NG, I_MNG, I_WIN, I_AQN, I_AKN, I_CW, I_WKV, I_MQN, I_MKN, I_WBA, I_WBC, I_WBM, I_WOUT };
constexpr int NPHASE = 10;

__global__ void __launch_bounds__(NTHR, 2) mega(Args a) {
    extern __shared__ __attribute__((aligned(16))) unsigned char lds_raw[];
    LAS unsigned char* lds = (LAS unsigned char*)lds_raw;
    const int G = gridDim.x, bx = blockIdx.x;
    unsigned char* ws = a.ws;
    bf16_t* WIN = (bf16_t*)(ws + WS_WIN); bf16_t* WKV = (bf16_t*)(ws + WS_WKV); bf16_t* WBR = (bf16_t*)(ws + WS_WBR); bf16_t* WOUT = (bf16_t*)(ws + WS_WOUT);
    bf16_t* MH = (bf16_t*)(ws + WS_MH); bf16_t* MKV = (bf16_t*)(ws + WS_MKV); bf16_t* PROJ = (bf16_t*)(ws + WS_PROJ); bf16_t* OG = (bf16_t*)(ws + WS_OG);
    float* LSE = (float*)(ws + WS_LSE); bf16_t* ACT = (bf16_t*)(ws + WS_ACT); u32x4* GF = (u32x4*)(ws + WS_GF); bf16_t* MB = (bf16_t*)(ws + WS_MB);
    bf16_t* H = (bf16_t*)((unsigned char*)a.out + OUT_H_OFF);

    for (int ph = a.lo; ph < a.hi; ++ph) {
      const int nrep = ((REP_MASK >> ph) & 1) ? 2 : 1;
#pragma unroll 1
      for (int rep = 0; rep < nrep; ++rep) {
        int tid = threadIdx.x; asm volatile("" : "+v"(tid));
        const int lane = tid & 63, wave = tid >> 6;
        if (ph == 0) {
            rmsnorm_rows(a.in[I_X], a.in[I_NG], H, NTOK, bx * 8 + wave, G * 8, lane);
            rmsnorm_rows(a.in[I_MEM], a.in[I_MNG], MH, 4096, bx * 8 + wave, G * 8, lane);
            constexpr int T0 = 32 * 272, T1 = T0 + 1024, T2 = T1 + 256, T3 = T2 + 512, T4 = T3 + 512, T5 = T4 + 1024;
            for (int t = bx; t < T5; t += G) {
                const float* src; int C, ld, koff, ti; bf16_t* dst;
                if (t < T0) { src = a.in[I_WIN]; C = PC; dst = WIN; ld = DM; koff = 0; ti = t; }
                else if (t < T1) { src = a.in[I_WKV]; C = DM; dst = WKV; ld = DM; koff = 0; ti = t - T0; }
                else if (t < T2) { src = a.in[I_WBA]; C = DM; dst = WBR; ld = ACTW; koff = 0; ti = t - T1; }
                else if (t < T3) { src = a.in[I_WBC]; C = DM; dst = WBR; ld = ACTW; koff = 512; ti = t - T2; }
                else if (t < T4) { src = a.in[I_WBM]; C = DM; dst = WBR; ld = ACTW; koff = 1536; ti = t - T3; }
                else { src = a.in[I_WOUT]; C = DM; dst = WOUT; ld = DM; koff = 0; ti = t - T4; }
                const int nct = C / 64, tr = ti / nct, tc = ti % nct;
                transpose_tile((LAS float*)lds, src, C, tr * 64, tc * 64, dst, ld, koff, tid);
            }
        } else if (ph == 1 || ph == 5 || ph == 4 || ph == 8 || ph == 9) {
            const int nj = (ph == 1 || ph == 5) ? 2 : 1;
#pragma unroll 1
            for (int j = 0; j < nj; ++j) {
                pg8::Gemm g; pg8::Epi E;
                if (ph == 4 || ph == 8) {
                    g = pg8::Gemm{ACT, WBR, HT, DM, ACTW, ACTW, ACTW}; E = pg8::Epi{5, MB, GF, nullptr, DM, 1 << 20};
                } else if (ph == 1 && j == 0) {
                    g = pg8::Gemm{MH, WKV, 4096, DM, DM, DM, DM}; E = pg8::Epi{0, MKV, nullptr, nullptr, DM, 1 << 20};
                } else if ((ph == 5 && j == 0) || ph == 9) {
                    const size_t ro = (ph == 9) ? (size_t)HT * DM : 0;
                    g = pg8::Gemm{MB, WOUT, HT, DM, DM, DM, DM}; E = pg8::Epi{4, a.out + ro, a.in[I_X] + ro, nullptr, DM, 1 << 20};
                } else {
                    const int half = (ph == 1) ? 0 : 1;
                    g = pg8::Gemm{H + (size_t)half * HT * DM, WIN, HT, PC, DM, DM, DM}; E = pg8::Epi{0, PROJ, nullptr, GF, PS, PS / 256};
                }
                pg8::StaticOrder S; S.init(g.M, g.N, G, bx);
                pg8::gemm_phase(lds, g, S, E, tid);
            }
        } else if (ph == 2 || ph == 6) {
            const int half = (ph == 2) ? 0 : 1;
            for (int it = bx; it < 2048; it += G) {
                const int type = it >> 9, idx = it & 511;
                if (type < 3) {
                    const int g = type, dsh = 2 * g, d = 1 << dsh, nqb = 16 >> dsh;
                    const int qb = idx % nqb; int rest = idx / nqb; const int r = rest % d; rest /= d; const int h = rest & 3, bl = rest >> 2;
                    const size_t row0 = (size_t)bl * SEQ + r;
                    attn_banded_item(lds, PROJ + row0 * PS + g * 512 + h * 128, (size_t)d * PS, qb, a.in[I_AQN] + g * 128, a.in[I_AKN] + g * 128,
                                     OG + row0 * 1536 + g * 512 + h * 128, (size_t)d * 1536, LSE + row0 * 12 + g * 4 + h, (size_t)d * 12, tid);
                } else {
                    const int qb = idx & 15, h = (idx >> 4) & 3, bl = idx >> 6, b = half * 8 + bl;
                    const size_t row0 = (size_t)bl * SEQ + qb * 128;
                    attn_mem_item(lds, PROJ + row0 * PS + C_MQ + h * 256, MKV + (size_t)b * 256 * DM + h * 256, MKV + (size_t)b * 256 * DM + 1024 + h * 256,
                                  a.in[I_MQN], a.in[I_MKN], PROJ + row0 * PS + C_ZM + h * 256, ACT + row0 * ACTW + 1536 + h * 256, tid);
                }
            }
        } else if (ph == 3 || ph == 7) {
            const int gt = bx * NTHR + tid, nth = G * NTHR;
            for (int idx = gt; idx < HT * 64; idx += nth) {
                const int row = idx >> 6, c8 = (idx & 63) * 8, h = c8 >> 7;
                const float l0 = LSE[(size_t)row * 12 + h], l1 = LSE[(size_t)row * 12 + 4 + h], l2 = LSE[(size_t)row * 12 + 8 + h];
                const float m = fmaxf(l0, fmaxf(l1, l2)); float w0 = __expf(l0 - m), w1 = __expf(l1 - m), w2 = __expf(l2 - m); const float inv = 1.0f / (w0 + w1 + w2); w0 *= inv; w1 *= inv; w2 *= inv;
                const u32x4 o0 = *(const u32x4*)(OG + (size_t)row * 1536 + c8), o1 = *(const u32x4*)(OG + (size_t)row * 1536 + 512 + c8), o2 = *(const u32x4*)(OG + (size_t)row * 1536 + 1024 + c8);
                const u32x4 z = *(const u32x4*)(PROJ + (size_t)row * PS + C_ZA + c8);
                u32x4 o;
#define CMB(k) o.k = cvt_pk_bf16((w0 * bflo(o0.k) + w1 * bflo(o1.k) + w2 * bflo(o2.k)) * siluf_(bflo(z.k)), (w0 * bfhi(o0.k) + w1 * bfhi(o1.k) + w2 * bfhi(o2.k)) * siluf_(bfhi(z.k)))
                CMB(x); CMB(y); CMB(z); CMB(w);
#undef CMB
                *(u32x4*)(ACT + (size_t)row * ACTW + c8) = o;
            }
            const float* cw = a.in[I_CW];
            for (int idx = gt; idx < HT * 128; idx += nth) {
                const int row = idx >> 7, c8 = (idx & 127) * 8, t = row & (SEQ - 1);
                const bf16_t* pr = PROJ + (size_t)row * PS;
                const u32x4 z4 = (u32x4){0u, 0u, 0u, 0u};
                const u32x4 c0 = *(const u32x4*)(pr + C_CC + c8), v0 = *(const u32x4*)(pr + C_CV + c8);
                const u32x4 c1 = t >= 1 ? *(const u32x4*)(pr - PS + C_CC + c8) : z4, v1 = t >= 1 ? *(const u32x4*)(pr - PS + C_CV + c8) : z4;
                const u32x4 c2 = t >= 2 ? *(const u32x4*)(pr - 2 * PS + C_CC + c8) : z4, v2 = t >= 2 ? *(const u32x4*)(pr - 2 * PS + C_CV + c8) : z4;
                const u32x4 bb = *(const u32x4*)(pr + C_CB + c8), zz = *(const u32x4*)(pr + C_ZC + c8);
                const float4 wa0 = *(const float4*)(cw + c8), wb0 = *(const float4*)(cw + c8 + 4), wa1 = *(const float4*)(cw + 1024 + c8), wb1 = *(const float4*)(cw + 1024 + c8 + 4), wa2 = *(const float4*)(cw + 2048 + c8), wb2 = *(const float4*)(cw + 2048 + c8 + 4);
                u32x4 o;
#define CV1(f, k, W0, W1, W2) ((W0 * (f(c0.k) * f(v0.k)) + W1 * (f(c1.k) * f(v1.k)) + W2 * (f(c2.k) * f(v2.k))) * f(bb.k) * siluf_(f(zz.k)))
                o.x = cvt_pk_bf16(CV1(bflo, x, wa0.x, wa1.x, wa2.x), CV1(bfhi, x, wa0.y, wa1.y, wa2.y));
                o.y = cvt_pk_bf16(CV1(bflo, y, wa0.z, wa1.z, wa2.z), CV1(bfhi, y, wa0.w, wa1.w, wa2.w));
                o.z = cvt_pk_bf16(CV1(bflo, z, wb0.x, wb1.x, wb2.x), CV1(bfhi, z, wb0.y, wb1.y, wb2.y));
                o.w = cvt_pk_bf16(CV1(bflo, w, wb0.z, wb1.z, wb2.z), CV1(bfhi, w, wb0.w, wb1.w, wb2.w));
#undef CV1
                *(u32x4*)(ACT + (size_t)row * ACTW + 512 + c8) = o;
            }
        }
      }
        if (ph + 1 < a.hi) cg::this_grid().sync();
    }
}

extern "C" void kernel_launch(void* const* d_in, const int* in_sizes, int n_in, void* d_out, int out_size, void* d_ws, size_t ws_size, hipStream_t stream) {
    static int grid = 0;
    if (grid == 0) {
        if (n_in != 15 || ws_size < WS_END) { fprintf(stderr, "kernel_launch: unexpected inputs (n_in %d, ws %zu < %zu)\n", n_in, ws_size, (size_t)WS_END); grid = -1; return; }
        int dev = 0, cus = 0, per_cu = 0;
        hipGetDevice(&dev); hipDeviceGetAttribute(&cus, hipDeviceAttributeMultiprocessorCount, dev);
        if (hipFuncSetAttribute((const void*)mega, hipFuncAttributeMaxDynamicSharedMemorySize, LDS_BYTES) != hipSuccess) { fprintf(stderr, "kernel_launch: hipFuncSetAttribute failed\n"); grid = -1; return; }
        hipOccupancyMaxActiveBlocksPerMultiprocessor(&per_cu, (const void*)mega, NTHR, LDS_BYTES);
        if (per_cu < 1) per_cu = 1;
        grid = cus * 1;
        (void)hipGetLastError();
    }
    if (grid < 0) return;
    Args a{};
    for (int i = 0; i < 15; ++i) a.in[i] = (const float*)d_in[i];
    a.out = (float*)d_out; a.ws = (unsigned char*)d_ws;
#if ONE_LAUNCH
    a.lo = 0; a.hi = NPHASE;
    void* args[] = {&a};
    hipError_t e = hipLaunchCooperativeKernel((const void*)mega, dim3(grid), dim3(NTHR), args, LDS_BYTES, stream);
    if (e != hipSuccess) fprintf(stderr, "cooperative launch failed: %s (grid %d)\n", hipGetErrorString(e), grid);
#else
    for (int ph = 0; ph < NPHASE; ++ph) { a.lo = ph; a.hi = ph + 1; hipLaunchKernelGGL(mega, dim3(grid), dim3(NTHR), LDS_BYTES, stream, a); }
#endif
}
```

```cpp
#include <hip/hip_runtime.h>
#include <hip/hip_cooperative_groups.h>
#include <cstdio>
namespace cg = cooperative_groups;

#ifndef ONE_LAUNCH
#define ONE_LAUNCH 1
#endif

#ifndef REP_MASK
#define REP_MASK 0
#endif
#define LAS __attribute__((address_space(3)))
typedef unsigned short bf16_t;
typedef short bf16x8 __attribute__((ext_vector_type(8)));
typedef short s16x4 __attribute__((ext_vector_type(4)));
typedef float f32x4 __attribute__((ext_vector_type(4)));
typedef unsigned u32x4 __attribute__((ext_vector_type(4)));
typedef unsigned u32x2 __attribute__((ext_vector_type(2)));

constexpr int DM = 2048, SEQ = 2048, NB = 16, NTOK = NB * SEQ;
constexpr int PC = 17408;
constexpr int PS = 11264;
constexpr int HT = NTOK / 2;
constexpr int C_Q = 0, C_K = 1536, C_V = 3072, C_ZA = 4608, C_CB = 5120, C_CC = 6144, C_CV = 7168, C_ZC = 8192, C_MQ = 9216, C_ZM = 10240, C_G = 11264;
constexpr int ACTW = 2560;
constexpr float EPSF = 1e-6f;
constexpr int NTHR = 512;
constexpr int LDS_BYTES = 149504;

constexpr size_t WS_WIN = 0;
constexpr size_t WS_WKV = WS_WIN + (size_t)PC * DM * 2;
constexpr size_t WS_WBR = WS_WKV + (size_t)DM * DM * 2;
constexpr size_t WS_WOUT = WS_WBR + (size_t)DM * ACTW * 2;
constexpr size_t WS_MH = WS_WOUT + (size_t)DM * DM * 2;
constexpr size_t WS_MKV = WS_MH + (size_t)4096 * DM * 2;
constexpr size_t WS_PROJ = WS_MKV + (size_t)4096 * DM * 2;
constexpr size_t WS_OG = WS_PROJ + (size_t)HT * PS * 2;
constexpr size_t WS_LSE = WS_OG + (size_t)HT * 1536 * 2;
constexpr size_t WS_ACT = WS_LSE + (size_t)HT * 12 * 4;
constexpr size_t WS_GF = WS_ACT + (size_t)HT * ACTW * 2;
constexpr size_t WS_MB = WS_GF + (size_t)HT * 6144 * 2;
constexpr size_t WS_END = WS_MB + (size_t)HT * DM * 2;
constexpr size_t OUT_H_OFF = (size_t)HT * DM * 4;

__device__ __forceinline__ float bflo(unsigned w) { return __uint_as_float(w << 16); }
__device__ __forceinline__ float bfhi(unsigned w) { return __uint_as_float(w & 0xffff0000u); }
__device__ __forceinline__ unsigned cvt_pk_bf16(float lo, float hi) { unsigned r; asm volatile("v_cvt_pk_bf16_f32 %0, %1, %2" : "=v"(r) : "v"(lo), "v"(hi)); return r; }
__device__ __forceinline__ float sigmoidf_(float x) { return 1.0f / (1.0f + __expf(-x)); }
__device__ __forceinline__ float siluf_(float x) { return x / (1.0f + __expf(-x)); }

namespace pg8 {
constexpr int BM = 256, BK = 64, HALF = 128, HTB = HALF * BK * 2, STAGE_BYTES = 8 * HTB, NXCD = 8, WGM = 8;
__host__ __device__ __forceinline__ int lds_byte(int r, int c) { const int st = (r >> 4) * 2 + (c >> 5), rr = r & 15, cc = c & 31, ob = rr * 64 + cc * 2; return st * 1024 + (ob ^ (((ob >> 9) & 1) << 5)); }
__host__ __device__ __forceinline__ void stage_rc(int b, int& R, int& C) { const int st = b / 1024, sb = b % 1024, swz = sb ^ (((sb >> 9) & 1) << 5); R = (st >> 1) * 16 + swz / 64; C = (st & 1) * 32 + (swz % 64) / 2; }
__host__ __device__ __forceinline__ int perm32(int rho) { const int n = rho >> 4, i = rho & 15; return 8 * (i >> 2) + 4 * n + (i & 3); }
struct Unit { int pm, pn; };
struct Gemm { const bf16_t* A; const bf16_t* Bt; int M, N, K, lda, ldb; };
struct StaticOrder {
    int nM, nN, nwg, G, c;
    __device__ void init(int M, int N, int G_, int c_) { nM = M / BM; nN = N / BM; nwg = nM * nN; G = G_; c = c_; }
    __device__ bool next(int i, Unit& u) const {
        const long L = (long)i * G + c; if (L >= nwg) return false;
        int wgid = (int)L; { const int q = nwg / NXCD, r = nwg % NXCD, xcd = wgid % NXCD, off = wgid / NXCD; wgid = (xcd < r ? xcd * (q + 1) : r * (q + 1) + (xcd - r) * q) + off; }
        const int nig = WGM * nN, gid = wgid / nig, fm = gid * WGM, gsz = (nM - fm) < WGM ? (nM - fm) : WGM;
        u.pm = fm + ((wgid % nig) % gsz); u.pn = (wgid % nig) / gsz; return true;
    }
};

struct Epi;
template <class Epi, class Sched>
__device__ __forceinline__ void gemm_phase(LAS unsigned char* lds, const Gemm g, const Sched& S, const Epi& E, const int tid) {
    const int wid = __builtin_amdgcn_readfirstlane(tid >> 6), lane = tid & 63, wr = wid >> 2, wc = wid & 3, fr = lane & 15, fq = lane >> 4;
    const int K = g.K, nt = K / BK;
    unsigned voffA[2], voffB[2];
#pragma unroll
    for (int i = 0; i < 2; ++i) { int R, C; stage_rc(tid * 16 + i * 8192, R, C); const int Rb = E.perm() ? ((R & ~31) + perm32(R & 31)) : R;
        voffA[i] = (unsigned)(R * g.lda + C) * 2u; voffB[i] = (unsigned)(Rb * g.ldb + C) * 2u; }
    const size_t kstep = (size_t)(BK * 2);
    const size_t hstepA = (size_t)HALF * g.lda * 2, hstepB = (size_t)HALF * g.ldb * 2;
    const size_t tstepA = 2 * hstepA, tstepB = 2 * hstepB;
    const unsigned ldsw = (unsigned)wid * 1024u;
    const int aoff = lds_byte(wr * 64 + fr, fq * 8), boff = lds_byte(wc * 32 + fr, fq * 8);
#define PG8_SA(b, h) (((b) * 2 + (h)) * HTB)
#define PG8_SB(b, h) ((4 + (b) * 2 + (h)) * HTB)
#define PG8_STAGE(bufoff, gbase, voff) do { _Pragma("unroll") for (int _i = 0; _i < 2; ++_i) \
        __builtin_amdgcn_global_load_lds((const unsigned*)((const char*)(gbase) + (voff)[_i]), (LAS unsigned*)(lds + (bufoff) + ldsw + _i * 8192), 16, 0, 0); } while (0)
#define PG8_LDA(dst, b, h) do { _Pragma("unroll") for (int m = 0; m < 4; ++m) _Pragma("unroll") for (int k = 0; k < 2; ++k) dst[m][k] = *(const LAS bf16x8*)(lds + PG8_SA(b, h) + aoff + m * 2048 + k * 1024); } while (0)
#define PG8_LDB(dst, b, h) do { _Pragma("unroll") for (int n = 0; n < 2; ++n) _Pragma("unroll") for (int k = 0; k < 2; ++k) dst[n][k] = *(const LAS bf16x8*)(lds + PG8_SB(b, h) + boff + n * 2048 + k * 1024); } while (0)
#define PG8_MMA(ai, bj, At, Bt) do { __builtin_amdgcn_s_setprio(1); _Pragma("unroll") for (int m = 0; m < 4; ++m) _Pragma("unroll") for (int n = 0; n < 2; ++n) _Pragma("unroll") for (int k = 0; k < 2; ++k) \
        acc[ai][bj][m][n] = __builtin_amdgcn_mfma_f32_16x16x32_bf16(Bt[n][k], At[m][k], acc[ai][bj][m][n], 0, 0, 0); __builtin_amdgcn_s_setprio(0); } while (0)
#define PG8_WAIT_V(n) asm volatile("s_waitcnt vmcnt(" #n ")" ::: "memory")
#define PG8_WAIT_L(n) asm volatile("s_waitcnt lgkmcnt(" #n ")" ::: "memory")
#define PG8_BAR __builtin_amdgcn_s_barrier()
#define PG8_SCHED __builtin_amdgcn_sched_barrier(0)
    Unit cur, nxt; int ui = 0;
    if (!S.next(0, cur)) return;
    f32x4 acc[2][2][4][2];
#pragma unroll
    for (int a = 0; a < 2; ++a)
#pragma unroll
        for (int b = 0; b < 2; ++b)
#pragma unroll
            for (int m = 0; m < 4; ++m)
#pragma unroll
                for (int n = 0; n < 2; ++n) acc[a][b][m][n] = (f32x4){0.f, 0.f, 0.f, 0.f};
    bf16x8 At[4][2], B0[2][2], B1[2][2];
    const char* cA = (const char*)g.A + (size_t)cur.pm * tstepA; const char* cB = (const char*)g.Bt + (size_t)cur.pn * tstepB;
    PG8_STAGE(PG8_SB(0, 0), cB, voffB); PG8_STAGE(PG8_SA(0, 0), cA, voffA); PG8_STAGE(PG8_SB(0, 1), cB + hstepB, voffB); PG8_STAGE(PG8_SA(0, 1), cA + hstepA, voffA);
    if (wr == 1) PG8_BAR;
    PG8_WAIT_V(4); PG8_BAR;
    PG8_STAGE(PG8_SB(1, 0), cB + kstep, voffB); PG8_STAGE(PG8_SA(1, 0), cA + kstep, voffA); PG8_STAGE(PG8_SB(1, 1), cB + hstepB + kstep, voffB);
    PG8_WAIT_V(6); PG8_BAR;
    for (;;) {
        const bool has_next = S.next(ui + 1, nxt);
        const char* nA = has_next ? (const char*)g.A + (size_t)nxt.pm * tstepA : cA; const char* nB = has_next ? (const char*)g.Bt + (size_t)nxt.pn * tstepB : cB;
        for (int t = 0; t < nt; t += 2) {
            const bool last = (t == nt - 2);
            const char* a1 = cA + (size_t)(t + 1) * kstep;
            const char* a2 = last ? nA : cA + (size_t)(t + 2) * kstep; const char* b2 = last ? nB : cB + (size_t)(t + 2) * kstep;
            const char* a3 = a2 + kstep; const char* b3 = b2 + kstep;
            if (E.has_mid() && (t == 8 || t == 24)) E.mid(acc, cur, tid, t == 8 ? 0 : 1);
            PG8_LDB(B0, 0, 0); PG8_SCHED; PG8_LDA(At, 0, 0); PG8_STAGE(PG8_SA(1, 1), a1 + hstepA, voffA);
            PG8_WAIT_L(8); PG8_BAR; PG8_WAIT_L(0); PG8_MMA(0, 0, At, B0); PG8_BAR; PG8_SCHED;
            PG8_LDB(B1, 0, 1); PG8_STAGE(PG8_SB(0, 0), b2, voffB);
            PG8_BAR; PG8_WAIT_L(0); PG8_MMA(0, 1, At, B1); PG8_BAR;
            PG8_LDA(At, 0, 1); PG8_STAGE(PG8_SA(0, 0), a2, voffA);
            PG8_BAR; PG8_WAIT_L(0); PG8_MMA(1, 0, At, B0); PG8_BAR; PG8_SCHED;
            PG8_STAGE(PG8_SB(0, 1), b2 + hstepB, voffB);
            PG8_WAIT_V(6); PG8_BAR; PG8_MMA(1, 1, At, B1); PG8_BAR;
            PG8_LDB(B0, 1, 0); PG8_SCHED; PG8_LDA(At, 1, 0); PG8_STAGE(PG8_SA(0, 1), a2 + hstepA, voffA);
            PG8_WAIT_L(8); PG8_BAR; PG8_WAIT_L(0); PG8_MMA(0, 0, At, B0); PG8_BAR; PG8_SCHED;
            PG8_LDB(B1, 1, 1); PG8_STAGE(PG8_SB(1, 0), b3, voffB);
            PG8_BAR; PG8_WAIT_L(0); PG8_MMA(0, 1, At, B1); PG8_BAR;
            PG8_LDA(At, 1, 1); PG8_STAGE(PG8_SA(1, 0), a3, voffA);
            PG8_BAR; PG8_WAIT_L(0); PG8_MMA(1, 0, At, B0); PG8_BAR; PG8_SCHED;
            PG8_STAGE(PG8_SB(1, 1), b3 + hstepB, voffB);
            PG8_WAIT_V(6); PG8_BAR; PG8_MMA(1, 1, At, B1); PG8_BAR;
        }
        E(acc, cur, wr, wc, fr, fq, tid);
        if (!has_next) break;
#pragma unroll
        for (int a = 0; a < 2; ++a)
#pragma unroll
            for (int b = 0; b < 2; ++b)
#pragma unroll
                for (int m = 0; m < 4; ++m)
#pragma unroll
                    for (int n = 0; n < 2; ++n) acc[a][b][m][n] = (f32x4){0.f, 0.f, 0.f, 0.f};
        cur = nxt; cA = nA; cB = nB; ++ui;
    }
    PG8_WAIT_V(0);
    if (wr == 0) PG8_BAR;
    PG8_BAR;
#undef PG8_SA
#undef PG8_SB
#undef PG8_STAGE
#undef PG8_LDA
#undef PG8_LDB
#undef PG8_MMA
#undef PG8_WAIT_V
#undef PG8_WAIT_L
#undef PG8_BAR
#undef PG8_SCHED
}

struct Epi {
    int kind; void* p0; const void* p1; void* p2; int ldc, gpn0;
    __device__ __forceinline__ bool perm() const { return kind != 4; }
    __device__ __forceinline__ bool has_mid() const { return kind == 5; }
    __device__ __forceinline__ void mid(f32x4 (&acc)[2][2][4][2], const Unit& u, int tid, int which) const {
        const u32x4* ga = (const u32x4*)p1 + ((size_t)(u.pm * 24 + 8 * which + u.pn) * 16) * 512 + tid; const u32x4* gb = ga + (size_t)8 * 16 * 512;
        u32x4 x[16];
#pragma unroll
        for (int i = 0; i < 16; ++i) x[i] = ga[i * 512];
        asm volatile("s_waitcnt vmcnt(0)" ::: "memory");
#pragma unroll
        for (int i = 0; i < 16; ++i) { const int ai = i >> 3, m = (i >> 1) & 3, bj = i & 1; const u32x4 y = x[i];
            acc[ai][bj][m][0] *= (f32x4){bflo(y.x), bfhi(y.x), bflo(y.y), bfhi(y.y)}; acc[ai][bj][m][1] *= (f32x4){bflo(y.z), bfhi(y.z), bflo(y.w), bfhi(y.w)}; }
        asm volatile("" ::: "memory");
#pragma unroll
        for (int i = 0; i < 16; ++i) x[i] = gb[i * 512];
        asm volatile("s_waitcnt vmcnt(0)" ::: "memory");
#pragma unroll
        for (int i = 0; i < 16; ++i) { const int ai = i >> 3, m = (i >> 1) & 3, bj = i & 1; const u32x4 y = x[i];
            acc[ai][bj][m][0] *= (f32x4){__builtin_amdgcn_rcpf(bflo(y.x)), __builtin_amdgcn_rcpf(bfhi(y.x)), __builtin_amdgcn_rcpf(bflo(y.y)), __builtin_amdgcn_rcpf(bfhi(y.y))};
            acc[ai][bj][m][1] *= (f32x4){__builtin_amdgcn_rcpf(bflo(y.z)), __builtin_amdgcn_rcpf(bfhi(y.z)), __builtin_amdgcn_rcpf(bflo(y.w)), __builtin_amdgcn_rcpf(bfhi(y.w))}; }
    }
    __device__ __forceinline__ void operator()(const f32x4 (&acc)[2][2][4][2], const Unit& u, int wr, int wc, int fr, int fq, int tid) const {
        const int row0 = u.pm * BM + wr * 64 + fr;
        if (kind == 0 && u.pn >= gpn0) {
            u32x4* gf = (u32x4*)p2 + ((size_t)(u.pm * 24 + (u.pn - gpn0)) * 16) * 512 + tid;
#pragma unroll
            for (int ai = 0; ai < 2; ++ai)
#pragma unroll
                for (int m = 0; m < 4; ++m)
#pragma unroll
                    for (int bj = 0; bj < 2; ++bj) { const f32x4 v0 = acc[ai][bj][m][0], v1 = acc[ai][bj][m][1];
                        u32x4 w; w.x = cvt_pk_bf16(sigmoidf_(v0[0]), sigmoidf_(v0[1])); w.y = cvt_pk_bf16(sigmoidf_(v0[2]), sigmoidf_(v0[3])); w.z = cvt_pk_bf16(sigmoidf_(v1[0]), sigmoidf_(v1[1])); w.w = cvt_pk_bf16(sigmoidf_(v1[2]), sigmoidf_(v1[3]));
                        gf[((ai * 4 + m) * 2 + bj) * 512] = w; }
        } else if (kind == 0) {
            bf16_t* O = (bf16_t*)p0; const int col0 = u.pn * BM + wc * 32 + 8 * fq;
#pragma unroll
            for (int ai = 0; ai < 2; ++ai)
#pragma unroll
                for (int m = 0; m < 4; ++m) { bf16_t* rowp = O + (size_t)(row0 + ai * HALF + m * 16) * ldc + col0;
#pragma unroll
                    for (int bj = 0; bj < 2; ++bj) { const f32x4 v0 = acc[ai][bj][m][0], v1 = acc[ai][bj][m][1];
                        u32x4 w; w.x = cvt_pk_bf16(v0[0], v0[1]); w.y = cvt_pk_bf16(v0[2], v0[3]); w.z = cvt_pk_bf16(v1[0], v1[1]); w.w = cvt_pk_bf16(v1[2], v1[3]);
                        *(u32x4*)(rowp + bj * HALF) = w; } }
        } else if (kind == 4) {
            const float* x = (const float*)p1; float* out = (float*)p0; const int col0 = u.pn * BM + wc * 32 + 4 * fq;
#pragma unroll
            for (int am = 0; am < 4; ++am) {
                const int ai = am >> 1, mb = (am & 1) * 2;
                f32x4 xv[2][2][2];
#pragma unroll
                for (int m = 0; m < 2; ++m) { const size_t off = (size_t)(row0 + ai * HALF + (mb + m) * 16) * DM + col0;
#pragma unroll
                    for (int bj = 0; bj < 2; ++bj)
#pragma unroll
                        for (int n = 0; n < 2; ++n) xv[m][bj][n] = *(const f32x4*)(x + off + bj * HALF + n * 16); }
                asm volatile("s_waitcnt vmcnt(0)" ::: "memory");
#pragma unroll
                for (int m = 0; m < 2; ++m) { const size_t off = (size_t)(row0 + ai * HALF + (mb + m) * 16) * DM + col0;
#pragma unroll
                    for (int bj = 0; bj < 2; ++bj)
#pragma unroll
                        for (int n = 0; n < 2; ++n) *(f32x4*)(out + off + bj * HALF + n * 16) = xv[m][bj][n] + acc[ai][bj][mb + m][n]; }
                asm volatile("" ::: "memory");
            }
        } else {
            bf16_t* O = (bf16_t*)p0; const int col0 = u.pn * BM + wc * 32 + 8 * fq;
            const u32x4* gc = (const u32x4*)p1 + ((size_t)(u.pm * 24 + 16 + u.pn) * 16) * 512 + tid;
            u32x4 gy[16];
#pragma unroll
            for (int i = 0; i < 16; ++i) gy[i] = gc[i * 512];
            asm volatile("s_waitcnt vmcnt(0)" ::: "memory");
#pragma unroll
            for (int ai = 0; ai < 2; ++ai)
#pragma unroll
                for (int m = 0; m < 4; ++m) { bf16_t* rowp = O + (size_t)(row0 + ai * HALF + m * 16) * ldc + col0;
#pragma unroll
                    for (int bj = 0; bj < 2; ++bj) { const f32x4 v0 = acc[ai][bj][m][0], v1 = acc[ai][bj][m][1]; const u32x4 y = gy[(ai * 4 + m) * 2 + bj];
                        u32x4 w; w.x = cvt_pk_bf16(v0[0] * bflo(y.x), v0[1] * bfhi(y.x)); w.y = cvt_pk_bf16(v0[2] * bflo(y.y), v0[3] * bfhi(y.y)); w.z = cvt_pk_bf16(v1[0] * bflo(y.z), v1[1] * bfhi(y.z)); w.w = cvt_pk_bf16(v1[2] * bflo(y.w), v1[3] * bfhi(y.w));
                        *(u32x4*)(rowp + bj * HALF) = w; } }
        }
    }
};
}

__device__ __forceinline__ void rmsnorm_rows(const float* __restrict__ x, const float* __restrict__ g, bf16_t* __restrict__ out, int nrows, int gw, int nw, int lane) {
    for (int row = gw; row < nrows; row += nw) {
        const float4* xr = (const float4*)(x + (size_t)row * DM);
        float4 v[8]; float ss = 0.f;
#pragma unroll
        for (int i = 0; i < 4; ++i) { const int c = lane + 64 * i; v[2 * i] = xr[2 * c]; v[2 * i + 1] = xr[2 * c + 1]; }
#pragma unroll
        for (int i = 0; i < 8; ++i) ss += v[i].x * v[i].x + v[i].y * v[i].y + v[i].z * v[i].z + v[i].w * v[i].w;
#pragma unroll
        for (int o = 32; o >= 1; o >>= 1) ss += __shfl_xor(ss, o);
        const float rstd = rsqrtf(ss * (1.0f / DM) + EPSF);
#pragma unroll
        for (int i = 0; i < 4; ++i) { const int c = lane + 64 * i; const float4 ga = ((const float4*)g)[2 * c], gb = ((const float4*)g)[2 * c + 1]; const float4 a = v[2 * i], b = v[2 * i + 1];
            u32x4 w; w.x = cvt_pk_bf16(a.x * rstd * ga.x, a.y * rstd * ga.y); w.y = cvt_pk_bf16(a.z * rstd * ga.z, a.w * rstd * ga.w);
            w.z = cvt_pk_bf16(b.x * rstd * gb.x, b.y * rstd * gb.y); w.w = cvt_pk_bf16(b.z * rstd * gb.z, b.w * rstd * gb.w);
            *(u32x4*)(out + (size_t)row * DM + c * 8) = w; }
    }
}
__device__ __forceinline__ void transpose_tile(LAS float* t, const float* __restrict__ src, int ldsrc, int r0, int c0, bf16_t* __restrict__ dst, int lddst, int koff, int tid) {
#pragma unroll
    for (int pass = 0; pass < 2; ++pass) { const int r = pass * 32 + (tid >> 4), c4 = (tid & 15) * 4; const float4 v = *(const float4*)(src + (size_t)(r0 + r) * ldsrc + c0 + c4);
        t[r * 65 + c4 + 0] = v.x; t[r * 65 + c4 + 1] = v.y; t[r * 65 + c4 + 2] = v.z; t[r * 65 + c4 + 3] = v.w; }
    __syncthreads();
    { const int c = tid >> 3, rc = (tid & 7) * 8; float f[8];
#pragma unroll
        for (int j = 0; j < 8; ++j) f[j] = t[(rc + j) * 65 + c];
        u32x4 w; w.x = cvt_pk_bf16(f[0], f[1]); w.y = cvt_pk_bf16(f[2], f[3]); w.z = cvt_pk_bf16(f[4], f[5]); w.w = cvt_pk_bf16(f[6], f[7]);
        *(u32x4*)(dst + (size_t)(c0 + c) * lddst + koff + r0 + rc) = w; }
    __syncthreads();
}

template <int HD> struct AttnGeo { static constexpr int KSTR = HD * 2 + 16, VSTR = HD * 2 + 32, PPR = HD / 8, NKS = HD / 32, NDT = HD / 16; };

template <int HD, bool BANDED>
__device__ __forceinline__ void stage_k(LAS unsigned char* kl, const bf16_t* __restrict__ kp, size_t kvstride, int jbase, const float* __restrict__ wk, int tid) {
    typedef AttnGeo<HD> G;
#pragma unroll 4
    for (int p = tid; p < 256 * G::PPR; p += NTHR) {
        const int row = p / G::PPR, pc = p % G::PPR; const int j = jbase + row;
        u32x4 w = (u32x4){0u, 0u, 0u, 0u};
        if (!BANDED || j >= 0) w = *(const u32x4*)(kp + (size_t)j * kvstride + pc * 8);
        float f[8] = {bflo(w.x), bfhi(w.x), bflo(w.y), bfhi(w.y), bflo(w.z), bfhi(w.z), bflo(w.w), bfhi(w.w)};
        float ss = 0.f;
#pragma unroll
        for (int i = 0; i < 8; ++i) ss += f[i] * f[i];
#pragma unroll
        for (int o = 1; o < G::PPR; o <<= 1) ss += __shfl_xor(ss, o);
        const float rstd = rsqrtf(ss * (1.0f / HD) + EPSF);
        const float4 wa = *(const float4*)(wk + pc * 8), wb = *(const float4*)(wk + pc * 8 + 4);
        u32x4 o4; o4.x = cvt_pk_bf16(f[0] * rstd * wa.x, f[1] * rstd * wa.y); o4.y = cvt_pk_bf16(f[2] * rstd * wa.z, f[3] * rstd * wa.w);
        o4.z = cvt_pk_bf16(f[4] * rstd * wb.x, f[5] * rstd * wb.y); o4.w = cvt_pk_bf16(f[6] * rstd * wb.z, f[7] * rstd * wb.w);
        *(LAS u32x4*)(kl + row * G::KSTR + pc * 16) = o4;
    }
}
template <int HD, bool BANDED>
__device__ __forceinline__ void stage_v(LAS unsigned char* vl, const bf16_t* __restrict__ vp, size_t kvstride, int jbase, int tid) {
    typedef AttnGeo<HD> G;
#pragma unroll 4
    for (int p = tid; p < 256 * G::PPR; p += NTHR) {
        const int row = p / G::PPR, pc = p % G::PPR; const int j = jbase + row;
        u32x4 w = (u32x4){0u, 0u, 0u, 0u};
        if (!BANDED || j >= 0) w = *(const u32x4*)(vp + (size_t)j * kvstride + pc * 8);
        *(LAS u32x4*)(vl + row * G::VSTR + pc * 16) = w;
    }
    if (BANDED) { for (int p = tid; p < 16 * G::PPR; p += NTHR) { const int row = 256 + p / G::PPR, pc = p % G::PPR; *(LAS u32x4*)(vl + row * G::VSTR + pc * 16) = (u32x4){0u, 0u, 0u, 0u}; } }
}

__device__ __forceinline__ void attn_banded_item(LAS unsigned char* lds, const bf16_t* __restrict__ qp, size_t rstride, int qb, const float* __restrict__ wq, const float* __restrict__ wk,
                                                 bf16_t* __restrict__ og, size_t ogstride, float* __restrict__ lsep, size_t lsestride, const int tid) {
    constexpr int HD = 128; typedef AttnGeo<HD> G;
    const int w = __builtin_amdgcn_readfirstlane(tid >> 6), lane = tid & 63, lq = lane & 15, g4 = lane >> 4;
    LAS unsigned char* kl = lds; LAS unsigned char* vl = lds + 256 * G::KSTR;
    const int q0 = qb * 128, jbase = q0 - 128;
    const int qi = q0 + 16 * w + lq;
    const bf16_t* qrow = qp + (size_t)qi * rstride;
    u32x4 qw[G::NKS];
#pragma unroll
    for (int ks = 0; ks < G::NKS; ++ks) qw[ks] = *(const u32x4*)(qrow + ks * 32 + g4 * 8);
    stage_k<HD, true>(kl, qp + C_K, rstride, jbase, wk, tid);
    stage_v<HD, true>(vl, qp + C_V, rstride, jbase, tid);
    bf16x8 qf[G::NKS];
    {
        float ss = 0.f;
#pragma unroll
        for (int ks = 0; ks < G::NKS; ++ks) { const u32x4 x = qw[ks]; const float a0 = bflo(x.x), a1 = bfhi(x.x), a2 = bflo(x.y), a3 = bfhi(x.y), a4 = bflo(x.z), a5 = bfhi(x.z), a6 = bflo(x.w), a7 = bfhi(x.w);
            ss += a0 * a0 + a1 * a1 + a2 * a2 + a3 * a3 + a4 * a4 + a5 * a5 + a6 * a6 + a7 * a7; }
        ss += __shfl_xor(ss, 16); ss += __shfl_xor(ss, 32);
        const float sc = rsqrtf(ss * (1.0f / HD) + EPSF) * 0.08838834764831845f * 1.4426950408889634f;
#pragma unroll
        for (int ks = 0; ks < G::NKS; ++ks) { const u32x4 x = qw[ks]; const float4 wa = *(const float4*)(wq + ks * 32 + g4 * 8), wb = *(const float4*)(wq + ks * 32 + g4 * 8 + 4);
            u32x4 o; o.x = cvt_pk_bf16(bflo(x.x) * sc * wa.x, bfhi(x.x) * sc * wa.y); o.y = cvt_pk_bf16(bflo(x.y) * sc * wa.z, bfhi(x.y) * sc * wa.w);
            o.z = cvt_pk_bf16(bflo(x.z) * sc * wb.x, bfhi(x.z) * sc * wb.y); o.w = cvt_pk_bf16(bflo(x.w) * sc * wb.z, bfhi(x.w) * sc * wb.w);
            qf[ks] = __builtin_bit_cast(bf16x8, o); }
    }
    __syncthreads();
    f32x4 S[10];
    const float NEG = -__builtin_inff();
#pragma unroll
    for (int t = 0; t < 9; ++t) {
        const int kt = w + t;
        if (jbase + kt * 16 >= 0) {
            f32x4 s = (f32x4){0.f, 0.f, 0.f, 0.f};
#pragma unroll
            for (int ks = 0; ks < G::NKS; ++ks) { const bf16x8 kf = *(const LAS bf16x8*)(kl + (kt * 16 + lq) * G::KSTR + ks * 64 + g4 * 16); s = __builtin_amdgcn_mfma_f32_16x16x32_bf16(kf, qf[ks], s, 0, 0, 0); }
            if (t == 0) {
#pragma unroll
                for (int r = 0; r < 4; ++r) s[r] = (4 * g4 + r >= lq) ? s[r] : NEG; }
            if (t == 8) {
#pragma unroll
                for (int r = 0; r < 4; ++r) s[r] = (4 * g4 + r <= lq) ? s[r] : NEG; }
            S[t] = s;
        } else S[t] = (f32x4){NEG, NEG, NEG, NEG};
    }
    S[9] = (f32x4){NEG, NEG, NEG, NEG};
    float mx = NEG;
#pragma unroll
    for (int t = 0; t < 9; ++t)
#pragma unroll
        for (int r = 0; r < 4; ++r) mx = fmaxf(mx, S[t][r]);
    mx = fmaxf(mx, __shfl_xor(mx, 16)); mx = fmaxf(mx, __shfl_xor(mx, 32));
    float l = 0.f;
#pragma unroll
    for (int t = 0; t < 10; ++t)
#pragma unroll
        for (int r = 0; r < 4; ++r) { const float p = __builtin_amdgcn_exp2f(S[t][r] - mx); l += p; S[t][r] = p; }
    l += __shfl_xor(l, 16); l += __shfl_xor(l, 32);
    f32x4 O[G::NDT];
#pragma unroll
    for (int dt = 0; dt < G::NDT; ++dt) O[dt] = (f32x4){0.f, 0.f, 0.f, 0.f};
#pragma unroll
    for (int u = 0; u < 5; ++u) {
        u32x4 pw; pw.x = cvt_pk_bf16(S[2 * u][0], S[2 * u][1]); pw.y = cvt_pk_bf16(S[2 * u][2], S[2 * u][3]); pw.z = cvt_pk_bf16(S[2 * u + 1][0], S[2 * u + 1][1]); pw.w = cvt_pk_bf16(S[2 * u + 1][2], S[2 * u + 1][3]);
        const bf16x8 pb = __builtin_bit_cast(bf16x8, pw);
        const int ka = (w + 2 * u) * 16 + 4 * g4 + (lq >> 2), kb = ka + 16;
        LAS unsigned char* va = vl + ka * G::VSTR + (lane & 3) * 8; LAS unsigned char* vb = vl + kb * G::VSTR + (lane & 3) * 8;
#pragma unroll
        for (int dt = 0; dt < G::NDT; ++dt) {
            const s16x4 x = __builtin_amdgcn_ds_read_tr16_b64_v4i16((LAS s16x4*)(va + dt * 32));
            const s16x4 y = __builtin_amdgcn_ds_read_tr16_b64_v4i16((LAS s16x4*)(vb + dt * 32));
            const bf16x8 a = (bf16x8){x[0], x[1], x[2], x[3], y[0], y[1], y[2], y[3]};
            O[dt] = __builtin_amdgcn_mfma_f32_16x16x32_bf16(a, pb, O[dt], 0, 0, 0);
        }
    }
    const float inv = 1.0f / l;
    bf16_t* orow = og + (size_t)qi * ogstride;
#pragma unroll
    for (int dt = 0; dt < G::NDT; ++dt) { u32x2 o; o.x = cvt_pk_bf16(O[dt][0] * inv, O[dt][1] * inv); o.y = cvt_pk_bf16(O[dt][2] * inv, O[dt][3] * inv); *(u32x2*)(orow + dt * 16 + 4 * g4) = o; }
    if (g4 == 0) lsep[(size_t)qi * lsestride] = (mx + __builtin_amdgcn_logf(l)) * 0.6931471805599453f;
    __syncthreads();
}

__device__ __forceinline__ void attn_mem_item(LAS unsigned char* lds, const bf16_t* __restrict__ qp  , const bf16_t* __restrict__ kp, const bf16_t* __restrict__ vp,
                                              const float* __restrict__ wq, const float* __restrict__ wk, const bf16_t* __restrict__ zp  , bf16_t* __restrict__ ap  , const int tid) {
    constexpr int HD = 256; typedef AttnGeo<HD> G;
    const int w = __builtin_amdgcn_readfirstlane(tid >> 6), lane = tid & 63, lq = lane & 15, g4 = lane >> 4;
    const int qi = 16 * w + lq;
    const bf16_t* qrow = qp + (size_t)qi * PS;
    u32x4 qw[G::NKS];
#pragma unroll
    for (int ks = 0; ks < G::NKS; ++ks) qw[ks] = *(const u32x4*)(qrow + ks * 32 + g4 * 8);
    stage_k<HD, false>(lds, kp, DM, 0, wk, tid);
    bf16x8 qf[G::NKS];
    {
        float ss = 0.f;
#pragma unroll
        for (int ks = 0; ks < G::NKS; ++ks) { const u32x4 x = qw[ks]; const float a0 = bflo(x.x), a1 = bfhi(x.x), a2 = bflo(x.y), a3 = bfhi(x.y), a4 = bflo(x.z), a5 = bfhi(x.z), a6 = bflo(x.w), a7 = bfhi(x.w);
            ss += a0 * a0 + a1 * a1 + a2 * a2 + a3 * a3 + a4 * a4 + a5 * a5 + a6 * a6 + a7 * a7; }
        ss += __shfl_xor(ss, 16); ss += __shfl_xor(ss, 32);
        const float sc = rsqrtf(ss * (1.0f / HD) + EPSF) * 0.0625f * 1.4426950408889634f;
#pragma unroll
        for (int ks = 0; ks < G::NKS; ++ks) { const u32x4 x = qw[ks]; const float4 wa = *(const float4*)(wq + ks * 32 + g4 * 8), wb = *(const float4*)(wq + ks * 32 + g4 * 8 + 4);
            u32x4 o; o.x = cvt_pk_bf16(bflo(x.x) * sc * wa.x, bfhi(x.x) * sc * wa.y); o.y = cvt_pk_bf16(bflo(x.y) * sc * wa.z, bfhi(x.y) * sc * wa.w);
            o.z = cvt_pk_bf16(bflo(x.z) * sc * wb.x, bfhi(x.z) * sc * wb.y); o.w = cvt_pk_bf16(bflo(x.w) * sc * wb.z, bfhi(x.w) * sc * wb.w);
            qf[ks] = __builtin_bit_cast(bf16x8, o); }
    }
    __syncthreads();
    f32x4 S[16];
#pragma unroll
    for (int t = 0; t < 16; ++t) {
        f32x4 s = (f32x4){0.f, 0.f, 0.f, 0.f};
#pragma unroll
        for (int ks = 0; ks < G::NKS; ++ks) { const bf16x8 kf = *(const LAS bf16x8*)(lds + (t * 16 + lq) * G::KSTR + ks * 64 + g4 * 16); s = __builtin_amdgcn_mfma_f32_16x16x32_bf16(kf, qf[ks], s, 0, 0, 0); }
        S[t] = s;
    }
    float mx = -__builtin_inff();
#pragma unroll
    for (int t = 0; t < 16; ++t)
#pragma unroll
        for (int r = 0; r < 4; ++r) mx = fmaxf(mx, S[t][r]);
    mx = fmaxf(mx, __shfl_xor(mx, 16)); mx = fmaxf(mx, __shfl_xor(mx, 32));
    float l = 0.f; u32x2 P[16];
#pragma unroll
    for (int t = 0; t < 16; ++t) { const float p0 = __builtin_amdgcn_exp2f(S[t][0] - mx), p1 = __builtin_amdgcn_exp2f(S[t][1] - mx), p2 = __builtin_amdgcn_exp2f(S[t][2] - mx), p3 = __builtin_amdgcn_exp2f(S[t][3] - mx);
        l += (p0 + p1) + (p2 + p3); P[t].x = cvt_pk_bf16(p0, p1); P[t].y = cvt_pk_bf16(p2, p3); }
    l += __shfl_xor(l, 16); l += __shfl_xor(l, 32);
    __syncthreads();
    stage_v<HD, false>(lds, vp, DM, 0, tid);
    __syncthreads();
    f32x4 O[G::NDT];
#pragma unroll
    for (int dt = 0; dt < G::NDT; ++dt) O[dt] = (f32x4){0.f, 0.f, 0.f, 0.f};
#pragma unroll
    for (int u = 0; u < 8; ++u) {
        u32x4 pw; pw.x = P[2 * u].x; pw.y = P[2 * u].y; pw.z = P[2 * u + 1].x; pw.w = P[2 * u + 1].y;
        const bf16x8 pb = __builtin_bit_cast(bf16x8, pw);
        const int ka = (2 * u) * 16 + 4 * g4 + (lq >> 2), kb = ka + 16;
        LAS unsigned char* va = lds + ka * G::VSTR + (lane & 3) * 8; LAS unsigned char* vb = lds + kb * G::VSTR + (lane & 3) * 8;
#pragma unroll
        for (int dt = 0; dt < G::NDT; ++dt) {
            const s16x4 x = __builtin_amdgcn_ds_read_tr16_b64_v4i16((LAS s16x4*)(va + dt * 32));
            const s16x4 y = __builtin_amdgcn_ds_read_tr16_b64_v4i16((LAS s16x4*)(vb + dt * 32));
            const bf16x8 a = (bf16x8){x[0], x[1], x[2], x[3], y[0], y[1], y[2], y[3]};
            O[dt] = __builtin_amdgcn_mfma_f32_16x16x32_bf16(a, pb, O[dt], 0, 0, 0);
        }
    }
    const float inv = 1.0f / l;
    const bf16_t* zrow = zp + (size_t)qi * PS; bf16_t* arow = ap + (size_t)qi * ACTW;
#pragma unroll
    for (int dt = 0; dt < G::NDT; ++dt) { const u32x2 z = *(const u32x2*)(zrow + dt * 16 + 4 * g4);
        u32x2 o; o.x = cvt_pk_bf16(O[dt][0] * inv * siluf_(bflo(z.x)), O[dt][1] * inv * siluf_(bfhi(z.x))); o.y = cvt_pk_bf16(O[dt][2] * inv * siluf_(bflo(z.y)), O[dt][3] * inv * siluf_(bfhi(z.y)));
        *(u32x2*)(arow + dt * 16 + 4 * g4) = o; }
    __syncthreads();
}

struct Args { const float* in[15]; float* out; unsigned char* ws; int lo, hi; };
enum { I_X = 0, I_MEM, I_NG, I_MNG, I_WIN, I_AQN, I_AKN, I_CW, I_WKV, I_MQN, I_MKN, I_WBA, I_WBC, I_WBM, I_WOUT };
constexpr int NPHASE = 10;

__global__ void __launch_bounds__(NTHR, 2) mega(Args a) {
    extern __shared__ __attribute__((aligned(16))) unsigned char lds_raw[];
    LAS unsigned char* lds = (LAS unsigned char*)lds_raw;
    const int G = gridDim.x, bx = blockIdx.x;
    unsigned char* ws = a.ws;
    bf16_t* WIN = (bf16_t*)(ws + WS_WIN); bf16_t* WKV = (bf16_t*)(ws + WS_WKV); bf16_t* WBR = (bf16_t*)(ws + WS_WBR); bf16_t* WOUT = (bf16_t*)(ws + WS_WOUT);
    bf16_t* MH = (bf16_t*)(ws + WS_MH); bf16_t* MKV = (bf16_t*)(ws + WS_MKV); bf16_t* PROJ = (bf16_t*)(ws + WS_PROJ); bf16_t* OG = (bf16_t*)(ws + WS_OG);
    float* LSE = (float*)(ws + WS_LSE); bf16_t* ACT = (bf16_t*)(ws + WS_ACT); u32x4* GF = (u32x4*)(ws + WS_GF); bf16_t* MB = (bf16_t*)(ws + WS_MB);
    bf16_t* H = (bf16_t*)((unsigned char*)a.out + OUT_H_OFF);

    for (int ph = a.lo; ph < a.hi; ++ph) {
        int tid = threadIdx.x; asm volatile("" : "+v"(tid));
        const int lane = tid & 63, wave = tid >> 6;
        if (ph == 0) {
            rmsnorm_rows(a.in[I_X], a.in[I_NG], H, NTOK, bx * 8 + wave, G * 8, lane);
            rmsnorm_rows(a.in[I_MEM], a.in[I_MNG], MH, 4096, bx * 8 + wave, G * 8, lane);
            constexpr int T0 = 32 * 272, T1 = T0 + 1024, T2 = T1 + 256, T3 = T2 + 512, T4 = T3 + 512, T5 = T4 + 1024;
            for (int tt = bx; tt < T5 * ((REP_MASK & 1) + 1); tt += G) {
                const int t = tt >= T5 ? tt - T5 : tt;
                const float* src; int C, ld, koff, ti; bf16_t* dst;
                if (t < T0) { src = a.in[I_WIN]; C = PC; dst = WIN; ld = DM; koff = 0; ti = t; }
                else if (t < T1) { src = a.in[I_WKV]; C = DM; dst = WKV; ld = DM; koff = 0; ti = t - T0; }
                else if (t < T2) { src = a.in[I_WBA]; C = DM; dst = WBR; ld = ACTW; koff = 0; ti = t - T1; }
                else if (t < T3) { src = a.in[I_WBC]; C = DM; dst = WBR; ld = ACTW; koff = 512; ti = t - T2; }
                else if (t < T4) { src = a.in[I_WBM]; C = DM; dst = WBR; ld = ACTW; koff = 1536; ti = t - T3; }
                else { src = a.in[I_WOUT]; C = DM; dst = WOUT; ld = DM; koff = 0; ti = t - T4; }
                const int nct = C / 64, tr = ti / nct, tc = ti % nct;
                transpose_tile((LAS float*)lds, src, C, tr * 64, tc * 64, dst, ld, koff, tid);
            }
        } else if (ph == 1 || ph == 5 || ph == 4 || ph == 8 || ph == 9) {
            const int nj = (ph == 1 || ph == 5) ? 2 : 1, njr = ((REP_MASK >> ph) & 1) ? 2 * nj : nj;
#pragma unroll 1
            for (int jr = 0; jr < njr; ++jr) {
                const int j = jr >= nj ? jr - nj : jr;
                pg8::Gemm g; pg8::Epi E;
                if (ph == 4 || ph == 8) {
                    g = pg8::Gemm{ACT, WBR, HT, DM, ACTW, ACTW, ACTW}; E = pg8::Epi{5, MB, GF, nullptr, DM, 1 << 20};
                } else if (ph == 1 && j == 0) {
                    g = pg8::Gemm{MH, WKV, 4096, DM, DM, DM, DM}; E = pg8::Epi{0, MKV, nullptr, nullptr, DM, 1 << 20};
                } else if ((ph == 5 && j == 0) || ph == 9) {
                    const size_t ro = (ph == 9) ? (size_t)HT * DM : 0;
                    g = pg8::Gemm{MB, WOUT, HT, DM, DM, DM, DM}; E = pg8::Epi{4, a.out + ro, a.in[I_X] + ro, nullptr, DM, 1 << 20};
                } else {
                    const int half = (ph == 1) ? 0 : 1;
                    g = pg8::Gemm{H + (size_t)half * HT * DM, WIN, HT, PC, DM, DM, DM}; E = pg8::Epi{0, PROJ, nullptr, GF, PS, PS / 256};
                }
                pg8::StaticOrder S; S.init(g.M, g.N, G, bx);
                pg8::gemm_phase(lds, g, S, E, tid);
            }
        } else if (ph == 2 || ph == 6) {
            const int half = (ph == 2) ? 0 : 1;
            for (int it = bx; it < 2048; it += G) {
                const int type = it >> 9, idx = it & 511;
                if (type < 3) {
                    const int g = type, dsh = 2 * g, d = 1 << dsh, nqb = 16 >> dsh;
                    const int qb = idx % nqb; int rest = idx / nqb; const int r = rest % d; rest /= d; const int h = rest & 3, bl = rest >> 2;
                    const size_t row0 = (size_t)bl * SEQ + r;
                    attn_banded_item(lds, PROJ + row0 * PS + g * 512 + h * 128, (size_t)d * PS, qb, a.in[I_AQN] + g * 128, a.in[I_AKN] + g * 128,
                                     OG + row0 * 1536 + g * 512 + h * 128, (size_t)d * 1536, LSE + row0 * 12 + g * 4 + h, (size_t)d * 12, tid);
                } else {
                    const int qb = idx & 15, h = (idx >> 4) & 3, bl = idx >> 6, b = half * 8 + bl;
                    const size_t row0 = (size_t)bl * SEQ + qb * 128;
                    attn_mem_item(lds, PROJ + row0 * PS + C_MQ + h * 256, MKV + (size_t)b * 256 * DM + h * 256, MKV + (size_t)b * 256 * DM + 1024 + h * 256,
                                  a.in[I_MQN], a.in[I_MKN], PROJ + row0 * PS + C_ZM + h * 256, ACT + row0 * ACTW + 1536 + h * 256, tid);
                }
            }
        } else if (ph == 3 || ph == 7) {
            const int gt = bx * NTHR + tid, nth = G * NTHR;
            for (int idx = gt; idx < HT * 64; idx += nth) {
                const int row = idx >> 6, c8 = (idx & 63) * 8, h = c8 >> 7;
                const float l0 = LSE[(size_t)row * 12 + h], l1 = LSE[(size_t)row * 12 + 4 + h], l2 = LSE[(size_t)row * 12 + 8 + h];
                const float m = fmaxf(l0, fmaxf(l1, l2)); float w0 = __expf(l0 - m), w1 = __expf(l1 - m), w2 = __expf(l2 - m); const float inv = 1.0f / (w0 + w1 + w2); w0 *= inv; w1 *= inv; w2 *= inv;
                const u32x4 o0 = *(const u32x4*)(OG + (size_t)row * 1536 + c8), o1 = *(const u32x4*)(OG + (size_t)row * 1536 + 512 + c8), o2 = *(const u32x4*)(OG + (size_t)row * 1536 + 1024 + c8);
                const u32x4 z = *(const u32x4*)(PROJ + (size_t)row * PS + C_ZA + c8);
                u32x4 o;
#define CMB(k) o.k = cvt_pk_bf16((w0 * bflo(o0.k) + w1 * bflo(o1.k) + w2 * bflo(o2.k)) * siluf_(bflo(z.k)), (w0 * bfhi(o0.k) + w1 * bfhi(o1.k) + w2 * bfhi(o2.k)) * siluf_(bfhi(z.k)))
                CMB(x); CMB(y); CMB(z); CMB(w);
#undef CMB
                *(u32x4*)(ACT + (size_t)row * ACTW + c8) = o;
            }
            const float* cw = a.in[I_CW];
            for (int idx = gt; idx < HT * 128; idx += nth) {
                const int row = idx >> 7, c8 = (idx & 127) * 8, t = row & (SEQ - 1);
                const bf16_t* pr = PROJ + (size_t)row * PS;
                const u32x4 z4 = (u32x4){0u, 0u, 0u, 0u};
                const u32x4 c0 = *(const u32x4*)(pr + C_CC + c8), v0 = *(const u32x4*)(pr + C_CV + c8);
                const u32x4 c1 = t >= 1 ? *(const u32x4*)(pr - PS + C_CC + c8) : z4, v1 = t >= 1 ? *(const u32x4*)(pr - PS + C_CV + c8) : z4;
                const u32x4 c2 = t >= 2 ? *(const u32x4*)(pr - 2 * PS + C_CC + c8) : z4, v2 = t >= 2 ? *(const u32x4*)(pr - 2 * PS + C_CV + c8) : z4;
                const u32x4 bb = *(const u32x4*)(pr + C_CB + c8), zz = *(const u32x4*)(pr + C_ZC + c8);
                const float4 wa0 = *(const float4*)(cw + c8), wb0 = *(const float4*)(cw + c8 + 4), wa1 = *(const float4*)(cw + 1024 + c8), wb1 = *(const float4*)(cw + 1024 + c8 + 4), wa2 = *(const float4*)(cw + 2048 + c8), wb2 = *(const float4*)(cw + 2048 + c8 + 4);
                u32x4 o;
#define CV1(f, k, W0, W1, W2) ((W0 * (f(c0.k) * f(v0.k)) + W1 * (f(c1.k) * f(v1.k)) + W2 * (f(c2.k) * f(v2.k))) * f(bb.k) * siluf_(f(zz.k)))
                o.x = cvt_pk_bf16(CV1(bflo, x, wa0.x, wa1.x, wa2.x), CV1(bfhi, x, wa0.y, wa1.y, wa2.y));
                o.y = cvt_pk_bf16(CV1(bflo, y, wa0.z, wa1.z, wa2.z), CV1(bfhi, y, wa0.w, wa1.w, wa2.w));
                o.z = cvt_pk_bf16(CV1(bflo, z, wb0.x, wb1.x, wb2.x), CV1(bfhi, z, wb0.y, wb1.y, wb2.y));
                o.w = cvt_pk_bf16(CV1(bflo, w, wb0.z, wb1.z, wb2.z), CV1(bfhi, w, wb0.w, wb1.w, wb2.w));
#undef CV1
                *(u32x4*)(ACT + (size_t)row * ACTW + 512 + c8) = o;
            }
        }
        if (ph + 1 < a.hi) cg::this_grid().sync();
    }
}

extern "C" void kernel_launch(void* const* d_in, const int* in_sizes, int n_in, void* d_out, int out_size, void* d_ws, size_t ws_size, hipStream_t stream) {
    static int grid = 0;
    if (grid == 0) {
        if (n_in != 15 || ws_size < WS_END) { fprintf(stderr, "kernel_launch: unexpected inputs (n_in %d, ws %zu < %zu)\n", n_in, ws_size, (size_t)WS_END); grid = -1; return; }
        int dev = 0, cus = 0, per_cu = 0;
        hipGetDevice(&dev); hipDeviceGetAttribute(&cus, hipDeviceAttributeMultiprocessorCount, dev);
        if (hipFuncSetAttribute((const void*)mega, hipFuncAttributeMaxDynamicSharedMemorySize, LDS_BYTES) != hipSuccess) { fprintf(stderr, "kernel_launch: hipFuncSetAttribute failed\n"); grid = -1; return; }
        hipOccupancyMaxActiveBlocksPerMultiprocessor(&per_cu, (const void*)mega, NTHR, LDS_BYTES);
        if (per_cu < 1) per_cu = 1;
        grid = cus * 1;
        (void)hipGetLastError();
    }
    if (grid < 0) return;
    Args a{};
    for (int i = 0; i < 15; ++i) a.in[i] = (const float*)d_in[i];
    a.out = (float*)d_out; a.ws = (unsigned char*)d_ws;
#if ONE_LAUNCH
    a.lo = 0; a.hi = NPHASE;
    void* args[] = {&a};
    hipError_t e = hipLaunchCooperativeKernel((const void*)mega, dim3(grid), dim3(NTHR), args, LDS_BYTES, stream);
    if (e != hipSuccess) fprintf(stderr, "cooperative launch failed: %s (grid %d)\n", hipGetErrorString(e), grid);
#else
    for (int ph = 0; ph < NPHASE; ++ph) { a.lo = ph; a.hi = ph + 1; hipLaunchKernelGGL(mega, dim3(grid), dim3(NTHR), LDS_BYTES, stream, a); }
#endif
}
```

```cpp
#include <hip/hip_runtime.h>
#include <hip/hip_cooperative_groups.h>
#include <cstdio>
namespace cg = cooperative_groups;

#ifndef ONE_LAUNCH
#define ONE_LAUNCH 1
#endif

#ifndef REP_MASK
#define REP_MASK 0
#endif
#define LAS __attribute__((address_space(3)))
typedef unsigned short bf16_t;
typedef short bf16x8 __attribute__((ext_vector_type(8)));
typedef short s16x4 __attribute__((ext_vector_type(4)));
typedef float f32x4 __attribute__((ext_vector_type(4)));
typedef unsigned u32x4 __attribute__((ext_vector_type(4)));
typedef unsigned u32x2 __attribute__((ext_vector_type(2)));

constexpr int DM = 2048, SEQ = 2048, NB = 16, NTOK = NB * SEQ;
constexpr int PC = 17408;
constexpr int PS = 11264;
constexpr int HT = NTOK / 2;
constexpr int C_Q = 0, C_K = 1536, C_V = 3072, C_ZA = 4608, C_CB = 5120, C_CC = 6144, C_CV = 7168, C_ZC = 8192, C_MQ = 9216, C_ZM = 10240, C_G = 11264;
constexpr int ACTW = 2560;
constexpr float EPSF = 1e-6f;
constexpr int NTHR = 512;
constexpr int LDS_BYTES = 149504;

constexpr size_t WS_WIN = 0;
constexpr size_t WS_WKV = WS_WIN + (size_t)PC * DM * 2;
constexpr size_t WS_WBR = WS_WKV + (size_t)DM * DM * 2;
constexpr size_t WS_WOUT = WS_WBR + (size_t)DM * ACTW * 2;
constexpr size_t WS_MH = WS_WOUT + (size_t)DM * DM * 2;
constexpr size_t WS_MKV = WS_MH + (size_t)4096 * DM * 2;
constexpr size_t WS_PROJ = WS_MKV + (size_t)4096 * DM * 2;
constexpr size_t WS_OG = WS_PROJ + (size_t)HT * PS * 2;
constexpr size_t WS_LSE = WS_OG + (size_t)HT * 1536 * 2;
constexpr size_t WS_ACT = WS_LSE + (size_t)HT * 12 * 4;
constexpr size_t WS_GF = WS_ACT + (size_t)HT * ACTW * 2;
constexpr size_t WS_MB = WS_GF + (size_t)HT * 6144 * 2;
constexpr size_t WS_END = WS_MB + (size_t)HT * DM * 2;
constexpr size_t OUT_H_OFF = (size_t)HT * DM * 4;

__device__ __forceinline__ float bflo(unsigned w) { return __uint_as_float(w << 16); }
__device__ __forceinline__ float bfhi(unsigned w) { return __uint_as_float(w & 0xffff0000u); }
__device__ __forceinline__ unsigned cvt_pk_bf16(float lo, float hi) { unsigned r; asm volatile("v_cvt_pk_bf16_f32 %0, %1, %2" : "=v"(r) : "v"(lo), "v"(hi)); return r; }
__device__ __forceinline__ float sigmoidf_(float x) { return 1.0f / (1.0f + __expf(-x)); }
__device__ __forceinline__ float siluf_(float x) { return x / (1.0f + __expf(-x)); }

namespace pg8 {
constexpr int BM = 256, BK = 64, HALF = 128, HTB = HALF * BK * 2, STAGE_BYTES = 8 * HTB, NXCD = 8, WGM = 8;
__host__ __device__ __forceinline__ int lds_byte(int r, int c) { const int st = (r >> 4) * 2 + (c >> 5), rr = r & 15, cc = c & 31, ob = rr * 64 + cc * 2; return st * 1024 + (ob ^ (((ob >> 9) & 1) << 5)); }
__host__ __device__ __forceinline__ void stage_rc(int b, int& R, int& C) { const int st = b / 1024, sb = b % 1024, swz = sb ^ (((sb >> 9) & 1) << 5); R = (st >> 1) * 16 + swz / 64; C = (st & 1) * 32 + (swz % 64) / 2; }
__host__ __device__ __forceinline__ int perm32(int rho) { const int n = rho >> 4, i = rho & 15; return 8 * (i >> 2) + 4 * n + (i & 3); }
struct Unit { int pm, pn; };
struct Gemm { const bf16_t* A; const bf16_t* Bt; int M, N, K, lda, ldb; };
struct StaticOrder {
    int nM, nN, nwg, G, c;
    __device__ void init(int M, int N, int G_, int c_) { nM = M / BM; nN = N / BM; nwg = nM * nN; G = G_; c = c_; }
    __device__ bool next(int i, Unit& u) const {
        const long L = (long)i * G + c; if (L >= nwg) return false;
        int wgid = (int)L; { const int q = nwg / NXCD, r = nwg % NXCD, xcd = wgid % NXCD, off = wgid / NXCD; wgid = (xcd < r ? xcd * (q + 1) : r * (q + 1) + (xcd - r) * q) + off; }
        const int nig = WGM * nN, gid = wgid / nig, fm = gid * WGM, gsz = (nM - fm) < WGM ? (nM - fm) : WGM;
        u.pm = fm + ((wgid % nig) % gsz); u.pn = (wgid % nig) / gsz; return true;
    }
};

struct Epi;
template <class Epi, class Sched>
__device__ __forceinline__ void gemm_phase(LAS unsigned char* lds, const Gemm g, const Sched& S, const Epi& E, const int tid) {
    const int wid = __builtin_amdgcn_readfirstlane(tid >> 6), lane = tid & 63, wr = wid >> 2, wc = wid & 3, fr = lane & 15, fq = lane >> 4;
    const int K = g.K, nt = K / BK;
    unsigned voffA[2], voffB[2];
#pragma unroll
    for (int i = 0; i < 2; ++i) { int R, C; stage_rc(tid * 16 + i * 8192, R, C); const int Rb = E.perm() ? ((R & ~31) + perm32(R & 31)) : R;
        voffA[i] = (unsigned)(R * g.lda + C) * 2u; voffB[i] = (unsigned)(Rb * g.ldb + C) * 2u; }
    const size_t kstep = (size_t)(BK * 2);
    const size_t hstepA = (size_t)HALF * g.lda * 2, hstepB = (size_t)HALF * g.ldb * 2;
    const size_t tstepA = 2 * hstepA, tstepB = 2 * hstepB;
    const unsigned ldsw = (unsigned)wid * 1024u;
    const int aoff = lds_byte(wr * 64 + fr, fq * 8), boff = lds_byte(wc * 32 + fr, fq * 8);
#define PG8_SA(b, h) (((b) * 2 + (h)) * HTB)
#define PG8_SB(b, h) ((4 + (b) * 2 + (h)) * HTB)
#define PG8_STAGE(bufoff, gbase, voff) do { _Pragma("unroll") for (int _i = 0; _i < 2; ++_i) \
        __builtin_amdgcn_global_load_lds((const unsigned*)((const char*)(gbase) + (voff)[_i]), (LAS unsigned*)(lds + (bufoff) + ldsw + _i * 8192), 16, 0, 0); } while (0)
#define PG8_LDA(dst, b, h) do { _Pragma("unroll") for (int m = 0; m < 4; ++m) _Pragma("unroll") for (int k = 0; k < 2; ++k) dst[m][k] = *(const LAS bf16x8*)(lds + PG8_SA(b, h) + aoff + m * 2048 + k * 1024); } while (0)
#define PG8_LDB(dst, b, h) do { _Pragma("unroll") for (int n = 0; n < 2; ++n) _Pragma("unroll") for (int k = 0; k < 2; ++k) dst[n][k] = *(const LAS bf16x8*)(lds + PG8_SB(b, h) + boff + n * 2048 + k * 1024); } while (0)
#define PG8_MMA(ai, bj, At, Bt) do { __builtin_amdgcn_s_setprio(1); _Pragma("unroll") for (int m = 0; m < 4; ++m) _Pragma("unroll") for (int n = 0; n < 2; ++n) _Pragma("unroll") for (int k = 0; k < 2; ++k) \
        acc[ai][bj][m][n] = __builtin_amdgcn_mfma_f32_16x16x32_bf16(Bt[n][k], At[m][k], acc[ai][bj][m][n], 0, 0, 0); __builtin_amdgcn_s_setprio(0); } while (0)
#define PG8_WAIT_V(n) asm volatile("s_waitcnt vmcnt(" #n ")" ::: "memory")
#define PG8_WAIT_L(n) asm volatile("s_waitcnt lgkmcnt(" #n ")" ::: "memory")
#define PG8_BAR __builtin_amdgcn_s_barrier()
#define PG8_SCHED __builtin_amdgcn_sched_barrier(0)
    Unit cur, nxt; int ui = 0;
    if (!S.next(0, cur)) return;
    f32x4 acc[2][2][4][2];
#pragma unroll
    for (int a = 0; a < 2; ++a)
#pragma unroll
        for (int b = 0; b < 2; ++b)
#pragma unroll
            for (int m = 0; m < 4; ++m)
#pragma unroll
                for (int n = 0; n < 2; ++n) acc[a][b][m][n] = (f32x4){0.f, 0.f, 0.f, 0.f};
    bf16x8 At[4][2], B0[2][2], B1[2][2];
    const char* cA = (const char*)g.A + (size_t)cur.pm * tstepA; const char* cB = (const char*)g.Bt + (size_t)cur.pn * tstepB;
    PG8_STAGE(PG8_SB(0, 0), cB, voffB); PG8_STAGE(PG8_SA(0, 0), cA, voffA); PG8_STAGE(PG8_SB(0, 1), cB + hstepB, voffB); PG8_STAGE(PG8_SA(0, 1), cA + hstepA, voffA);
    if (wr == 1) PG8_BAR;
    PG8_WAIT_V(4); PG8_BAR;
    PG8_STAGE(PG8_SB(1, 0), cB + kstep, voffB); PG8_STAGE(PG8_SA(1, 0), cA + kstep, voffA); PG8_STAGE(PG8_SB(1, 1), cB + hstepB + kstep, voffB);
    PG8_WAIT_V(6); PG8_BAR;
    for (;;) {
        const bool has_next = S.next(ui + 1, nxt);
        const char* nA = has_next ? (const char*)g.A + (size_t)nxt.pm * tstepA : cA; const char* nB = has_next ? (const char*)g.Bt + (size_t)nxt.pn * tstepB : cB;
        for (int t = 0; t < nt; t += 2) {
            const bool last = (t == nt - 2);
            const char* a1 = cA + (size_t)(t + 1) * kstep;
            const char* a2 = last ? nA : cA + (size_t)(t + 2) * kstep; const char* b2 = last ? nB : cB + (size_t)(t + 2) * kstep;
            const char* a3 = a2 + kstep; const char* b3 = b2 + kstep;
            if (E.has_mid() && (t == 8 || t == 24)) E.mid(acc, cur, tid, t == 8 ? 0 : 1);
            PG8_LDB(B0, 0, 0); PG8_SCHED; PG8_LDA(At, 0, 0); PG8_STAGE(PG8_SA(1, 1), a1 + hstepA, voffA);
            PG8_WAIT_L(8); PG8_BAR; PG8_WAIT_L(0); PG8_MMA(0, 0, At, B0); PG8_BAR; PG8_SCHED;
            PG8_LDB(B1, 0, 1); PG8_STAGE(PG8_SB(0, 0), b2, voffB);
            PG8_BAR; PG8_WAIT_L(0); PG8_MMA(0, 1, At, B1); PG8_BAR;
            PG8_LDA(At, 0, 1); PG8_STAGE(PG8_SA(0, 0), a2, voffA);
            PG8_BAR; PG8_WAIT_L(0); PG8_MMA(1, 0, At, B0); PG8_BAR; PG8_SCHED;
            PG8_STAGE(PG8_SB(0, 1), b2 + hstepB, voffB);
            PG8_WAIT_V(6); PG8_BAR; PG8_MMA(1, 1, At, B1); PG8_BAR;
            PG8_LDB(B0, 1, 0); PG8_SCHED; PG8_LDA(At, 1, 0); PG8_STAGE(PG8_SA(0, 1), a2 + hstepA, voffA);
            PG8_WAIT_L(8); PG8_BAR; PG8_WAIT_L(0); PG8_MMA(0, 0, At, B0); PG8_BAR; PG8_SCHED;
            PG8_LDB(B1, 1, 1); PG8_STAGE(PG8_SB(1, 0), b3, voffB);
            PG8_BAR; PG8_WAIT_L(0); PG8_MMA(0, 1, At, B1); PG8_BAR;
            PG8_LDA(At, 1, 1); PG8_STAGE(PG8_SA(1, 0), a3, voffA);
            PG8_BAR; PG8_WAIT_L(0); PG8_MMA(1, 0, At, B0); PG8_BAR; PG8_SCHED;
            PG8_STAGE(PG8_SB(1, 1), b3 + hstepB, voffB);
            PG8_WAIT_V(6); PG8_BAR; PG8_MMA(1, 1, At, B1); PG8_BAR;
        }
        E(acc, cur, wr, wc, fr, fq, tid);
        if (!has_next) break;
#pragma unroll
        for (int a = 0; a < 2; ++a)
#pragma unroll
            for (int b = 0; b < 2; ++b)
#pragma unroll
                for (int m = 0; m < 4; ++m)
#pragma unroll
                    for (int n = 0; n < 2; ++n) acc[a][b][m][n] = (f32x4){0.f, 0.f, 0.f, 0.f};
        cur = nxt; cA = nA; cB = nB; ++ui;
    }
    PG8_WAIT_V(0);
    if (wr == 0) PG8_BAR;
    PG8_BAR;
#undef PG8_SA
#undef PG8_SB
#undef PG8_STAGE
#undef PG8_LDA
#undef PG8_LDB
#undef PG8_MMA
#undef PG8_WAIT_V
#undef PG8_WAIT_L
#undef PG8_BAR
#undef PG8_SCHED
}

struct Epi {
    int kind; void* p0; const void* p1; void* p2; int ldc, gpn0;
    __device__ __forceinline__ bool perm() const { return kind != 4; }
    __device__ __forceinline__ bool has_mid() const { return kind == 5; }
    __device__ __forceinline__ void mid(f32x4 (&acc)[2][2][4][2], const Unit& u, int tid, int which) const {
        const u32x4* ga = (const u32x4*)p1 + ((size_t)(u.pm * 24 + 8 * which + u.pn) * 16) * 512 + tid; const u32x4* gb = ga + (size_t)8 * 16 * 512;
        u32x4 x[16];
#pragma unroll
        for (int i = 0; i < 16; ++i) x[i] = ga[i * 512];
        asm volatile("s_waitcnt vmcnt(0)" ::: "memory");
#pragma unroll
        for (int i = 0; i < 16; ++i) { const int ai = i >> 3, m = (i >> 1) & 3, bj = i & 1; const u32x4 y = x[i];
            acc[ai][bj][m][0] *= (f32x4){bflo(y.x), bfhi(y.x), bflo(y.y), bfhi(y.y)}; acc[ai][bj][m][1] *= (f32x4){bflo(y.z), bfhi(y.z), bflo(y.w), bfhi(y.w)}; }
        asm volatile("" ::: "memory");
#pragma unroll
        for (int i = 0; i < 16; ++i) x[i] = gb[i * 512];
        asm volatile("s_waitcnt vmcnt(0)" ::: "memory");
#pragma unroll
        for (int i = 0; i < 16; ++i) { const int ai = i >> 3, m = (i >> 1) & 3, bj = i & 1; const u32x4 y = x[i];
            acc[ai][bj][m][0] *= (f32x4){__builtin_amdgcn_rcpf(bflo(y.x)), __builtin_amdgcn_rcpf(bfhi(y.x)), __builtin_amdgcn_rcpf(bflo(y.y)), __builtin_amdgcn_rcpf(bfhi(y.y))};
            acc[ai][bj][m][1] *= (f32x4){__builtin_amdgcn_rcpf(bflo(y.z)), __builtin_amdgcn_rcpf(bfhi(y.z)), __builtin_amdgcn_rcpf(bflo(y.w)), __builtin_amdgcn_rcpf(bfhi(y.w))}; }
    }
    __device__ __forceinline__ void operator()(const f32x4 (&acc)[2][2][4][2], const Unit& u, int wr, int wc, int fr, int fq, int tid) const {
        const int row0 = u.pm * BM + wr * 64 + fr;
        if (kind == 0 && u.pn >= gpn0) {
            u32x4* gf = (u32x4*)p2 + ((size_t)(u.pm * 24 + (u.pn - gpn0)) * 16) * 512 + tid;
#pragma unroll
            for (int ai = 0; ai < 2; ++ai)
#pragma unroll
                for (int m = 0; m < 4; ++m)
#pragma unroll
                    for (int bj = 0; bj < 2; ++bj) { const f32x4 v0 = acc[ai][bj][m][0], v1 = acc[ai][bj][m][1];
                        u32x4 w; w.x = cvt_pk_bf16(sigmoidf_(v0[0]), sigmoidf_(v0[1])); w.y = cvt_pk_bf16(sigmoidf_(v0[2]), sigmoidf_(v0[3])); w.z = cvt_pk_bf16(sigmoidf_(v1[0]), sigmoidf_(v1[1])); w.w = cvt_pk_bf16(sigmoidf_(v1[2]), sigmoidf_(v1[3]));
                        gf[((ai * 4 + m) * 2 + bj) * 512] = w; }
        } else if (kind == 0) {
            bf16_t* O = (bf16_t*)p0; const int col0 = u.pn * BM + wc * 32 + 8 * fq;
#pragma unroll
            for (int ai = 0; ai < 2; ++ai)
#pragma unroll
                for (int m = 0; m < 4; ++m) { bf16_t* rowp = O + (size_t)(row0 + ai * HALF + m * 16) * ldc + col0;
#pragma unroll
                    for (int bj = 0; bj < 2; ++bj) { const f32x4 v0 = acc[ai][bj][m][0], v1 = acc[ai][bj][m][1];
                        u32x4 w; w.x = cvt_pk_bf16(v0[0], v0[1]); w.y = cvt_pk_bf16(v0[2], v0[3]); w.z = cvt_pk_bf16(v1[0], v1[1]); w.w = cvt_pk_bf16(v1[2], v1[3]);
                        *(u32x4*)(rowp + bj * HALF) = w; } }
        } else if (kind == 4) {
            const float* x = (const float*)p1; float* out = (float*)p0; const int col0 = u.pn * BM + wc * 32 + 4 * fq;
#pragma unroll
            for (int am = 0; am < 4; ++am) {
                const int ai = am >> 1, mb = (am & 1) * 2;
                f32x4 xv[2][2][2];
#pragma unroll
                for (int m = 0; m < 2; ++m) { const size_t off = (size_t)(row0 + ai * HALF + (mb + m) * 16) * DM + col0;
#pragma unroll
                    for (int bj = 0; bj < 2; ++bj)
#pragma unroll
                        for (int n = 0; n < 2; ++n) xv[m][bj][n] = *(const f32x4*)(x + off + bj * HALF + n * 16); }
                asm volatile("s_waitcnt vmcnt(0)" ::: "memory");
#pragma unroll
                for (int m = 0; m < 2; ++m) { const size_t off = (size_t)(row0 + ai * HALF + (mb + m) * 16) * DM + col0;
#pragma unroll
                    for (int bj = 0; bj < 2; ++bj)
#pragma unroll
                        for (int n = 0; n < 2; ++n) *(f32x4*)(out + off + bj * HALF + n * 16) = xv[m][bj][n] + acc[ai][bj][mb + m][n]; }
                asm volatile("" ::: "memory");
            }
        } else {
            bf16_t* O = (bf16_t*)p0; const int col0 = u.pn * BM + wc * 32 + 8 * fq;
            const u32x4* gc = (const u32x4*)p1 + ((size_t)(u.pm * 24 + 16 + u.pn) * 16) * 512 + tid;
            u32x4 gy[16];
#pragma unroll
            for (int i = 0; i < 16; ++i) gy[i] = gc[i * 512];
            asm volatile("s_waitcnt vmcnt(0)" ::: "memory");
#pragma unroll
            for (int ai = 0; ai < 2; ++ai)
#pragma unroll
                for (int m = 0; m < 4; ++m) { bf16_t* rowp = O + (size_t)(row0 + ai * HALF + m * 16) * ldc + col0;
#pragma unroll
                    for (int bj = 0; bj < 2; ++bj) { const f32x4 v0 = acc[ai][bj][m][0], v1 = acc[ai][bj][m][1]; const u32x4 y = gy[(ai * 4 + m) * 2 + bj];
                        u32x4 w; w.x = cvt_pk_bf16(v0[0] * bflo(y.x), v0[1] * bfhi(y.x)); w.y = cvt_pk_bf16(v0[2] * bflo(y.y), v0[3] * bfhi(y.y)); w.z = cvt_pk_bf16(v1[0] * bflo(y.z), v1[1] * bfhi(y.z)); w.w = cvt_pk_bf16(v1[2] * bflo(y.w), v1[3] * bfhi(y.w));
                        *(u32x4*)(rowp + bj * HALF) = w; } }
        }
    }
};
}

__device__ __forceinline__ void rmsnorm_rows(const float* __restrict__ x, const float* __restrict__ g, bf16_t* __restrict__ out, int nrows, int gw, int nw, int lane) {
    for (int row = gw; row < nrows; row += nw) {
        const float4* xr = (const float4*)(x + (size_t)row * DM);
        float4 v[8]; float ss = 0.f;
#pragma unroll
        for (int i = 0; i < 4; ++i) { const int c = lane + 64 * i; v[2 * i] = xr[2 * c]; v[2 * i + 1] = xr[2 * c + 1]; }
#pragma unroll
        for (int i = 0; i < 8; ++i) ss += v[i].x * v[i].x + v[i].y * v[i].y + v[i].z * v[i].z + v[i].w * v[i].w;
#pragma unroll
        for (int o = 32; o >= 1; o >>= 1) ss += __shfl_xor(ss, o);
        const float rstd = rsqrtf(ss * (1.0f / DM) + EPSF);
#pragma unroll
        for (int i = 0; i < 4; ++i) { const int c = lane + 64 * i; const float4 ga = ((const float4*)g)[2 * c], gb = ((const float4*)g)[2 * c + 1]; const float4 a = v[2 * i], b = v[2 * i + 1];
            u32x4 w; w.x = cvt_pk_bf16(a.x * rstd * ga.x, a.y * rstd * ga.y); w.y = cvt_pk_bf16(a.z * rstd * ga.z, a.w * rstd * ga.w);
            w.z = cvt_pk_bf16(b.x * rstd * gb.x, b.y * rstd * gb.y); w.w = cvt_pk_bf16(b.z * rstd * gb.z, b.w * rstd * gb.w);
            *(u32x4*)(out + (size_t)row * DM + c * 8) = w; }
    }
}
__device__ __forceinline__ void transpose_tile(LAS float* t, const float* __restrict__ src, int ldsrc, int r0, int c0, bf16_t* __restrict__ dst, int lddst, int koff, int tid) {
#pragma unroll
    for (int pass = 0; pass < 2; ++pass) { const int r = pass * 32 + (tid >> 4), c4 = (tid & 15) * 4; const float4 v = *(const float4*)(src + (size_t)(r0 + r) * ldsrc + c0 + c4);
        t[r * 65 + c4 + 0] = v.x; t[r * 65 + c4 + 1] = v.y; t[r * 65 + c4 + 2] = v.z; t[r * 65 + c4 + 3] = v.w; }
    __syncthreads();
    { const int c = tid >> 3, rc = (tid & 7) * 8; float f[8];
#pragma unroll
        for (int j = 0; j < 8; ++j) f[j] = t[(rc + j) * 65 + c];
        u32x4 w; w.x = cvt_pk_bf16(f[0], f[1]); w.y = cvt_pk_bf16(f[2], f[3]); w.z = cvt_pk_bf16(f[4], f[5]); w.w = cvt_pk_bf16(f[6], f[7]);
        *(u32x4*)(dst + (size_t)(c0 + c) * lddst + koff + r0 + rc) = w; }
    __syncthreads();
}

template <int HD> struct AttnGeo { static constexpr int KSTR = HD * 2 + 16, VSTR = HD * 2 + 32, PPR = HD / 8, NKS = HD / 32, NDT = HD / 16, NPC = 256 * (HD / 8) / NTHR; };

template <int HD> __device__ __forceinline__ void issue_rows(u32x4 (&r)[AttnGeo<HD>::NPC], const bf16_t* __restrict__ p, int stride, int jbase, int tid) {
    typedef AttnGeo<HD> G; constexpr int RS = NTHR / G::PPR;
    const int r0 = tid / G::PPR, pc = tid % G::PPR;
#pragma unroll
    for (int i = 0; i < G::NPC; ++i) { int j = jbase + r0 + i * RS; j = j < 0 ? 0 : j;
        r[i] = *(const u32x4*)(p + ((unsigned)j * (unsigned)stride + (unsigned)(pc * 8))); }
}
template <int HD> __device__ __forceinline__ void issue_q(u32x4 (&q)[AttnGeo<HD>::NKS], const bf16_t* __restrict__ qrow, int g4) {
#pragma unroll
    for (int ks = 0; ks < AttnGeo<HD>::NKS; ++ks) q[ks] = *(const u32x4*)(qrow + ks * 32 + g4 * 8);
}
template <int HD> __device__ __forceinline__ void write_k(LAS unsigned char* kl, const u32x4 (&r)[AttnGeo<HD>::NPC], int jbase, const float* __restrict__ wk, int tid) {
    typedef AttnGeo<HD> G; constexpr int RS = NTHR / G::PPR;
    const int r0 = tid / G::PPR, pc = tid % G::PPR;
    LAS unsigned char* base = kl + r0 * G::KSTR + pc * 16;
    const float4 wa = *(const float4*)(wk + pc * 8), wb = *(const float4*)(wk + pc * 8 + 4);
#pragma unroll
    for (int i = 0; i < G::NPC; ++i) { const u32x4 w = r[i];
        float f[8] = {bflo(w.x), bfhi(w.x), bflo(w.y), bfhi(w.y), bflo(w.z), bfhi(w.z), bflo(w.w), bfhi(w.w)};
        float ss = 0.f;
#pragma unroll
        for (int e = 0; e < 8; ++e) ss += f[e] * f[e];
#pragma unroll
        for (int o = 1; o < G::PPR; o <<= 1) ss += __shfl_xor(ss, o);
        const float rstd = (jbase + r0 + i * RS >= 0) ? rsqrtf(ss * (1.0f / HD) + EPSF) : 0.f;
        u32x4 o4; o4.x = cvt_pk_bf16(f[0] * rstd * wa.x, f[1] * rstd * wa.y); o4.y = cvt_pk_bf16(f[2] * rstd * wa.z, f[3] * rstd * wa.w);
        o4.z = cvt_pk_bf16(f[4] * rstd * wb.x, f[5] * rstd * wb.y); o4.w = cvt_pk_bf16(f[6] * rstd * wb.z, f[7] * rstd * wb.w);
        *(LAS u32x4*)(base + i * (RS * G::KSTR)) = o4;
        if (G::NPC > 8) __builtin_amdgcn_sched_barrier(0); }
}
template <int HD> __device__ __forceinline__ void write_v(LAS unsigned char* vl, const u32x4 (&r)[AttnGeo<HD>::NPC], int jbase, int tid) {
    typedef AttnGeo<HD> G; constexpr int RS = NTHR / G::PPR;
    const int r0 = tid / G::PPR, pc = tid % G::PPR;
    LAS unsigned char* base = vl + r0 * G::VSTR + pc * 16;
#pragma unroll
    for (int i = 0; i < G::NPC; ++i) { const bool ok = jbase + r0 + i * RS >= 0; u32x4 w = r[i];
        w.x = ok ? w.x : 0u; w.y = ok ? w.y : 0u; w.z = ok ? w.z : 0u; w.w = ok ? w.w : 0u;
        *(LAS u32x4*)(base + i * (RS * G::VSTR)) = w; }
}
template <int HD, bool ISK> __device__ __forceinline__ void stage_rows(LAS unsigned char* dst, const bf16_t* __restrict__ p, int stride, const float* __restrict__ wk, int tid) {
    typedef AttnGeo<HD> G; constexpr int RS = NTHR / G::PPR, STR = ISK ? G::KSTR : G::VSTR, NB = 8;
    const int r0 = tid / G::PPR, pc = tid % G::PPR;
    LAS unsigned char* base = dst + r0 * STR + pc * 16;
    float4 wa = make_float4(1.f, 1.f, 1.f, 1.f), wb = wa;
    if (ISK) { wa = *(const float4*)(wk + pc * 8); wb = *(const float4*)(wk + pc * 8 + 4); }
#pragma unroll 1
    for (int i0 = 0; i0 < G::NPC; i0 += NB) {
        u32x4 r[NB];
#pragma unroll
        for (int i = 0; i < NB; ++i) r[i] = *(const u32x4*)(p + ((unsigned)(r0 + (i0 + i) * RS) * (unsigned)stride + (unsigned)(pc * 8)));
#pragma unroll
        for (int i = 0; i < NB; ++i) { u32x4 w = r[i];
            if (ISK) {
                float f[8] = {bflo(w.x), bfhi(w.x), bflo(w.y), bfhi(w.y), bflo(w.z), bfhi(w.z), bflo(w.w), bfhi(w.w)};
                float ss = 0.f;
#pragma unroll
                for (int e = 0; e < 8; ++e) ss += f[e] * f[e];
#pragma unroll
                for (int o = 1; o < G::PPR; o <<= 1) ss += __shfl_xor(ss, o);
                const float rstd = rsqrtf(ss * (1.0f / HD) + EPSF);
                w.x = cvt_pk_bf16(f[0] * rstd * wa.x, f[1] * rstd * wa.y); w.y = cvt_pk_bf16(f[2] * rstd * wa.z, f[3] * rstd * wa.w);
                w.z = cvt_pk_bf16(f[4] * rstd * wb.x, f[5] * rstd * wb.y); w.w = cvt_pk_bf16(f[6] * rstd * wb.z, f[7] * rstd * wb.w);
            }
            *(LAS u32x4*)(base + (i0 + i) * (RS * STR)) = w; }
    }
}
template <int HD> __device__ __forceinline__ void norm_q(bf16x8 (&qf)[AttnGeo<HD>::NKS], const u32x4 (&qw)[AttnGeo<HD>::NKS], const float* __restrict__ wq, float scale, int g4) {
    typedef AttnGeo<HD> G;
    float ss = 0.f;
#pragma unroll
    for (int ks = 0; ks < G::NKS; ++ks) { const u32x4 x = qw[ks]; const float a0 = bflo(x.x), a1 = bfhi(x.x), a2 = bflo(x.y), a3 = bfhi(x.y), a4 = bflo(x.z), a5 = bfhi(x.z), a6 = bflo(x.w), a7 = bfhi(x.w);
        ss += a0 * a0 + a1 * a1 + a2 * a2 + a3 * a3 + a4 * a4 + a5 * a5 + a6 * a6 + a7 * a7; }
    ss += __shfl_xor(ss, 16); ss += __shfl_xor(ss, 32);
    const float sc = rsqrtf(ss * (1.0f / HD) + EPSF) * scale;
#pragma unroll
    for (int ks = 0; ks < G::NKS; ++ks) { const u32x4 x = qw[ks]; const float4 wa = *(const float4*)(wq + ks * 32 + g4 * 8), wb = *(const float4*)(wq + ks * 32 + g4 * 8 + 4);
        u32x4 o; o.x = cvt_pk_bf16(bflo(x.x) * sc * wa.x, bfhi(x.x) * sc * wa.y); o.y = cvt_pk_bf16(bflo(x.y) * sc * wa.z, bfhi(x.y) * sc * wa.w);
        o.z = cvt_pk_bf16(bflo(x.z) * sc * wb.x, bfhi(x.z) * sc * wb.y); o.w = cvt_pk_bf16(bflo(x.w) * sc * wb.z, bfhi(x.w) * sc * wb.w);
        qf[ks] = __builtin_bit_cast(bf16x8, o); }
}

struct BandItem { const bf16_t* qp; int rstride; int qb, g, h; size_t row0; int d; };
__device__ __forceinline__ BandItem band_decode(int it, const bf16_t* PROJ) {
    BandItem I; const int g = it >> 9, idx = it & 511, dsh = 2 * g, d = 1 << dsh, nqb = 16 >> dsh;
    I.qb = idx % nqb; int rest = idx / nqb; const int r = rest % d; rest /= d; I.h = rest & 3; const int bl = rest >> 2;
    I.g = g; I.d = d; I.row0 = (size_t)bl * SEQ + r; I.qp = PROJ + I.row0 * PS + g * 512 + I.h * 128; I.rstride = d * PS; return I;
}
__device__ __forceinline__ void attn_banded_run(LAS unsigned char* lds, const bf16_t* __restrict__ PROJ, const float* __restrict__ aqn, const float* __restrict__ akn, bf16_t* __restrict__ OG, float* __restrict__ LSE,
                                                int bx, int G_, const int tid) {
    constexpr int HD = 128; typedef AttnGeo<HD> G;
    const int w = __builtin_amdgcn_readfirstlane(tid >> 6), lane = tid & 63, lq = lane & 15, g4 = lane >> 4;
    LAS unsigned char* kl = lds; LAS unsigned char* vl = lds + 256 * G::KSTR;
    const int n = (1536 - bx + G_ - 1) / G_;
    if (n <= 0) return;
    u32x4 rk[G::NPC], rv[G::NPC], rq[G::NKS];
    { const BandItem I = band_decode(bx, PROJ); const int jb = I.qb * 128 - 128;
      issue_rows<HD>(rk, I.qp + C_K, I.rstride, jb, tid); issue_rows<HD>(rv, I.qp + C_V, I.rstride, jb, tid); issue_q<HD>(rq, I.qp + (unsigned)(I.qb * 128 + 16 * w + lq) * (unsigned)I.rstride, g4); }
    { unsigned zl = 0u; asm volatile("" : "+v"(zl));
      for (int p = tid; p < 16 * G::PPR; p += NTHR) *(LAS u32x4*)(vl + (256 + p / G::PPR) * G::VSTR + (p % G::PPR) * 16) = (u32x4){zl, zl, zl, zl}; }
#pragma unroll 1
    for (int k = 0; k < n; ++k) {
        const BandItem I = band_decode(bx + k * G_, PROJ);
        const int jbase = I.qb * 128 - 128, qi = I.qb * 128 + 16 * w + lq;
        write_k<HD>(kl, rk, jbase, akn + I.g * 128, tid);
        write_v<HD>(vl, rv, jbase, tid);
        bf16x8 qf[G::NKS];
        norm_q<HD>(qf, rq, aqn + I.g * 128, 0.08838834764831845f * 1.4426950408889634f, g4);
        __syncthreads();
        { const int kn = (k + 1 < n) ? k + 1 : k; const BandItem J = band_decode(bx + kn * G_, PROJ); const int jb = J.qb * 128 - 128;
          issue_rows<HD>(rk, J.qp + C_K, J.rstride, jb, tid); issue_rows<HD>(rv, J.qp + C_V, J.rstride, jb, tid); issue_q<HD>(rq, J.qp + (unsigned)(J.qb * 128 + 16 * w + lq) * (unsigned)J.rstride, g4); }
        f32x4 S[10];
        float NEG = -__builtin_inff(); asm volatile("" : "+v"(NEG));
#pragma unroll
        for (int t = 0; t < 9; ++t) {
            const int kt = w + t;
            if (jbase + kt * 16 >= 0) {
                f32x4 sv = (f32x4){0.f, 0.f, 0.f, 0.f};
#pragma unroll
                for (int ks = 0; ks < G::NKS; ++ks) { const bf16x8 kf = *(const LAS bf16x8*)(kl + (kt * 16 + lq) * G::KSTR + ks * 64 + g4 * 16); sv = __builtin_amdgcn_mfma_f32_16x16x32_bf16(kf, qf[ks], sv, 0, 0, 0); }
                if (t == 0) {
#pragma unroll
                    for (int r = 0; r < 4; ++r) sv[r] = (4 * g4 + r >= lq) ? sv[r] : NEG; }
                if (t == 8) {
#pragma unroll
                    for (int r = 0; r < 4; ++r) sv[r] = (4 * g4 + r <= lq) ? sv[r] : NEG; }
                S[t] = sv;
            } else S[t] = (f32x4){NEG, NEG, NEG, NEG};
        }
        S[9] = (f32x4){NEG, NEG, NEG, NEG};
        float mx = NEG;
#pragma unroll
        for (int t = 0; t < 9; ++t)
#pragma unroll
            for (int r = 0; r < 4; ++r) mx = fmaxf(mx, S[t][r]);
        mx = fmaxf(mx, __shfl_xor(mx, 16)); mx = fmaxf(mx, __shfl_xor(mx, 32));
        float l = 0.f;
#pragma unroll
        for (int t = 0; t < 10; ++t)
#pragma unroll
            for (int r = 0; r < 4; ++r) { const float pv = __builtin_amdgcn_exp2f(S[t][r] - mx); l += pv; S[t][r] = pv; }
        l += __shfl_xor(l, 16); l += __shfl_xor(l, 32);
        f32x4 O[G::NDT];
#pragma unroll
        for (int dt = 0; dt < G::NDT; ++dt) O[dt] = (f32x4){0.f, 0.f, 0.f, 0.f};
#pragma unroll
        for (int u = 0; u < 5; ++u) {
            u32x4 pw; pw.x = cvt_pk_bf16(S[2 * u][0], S[2 * u][1]); pw.y = cvt_pk_bf16(S[2 * u][2], S[2 * u][3]); pw.z = cvt_pk_bf16(S[2 * u + 1][0], S[2 * u + 1][1]); pw.w = cvt_pk_bf16(S[2 * u + 1][2], S[2 * u + 1][3]);
            const bf16x8 pb = __builtin_bit_cast(bf16x8, pw);
            const int ka = (w + 2 * u) * 16 + 4 * g4 + (lq >> 2), kb = ka + 16;
            LAS unsigned char* va = vl + ka * G::VSTR + (lane & 3) * 8; LAS unsigned char* vb = vl + kb * G::VSTR + (lane & 3) * 8;
#pragma unroll
            for (int dt = 0; dt < G::NDT; ++dt) {
                const s16x4 x = __builtin_amdgcn_ds_read_tr16_b64_v4i16((LAS s16x4*)(va + dt * 32));
                const s16x4 y = __builtin_amdgcn_ds_read_tr16_b64_v4i16((LAS s16x4*)(vb + dt * 32));
                const bf16x8 av = (bf16x8){x[0], x[1], x[2], x[3], y[0], y[1], y[2], y[3]};
                O[dt] = __builtin_amdgcn_mfma_f32_16x16x32_bf16(av, pb, O[dt], 0, 0, 0);
            }
        }
        const float inv = 1.0f / l;
        const size_t trow = I.row0 + (size_t)qi * I.d;
        bf16_t* orow = OG + trow * 1536 + I.g * 512 + I.h * 128;
#pragma unroll
        for (int dt = 0; dt < G::NDT; ++dt) { u32x2 o; o.x = cvt_pk_bf16(O[dt][0] * inv, O[dt][1] * inv); o.y = cvt_pk_bf16(O[dt][2] * inv, O[dt][3] * inv); *(u32x2*)(orow + dt * 16 + 4 * g4) = o; }
        if (g4 == 0) LSE[trow * 12 + I.g * 4 + I.h] = (mx + __builtin_amdgcn_logf(l)) * 0.6931471805599453f;
        __syncthreads();
    }
}

__device__ __forceinline__ void attn_mem_run(LAS unsigned char* lds, const bf16_t* __restrict__ PROJ, const bf16_t* __restrict__ MKV, const float* __restrict__ wq, const float* __restrict__ wk, bf16_t* __restrict__ ACT,
                                             int half, int bx, int G_, const int tid) {
    constexpr int HD = 256; typedef AttnGeo<HD> G;
    const int w = __builtin_amdgcn_readfirstlane(tid >> 6), lane = tid & 63, lq = lane & 15, g4 = lane >> 4;
    const int n = (512 - bx + G_ - 1) / G_;
    if (n <= 0) return;
#pragma unroll 1
    for (int k = 0; k < n; ++k) {
        const int idx = bx + k * G_, qb = idx & 15, h = (idx >> 4) & 3, bl = idx >> 6, b = half * 8 + bl;
        const size_t trow = (size_t)bl * SEQ + qb * 128 + 16 * w + lq;
        u32x4 rq[G::NKS];
        issue_q<HD>(rq, PROJ + trow * PS + C_MQ + h * 256, g4);
        stage_rows<HD, true>(lds, MKV + (size_t)b * 256 * DM + h * 256, DM, wk, tid);
        bf16x8 qf[G::NKS];
        norm_q<HD>(qf, rq, wq, 0.0625f * 1.4426950408889634f, g4);
        __syncthreads();
        u32x2 P[16]; float l;
        {
            f32x4 S[16];
#pragma unroll
            for (int t = 0; t < 16; ++t) {
                f32x4 sv = (f32x4){0.f, 0.f, 0.f, 0.f};
#pragma unroll
                for (int ks = 0; ks < G::NKS; ++ks) { const bf16x8 kf = *(const LAS bf16x8*)(lds + (t * 16 + lq) * G::KSTR + ks * 64 + g4 * 16); sv = __builtin_amdgcn_mfma_f32_16x16x32_bf16(kf, qf[ks], sv, 0, 0, 0); }
                S[t] = sv;
            }
            float mx = -__builtin_inff(); asm volatile("" : "+v"(mx));
#pragma unroll
            for (int t = 0; t < 16; ++t)
#pragma unroll
                for (int r = 0; r < 4; ++r) mx = fmaxf(mx, S[t][r]);
            mx = fmaxf(mx, __shfl_xor(mx, 16)); mx = fmaxf(mx, __shfl_xor(mx, 32));
            l = 0.f;
#pragma unroll
            for (int t = 0; t < 16; ++t) { const float p0 = __builtin_amdgcn_exp2f(S[t][0] - mx), p1 = __builtin_amdgcn_exp2f(S[t][1] - mx), p2 = __builtin_amdgcn_exp2f(S[t][2] - mx), p3 = __builtin_amdgcn_exp2f(S[t][3] - mx);
                l += (p0 + p1) + (p2 + p3); P[t].x = cvt_pk_bf16(p0, p1); P[t].y = cvt_pk_bf16(p2, p3); }
            l += __shfl_xor(l, 16); l += __shfl_xor(l, 32);
        }
        __syncthreads();
        stage_rows<HD, false>(lds, MKV + (size_t)b * 256 * DM + 1024 + h * 256, DM, wk, tid);
        __syncthreads();
        f32x4 O[G::NDT];
#pragma unroll
        for (int dt = 0; dt < G::NDT; ++dt) O[dt] = (f32x4){0.f, 0.f, 0.f, 0.f};
#pragma unroll
        for (int u = 0; u < 8; ++u) {
            u32x4 pw; pw.x = P[2 * u].x; pw.y = P[2 * u].y; pw.z = P[2 * u + 1].x; pw.w = P[2 * u + 1].y;
            const bf16x8 pb = __builtin_bit_cast(bf16x8, pw);
            const int ka = (2 * u) * 16 + 4 * g4 + (lq >> 2), kb = ka + 16;
            LAS unsigned char* va = lds + ka * G::VSTR + (lane & 3) * 8; LAS unsigned char* vb = lds + kb * G::VSTR + (lane & 3) * 8;
#pragma unroll
            for (int dt = 0; dt < G::NDT; ++dt) {
                const s16x4 x = __builtin_amdgcn_ds_read_tr16_b64_v4i16((LAS s16x4*)(va + dt * 32));
                const s16x4 y = __builtin_amdgcn_ds_read_tr16_b64_v4i16((LAS s16x4*)(vb + dt * 32));
                const bf16x8 av = (bf16x8){x[0], x[1], x[2], x[3], y[0], y[1], y[2], y[3]};
                O[dt] = __builtin_amdgcn_mfma_f32_16x16x32_bf16(av, pb, O[dt], 0, 0, 0);
            }
        }
        const float inv = 1.0f / l;
        const bf16_t* zrow = PROJ + trow * PS + C_ZM + h * 256; bf16_t* arow = ACT + trow * ACTW + 1536 + h * 256;
#pragma unroll
        for (int dt = 0; dt < G::NDT; ++dt) { const u32x2 z = *(const u32x2*)(zrow + dt * 16 + 4 * g4);
            u32x2 o; o.x = cvt_pk_bf16(O[dt][0] * inv * siluf_(bflo(z.x)), O[dt][1] * inv * siluf_(bfhi(z.x))); o.y = cvt_pk_bf16(O[dt][2] * inv * siluf_(bflo(z.y)), O[dt][3] * inv * siluf_(bfhi(z.y)));
            *(u32x2*)(arow + dt * 16 + 4 * g4) = o; }
        __syncthreads();
    }
}

struct Args { const float* in[15]; float* out; unsigned char* ws; int lo, hi; };
enum { I_X = 0, I_MEM, I_NG, I_MNG, I_WIN, I_AQN, I_AKN, I_CW, I_WKV, I_MQN, I_MKN, I_WBA, I_WBC, I_WBM, I_WOUT };
constexpr int NPHASE = 10;

__global__ void __launch_bounds__(NTHR, 2) mega(Args a) {
    extern __shared__ __attribute__((aligned(16))) unsigned char lds_raw[];
    LAS unsigned char* lds = (LAS unsigned char*)lds_raw;
    const int G = gridDim.x, bx = blockIdx.x, wave_s = __builtin_amdgcn_readfirstlane((int)threadIdx.x >> 6);
    unsigned char* ws = a.ws;
    bf16_t* WIN = (bf16_t*)(ws + WS_WIN); bf16_t* WKV = (bf16_t*)(ws + WS_WKV); bf16_t* WBR = (bf16_t*)(ws + WS_WBR); bf16_t* WOUT = (bf16_t*)(ws + WS_WOUT);
    bf16_t* MH = (bf16_t*)(ws + WS_MH); bf16_t* MKV = (bf16_t*)(ws + WS_MKV); bf16_t* PROJ = (bf16_t*)(ws + WS_PROJ); bf16_t* OG = (bf16_t*)(ws + WS_OG);
    float* LSE = (float*)(ws + WS_LSE); bf16_t* ACT = (bf16_t*)(ws + WS_ACT); u32x4* GF = (u32x4*)(ws + WS_GF); bf16_t* MB = (bf16_t*)(ws + WS_MB);
    bf16_t* H = (bf16_t*)((unsigned char*)a.out + OUT_H_OFF);

    for (int ph = a.lo; ph < a.hi; ++ph) {
        unsigned ones = ~0u; asm volatile("" : "+s"(ones));
        int tid = wave_s * 64 + (int)__builtin_amdgcn_mbcnt_hi(ones, __builtin_amdgcn_mbcnt_lo(ones, 0u)); asm volatile("" : "+v"(tid));
        const int lane = tid & 63, wave = tid >> 6;
        if (ph == 0) {
            rmsnorm_rows(a.in[I_X], a.in[I_NG], H, NTOK, bx * 8 + wave, G * 8, lane);
            rmsnorm_rows(a.in[I_MEM], a.in[I_MNG], MH, 4096, bx * 8 + wave, G * 8, lane);
            constexpr int T0 = 32 * 272, T1 = T0 + 1024, T2 = T1 + 256, T3 = T2 + 512, T4 = T3 + 512, T5 = T4 + 1024;
            for (int tt = bx; tt < T5 * ((REP_MASK & 1) + 1); tt += G) {
                const int t = tt >= T5 ? tt - T5 : tt;
                const float* src; int C, ld, koff, ti; bf16_t* dst;
                if (t < T0) { src = a.in[I_WIN]; C = PC; dst = WIN; ld = DM; koff = 0; ti = t; }
                else if (t < T1) { src = a.in[I_WKV]; C = DM; dst = WKV; ld = DM; koff = 0; ti = t - T0; }
                else if (t < T2) { src = a.in[I_WBA]; C = DM; dst = WBR; ld = ACTW; koff = 0; ti = t - T1; }
                else if (t < T3) { src = a.in[I_WBC]; C = DM; dst = WBR; ld = ACTW; koff = 512; ti = t - T2; }
                else if (t < T4) { src = a.in[I_WBM]; C = DM; dst = WBR; ld = ACTW; koff = 1536; ti = t - T3; }
                else { src = a.in[I_WOUT]; C = DM; dst = WOUT; ld = DM; koff = 0; ti = t - T4; }
                const int nct = C / 64, tr = ti / nct, tc = ti % nct;
                transpose_tile((LAS float*)lds, src, C, tr * 64, tc * 64, dst, ld, koff, tid);
            }
        } else if (ph == 1 || ph == 5 || ph == 4 || ph == 8 || ph == 9) {
            const int nj = (ph == 1 || ph == 5) ? 2 : 1, njr = ((REP_MASK >> ph) & 1) ? 2 * nj : nj;
#pragma unroll 1
            for (int jr = 0; jr < njr; ++jr) {
                const int j = jr >= nj ? jr - nj : jr;
                pg8::Gemm g; pg8::Epi E;
                if (ph == 4 || ph == 8) {
                    g = pg8::Gemm{ACT, WBR, HT, DM, ACTW, ACTW, ACTW}; E = pg8::Epi{5, MB, GF, nullptr, DM, 1 << 20};
                } else if (ph == 1 && j == 0) {
                    g = pg8::Gemm{MH, WKV, 4096, DM, DM, DM, DM}; E = pg8::Epi{0, MKV, nullptr, nullptr, DM, 1 << 20};
                } else if ((ph == 5 && j == 0) || ph == 9) {
                    const size_t ro = (ph == 9) ? (size_t)HT * DM : 0;
                    g = pg8::Gemm{MB, WOUT, HT, DM, DM, DM, DM}; E = pg8::Epi{4, a.out + ro, a.in[I_X] + ro, nullptr, DM, 1 << 20};
                } else {
                    const int half = (ph == 1) ? 0 : 1;
                    g = pg8::Gemm{H + (size_t)half * HT * DM, WIN, HT, PC, DM, DM, DM}; E = pg8::Epi{0, PROJ, nullptr, GF, PS, PS / 256};
                }
                pg8::StaticOrder S; S.init(g.M, g.N, G, bx);
                pg8::gemm_phase(lds, g, S, E, tid);
            }
        } else if (ph == 2 || ph == 6) {
            const int half = (ph == 2) ? 0 : 1;
            attn_banded_run(lds, PROJ, a.in[I_AQN], a.in[I_AKN], OG, LSE, bx, G, tid);
            attn_mem_run(lds, PROJ, MKV, a.in[I_MQN], a.in[I_MKN], ACT, half, bx, G, tid);
        } else if (ph == 3 || ph == 7) {
            const int gt = bx * NTHR + tid, nth = G * NTHR;
            for (int idx = gt; idx < HT * 64; idx += nth) {
                const int row = idx >> 6, c8 = (idx & 63) * 8, h = c8 >> 7;
                const float l0 = LSE[(size_t)row * 12 + h], l1 = LSE[(size_t)row * 12 + 4 + h], l2 = LSE[(size_t)row * 12 + 8 + h];
                const float m = fmaxf(l0, fmaxf(l1, l2)); float w0 = __expf(l0 - m), w1 = __expf(l1 - m), w2 = __expf(l2 - m); const float inv = 1.0f / (w0 + w1 + w2); w0 *= inv; w1 *= inv; w2 *= inv;
                const u32x4 o0 = *(const u32x4*)(OG + (size_t)row * 1536 + c8), o1 = *(const u32x4*)(OG + (size_t)row * 1536 + 512 + c8), o2 = *(const u32x4*)(OG + (size_t)row * 1536 + 1024 + c8);
                const u32x4 z = *(const u32x4*)(PROJ + (size_t)row * PS + C_ZA + c8);
                u32x4 o;
#define CMB(k) o.k = cvt_pk_bf16((w0 * bflo(o0.k) + w1 * bflo(o1.k) + w2 * bflo(o2.k)) * siluf_(bflo(z.k)), (w0 * bfhi(o0.k) + w1 * bfhi(o1.k) + w2 * bfhi(o2.k)) * siluf_(bfhi(z.k)))
                CMB(x); CMB(y); CMB(z); CMB(w);
#undef CMB
                *(u32x4*)(ACT + (size_t)row * ACTW + c8) = o;
            }
            const float* cw = a.in[I_CW];
            for (int idx = gt; idx < HT * 128; idx += nth) {
                const int row = idx >> 7, c8 = (idx & 127) * 8, t = row & (SEQ - 1);
                const bf16_t* pr = PROJ + (size_t)row * PS;
                unsigned zl = 0u; asm volatile("" : "+v"(zl)); const u32x4 z4 = (u32x4){zl, zl, zl, zl};
                const u32x4 c0 = *(const u32x4*)(pr + C_CC + c8), v0 = *(const u32x4*)(pr + C_CV + c8);
                const u32x4 c1 = t >= 1 ? *(const u32x4*)(pr - PS + C_CC + c8) : z4, v1 = t >= 1 ? *(const u32x4*)(pr - PS + C_CV + c8) : z4;
                const u32x4 c2 = t >= 2 ? *(const u32x4*)(pr - 2 * PS + C_CC + c8) : z4, v2 = t >= 2 ? *(const u32x4*)(pr - 2 * PS + C_CV + c8) : z4;
                const u32x4 bb = *(const u32x4*)(pr + C_CB + c8), zz = *(const u32x4*)(pr + C_ZC + c8);
                const float4 wa0 = *(const float4*)(cw + c8), wb0 = *(const float4*)(cw + c8 + 4), wa1 = *(const float4*)(cw + 1024 + c8), wb1 = *(const float4*)(cw + 1024 + c8 + 4), wa2 = *(const float4*)(cw + 2048 + c8), wb2 = *(const float4*)(cw + 2048 + c8 + 4);
                u32x4 o;
#define CV1(f, k, W0, W1, W2) ((W0 * (f(c0.k) * f(v0.k)) + W1 * (f(c1.k) * f(v1.k)) + W2 * (f(c2.k) * f(v2.k))) * f(bb.k) * siluf_(f(zz.k)))
                o.x = cvt_pk_bf16(CV1(bflo, x, wa0.x, wa1.x, wa2.x), CV1(bfhi, x, wa0.y, wa1.y, wa2.y));
                o.y = cvt_pk_bf16(CV1(bflo, y, wa0.z, wa1.z, wa2.z), CV1(bfhi, y, wa0.w, wa1.w, wa2.w));
                o.z = cvt_pk_bf16(CV1(bflo, z, wb0.x, wb1.x, wb2.x), CV1(bfhi, z, wb0.y, wb1.y, wb2.y));
                o.w = cvt_pk_bf16(CV1(bflo, w, wb0.z, wb1.z, wb2.z), CV1(bfhi, w, wb0.w, wb1.w, wb2.w));
#undef CV1
                *(u32x4*)(ACT + (size_t)row * ACTW + 512 + c8) = o;
            }
        }
        if (ph + 1 < a.hi) cg::this_grid().sync();
    }
}

extern "C" void kernel_launch(void* const* d_in, const int* in_sizes, int n_in, void* d_out, int out_size, void* d_ws, size_t ws_size, hipStream_t stream) {
    static int grid = 0;
    if (grid == 0) {
        if (n_in != 15 || ws_size < WS_END) { fprintf(stderr, "kernel_launch: unexpected inputs (n_in %d, ws %zu < %zu)\n", n_in, ws_size, (size_t)WS_END); grid = -1; return; }
        int dev = 0, cus = 0, per_cu = 0;
        hipGetDevice(&dev); hipDeviceGetAttribute(&cus, hipDeviceAttributeMultiprocessorCount, dev);
        if (hipFuncSetAttribute((const void*)mega, hipFuncAttributeMaxDynamicSharedMemorySize, LDS_BYTES) != hipSuccess) { fprintf(stderr, "kernel_launch: hipFuncSetAttribute failed\n"); grid = -1; return; }
        hipOccupancyMaxActiveBlocksPerMultiprocessor(&per_cu, (const void*)mega, NTHR, LDS_BYTES);
        if (per_cu < 1) per_cu = 1;
        grid = cus * 1;
        (void)hipGetLastError();
    }
    if (grid < 0) return;
    Args a{};
    for (int i = 0; i < 15; ++i) a.in[i] = (const float*)d_in[i];
    a.out = (float*)d_out; a.ws = (unsigned char*)d_ws;
#if ONE_LAUNCH
    a.lo = 0; a.hi = NPHASE;
    void* args[] = {&a};
    hipError_t e = hipLaunchCooperativeKernel((const void*)mega, dim3(grid), dim3(NTHR), args, LDS_BYTES, stream);
    if (e != hipSuccess) fprintf(stderr, "cooperative launch failed: %s (grid %d)\n", hipGetErrorString(e), grid);
#else
    for (int ph = 0; ph < NPHASE; ++ph) { a.lo = ph; a.hi = ph + 1; hipLaunchKernelGGL(mega, dim3(grid), dim3(NTHR), LDS_BYTES, stream, a); }
#endif
}
```

```cpp
#include <hip/hip_runtime.h>
#include <hip/hip_cooperative_groups.h>
#include <cstdio>
namespace cg = cooperative_groups;

#ifndef ONE_LAUNCH
#define ONE_LAUNCH 1
#endif

#ifndef REP_MASK
#define REP_MASK 0
#endif
#define REP_BAND 1
#define LAS __attribute__((address_space(3)))
typedef unsigned short bf16_t;
typedef short bf16x8 __attribute__((ext_vector_type(8)));
typedef short s16x4 __attribute__((ext_vector_type(4)));
typedef float f32x4 __attribute__((ext_vector_type(4)));
typedef unsigned u32x4 __attribute__((ext_vector_type(4)));
typedef unsigned u32x2 __attribute__((ext_vector_type(2)));

constexpr int DM = 2048, SEQ = 2048, NB = 16, NTOK = NB * SEQ;
constexpr int PC = 17408;
constexpr int PS = 11264;
constexpr int HT = NTOK / 2;
constexpr int C_Q = 0, C_K = 1536, C_V = 3072, C_ZA = 4608, C_CB = 5120, C_CC = 6144, C_CV = 7168, C_ZC = 8192, C_MQ = 9216, C_ZM = 10240, C_G = 11264;
constexpr int ACTW = 2560;
constexpr int LDP = 2048 + 64;
constexpr float EPSF = 1e-6f;
constexpr int NTHR = 512;
constexpr int LDS_BYTES = 149504;

constexpr size_t WS_WIN = 0;
constexpr size_t WS_WKV = WS_WIN + (size_t)PC * LDP * 2;
constexpr size_t WS_WBR = WS_WKV + (size_t)DM * DM * 2;
constexpr size_t WS_WOUT = WS_WBR + (size_t)DM * ACTW * 2;
constexpr size_t WS_MH = WS_WOUT + (size_t)DM * DM * 2;
constexpr size_t WS_MKV = WS_MH + (size_t)4096 * DM * 2;
constexpr size_t WS_PROJ = WS_MKV + (size_t)4096 * DM * 2;
constexpr size_t WS_OG = WS_PROJ + (size_t)HT * PS * 2;
constexpr size_t WS_LSE = WS_OG + (size_t)HT * 1536 * 2;
constexpr size_t WS_ACT = WS_LSE + (size_t)HT * 12 * 4;
constexpr size_t WS_GF = WS_ACT + (size_t)HT * ACTW * 2;
constexpr size_t WS_MB = WS_GF + (size_t)HT * 6144 * 2;
constexpr size_t WS_H = WS_MB + (size_t)HT * DM * 2;
constexpr size_t WS_END = WS_H + (size_t)NTOK * LDP * 2;
constexpr size_t OUT_H_OFF = (size_t)HT * DM * 4;

__device__ __forceinline__ float bflo(unsigned w) { return __uint_as_float(w << 16); }
__device__ __forceinline__ float bfhi(unsigned w) { return __uint_as_float(w & 0xffff0000u); }
typedef __bf16 bf16x2_t __attribute__((ext_vector_type(2)));
typedef float f32x2_t __attribute__((ext_vector_type(2)));
__device__ __forceinline__ unsigned cvt_pk_bf16(float lo, float hi) { f32x2_t v = {lo, hi}; bf16x2_t b = __builtin_convertvector(v, bf16x2_t); return __builtin_bit_cast(unsigned, b); }
__device__ __forceinline__ float sigmoidf_(float x) { return __builtin_amdgcn_rcpf(1.0f + __builtin_amdgcn_exp2f(x * -1.4426950408889634f)); }
__device__ __forceinline__ float siluf_(float x) { return x * __builtin_amdgcn_rcpf(1.0f + __builtin_amdgcn_exp2f(x * -1.4426950408889634f)); }

namespace pg8 {
constexpr int BM = 256, BK = 64, HALF = 128, HTB = HALF * BK * 2, STAGE_BYTES = 8 * HTB, NXCD = 8, WGM = 8;
__host__ __device__ __forceinline__ int lds_byte(int r, int c) { const int st = (r >> 4) * 2 + (c >> 5), rr = r & 15, cc = c & 31, ob = rr * 64 + cc * 2; return st * 1024 + (ob ^ (((ob >> 9) & 1) << 5)); }
__host__ __device__ __forceinline__ void stage_rc(int b, int& R, int& C) { const int st = b / 1024, sb = b % 1024, swz = sb ^ (((sb >> 9) & 1) << 5); R = (st >> 1) * 16 + swz / 64; C = (st & 1) * 32 + (swz % 64) / 2; }
__host__ __device__ __forceinline__ int perm32(int rho) { const int n = rho >> 4, i = rho & 15; return 8 * (i >> 2) + 4 * n + (i & 3); }
struct Unit { int pm, pn; };
struct Gemm { const bf16_t* A; const bf16_t* Bt; int M, N, K, lda, ldb; };
struct StaticOrder {
    int nM, nN, nwg, G, c;
    __device__ void init(int M, int N, int G_, int c_) { nM = M / BM; nN = N / BM; nwg = nM * nN; G = G_; c = c_; }
    __device__ bool next(int i, Unit& u) const {
        const long L = (long)i * G + c; if (L >= nwg) return false;
        int wgid = (int)L; { const int q = nwg / NXCD, r = nwg % NXCD, xcd = wgid % NXCD, off = wgid / NXCD; wgid = (xcd < r ? xcd * (q + 1) : r * (q + 1) + (xcd - r) * q) + off; }
        const int nig = WGM * nN, gid = wgid / nig, fm = gid * WGM, gsz = (nM - fm) < WGM ? (nM - fm) : WGM;
        u.pm = fm + ((wgid % nig) % gsz); u.pn = (wgid % nig) / gsz; return true;
    }
};

struct Epi;
template <class Epi, class Sched>
__device__ __forceinline__ void gemm_phase(LAS unsigned char* lds, const Gemm g, const Sched& S, const Epi& E, const int tid) {
    const int wid = __builtin_amdgcn_readfirstlane(tid >> 6), lane = tid & 63, wr = wid >> 2, wc = wid & 3, fr = lane & 15, fq = lane >> 4;
    const int K = g.K, nt = K / BK;
    unsigned voffA[2], voffB[2];
#pragma unroll
    for (int i = 0; i < 2; ++i) { int R, C; stage_rc(tid * 16 + i * 8192, R, C); const int Rb = 2 * (R & ~31) + (E.perm() ? perm32(R & 31) : (R & 31));
        voffA[i] = (unsigned)(R * g.lda + C) * 2u; voffB[i] = (unsigned)(Rb * g.ldb + C) * 2u; }
    const size_t kstep = (size_t)(BK * 2);
    const size_t hstepA = (size_t)HALF * g.lda * 2, hstepB = (size_t)32 * g.ldb * 2;
    const size_t tstepA = 2 * hstepA, tstepB = (size_t)BM * g.ldb * 2;
    const unsigned ldsw = (unsigned)wid * 1024u;
    const int aoff = lds_byte(wr * 64 + fr, fq * 8), boff = lds_byte(wc * 32 + fr, fq * 8);
#define PG8_SA(b, h) (((b) * 2 + (h)) * HTB)
#define PG8_SB(b, h) ((4 + (b) * 2 + (h)) * HTB)
#define PG8_STAGE(bufoff, gbase, voff) do { _Pragma("unroll") for (int _i = 0; _i < 2; ++_i) \
        __builtin_amdgcn_global_load_lds((const unsigned*)((const char*)(gbase) + (voff)[_i]), (LAS unsigned*)(lds + (bufoff) + ldsw + _i * 8192), 16, 0, 0); } while (0)
#define PG8_LDA(dst, b, h) do { _Pragma("unroll") for (int m = 0; m < 4; ++m) _Pragma("unroll") for (int k = 0; k < 2; ++k) dst[m][k] = *(const LAS bf16x8*)(lds + PG8_SA(b, h) + aoff + m * 2048 + k * 1024); } while (0)
#define PG8_LDB(dst, b, h) do { _Pragma("unroll") for (int n = 0; n < 2; ++n) _Pragma("unroll") for (int k = 0; k < 2; ++k) dst[n][k] = *(const LAS bf16x8*)(lds + PG8_SB(b, h) + boff + n * 2048 + k * 1024); } while (0)
#define PG8_MMA(ai, bj, At, Bt) do { __builtin_amdgcn_s_setprio(1); _Pragma("unroll") for (int m = 0; m < 4; ++m) _Pragma("unroll") for (int n = 0; n < 2; ++n) _Pragma("unroll") for (int k = 0; k < 2; ++k) \
        acc[ai][bj][m][n] = __builtin_amdgcn_mfma_f32_16x16x32_bf16(Bt[n][k], At[m][k], acc[ai][bj][m][n], 0, 0, 0); __builtin_amdgcn_s_setprio(0); } while (0)
#define PG8_WAIT_V(n) asm volatile("s_waitcnt vmcnt(" #n ")" ::: "memory")
#define PG8_WAIT_L(n) asm volatile("s_waitcnt lgkmcnt(" #n ")" ::: "memory")
#define PG8_BAR __builtin_amdgcn_s_barrier()
#define PG8_SCHED __builtin_amdgcn_sched_barrier(0)
    Unit cur, nxt; int ui = 0;
    if (!S.next(0, cur)) return;
    f32x4 acc[2][2][4][2];
#pragma unroll
    for (int a = 0; a < 2; ++a)
#pragma unroll
        for (int b = 0; b < 2; ++b)
#pragma unroll
            for (int m = 0; m < 4; ++m)
#pragma unroll
                for (int n = 0; n < 2; ++n) acc[a][b][m][n] = (f32x4){0.f, 0.f, 0.f, 0.f};
    bf16x8 At[4][2], B0[2][2], B1[2][2];
    const char* cA = (const char*)g.A + (size_t)cur.pm * tstepA; const char* cB = (const char*)g.Bt + (size_t)cur.pn * tstepB;
    PG8_STAGE(PG8_SB(0, 0), cB, voffB); PG8_STAGE(PG8_SA(0, 0), cA, voffA); PG8_STAGE(PG8_SB(0, 1), cB + hstepB, voffB); PG8_STAGE(PG8_SA(0, 1), cA + hstepA, voffA);
    if (wr == 1) PG8_BAR;
    PG8_WAIT_V(4); PG8_BAR;
    PG8_STAGE(PG8_SB(1, 0), cB + kstep, voffB); PG8_STAGE(PG8_SA(1, 0), cA + kstep, voffA); PG8_STAGE(PG8_SB(1, 1), cB + hstepB + kstep, voffB);
    PG8_WAIT_V(6); PG8_BAR;
    for (;;) {
        const bool has_next = S.next(ui + 1, nxt);
        const char* nA = has_next ? (const char*)g.A + (size_t)nxt.pm * tstepA : cA; const char* nB = has_next ? (const char*)g.Bt + (size_t)nxt.pn * tstepB : cB;
        for (int t = 0; t < nt; t += 2) {
            const bool last = (t == nt - 2);
            const char* a1 = cA + (size_t)(t + 1) * kstep;
            const char* a2 = last ? nA : cA + (size_t)(t + 2) * kstep; const char* b2 = last ? nB : cB + (size_t)(t + 2) * kstep;
            const char* a3 = a2 + kstep; const char* b3 = b2 + kstep;
            if (E.has_mid() && (t == 8 || t == 24)) E.mid(acc, cur, tid, t == 8 ? 0 : 1);
            PG8_LDB(B0, 0, 0); PG8_SCHED; PG8_LDA(At, 0, 0); PG8_STAGE(PG8_SA(1, 1), a1 + hstepA, voffA);
            PG8_WAIT_L(8); PG8_BAR; PG8_WAIT_L(0); PG8_MMA(0, 0, At, B0); PG8_BAR; PG8_SCHED;
            PG8_LDB(B1, 0, 1); PG8_STAGE(PG8_SB(0, 0), b2, voffB);
            PG8_BAR; PG8_WAIT_L(0); PG8_MMA(0, 1, At, B1); PG8_BAR;
            PG8_LDA(At, 0, 1); PG8_STAGE(PG8_SA(0, 0), a2, voffA);
            PG8_BAR; PG8_WAIT_L(0); PG8_MMA(1, 0, At, B0); PG8_BAR; PG8_SCHED;
            PG8_STAGE(PG8_SB(0, 1), b2 + hstepB, voffB);
            PG8_WAIT_V(6); PG8_BAR; PG8_MMA(1, 1, At, B1); PG8_BAR;
            PG8_LDB(B0, 1, 0); PG8_SCHED; PG8_LDA(At, 1, 0); PG8_STAGE(PG8_SA(0, 1), a2 + hstepA, voffA);
            PG8_WAIT_L(8); PG8_BAR; PG8_WAIT_L(0); PG8_MMA(0, 0, At, B0); PG8_BAR; PG8_SCHED;
            PG8_LDB(B1, 1, 1); PG8_STAGE(PG8_SB(1, 0), b3, voffB);
            PG8_BAR; PG8_WAIT_L(0); PG8_MMA(0, 1, At, B1); PG8_BAR;
            PG8_LDA(At, 1, 1); PG8_STAGE(PG8_SA(1, 0), a3, voffA);
            PG8_BAR; PG8_WAIT_L(0); PG8_MMA(1, 0, At, B0); PG8_BAR; PG8_SCHED;
            PG8_STAGE(PG8_SB(1, 1), b3 + hstepB, voffB);
            PG8_WAIT_V(6); PG8_BAR; PG8_MMA(1, 1, At, B1); PG8_BAR;
        }
        E(acc, cur, wr, wc, fr, fq, tid);
        if (!has_next) break;
#pragma unroll
        for (int a = 0; a < 2; ++a)
#pragma unroll
            for (int b = 0; b < 2; ++b)
#pragma unroll
                for (int m = 0; m < 4; ++m)
#pragma unroll
                    for (int n = 0; n < 2; ++n) acc[a][b][m][n] = (f32x4){0.f, 0.f, 0.f, 0.f};
        cur = nxt; cA = nA; cB = nB; ++ui;
    }
    PG8_WAIT_V(0);
    if (wr == 0) PG8_BAR;
    PG8_BAR;
#undef PG8_SA
#undef PG8_SB
#undef PG8_STAGE
#undef PG8_LDA
#undef PG8_LDB
#undef PG8_MMA
#undef PG8_WAIT_V
#undef PG8_WAIT_L
#undef PG8_BAR
#undef PG8_SCHED
}

struct Epi {
    int kind; void* p0; const void* p1; void* p2; int ldc, gpn0;
    __device__ __forceinline__ bool perm() const { return kind != 4; }
    __device__ __forceinline__ bool has_mid() const { return kind == 5; }
    __device__ __forceinline__ void mid(f32x4 (&acc)[2][2][4][2], const Unit& u, int tid, int which) const {
        const u32x4* ga = (const u32x4*)p1 + ((size_t)(u.pm * 24 + 8 * which + u.pn) * 16) * 512 + tid; const u32x4* gb = ga + (size_t)8 * 16 * 512;
        u32x4 x[16];
#pragma unroll
        for (int i = 0; i < 16; ++i) x[i] = ga[i * 512];
        asm volatile("s_waitcnt vmcnt(0)" ::: "memory");
#pragma unroll
        for (int i = 0; i < 16; ++i) { const int ai = i >> 3, m = (i >> 1) & 3, bj = i & 1; const u32x4 y = x[i];
            acc[ai][bj][m][0] *= (f32x4){bflo(y.x), bfhi(y.x), bflo(y.y), bfhi(y.y)}; acc[ai][bj][m][1] *= (f32x4){bflo(y.z), bfhi(y.z), bflo(y.w), bfhi(y.w)}; }
        asm volatile("" ::: "memory");
#pragma unroll
        for (int i = 0; i < 16; ++i) x[i] = gb[i * 512];
        asm volatile("s_waitcnt vmcnt(0)" ::: "memory");
#pragma unroll
        for (int i = 0; i < 16; ++i) { const int ai = i >> 3, m = (i >> 1) & 3, bj = i & 1; const u32x4 y = x[i];
            acc[ai][bj][m][0] *= (f32x4){__builtin_amdgcn_rcpf(bflo(y.x)), __builtin_amdgcn_rcpf(bfhi(y.x)), __builtin_amdgcn_rcpf(bflo(y.y)), __builtin_amdgcn_rcpf(bfhi(y.y))};
            acc[ai][bj][m][1] *= (f32x4){__builtin_amdgcn_rcpf(bflo(y.z)), __builtin_amdgcn_rcpf(bfhi(y.z)), __builtin_amdgcn_rcpf(bflo(y.w)), __builtin_amdgcn_rcpf(bfhi(y.w))}; }
    }
    __device__ __forceinline__ void operator()(const f32x4 (&acc)[2][2][4][2], const Unit& u, int wr, int wc, int fr, int fq, int tid) const {
        const int row0 = u.pm * BM + wr * 64 + fr;
        if (kind == 0 && u.pn >= gpn0) {
            u32x4* gf = (u32x4*)p2 + ((size_t)(u.pm * 24 + (u.pn - gpn0)) * 16) * 512 + tid;
#pragma unroll
            for (int ai = 0; ai < 2; ++ai)
#pragma unroll
                for (int m = 0; m < 4; ++m)
#pragma unroll
                    for (int bj = 0; bj < 2; ++bj) { const f32x4 v0 = acc[ai][bj][m][0], v1 = acc[ai][bj][m][1];
                        u32x4 w; w.x = cvt_pk_bf16(sigmoidf_(v0[0]), sigmoidf_(v0[1])); w.y = cvt_pk_bf16(sigmoidf_(v0[2]), sigmoidf_(v0[3])); w.z = cvt_pk_bf16(sigmoidf_(v1[0]), sigmoidf_(v1[1])); w.w = cvt_pk_bf16(sigmoidf_(v1[2]), sigmoidf_(v1[3]));
                        gf[((ai * 4 + m) * 2 + bj) * 512] = w; }
        } else if (kind == 0) {
            bf16_t* O = (bf16_t*)p0; const int col0 = u.pn * BM + wc * 64 + 8 * fq;
#pragma unroll
            for (int ai = 0; ai < 2; ++ai)
#pragma unroll
                for (int m = 0; m < 4; ++m) { bf16_t* rowp = O + (size_t)(row0 + ai * HALF + m * 16) * ldc + col0;
#pragma unroll
                    for (int bj = 0; bj < 2; ++bj) { const f32x4 v0 = acc[ai][bj][m][0], v1 = acc[ai][bj][m][1];
                        u32x4 w; w.x = cvt_pk_bf16(v0[0], v0[1]); w.y = cvt_pk_bf16(v0[2], v0[3]); w.z = cvt_pk_bf16(v1[0], v1[1]); w.w = cvt_pk_bf16(v1[2], v1[3]);
                        *(u32x4*)(rowp + bj * 32) = w; } }
        } else if (kind == 4) {
            const float* x = (const float*)p1; float* out = (float*)p0; const int col0 = u.pn * BM + wc * 64 + 4 * fq;
#pragma unroll
            for (int am = 0; am < 4; ++am) {
                const int ai = am >> 1, mb = (am & 1) * 2;
                f32x4 xv[2][2][2];
#pragma unroll
                for (int m = 0; m < 2; ++m) { const size_t off = (size_t)(row0 + ai * HALF + (mb + m) * 16) * DM + col0;
#pragma unroll
                    for (int bj = 0; bj < 2; ++bj)
#pragma unroll
                        for (int n = 0; n < 2; ++n) xv[m][bj][n] = *(const f32x4*)(x + off + bj * 32 + n * 16); }
                asm volatile("s_waitcnt vmcnt(0)" ::: "memory");
#pragma unroll
                for (int m = 0; m < 2; ++m) { const size_t off = (size_t)(row0 + ai * HALF + (mb + m) * 16) * DM + col0;
#pragma unroll
                    for (int bj = 0; bj < 2; ++bj)
#pragma unroll
                        for (int n = 0; n < 2; ++n) *(f32x4*)(out + off + bj * 32 + n * 16) = xv[m][bj][n] + acc[ai][bj][mb + m][n]; }
                asm volatile("" ::: "memory");
            }
        } else if (kind == 5) {
            bf16_t* O = (bf16_t*)p0; const int col0 = u.pn * BM + wc * 64 + 8 * fq;
            const u32x4* gc = (const u32x4*)p1 + ((size_t)(u.pm * 24 + 16 + u.pn) * 16) * 512 + tid;
            u32x4 gy[16];
#pragma unroll
            for (int i = 0; i < 16; ++i) gy[i] = gc[i * 512];
            asm volatile("s_waitcnt vmcnt(0)" ::: "memory");
#pragma unroll
            for (int ai = 0; ai < 2; ++ai)
#pragma unroll
                for (int m = 0; m < 4; ++m) { bf16_t* rowp = O + (size_t)(row0 + ai * HALF + m * 16) * ldc + col0;
#pragma unroll
                    for (int bj = 0; bj < 2; ++bj) { const f32x4 v0 = acc[ai][bj][m][0], v1 = acc[ai][bj][m][1]; const u32x4 y = gy[(ai * 4 + m) * 2 + bj];
                        u32x4 w; w.x = cvt_pk_bf16(v0[0] * bflo(y.x), v0[1] * bfhi(y.x)); w.y = cvt_pk_bf16(v0[2] * bflo(y.y), v0[3] * bfhi(y.y)); w.z = cvt_pk_bf16(v1[0] * bflo(y.z), v1[1] * bfhi(y.z)); w.w = cvt_pk_bf16(v1[2] * bflo(y.w), v1[3] * bfhi(y.w));
                        *(u32x4*)(rowp + bj * 32) = w; } }
        }
    }
};
}

__device__ __forceinline__ void rmsnorm_rows(const float* __restrict__ x, const float* __restrict__ g, bf16_t* __restrict__ out, int ldo, int nrows, int gw, int nw, int lane) {
    for (int row = gw; row < nrows; row += nw) {
        const float4* xr = (const float4*)(x + (size_t)row * DM);
        float4 v[8]; float ss = 0.f;
#pragma unroll
        for (int i = 0; i < 4; ++i) { const int c = lane + 64 * i; v[2 * i] = xr[2 * c]; v[2 * i + 1] = xr[2 * c + 1]; }
#pragma unroll
        for (int i = 0; i < 8; ++i) ss += v[i].x * v[i].x + v[i].y * v[i].y + v[i].z * v[i].z + v[i].w * v[i].w;
#pragma unroll
        for (int o = 32; o >= 1; o >>= 1) ss += __shfl_xor(ss, o);
        const float rstd = rsqrtf(ss * (1.0f / DM) + EPSF);
#pragma unroll
        for (int i = 0; i < 4; ++i) { const int c = lane + 64 * i; const float4 ga = ((const float4*)g)[2 * c], gb = ((const float4*)g)[2 * c + 1]; const float4 a = v[2 * i], b = v[2 * i + 1];
            u32x4 w; w.x = cvt_pk_bf16(a.x * rstd * ga.x, a.y * rstd * ga.y); w.y = cvt_pk_bf16(a.z * rstd * ga.z, a.w * rstd * ga.w);
            w.z = cvt_pk_bf16(b.x * rstd * gb.x, b.y * rstd * gb.y); w.w = cvt_pk_bf16(b.z * rstd * gb.z, b.w * rstd * gb.w);
            *(u32x4*)(out + (size_t)row * ldo + c * 8) = w; }
    }
}
struct TJob { const float* src; bf16_t* dst; int C, ld, koff, r0, c0; };
__device__ __forceinline__ void tile_load(float4 (&v)[4], const TJob& J, int tid) {
#pragma unroll
    for (int p = 0; p < 4; ++p) { const int r = p * 16 + (tid >> 5), c4 = (tid & 31) * 4; v[p] = *(const float4*)(J.src + (size_t)(J.r0 + r) * J.C + J.c0 + c4); }
}
__device__ __forceinline__ void tile_store(LAS float* t  , const float4 (&v)[4], const TJob& J, int tid) {
#pragma unroll
    for (int p = 0; p < 4; ++p) { const int r = p * 16 + (tid >> 5), c4 = (tid & 31) * 4; LAS float* q = t + r * 129 + c4; q[0] = v[p].x; q[1] = v[p].y; q[2] = v[p].z; q[3] = v[p].w; }
    __syncthreads();
#pragma unroll
    for (int h = 0; h < 2; ++h) { const int c = h * 64 + (tid >> 3), rc = (tid & 7) * 8; float f[8];
#pragma unroll
        for (int j = 0; j < 8; ++j) f[j] = t[(rc + j) * 129 + c];
        u32x4 w; w.x = cvt_pk_bf16(f[0], f[1]); w.y = cvt_pk_bf16(f[2], f[3]); w.z = cvt_pk_bf16(f[4], f[5]); w.w = cvt_pk_bf16(f[6], f[7]);
        *(u32x4*)(J.dst + (size_t)(J.c0 + c) * J.ld + J.koff + J.r0 + rc) = w; }
    __syncthreads();
}

template <int HD> struct AttnGeo { static constexpr int KSTR = HD * 2 + 16, VSTR = HD * 2 + 32, PPR = HD / 8, NKS = HD / 32, NDT = HD / 16, NPC = 256 * (HD / 8) / NTHR; };

template <int HD> __device__ __forceinline__ void issue_rows(u32x4 (&r)[AttnGeo<HD>::NPC], const bf16_t* __restrict__ p, int stride, int jbase, int tid) {
    typedef AttnGeo<HD> G; constexpr int RS = NTHR / G::PPR;
    const int r0 = tid / G::PPR, pc = tid % G::PPR;
#pragma unroll
    for (int i = 0; i < G::NPC; ++i) { int j = jbase + r0 + i * RS; j = j < 0 ? 0 : j;
        r[i] = *(const u32x4*)(p + ((unsigned)j * (unsigned)stride + (unsigned)(pc * 8))); }
}
template <int HD> __device__ __forceinline__ void issue_q(u32x4 (&q)[AttnGeo<HD>::NKS], const bf16_t* __restrict__ qrow, int g4) {
#pragma unroll
    for (int ks = 0; ks < AttnGeo<HD>::NKS; ++ks) q[ks] = *(const u32x4*)(qrow + ks * 32 + g4 * 8);
}
template <int HD> __device__ __forceinline__ void write_k(LAS unsigned char* kl, const u32x4 (&r)[AttnGeo<HD>::NPC], int jbase, const float* __restrict__ wk, int tid) {
    typedef AttnGeo<HD> G; constexpr int RS = NTHR / G::PPR;
    const int r0 = tid / G::PPR, pc = tid % G::PPR;
    LAS unsigned char* base = kl + r0 * G::KSTR + pc * 16;
    const float4 wa = *(const float4*)(wk + pc * 8), wb = *(const float4*)(wk + pc * 8 + 4);
#pragma unroll
    for (int i = 0; i < G::NPC; ++i) { const u32x4 w = r[i];
        float f[8] = {bflo(w.x), bfhi(w.x), bflo(w.y), bfhi(w.y), bflo(w.z), bfhi(w.z), bflo(w.w), bfhi(w.w)};
        float ss = 0.f;
#pragma unroll
        for (int e = 0; e < 8; ++e) ss += f[e] * f[e];
#pragma unroll
        for (int o = 1; o < G::PPR; o <<= 1) ss += __shfl_xor(ss, o);
        const float rstd = (jbase + r0 + i * RS >= 0) ? rsqrtf(ss * (1.0f / HD) + EPSF) : 0.f;
        u32x4 o4; o4.x = cvt_pk_bf16(f[0] * rstd * wa.x, f[1] * rstd * wa.y); o4.y = cvt_pk_bf16(f[2] * rstd * wa.z, f[3] * rstd * wa.w);
        o4.z = cvt_pk_bf16(f[4] * rstd * wb.x, f[5] * rstd * wb.y); o4.w = cvt_pk_bf16(f[6] * rstd * wb.z, f[7] * rstd * wb.w);
        *(LAS u32x4*)(base + i * (RS * G::KSTR)) = o4;
        if (G::NPC > 8) __builtin_amdgcn_sched_barrier(0); }
}
template <int HD> __device__ __forceinline__ void write_v(LAS unsigned char* vl, const u32x4 (&r)[AttnGeo<HD>::NPC], int jbase, int tid) {
    typedef AttnGeo<HD> G; constexpr int RS = NTHR / G::PPR;
    const int r0 = tid / G::PPR, pc = tid % G::PPR;
    LAS unsigned char* base = vl + r0 * G::VSTR + pc * 16;
#pragma unroll
    for (int i = 0; i < G::NPC; ++i) { const bool ok = jbase + r0 + i * RS >= 0; u32x4 w = r[i];
        w.x = ok ? w.x : 0u; w.y = ok ? w.y : 0u; w.z = ok ? w.z : 0u; w.w = ok ? w.w : 0u;
        *(LAS u32x4*)(base + i * (RS * G::VSTR)) = w; }
}
template <int HD, bool ISK> __device__ __forceinline__ void stage_rows(LAS unsigned char* dst, const bf16_t* __restrict__ p, int stride, const float* __restrict__ wk, int tid) {
    typedef AttnGeo<HD> G; constexpr int RS = NTHR / G::PPR, STR = ISK ? G::KSTR : G::VSTR, NB = 8;
    const int r0 = tid / G::PPR, pc = tid % G::PPR;
    LAS unsigned char* base = dst + r0 * STR + pc * 16;
    float4 wa = make_float4(1.f, 1.f, 1.f, 1.f), wb = wa;
    if (ISK) { wa = *(const float4*)(wk + pc * 8); wb = *(const float4*)(wk + pc * 8 + 4); }
#pragma unroll 1
    for (int i0 = 0; i0 < G::NPC; i0 += NB) {
        u32x4 r[NB];
#pragma unroll
        for (int i = 0; i < NB; ++i) r[i] = *(const u32x4*)(p + ((unsigned)(r0 + (i0 + i) * RS) * (unsigned)stride + (unsigned)(pc * 8)));
#pragma unroll
        for (int i = 0; i < NB; ++i) { u32x4 w = r[i];
            if (ISK) {
                float f[8] = {bflo(w.x), bfhi(w.x), bflo(w.y), bfhi(w.y), bflo(w.z), bfhi(w.z), bflo(w.w), bfhi(w.w)};
                float ss = 0.f;
#pragma unroll
                for (int e = 0; e < 8; ++e) ss += f[e] * f[e];
#pragma unroll
                for (int o = 1; o < G::PPR; o <<= 1) ss += __shfl_xor(ss, o);
                const float rstd = rsqrtf(ss * (1.0f / HD) + EPSF);
                w.x = cvt_pk_bf16(f[0] * rstd * wa.x, f[1] * rstd * wa.y); w.y = cvt_pk_bf16(f[2] * rstd * wa.z, f[3] * rstd * wa.w);
                w.z = cvt_pk_bf16(f[4] * rstd * wb.x, f[5] * rstd * wb.y); w.w = cvt_pk_bf16(f[6] * rstd * wb.z, f[7] * rstd * wb.w);
            }
            *(LAS u32x4*)(base + (i0 + i) * (RS * STR)) = w; }
    }
}
template <int HD> __device__ __forceinline__ void norm_q(bf16x8 (&qf)[AttnGeo<HD>::NKS], const u32x4 (&qw)[AttnGeo<HD>::NKS], const float* __restrict__ wq, float scale, int g4) {
    typedef AttnGeo<HD> G;
    float ss = 0.f;
#pragma unroll
    for (int ks = 0; ks < G::NKS; ++ks) { const u32x4 x = qw[ks]; const float a0 = bflo(x.x), a1 = bfhi(x.x), a2 = bflo(x.y), a3 = bfhi(x.y), a4 = bflo(x.z), a5 = bfhi(x.z), a6 = bflo(x.w), a7 = bfhi(x.w);
        ss += a0 * a0 + a1 * a1 + a2 * a2 + a3 * a3 + a4 * a4 + a5 * a5 + a6 * a6 + a7 * a7; }
    ss += __shfl_xor(ss, 16); ss += __shfl_xor(ss, 32);
    const float sc = rsqrtf(ss * (1.0f / HD) + EPSF) * scale;
#pragma unroll
    for (int ks = 0; ks < G::NKS; ++ks) { const u32x4 x = qw[ks]; const float4 wa = *(const float4*)(wq + ks * 32 + g4 * 8), wb = *(const float4*)(wq + ks * 32 + g4 * 8 + 4);
        u32x4 o; o.x = cvt_pk_bf16(bflo(x.x) * sc * wa.x, bfhi(x.x) * sc * wa.y); o.y = cvt_pk_bf16(bflo(x.y) * sc * wa.z, bfhi(x.y) * sc * wa.w);
        o.z = cvt_pk_bf16(bflo(x.z) * sc * wb.x, bfhi(x.z) * sc * wb.y); o.w = cvt_pk_bf16(bflo(x.w) * sc * wb.z, bfhi(x.w) * sc * wb.w);
        qf[ks] = __builtin_bit_cast(bf16x8, o); }
}

struct BandItem { const bf16_t* qp; int rstride; int qb, g, h; size_t row0; int d; };
__device__ __forceinline__ BandItem band_decode(int it, const bf16_t* PROJ) {
    BandItem I; const int g = it >> 9, idx = it & 511, dsh = 2 * g, d = 1 << dsh, nqb = 16 >> dsh;
    I.qb = idx % nqb; int rest = idx / nqb; const int r = rest % d; rest /= d; I.h = rest & 3; const int bl = rest >> 2;
    I.g = g; I.d = d; I.row0 = (size_t)bl * SEQ + r; I.qp = PROJ + I.row0 * PS + g * 512 + I.h * 128; I.rstride = d * PS; return I;
}
__device__ __forceinline__ void attn_banded_run(LAS unsigned char* lds, const bf16_t* __restrict__ PROJ, const float* __restrict__ aqn, const float* __restrict__ akn, bf16_t* __restrict__ OG, float* __restrict__ LSE,
                                                int bx, int G_, const int tid) {
    constexpr int HD = 128; typedef AttnGeo<HD> G;
    const int w = __builtin_amdgcn_readfirstlane(tid >> 6), lane = tid & 63, lq = lane & 15, g4 = lane >> 4;
    LAS unsigned char* kl = lds; LAS unsigned char* vl = lds + 256 * G::KSTR;
    const int n = (1536 - bx + G_ - 1) / G_;
    if (n <= 0) return;
    u32x4 rk[G::NPC], rv[G::NPC], rq[G::NKS];
    { const BandItem I = band_decode(bx, PROJ); const int jb = I.qb * 128 - 128;
      issue_rows<HD>(rk, I.qp + C_K, I.rstride, jb, tid); issue_rows<HD>(rv, I.qp + C_V, I.rstride, jb, tid); issue_q<HD>(rq, I.qp + (unsigned)(I.qb * 128 + 16 * w + lq) * (unsigned)I.rstride, g4); }
    { unsigned zl = 0u; asm volatile("" : "+v"(zl));
      for (int p = tid; p < 16 * G::PPR; p += NTHR) *(LAS u32x4*)(vl + (256 + p / G::PPR) * G::VSTR + (p % G::PPR) * 16) = (u32x4){zl, zl, zl, zl}; }
#pragma unroll 1
    for (int k = 0; k < n; ++k) {
        const BandItem I = band_decode(bx + k * G_, PROJ);
        const int jbase = I.qb * 128 - 128, qi = I.qb * 128 + 16 * w + lq;
        write_k<HD>(kl, rk, jbase, akn + I.g * 128, tid);
        write_v<HD>(vl, rv, jbase, tid);
        bf16x8 qf[G::NKS];
        norm_q<HD>(qf, rq, aqn + I.g * 128, 0.08838834764831845f * 1.4426950408889634f, g4);
        __syncthreads();
        { const int kn = (k + 1 < n) ? k + 1 : k; const BandItem J = band_decode(bx + kn * G_, PROJ); const int jb = J.qb * 128 - 128;
          issue_rows<HD>(rk, J.qp + C_K, J.rstride, jb, tid); issue_rows<HD>(rv, J.qp + C_V, J.rstride, jb, tid); issue_q<HD>(rq, J.qp + (unsigned)(J.qb * 128 + 16 * w + lq) * (unsigned)J.rstride, g4); }
        f32x4 S[10];
        float NEG = -__builtin_inff(); asm volatile("" : "+v"(NEG));
#pragma unroll
        for (int t = 0; t < 9; ++t) {
            const int kt = w + t;
            if (jbase + kt * 16 >= 0) {
                f32x4 sv = (f32x4){0.f, 0.f, 0.f, 0.f};
#pragma unroll
                for (int ks = 0; ks < G::NKS; ++ks) { const bf16x8 kf = *(const LAS bf16x8*)(kl + (kt * 16 + lq) * G::KSTR + ks * 64 + g4 * 16); sv = __builtin_amdgcn_mfma_f32_16x16x32_bf16(kf, qf[ks], sv, 0, 0, 0); }
                if (t == 0) {
#pragma unroll
                    for (int r = 0; r < 4; ++r) sv[r] = (4 * g4 + r >= lq) ? sv[r] : NEG; }
                if (t == 8) {
#pragma unroll
                    for (int r = 0; r < 4; ++r) sv[r] = (4 * g4 + r <= lq) ? sv[r] : NEG; }
                S[t] = sv;
            } else S[t] = (f32x4){NEG, NEG, NEG, NEG};
        }
        S[9] = (f32x4){NEG, NEG, NEG, NEG};
        float mx = NEG;
#pragma unroll
        for (int t = 0; t < 9; ++t)
#pragma unroll
            for (int r = 0; r < 4; ++r) mx = fmaxf(mx, S[t][r]);
        mx = fmaxf(mx, __shfl_xor(mx, 16)); mx = fmaxf(mx, __shfl_xor(mx, 32));
        float l = 0.f;
#pragma unroll
        for (int t = 0; t < 10; ++t)
#pragma unroll
            for (int r = 0; r < 4; ++r) { const float pv = __builtin_amdgcn_exp2f(S[t][r] - mx); l += pv; S[t][r] = pv; }
        l += __shfl_xor(l, 16); l += __shfl_xor(l, 32);
        f32x4 O[G::NDT];
#pragma unroll
        for (int dt = 0; dt < G::NDT; ++dt) O[dt] = (f32x4){0.f, 0.f, 0.f, 0.f};
#pragma unroll
        for (int u = 0; u < 5; ++u) {
            u32x4 pw; pw.x = cvt_pk_bf16(S[2 * u][0], S[2 * u][1]); pw.y = cvt_pk_bf16(S[2 * u][2], S[2 * u][3]); pw.z = cvt_pk_bf16(S[2 * u + 1][0], S[2 * u + 1][1]); pw.w = cvt_pk_bf16(S[2 * u + 1][2], S[2 * u + 1][3]);
            const bf16x8 pb = __builtin_bit_cast(bf16x8, pw);
            const int ka = (w + 2 * u) * 16 + 4 * g4 + (lq >> 2), kb = ka + 16;
            LAS unsigned char* va = vl + ka * G::VSTR + (lane & 3) * 8; LAS unsigned char* vb = vl + kb * G::VSTR + (lane & 3) * 8;
#pragma unroll
            for (int dt = 0; dt < G::NDT; ++dt) {
                const s16x4 x = __builtin_amdgcn_ds_read_tr16_b64_v4i16((LAS s16x4*)(va + dt * 32));
                const s16x4 y = __builtin_amdgcn_ds_read_tr16_b64_v4i16((LAS s16x4*)(vb + dt * 32));
                const bf16x8 av = (bf16x8){x[0], x[1], x[2], x[3], y[0], y[1], y[2], y[3]};
                O[dt] = __builtin_amdgcn_mfma_f32_16x16x32_bf16(av, pb, O[dt], 0, 0, 0);
            }
        }
        const float inv = 1.0f / l;
        const size_t trow = I.row0 + (size_t)qi * I.d;
        bf16_t* orow = OG + trow * 1536 + I.g * 512 + I.h * 128;
#pragma unroll
        for (int dt = 0; dt < G::NDT; ++dt) { u32x2 o; o.x = cvt_pk_bf16(O[dt][0] * inv, O[dt][1] * inv); o.y = cvt_pk_bf16(O[dt][2] * inv, O[dt][3] * inv); *(u32x2*)(orow + dt * 16 + 4 * g4) = o; }
        if (g4 == 0) LSE[trow * 12 + I.g * 4 + I.h] = (mx + __builtin_amdgcn_logf(l)) * 0.6931471805599453f;
        __syncthreads();
    }
}

__device__ __forceinline__ void attn_mem_run(LAS unsigned char* lds, const bf16_t* __restrict__ PROJ, const bf16_t* __restrict__ MKV, const float* __restrict__ wq, const float* __restrict__ wk, bf16_t* __restrict__ ACT,
                                             int half, int bx, int G_, const int tid) {
    constexpr int HD = 256; typedef AttnGeo<HD> G;
    const int w = __builtin_amdgcn_readfirstlane(tid >> 6), lane = tid & 63, lq = lane & 15, g4 = lane >> 4;
    const int n = (512 - bx + G_ - 1) / G_;
    if (n <= 0) return;
#pragma unroll 1
    for (int k = 0; k < n; ++k) {
        const int idx = bx + k * G_, qb = idx & 15, h = (idx >> 4) & 3, bl = idx >> 6, b = half * 8 + bl;
        const size_t trow = (size_t)bl * SEQ + qb * 128 + 16 * w + lq;
        u32x4 rq[G::NKS];
        issue_q<HD>(rq, PROJ + trow * PS + C_MQ + h * 256, g4);
        stage_rows<HD, true>(lds, MKV + (size_t)b * 256 * DM + h * 256, DM, wk, tid);
        bf16x8 qf[G::NKS];
        norm_q<HD>(qf, rq, wq, 0.0625f * 1.4426950408889634f, g4);
        __syncthreads();
        u32x2 P[16]; float l;
        {
            f32x4 S[16];
#pragma unroll
            for (int t = 0; t < 16; ++t) {
                f32x4 sv = (f32x4){0.f, 0.f, 0.f, 0.f};
#pragma unroll
                for (int ks = 0; ks < G::NKS; ++ks) { const bf16x8 kf = *(const LAS bf16x8*)(lds + (t * 16 + lq) * G::KSTR + ks * 64 + g4 * 16); sv = __builtin_amdgcn_mfma_f32_16x16x32_bf16(kf, qf[ks], sv, 0, 0, 0); }
                S[t] = sv;
            }
            float mx = -__builtin_inff(); asm volatile("" : "+v"(mx));
#pragma unroll
            for (int t = 0; t < 16; ++t)
#pragma unroll
                for (int r = 0; r < 4; ++r) mx = fmaxf(mx, S[t][r]);
            mx = fmaxf(mx, __shfl_xor(mx, 16)); mx = fmaxf(mx, __shfl_xor(mx, 32));
            l = 0.f;
#pragma unroll
            for (int t = 0; t < 16; ++t) { const float p0 = __builtin_amdgcn_exp2f(S[t][0] - mx), p1 = __builtin_amdgcn_exp2f(S[t][1] - mx), p2 = __builtin_amdgcn_exp2f(S[t][2] - mx), p3 = __builtin_amdgcn_exp2f(S[t][3] - mx);
                l += (p0 + p1) + (p2 + p3); P[t].x = cvt_pk_bf16(p0, p1); P[t].y = cvt_pk_bf16(p2, p3); }
            l += __shfl_xor(l, 16); l += __shfl_xor(l, 32);
        }
        __syncthreads();
        stage_rows<HD, false>(lds, MKV + (size_t)b * 256 * DM + 1024 + h * 256, DM, wk, tid);
        __syncthreads();
        f32x4 O[G::NDT];
#pragma unroll
        for (int dt = 0; dt < G::NDT; ++dt) O[dt] = (f32x4){0.f, 0.f, 0.f, 0.f};
#pragma unroll
        for (int u = 0; u < 8; ++u) {
            u32x4 pw; pw.x = P[2 * u].x; pw.y = P[2 * u].y; pw.z = P[2 * u + 1].x; pw.w = P[2 * u + 1].y;
            const bf16x8 pb = __builtin_bit_cast(bf16x8, pw);
            const int ka = (2 * u) * 16 + 4 * g4 + (lq >> 2), kb = ka + 16;
            LAS unsigned char* va = lds + ka * G::VSTR + (lane & 3) * 8; LAS unsigned char* vb = lds + kb * G::VSTR + (lane & 3) * 8;
#pragma unroll
            for (int dt = 0; dt < G::NDT; ++dt) {
                const s16x4 x = __builtin_amdgcn_ds_read_tr16_b64_v4i16((LAS s16x4*)(va + dt * 32));
                const s16x4 y = __builtin_amdgcn_ds_read_tr16_b64_v4i16((LAS s16x4*)(vb + dt * 32));
                const bf16x8 av = (bf16x8){x[0], x[1], x[2], x[3], y[0], y[1], y[2], y[3]};
                O[dt] = __builtin_amdgcn_mfma_f32_16x16x32_bf16(av, pb, O[dt], 0, 0, 0);
            }
        }
        const float inv = 1.0f / l;
        const bf16_t* zrow = PROJ + trow * PS + C_ZM + h * 256; bf16_t* arow = ACT + trow * ACTW + 1536 + h * 256;
#pragma unroll
        for (int dt = 0; dt < G::NDT; ++dt) { const u32x2 z = *(const u32x2*)(zrow + dt * 16 + 4 * g4);
            u32x2 o; o.x = cvt_pk_bf16(O[dt][0] * inv * siluf_(bflo(z.x)), O[dt][1] * inv * siluf_(bfhi(z.x))); o.y = cvt_pk_bf16(O[dt][2] * inv * siluf_(bflo(z.y)), O[dt][3] * inv * siluf_(bfhi(z.y)));
            *(u32x2*)(arow + dt * 16 + 4 * g4) = o; }
        __syncthreads();
    }
}

struct Args { const float* in[15]; float* out; unsigned char* ws; int lo, hi; };
enum { I_X = 0, I_MEM, I_NG, I_MNG, I_WIN, I_AQN, I_AKN, I_CW, I_WKV, I_MQN, I_MKN, I_WBA, I_WBC, I_WBM, I_WOUT };
constexpr int NPHASE = 10;

__global__ void __launch_bounds__(NTHR, 2) mega(Args a) {
    extern __shared__ __attribute__((aligned(16))) unsigned char lds_raw[];
    LAS unsigned char* lds = (LAS unsigned char*)lds_raw;
    const int G = gridDim.x, bx = blockIdx.x, wave_s = __builtin_amdgcn_readfirstlane((int)threadIdx.x >> 6);
    unsigned char* ws = a.ws;
    bf16_t* WIN = (bf16_t*)(ws + WS_WIN); bf16_t* WKV = (bf16_t*)(ws + WS_WKV); bf16_t* WBR = (bf16_t*)(ws + WS_WBR); bf16_t* WOUT = (bf16_t*)(ws + WS_WOUT);
    bf16_t* MH = (bf16_t*)(ws + WS_MH); bf16_t* MKV = (bf16_t*)(ws + WS_MKV); bf16_t* PROJ = (bf16_t*)(ws + WS_PROJ); bf16_t* OG = (bf16_t*)(ws + WS_OG);
    float* LSE = (float*)(ws + WS_LSE); bf16_t* ACT = (bf16_t*)(ws + WS_ACT); u32x4* GF = (u32x4*)(ws + WS_GF); bf16_t* MB = (bf16_t*)(ws + WS_MB);
    bf16_t* H = (bf16_t*)(ws + WS_H);

    for (int ph = a.lo; ph < a.hi; ++ph) {
        unsigned ones = ~0u; asm volatile("" : "+s"(ones));
        int tid = wave_s * 64 + (int)__builtin_amdgcn_mbcnt_hi(ones, __builtin_amdgcn_mbcnt_lo(ones, 0u)); asm volatile("" : "+v"(tid));
        const int lane = tid & 63, wave = tid >> 6;
        if (ph == 0) {
            rmsnorm_rows(a.in[I_X], a.in[I_NG], H, LDP, NTOK, bx * 8 + wave, G * 8, lane);
            rmsnorm_rows(a.in[I_MEM], a.in[I_MNG], MH, DM, 4096, bx * 8 + wave, G * 8, lane);
            constexpr int T0 = 32 * 136, T1 = T0 + 512, T2 = T1 + 128, T3 = T2 + 256, T4 = T3 + 256, T5 = T4 + 512;
            auto job = [&](int t) {
                TJob J; int ti;
                if (t < T0) { J.src = a.in[I_WIN]; J.C = PC; J.dst = WIN; J.ld = LDP; J.koff = 0; ti = t; }
                else if (t < T1) { J.src = a.in[I_WKV]; J.C = DM; J.dst = WKV; J.ld = DM; J.koff = 0; ti = t - T0; }
                else if (t < T2) { J.src = a.in[I_WBA]; J.C = DM; J.dst = WBR; J.ld = ACTW; J.koff = 0; ti = t - T1; }
                else if (t < T3) { J.src = a.in[I_WBC]; J.C = DM; J.dst = WBR; J.ld = ACTW; J.koff = 512; ti = t - T2; }
                else if (t < T4) { J.src = a.in[I_WBM]; J.C = DM; J.dst = WBR; J.ld = ACTW; J.koff = 1536; ti = t - T3; }
                else { J.src = a.in[I_WOUT]; J.C = DM; J.dst = WOUT; J.ld = DM; J.koff = 0; ti = t - T4; }
                const int nct = J.C / 128; J.r0 = (ti / nct) * 64; J.c0 = (ti % nct) * 128; return J;
            };
            if (bx < T5) {
                float4 v[4]; TJob J = job(bx); tile_load(v, J, tid);
#pragma unroll 1
                for (int t = bx; t < T5; t += G) {
                    float4 vn[4]; const int tn = (t + G < T5) ? t + G : t; const TJob Jn = job(tn); tile_load(vn, Jn, tid);
                    tile_store((LAS float*)lds, v, J, tid);
                    J = Jn;
#pragma unroll
                    for (int p = 0; p < 4; ++p) v[p] = vn[p];
                }
            }
        } else if (ph == 1 || ph == 5 || ph == 4 || ph == 8 || ph == 9) {
#ifdef PROBE_NOEPI
            const int nj = (ph == 1 || ph == 5) ? 3 : 1, njr = nj;
#else
            const int nj = (ph == 1 || ph == 5) ? 2 : 1, njr = ((REP_MASK >> ph) & 1) ? 2 * nj : nj;
#endif
#pragma unroll 1
            for (int jr = 0; jr < njr; ++jr) {
                const int j = jr >= nj ? jr - nj : jr;
                pg8::Gemm g; pg8::Epi E;
                if (ph == 4 || ph == 8) {
                    g = pg8::Gemm{ACT, WBR, HT, DM, ACTW, ACTW, ACTW}; E = pg8::Epi{5, MB, GF, nullptr, DM, 1 << 20};
                } else if (ph == 1 && j == 0) {
                    g = pg8::Gemm{MH, WKV, 4096, DM, DM, DM, DM}; E = pg8::Epi{0, MKV, nullptr, nullptr, DM, 1 << 20};
                } else if ((ph == 5 && j == 0) || ph == 9) {
                    const size_t ro = (ph == 9) ? (size_t)HT * DM : 0;
                    g = pg8::Gemm{MB, WOUT, HT, DM, DM, DM, DM}; E = pg8::Epi{4, a.out + ro, a.in[I_X] + ro, nullptr, DM, 1 << 20};
                } else {
                    const int half = (ph == 1) ? 0 : 1;
                    g = pg8::Gemm{H + (size_t)half * HT * LDP, WIN, HT, PC, DM, LDP, LDP}; E = pg8::Epi{0, PROJ, nullptr, GF, PS, PS / 256};
                    if (j == 2) E.kind = 9;
                }
                pg8::StaticOrder S; S.init(g.M, g.N, G, bx);
                pg8::gemm_phase(lds, g, S, E, tid);
            }
        } else if (ph == 2 || ph == 6) {
            const int half = (ph == 2) ? 0 : 1;
#pragma unroll 1
            for (int rep = 0; rep < REP_BAND; ++rep)
            attn_banded_run(lds, PROJ, a.in[I_AQN], a.in[I_AKN], OG, LSE, bx, G, tid);
            attn_mem_run(lds, PROJ, MKV, a.in[I_MQN], a.in[I_MKN], ACT, half, bx, G, tid);
        } else if (ph == 3 || ph == 7) {
            const int gt = bx * NTHR + tid, nth = G * NTHR;
            for (int idx = gt; idx < HT * 64; idx += nth) {
                const int row = idx >> 6, c8 = (idx & 63) * 8, h = c8 >> 7;
                const float l0 = LSE[(size_t)row * 12 + h], l1 = LSE[(size_t)row * 12 + 4 + h], l2 = LSE[(size_t)row * 12 + 8 + h];
                const float m = fmaxf(l0, fmaxf(l1, l2)); float w0 = __expf(l0 - m), w1 = __expf(l1 - m), w2 = __expf(l2 - m); const float inv = 1.0f / (w0 + w1 + w2); w0 *= inv; w1 *= inv; w2 *= inv;
                const u32x4 o0 = *(const u32x4*)(OG + (size_t)row * 1536 + c8), o1 = *(const u32x4*)(OG + (size_t)row * 1536 + 512 + c8), o2 = *(const u32x4*)(OG + (size_t)row * 1536 + 1024 + c8);
                const u32x4 z = *(const u32x4*)(PROJ + (size_t)row * PS + C_ZA + c8);
                u32x4 o;
#define CMB(k) o.k = cvt_pk_bf16((w0 * bflo(o0.k) + w1 * bflo(o1.k) + w2 * bflo(o2.k)) * siluf_(bflo(z.k)), (w0 * bfhi(o0.k) + w1 * bfhi(o1.k) + w2 * bfhi(o2.k)) * siluf_(bfhi(z.k)))
                CMB(x); CMB(y); CMB(z); CMB(w);
#undef CMB
                *(u32x4*)(ACT + (size_t)row * ACTW + c8) = o;
            }
            const float* cw = a.in[I_CW];
            for (int idx = gt; idx < HT * 128; idx += nth) {
                const int row = idx >> 7, c8 = (idx & 127) * 8, t = row & (SEQ - 1);
                const bf16_t* pr = PROJ + (size_t)row * PS;
                unsigned zl = 0u; asm volatile("" : "+v"(zl)); const u32x4 z4 = (u32x4){zl, zl, zl, zl};
                const u32x4 c0 = *(const u32x4*)(pr + C_CC + c8), v0 = *(const u32x4*)(pr + C_CV + c8);
                const u32x4 c1 = t >= 1 ? *(const u32x4*)(pr - PS + C_CC + c8) : z4, v1 = t >= 1 ? *(const u32x4*)(pr - PS + C_CV + c8) : z4;
                const u32x4 c2 = t >= 2 ? *(const u32x4*)(pr - 2 * PS + C_CC + c8) : z4, v2 = t >= 2 ? *(const u32x4*)(pr - 2 * PS + C_CV + c8) : z4;
                const u32x4 bb = *(const u32x4*)(pr + C_CB + c8), zz = *(const u32x4*)(pr + C_ZC + c8);
                const float4 wa0 = *(const float4*)(cw + c8), wb0 = *(const float4*)(cw + c8 + 4), wa1 = *(const float4*)(cw + 1024 + c8), wb1 = *(const float4*)(cw + 1024 + c8 + 4), wa2 = *(const float4*)(cw + 2048 + c8), wb2 = *(const float4*)(cw + 2048 + c8 + 4);
                u32x4 o;
#define CV1(f, k, W0, W1, W2) ((W0 * (f(c0.k) * f(v0.k)) + W1 * (f(c1.k) * f(v1.k)) + W2 * (f(c2.k) * f(v2.k))) * f(bb.k) * siluf_(f(zz.k)))
                o.x = cvt_pk_bf16(CV1(bflo, x, wa0.x, wa1.x, wa2.x), CV1(bfhi, x, wa0.y, wa1.y, wa2.y));
                o.y = cvt_pk_bf16(CV1(bflo, y, wa0.z, wa1.z, wa2.z), CV1(bfhi, y, wa0.w, wa1.w, wa2.w));
                o.z = cvt_pk_bf16(CV1(bflo, z, wb0.x, wb1.x, wb2.x), CV1(bfhi, z, wb0.y, wb1.y, wb2.y));
                o.w = cvt_pk_bf16(CV1(bflo, w, wb0.z, wb1.z, wb2.z), CV1(bfhi, w, wb0.w, wb1.w, wb2.w));
#undef CV1
                *(u32x4*)(ACT + (size_t)row * ACTW + 512 + c8) = o;
            }
        }
        if (ph + 1 < a.hi) cg::this_grid().sync();
    }
}

extern "C" void kernel_launch(void* const* d_in, const int* in_sizes, int n_in, void* d_out, int out_size, void* d_ws, size_t ws_size, hipStream_t stream) {
    static int grid = 0;
    if (grid == 0) {
        if (n_in != 15 || ws_size < WS_END) { fprintf(stderr, "kernel_launch: unexpected inputs (n_in %d, ws %zu < %zu)\n", n_in, ws_size, (size_t)WS_END); grid = -1; return; }
        int dev = 0, cus = 0, per_cu = 0;
        hipGetDevice(&dev); hipDeviceGetAttribute(&cus, hipDeviceAttributeMultiprocessorCount, dev);
        if (hipFuncSetAttribute((const void*)mega, hipFuncAttributeMaxDynamicSharedMemorySize, LDS_BYTES) != hipSuccess) { fprintf(stderr, "kernel_launch: hipFuncSetAttribute failed\n"); grid = -1; return; }
        hipOccupancyMaxActiveBlocksPerMultiprocessor(&per_cu, (const void*)mega, NTHR, LDS_BYTES);
        if (per_cu < 1) per_cu = 1;
        grid = cus * 1;
        (void)hipGetLastError();
    }
    if (grid < 0) return;
    Args a{};
    for (int i = 0; i < 15; ++i) a.in[i] = (const float*)d_in[i];
    a.out = (float*)d_out; a.ws = (unsigned char*)d_ws;
#if ONE_LAUNCH
    a.lo = 0; a.hi = NPHASE;
    void* args[] = {&a};
    hipError_t e = hipLaunchCooperativeKernel((const void*)mega, dim3(grid), dim3(NTHR), args, LDS_BYTES, stream);
    if (e != hipSuccess) fprintf(stderr, "cooperative launch failed: %s (grid %d)\n", hipGetErrorString(e), grid);
#else
    for (int ph = 0; ph < NPHASE; ++ph) { a.lo = ph; a.hi = ph + 1; hipLaunchKernelGGL(mega, dim3(grid), dim3(NTHR), LDS_BYTES, stream, a); }
#endif
}
```

```cpp
#include <hip/hip_runtime.h>
#include <hip/hip_cooperative_groups.h>
#include <cstdio>
namespace cg = cooperative_groups;

#ifndef ONE_LAUNCH
#define ONE_LAUNCH 1
#endif

#ifndef REP_MASK
#define REP_MASK 0
#endif
#define REP_BAND 1
#ifndef PG8_SP2
#define PG8_SP2 1
#endif
#define LAS __attribute__((address_space(3)))
typedef unsigned short bf16_t;
typedef short bf16x8 __attribute__((ext_vector_type(8)));
typedef short s16x4 __attribute__((ext_vector_type(4)));
typedef float f32x4 __attribute__((ext_vector_type(4)));
typedef unsigned u32x4 __attribute__((ext_vector_type(4)));
typedef unsigned u32x2 __attribute__((ext_vector_type(2)));

constexpr int DM = 2048, SEQ = 2048, NB = 16, NTOK = NB * SEQ;
constexpr int PC = 17408;
constexpr int PS = 11264;
constexpr int HT = NTOK / 2;
constexpr int C_Q = 0, C_K = 1536, C_V = 3072, C_ZA = 4608, C_CB = 5120, C_CC = 6144, C_CV = 7168, C_ZC = 8192, C_MQ = 9216, C_ZM = 10240, C_G = 11264;
constexpr int ACTW = 2560;
constexpr int LDP = 2048 + 64;
constexpr float EPSF = 1e-6f;
constexpr int NTHR = 512;
constexpr int LDS_BYTES = 149504;

constexpr size_t WS_WIN = 0;
constexpr size_t WS_WKV = WS_WIN + (size_t)PC * LDP * 2;
constexpr size_t WS_WBR = WS_WKV + (size_t)DM * DM * 2;
constexpr size_t WS_WOUT = WS_WBR + (size_t)DM * ACTW * 2;
constexpr size_t WS_MH = WS_WOUT + (size_t)DM * DM * 2;
constexpr size_t WS_MKV = WS_MH + (size_t)4096 * DM * 2;
constexpr size_t WS_PROJ = WS_MKV + (size_t)4096 * DM * 2;
constexpr size_t WS_OG = WS_PROJ + (size_t)HT * PS * 2;
constexpr size_t WS_LSE = WS_OG + (size_t)HT * 1536 * 2;
constexpr size_t WS_ACT = WS_LSE + (size_t)HT * 12 * 4;
constexpr size_t WS_GF = WS_ACT + (size_t)HT * ACTW * 2;
constexpr size_t WS_MB = WS_GF + (size_t)HT * 6144 * 2;
constexpr size_t WS_H = WS_MB + (size_t)HT * DM * 2;
constexpr size_t WS_END = WS_H + (size_t)NTOK * LDP * 2;
constexpr size_t OUT_H_OFF = (size_t)HT * DM * 4;

__device__ __forceinline__ float bflo(unsigned w) { return __uint_as_float(w << 16); }
__device__ __forceinline__ float bfhi(unsigned w) { return __uint_as_float(w & 0xffff0000u); }
typedef __bf16 bf16x2_t __attribute__((ext_vector_type(2)));
typedef float f32x2_t __attribute__((ext_vector_type(2)));
__device__ __forceinline__ unsigned cvt_pk_bf16(float lo, float hi) { f32x2_t v = {lo, hi}; bf16x2_t b = __builtin_convertvector(v, bf16x2_t); return __builtin_bit_cast(unsigned, b); }
__device__ __forceinline__ float sigmoidf_(float x) { return __builtin_amdgcn_rcpf(1.0f + __builtin_amdgcn_exp2f(x * -1.4426950408889634f)); }
__device__ __forceinline__ float siluf_(float x) { return x * __builtin_amdgcn_rcpf(1.0f + __builtin_amdgcn_exp2f(x * -1.4426950408889634f)); }

namespace pg8 {
constexpr int BM = 256, BK = 64, HALF = 128, HTB = HALF * BK * 2, STAGE_BYTES = 8 * HTB, NXCD = 8, WGM = 8;
__host__ __device__ __forceinline__ int lds_byte(int r, int c) { const int st = (r >> 4) * 2 + (c >> 5), rr = r & 15, cc = c & 31, ob = rr * 64 + cc * 2; return st * 1024 + (ob ^ (((ob >> 9) & 1) << 5)); }
__host__ __device__ __forceinline__ void stage_rc(int b, int& R, int& C) { const int st = b / 1024, sb = b % 1024, swz = sb ^ (((sb >> 9) & 1) << 5); R = (st >> 1) * 16 + swz / 64; C = (st & 1) * 32 + (swz % 64) / 2; }
__host__ __device__ __forceinline__ int perm32(int rho) { const int n = rho >> 4, i = rho & 15; return 8 * (i >> 2) + 4 * n + (i & 3); }
struct Unit { int pm, pn; };
struct Gemm { const bf16_t* A; const bf16_t* Bt; int M, N, K, lda, ldb; };
struct StaticOrder {
    int nM, nN, nwg, G, c;
    __device__ void init(int M, int N, int G_, int c_) { nM = M / BM; nN = N / BM; nwg = nM * nN; G = G_; c = c_; }
    __device__ bool next(int i, Unit& u) const {
        const long L = (long)i * G + c; if (L >= nwg) return false;
        int wgid = (int)L; { const int q = nwg / NXCD, r = nwg % NXCD, xcd = wgid % NXCD, off = wgid / NXCD; wgid = (xcd < r ? xcd * (q + 1) : r * (q + 1) + (xcd - r) * q) + off; }
        const int nig = WGM * nN, gid = wgid / nig, fm = gid * WGM, gsz = (nM - fm) < WGM ? (nM - fm) : WGM;
        u.pm = fm + ((wgid % nig) % gsz); u.pn = (wgid % nig) / gsz; return true;
    }
};

struct Epi;
template <class Epi, class Sched>
__device__ __forceinline__ void gemm_phase(LAS unsigned char* lds, const Gemm g, const Sched& S, const Epi& E, const int tid) {
    const int wid = __builtin_amdgcn_readfirstlane(tid >> 6), lane = tid & 63, wr = wid >> 2, wc = wid & 3, fr = lane & 15, fq = lane >> 4;
    const int K = g.K, nt = K / BK;
    unsigned voffA[2], voffB[2];
#pragma unroll
    for (int i = 0; i < 2; ++i) { int R, C; stage_rc(tid * 16 + i * 8192, R, C); const int Rb = 2 * (R & ~31) + (E.perm() ? perm32(R & 31) : (R & 31));
        voffA[i] = (unsigned)(R * g.lda + C) * 2u; voffB[i] = (unsigned)(Rb * g.ldb + C) * 2u; }
    const size_t kstep = (size_t)(BK * 2);
    const size_t hstepA = (size_t)HALF * g.lda * 2, hstepB = (size_t)32 * g.ldb * 2;
    const size_t tstepA = 2 * hstepA, tstepB = (size_t)BM * g.ldb * 2;
    const unsigned ldsw = (unsigned)wid * 1024u;
    const int aoff = lds_byte(wr * 64 + fr, fq * 8), boff = lds_byte(wc * 32 + fr, fq * 8);
#define PG8_SA(b, h) (((b) * 2 + (h)) * HTB)
#define PG8_SB(b, h) ((4 + (b) * 2 + (h)) * HTB)
#define PG8_STAGE(bufoff, gbase, voff) do { _Pragma("unroll") for (int _i = 0; _i < 2; ++_i) \
        __builtin_amdgcn_global_load_lds((const unsigned*)((const char*)(gbase) + (voff)[_i]), (LAS unsigned*)(lds + (bufoff) + ldsw + _i * 8192), 16, 0, 0); } while (0)
#define PG8_LDA(dst, b, h) do { _Pragma("unroll") for (int m = 0; m < 4; ++m) _Pragma("unroll") for (int k = 0; k < 2; ++k) dst[m][k] = *(const LAS bf16x8*)(lds + PG8_SA(b, h) + aoff + m * 2048 + k * 1024); } while (0)
#define PG8_LDB(dst, b, h) do { _Pragma("unroll") for (int n = 0; n < 2; ++n) _Pragma("unroll") for (int k = 0; k < 2; ++k) dst[n][k] = *(const LAS bf16x8*)(lds + PG8_SB(b, h) + boff + n * 2048 + k * 1024); } while (0)
#define PG8_MMA(ai, bj, At, Bt) do { __builtin_amdgcn_s_setprio(1); _Pragma("unroll") for (int m = 0; m < 4; ++m) _Pragma("unroll") for (int n = 0; n < 2; ++n) _Pragma("unroll") for (int k = 0; k < 2; ++k) \
        acc[ai][bj][m][n] = __builtin_amdgcn_mfma_f32_16x16x32_bf16(Bt[n][k], At[m][k], acc[ai][bj][m][n], 0, 0, 0); __builtin_amdgcn_s_setprio(0); } while (0)
#define PG8_WAIT_V(n) asm volatile("s_waitcnt vmcnt(" #n ")" ::: "memory")
#define PG8_WAIT_L(n) asm volatile("s_waitcnt lgkmcnt(" #n ")" ::: "memory")
#define PG8_BAR __builtin_amdgcn_s_barrier()
#define PG8_SCHED __builtin_amdgcn_sched_barrier(0)
    Unit cur, nxt; int ui = 0;
    if (!S.next(0, cur)) return;
    f32x4 acc[2][2][4][2];
#pragma unroll
    for (int a = 0; a < 2; ++a)
#pragma unroll
        for (int b = 0; b < 2; ++b)
#pragma unroll
            for (int m = 0; m < 4; ++m)
#pragma unroll
                for (int n = 0; n < 2; ++n) acc[a][b][m][n] = (f32x4){0.f, 0.f, 0.f, 0.f};
    bf16x8 At[4][2], B0[2][2], B1[2][2];
    const char* cA = (const char*)g.A + (size_t)cur.pm * tstepA; const char* cB = (const char*)g.Bt + (size_t)cur.pn * tstepB;
#if PG8_SP2
    PG8_STAGE(PG8_SB(0, 0), cB, voffB); PG8_STAGE(PG8_SB(0, 1), cB + hstepB, voffB); PG8_STAGE(PG8_SA(0, 0), cA, voffA); PG8_STAGE(PG8_SA(0, 1), cA + hstepA, voffA);
    if (wr == 1) PG8_BAR;
    PG8_WAIT_V(2); PG8_BAR;
    PG8_STAGE(PG8_SB(1, 0), cB + kstep, voffB); PG8_STAGE(PG8_SA(1, 0), cA + kstep, voffA); PG8_STAGE(PG8_SB(1, 1), cB + hstepB + kstep, voffB);
    PG8_WAIT_V(6); PG8_BAR;
#else
    PG8_STAGE(PG8_SB(0, 0), cB, voffB); PG8_STAGE(PG8_SA(0, 0), cA, voffA); PG8_STAGE(PG8_SB(0, 1), cB + hstepB, voffB); PG8_STAGE(PG8_SA(0, 1), cA + hstepA, voffA);
    if (wr == 1) PG8_BAR;
    PG8_WAIT_V(4); PG8_BAR;
    PG8_STAGE(PG8_SB(1, 0), cB + kstep, voffB); PG8_STAGE(PG8_SA(1, 0), cA + kstep, voffA); PG8_STAGE(PG8_SB(1, 1), cB + hstepB + kstep, voffB);
    PG8_WAIT_V(6); PG8_BAR;
#endif
    for (;;) {
        const bool has_next = S.next(ui + 1, nxt);
        const char* nA = has_next ? (const char*)g.A + (size_t)nxt.pm * tstepA : cA; const char* nB = has_next ? (const char*)g.Bt + (size_t)nxt.pn * tstepB : cB;
        for (int t = 0; t < nt; t += 2) {
            const bool last = (t == nt - 2);
            const char* a1 = cA + (size_t)(t + 1) * kstep;
            const char* a2 = last ? nA : cA + (size_t)(t + 2) * kstep; const char* b2 = last ? nB : cB + (size_t)(t + 2) * kstep;
            const char* a3 = a2 + kstep; const char* b3 = b2 + kstep;
            if (E.has_mid() && (t == 8 || t == 24)) E.mid(acc, cur, tid, t == 8 ? 0 : 1);
#if PG8_SP2
            PG8_LDB(B0, 0, 0); PG8_LDB(B1, 0, 1); PG8_SCHED; PG8_LDA(At, 0, 0); PG8_STAGE(PG8_SA(1, 1), a1 + hstepA, voffA);
            PG8_WAIT_V(8); PG8_WAIT_L(0); PG8_BAR; PG8_MMA(0, 0, At, B0); PG8_MMA(0, 1, At, B1); PG8_BAR; PG8_SCHED;
            PG8_LDA(At, 0, 1); PG8_STAGE(PG8_SB(0, 0), b2, voffB); PG8_STAGE(PG8_SB(0, 1), b2 + hstepB, voffB); PG8_STAGE(PG8_SA(0, 0), a2, voffA);
            PG8_WAIT_V(8); PG8_WAIT_L(0); PG8_BAR; PG8_MMA(1, 0, At, B0); PG8_MMA(1, 1, At, B1); PG8_BAR; PG8_SCHED;
            PG8_LDB(B0, 1, 0); PG8_LDB(B1, 1, 1); PG8_SCHED; PG8_LDA(At, 1, 0); PG8_STAGE(PG8_SA(0, 1), a2 + hstepA, voffA);
            PG8_WAIT_V(8); PG8_WAIT_L(0); PG8_BAR; PG8_MMA(0, 0, At, B0); PG8_MMA(0, 1, At, B1); PG8_BAR; PG8_SCHED;
            PG8_LDA(At, 1, 1); PG8_STAGE(PG8_SB(1, 0), b3, voffB); PG8_STAGE(PG8_SB(1, 1), b3 + hstepB, voffB); PG8_STAGE(PG8_SA(1, 0), a3, voffA);
            PG8_WAIT_V(8); PG8_WAIT_L(0); PG8_BAR; PG8_MMA(1, 0, At, B0); PG8_MMA(1, 1, At, B1); PG8_BAR; PG8_SCHED;
#else
            PG8_LDB(B0, 0, 0); PG8_SCHED; PG8_LDA(At, 0, 0); PG8_STAGE(PG8_SA(1, 1), a1 + hstepA, voffA);
            PG8_WAIT_L(8); PG8_BAR; PG8_WAIT_L(0); PG8_MMA(0, 0, At, B0); PG8_BAR; PG8_SCHED;
            PG8_LDB(B1, 0, 1); PG8_STAGE(PG8_SB(0, 0), b2, voffB);
            PG8_BAR; PG8_WAIT_L(0); PG8_MMA(0, 1, At, B1); PG8_BAR;
            PG8_LDA(At, 0, 1); PG8_STAGE(PG8_SA(0, 0), a2, voffA);
            PG8_BAR; PG8_WAIT_L(0); PG8_MMA(1, 0, At, B0); PG8_BAR; PG8_SCHED;
            PG8_STAGE(PG8_SB(0, 1), b2 + hstepB, voffB);
            PG8_WAIT_V(6); PG8_BAR; PG8_MMA(1, 1, At, B1); PG8_BAR;
            PG8_LDB(B0, 1, 0); PG8_SCHED; PG8_LDA(At, 1, 0); PG8_STAGE(PG8_SA(0, 1), a2 + hstepA, voffA);
            PG8_WAIT_L(8); PG8_BAR; PG8_WAIT_L(0); PG8_MMA(0, 0, At, B0); PG8_BAR; PG8_SCHED;
            PG8_LDB(B1, 1, 1); PG8_STAGE(PG8_SB(1, 0), b3, voffB);
            PG8_BAR; PG8_WAIT_L(0); PG8_MMA(0, 1, At, B1); PG8_BAR;
            PG8_LDA(At, 1, 1); PG8_STAGE(PG8_SA(1, 0), a3, voffA);
            PG8_BAR; PG8_WAIT_L(0); PG8_MMA(1, 0, At, B0); PG8_BAR; PG8_SCHED;
            PG8_STAGE(PG8_SB(1, 1), b3 + hstepB, voffB);
            PG8_WAIT_V(6); PG8_BAR; PG8_MMA(1, 1, At, B1); PG8_BAR;
#endif
        }
        E(acc, cur, wr, wc, fr, fq, tid);
        if (!has_next) break;
#pragma unroll
        for (int a = 0; a < 2; ++a)
#pragma unroll
            for (int b = 0; b < 2; ++b)
#pragma unroll
                for (int m = 0; m < 4; ++m)
#pragma unroll
                    for (int n = 0; n < 2; ++n) acc[a][b][m][n] = (f32x4){0.f, 0.f, 0.f, 0.f};
        cur = nxt; cA = nA; cB = nB; ++ui;
    }
    PG8_WAIT_V(0);
    if (wr == 0) PG8_BAR;
    PG8_BAR;
#undef PG8_SA
#undef PG8_SB
#undef PG8_STAGE
#undef PG8_LDA
#undef PG8_LDB
#undef PG8_MMA
#undef PG8_WAIT_V
#undef PG8_WAIT_L
#undef PG8_BAR
#undef PG8_SCHED
}

struct Epi {
    int kind; void* p0; const void* p1; void* p2; int ldc, gpn0;
    __device__ __forceinline__ bool perm() const { return kind != 4; }
    __device__ __forceinline__ bool has_mid() const { return kind == 5; }
    __device__ __forceinline__ void mid(f32x4 (&acc)[2][2][4][2], const Unit& u, int tid, int which) const {
        const u32x4* ga = (const u32x4*)p1 + ((size_t)(u.pm * 24 + 8 * which + u.pn) * 16) * 512 + tid; const u32x4* gb = ga + (size_t)8 * 16 * 512;
        u32x4 x[16];
#pragma unroll
        for (int i = 0; i < 16; ++i) x[i] = ga[i * 512];
        asm volatile("s_waitcnt vmcnt(0)" ::: "memory");
#pragma unroll
        for (int i = 0; i < 16; ++i) { const int ai = i >> 3, m = (i >> 1) & 3, bj = i & 1; const u32x4 y = x[i];
            acc[ai][bj][m][0] *= (f32x4){bflo(y.x), bfhi(y.x), bflo(y.y), bfhi(y.y)}; acc[ai][bj][m][1] *= (f32x4){bflo(y.z), bfhi(y.z), bflo(y.w), bfhi(y.w)}; }
        asm volatile("" ::: "memory");
#pragma unroll
        for (int i = 0; i < 16; ++i) x[i] = gb[i * 512];
        asm volatile("s_waitcnt vmcnt(0)" ::: "memory");
#pragma unroll
        for (int i = 0; i < 16; ++i) { const int ai = i >> 3, m = (i >> 1) & 3, bj = i & 1; const u32x4 y = x[i];
            acc[ai][bj][m][0] *= (f32x4){__builtin_amdgcn_rcpf(bflo(y.x)), __builtin_amdgcn_rcpf(bfhi(y.x)), __builtin_amdgcn_rcpf(bflo(y.y)), __builtin_amdgcn_rcpf(bfhi(y.y))};
            acc[ai][bj][m][1] *= (f32x4){__builtin_amdgcn_rcpf(bflo(y.z)), __builtin_amdgcn_rcpf(bfhi(y.z)), __builtin_amdgcn_rcpf(bflo(y.w)), __builtin_amdgcn_rcpf(bfhi(y.w))}; }
    }
    __device__ __forceinline__ void operator()(const f32x4 (&acc)[2][2][4][2], const Unit& u, int wr, int wc, int fr, int fq, int tid) const {
        const int row0 = u.pm * BM + wr * 64 + fr;
        if (kind == 0 && u.pn >= gpn0) {
            u32x4* gf = (u32x4*)p2 + ((size_t)(u.pm * 24 + (u.pn - gpn0)) * 16) * 512 + tid;
#pragma unroll
            for (int ai = 0; ai < 2; ++ai)
#pragma unroll
                for (int m = 0; m < 4; ++m)
#pragma unroll
                    for (int bj = 0; bj < 2; ++bj) { const f32x4 v0 = acc[ai][bj][m][0], v1 = acc[ai][bj][m][1];
                        u32x4 w; w.x = cvt_pk_bf16(sigmoidf_(v0[0]), sigmoidf_(v0[1])); w.y = cvt_pk_bf16(sigmoidf_(v0[2]), sigmoidf_(v0[3])); w.z = cvt_pk_bf16(sigmoidf_(v1[0]), sigmoidf_(v1[1])); w.w = cvt_pk_bf16(sigmoidf_(v1[2]), sigmoidf_(v1[3]));
                        gf[((ai * 4 + m) * 2 + bj) * 512] = w; }
        } else if (kind == 0) {
            bf16_t* O = (bf16_t*)p0; const int col0 = u.pn * BM + wc * 64 + 8 * fq;
#pragma unroll
            for (int ai = 0; ai < 2; ++ai)
#pragma unroll
                for (int m = 0; m < 4; ++m) { bf16_t* rowp = O + (size_t)(row0 + ai * HALF + m * 16) * ldc + col0;
#pragma unroll
                    for (int bj = 0; bj < 2; ++bj) { const f32x4 v0 = acc[ai][bj][m][0], v1 = acc[ai][bj][m][1];
                        u32x4 w; w.x = cvt_pk_bf16(v0[0], v0[1]); w.y = cvt_pk_bf16(v0[2], v0[3]); w.z = cvt_pk_bf16(v1[0], v1[1]); w.w = cvt_pk_bf16(v1[2], v1[3]);
                        *(u32x4*)(rowp + bj * 32) = w; } }
        } else if (kind == 4) {
            const float* x = (const float*)p1; float* out = (float*)p0; const int col0 = u.pn * BM + wc * 64 + 4 * fq;
#pragma unroll
            for (int am = 0; am < 4; ++am) {
                const int ai = am >> 1, mb = (am & 1) * 2;
                f32x4 xv[2][2][2];
#pragma unroll
                for (int m = 0; m < 2; ++m) { const size_t off = (size_t)(row0 + ai * HALF + (mb + m) * 16) * DM + col0;
#pragma unroll
                    for (int bj = 0; bj < 2; ++bj)
#pragma unroll
                        for (int n = 0; n < 2; ++n) xv[m][bj][n] = *(const f32x4*)(x + off + bj * 32 + n * 16); }
                asm volatile("s_waitcnt vmcnt(0)" ::: "memory");
#pragma unroll
                for (int m = 0; m < 2; ++m) { const size_t off = (size_t)(row0 + ai * HALF + (mb + m) * 16) * DM + col0;
#pragma unroll
                    for (int bj = 0; bj < 2; ++bj)
#pragma unroll
                        for (int n = 0; n < 2; ++n) *(f32x4*)(out + off + bj * 32 + n * 16) = xv[m][bj][n] + acc[ai][bj][mb + m][n]; }
                asm volatile("" ::: "memory");
            }
        } else if (kind == 5) {
            bf16_t* O = (bf16_t*)p0; const int col0 = u.pn * BM + wc * 64 + 8 * fq;
            const u32x4* gc = (const u32x4*)p1 + ((size_t)(u.pm * 24 + 16 + u.pn) * 16) * 512 + tid;
            u32x4 gy[16];
#pragma unroll
            for (int i = 0; i < 16; ++i) gy[i] = gc[i * 512];
            asm volatile("s_waitcnt vmcnt(0)" ::: "memory");
#pragma unroll
            for (int ai = 0; ai < 2; ++ai)
#pragma unroll
                for (int m = 0; m < 4; ++m) { bf16_t* rowp = O + (size_t)(row0 + ai * HALF + m * 16) * ldc + col0;
#pragma unroll
                    for (int bj = 0; bj < 2; ++bj) { const f32x4 v0 = acc[ai][bj][m][0], v1 = acc[ai][bj][m][1]; const u32x4 y = gy[(ai * 4 + m) * 2 + bj];
                        u32x4 w; w.x = cvt_pk_bf16(v0[0] * bflo(y.x), v0[1] * bfhi(y.x)); w.y = cvt_pk_bf16(v0[2] * bflo(y.y), v0[3] * bfhi(y.y)); w.z = cvt_pk_bf16(v1[0] * bflo(y.z), v1[1] * bfhi(y.z)); w.w = cvt_pk_bf16(v1[2] * bflo(y.w), v1[3] * bfhi(y.w));
                        *(u32x4*)(rowp + bj * 32) = w; } }
        }
    }
};
}

__device__ __forceinline__ void rmsnorm_rows(const float* __restrict__ x, const float* __restrict__ g, bf16_t* __restrict__ out, int ldo, int nrows, int gw, int nw, int lane) {
    for (int row = gw; row < nrows; row += nw) {
        const float4* xr = (const float4*)(x + (size_t)row * DM);
        float4 v[8]; float ss = 0.f;
#pragma unroll
        for (int i = 0; i < 4; ++i) { const int c = lane + 64 * i; v[2 * i] = xr[2 * c]; v[2 * i + 1] = xr[2 * c + 1]; }
#pragma unroll
        for (int i = 0; i < 8; ++i) ss += v[i].x * v[i].x + v[i].y * v[i].y + v[i].z * v[i].z + v[i].w * v[i].w;
#pragma unroll
        for (int o = 32; o >= 1; o >>= 1) ss += __shfl_xor(ss, o);
        const float rstd = rsqrtf(ss * (1.0f / DM) + EPSF);
#pragma unroll
        for (int i = 0; i < 4; ++i) { const int c = lane + 64 * i; const float4 ga = ((const float4*)g)[2 * c], gb = ((const float4*)g)[2 * c + 1]; const float4 a = v[2 * i], b = v[2 * i + 1];
            u32x4 w; w.x = cvt_pk_bf16(a.x * rstd * ga.x, a.y * rstd * ga.y); w.y = cvt_pk_bf16(a.z * rstd * ga.z, a.w * rstd * ga.w);
            w.z = cvt_pk_bf16(b.x * rstd * gb.x, b.y * rstd * gb.y); w.w = cvt_pk_bf16(b.z * rstd * gb.z, b.w * rstd * gb.w);
            *(u32x4*)(out + (size_t)row * ldo + c * 8) = w; }
    }
}
struct TJob { const float* src; bf16_t* dst; int C, ld, koff, r0, c0; };
__device__ __forceinline__ void tile_load(float4 (&v)[4], const TJob& J, int tid) {
#pragma unroll
    for (int p = 0; p < 4; ++p) { const int r = p * 16 + (tid >> 5), c4 = (tid & 31) * 4; v[p] = *(const float4*)(J.src + (size_t)(J.r0 + r) * J.C + J.c0 + c4); }
}
__device__ __forceinline__ void tile_store(LAS float* t  , const float4 (&v)[4], const TJob& J, int tid) {
#pragma unroll
    for (int p = 0; p < 4; ++p) { const int r = p * 16 + (tid >> 5), c4 = (tid & 31) * 4; LAS float* q = t + r * 129 + c4; q[0] = v[p].x; q[1] = v[p].y; q[2] = v[p].z; q[3] = v[p].w; }
    __syncthreads();
#pragma unroll
    for (int h = 0; h < 2; ++h) { const int c = h * 64 + (tid >> 3), rc = (tid & 7) * 8; float f[8];
#pragma unroll
        for (int j = 0; j < 8; ++j) f[j] = t[(rc + j) * 129 + c];
        u32x4 w; w.x = cvt_pk_bf16(f[0], f[1]); w.y = cvt_pk_bf16(f[2], f[3]); w.z = cvt_pk_bf16(f[4], f[5]); w.w = cvt_pk_bf16(f[6], f[7]);
        *(u32x4*)(J.dst + (size_t)(J.c0 + c) * J.ld + J.koff + J.r0 + rc) = w; }
    __syncthreads();
}

template <int HD> struct AttnGeo { static constexpr int KSTR = HD * 2 + 16, VSTR = HD * 2 + 32, PPR = HD / 8, NKS = HD / 32, NDT = HD / 16, NPC = 256 * (HD / 8) / NTHR; };

template <int HD> __device__ __forceinline__ void issue_rows(u32x4 (&r)[AttnGeo<HD>::NPC], const bf16_t* __restrict__ p, int stride, int jbase, int tid) {
    typedef AttnGeo<HD> G; constexpr int RS = NTHR / G::PPR;
    const int r0 = tid / G::PPR, pc = tid % G::PPR;
#pragma unroll
    for (int i = 0; i < G::NPC; ++i) { int j = jbase + r0 + i * RS; j = j < 0 ? 0 : j;
        r[i] = *(const u32x4*)(p + ((unsigned)j * (unsigned)stride + (unsigned)(pc * 8))); }
}
template <int HD> __device__ __forceinline__ void issue_q(u32x4 (&q)[AttnGeo<HD>::NKS], const bf16_t* __restrict__ qrow, int g4) {
#pragma unroll
    for (int ks = 0; ks < AttnGeo<HD>::NKS; ++ks) q[ks] = *(const u32x4*)(qrow + ks * 32 + g4 * 8);
}
template <int HD> __device__ __forceinline__ void write_k(LAS unsigned char* kl, const u32x4 (&r)[AttnGeo<HD>::NPC], int jbase, const float* __restrict__ wk, int tid) {
    typedef AttnGeo<HD> G; constexpr int RS = NTHR / G::PPR;
    const int r0 = tid / G::PPR, pc = tid % G::PPR;
    LAS unsigned char* base = kl + r0 * G::KSTR + pc * 16;
    const float4 wa = *(const float4*)(wk + pc * 8), wb = *(const float4*)(wk + pc * 8 + 4);
#pragma unroll
    for (int i = 0; i < G::NPC; ++i) { const u32x4 w = r[i];
        float f[8] = {bflo(w.x), bfhi(w.x), bflo(w.y), bfhi(w.y), bflo(w.z), bfhi(w.z), bflo(w.w), bfhi(w.w)};
        float ss = 0.f;
#pragma unroll
        for (int e = 0; e < 8; ++e) ss += f[e] * f[e];
#pragma unroll
        for (int o = 1; o < G::PPR; o <<= 1) ss += __shfl_xor(ss, o);
        const float rstd = (jbase + r0 + i * RS >= 0) ? rsqrtf(ss * (1.0f / HD) + EPSF) : 0.f;
        u32x4 o4; o4.x = cvt_pk_bf16(f[0] * rstd * wa.x, f[1] * rstd * wa.y); o4.y = cvt_pk_bf16(f[2] * rstd * wa.z, f[3] * rstd * wa.w);
        o4.z = cvt_pk_bf16(f[4] * rstd * wb.x, f[5] * rstd * wb.y); o4.w = cvt_pk_bf16(f[6] * rstd * wb.z, f[7] * rstd * wb.w);
        *(LAS u32x4*)(base + i * (RS * G::KSTR)) = o4;
        if (G::NPC > 8) __builtin_amdgcn_sched_barrier(0); }
}
template <int HD> __device__ __forceinline__ void write_v(LAS unsigned char* vl, const u32x4 (&r)[AttnGeo<HD>::NPC], int jbase, int tid) {
    typedef AttnGeo<HD> G; constexpr int RS = NTHR / G::PPR;
    const int r0 = tid / G::PPR, pc = tid % G::PPR;
    LAS unsigned char* base = vl + r0 * G::VSTR + pc * 16;
#pragma unroll
    for (int i = 0; i < G::NPC; ++i) { const bool ok = jbase + r0 + i * RS >= 0; u32x4 w = r[i];
        w.x = ok ? w.x : 0u; w.y = ok ? w.y : 0u; w.z = ok ? w.z : 0u; w.w = ok ? w.w : 0u;
        *(LAS u32x4*)(base + i * (RS * G::VSTR)) = w; }
}
template <int HD, bool ISK> __device__ __forceinline__ void stage_rows(LAS unsigned char* dst, const bf16_t* __restrict__ p, int stride, const float* __restrict__ wk, int tid) {
    typedef AttnGeo<HD> G; constexpr int RS = NTHR / G::PPR, STR = ISK ? G::KSTR : G::VSTR, NB = 8;
    const int r0 = tid / G::PPR, pc = tid % G::PPR;
    LAS unsigned char* base = dst + r0 * STR + pc * 16;
    float4 wa = make_float4(1.f, 1.f, 1.f, 1.f), wb = wa;
    if (ISK) { wa = *(const float4*)(wk + pc * 8); wb = *(const float4*)(wk + pc * 8 + 4); }
#pragma unroll 1
    for (int i0 = 0; i0 < G::NPC; i0 += NB) {
        u32x4 r[NB];
#pragma unroll
        for (int i = 0; i < NB; ++i) r[i] = *(const u32x4*)(p + ((unsigned)(r0 + (i0 + i) * RS) * (unsigned)stride + (unsigned)(pc * 8)));
#pragma unroll
        for (int i = 0; i < NB; ++i) { u32x4 w = r[i];
            if (ISK) {
                float f[8] = {bflo(w.x), bfhi(w.x), bflo(w.y), bfhi(w.y), bflo(w.z), bfhi(w.z), bflo(w.w), bfhi(w.w)};
                float ss = 0.f;
#pragma unroll
                for (int e = 0; e < 8; ++e) ss += f[e] * f[e];
#pragma unroll
                for (int o = 1; o < G::PPR; o <<= 1) ss += __shfl_xor(ss, o);
                const float rstd = rsqrtf(ss * (1.0f / HD) + EPSF);
                w.x = cvt_pk_bf16(f[0] * rstd * wa.x, f[1] * rstd * wa.y); w.y = cvt_pk_bf16(f[2] * rstd * wa.z, f[3] * rstd * wa.w);
                w.z = cvt_pk_bf16(f[4] * rstd * wb.x, f[5] * rstd * wb.y); w.w = cvt_pk_bf16(f[6] * rstd * wb.z, f[7] * rstd * wb.w);
            }
            *(LAS u32x4*)(base + (i0 + i) * (RS * STR)) = w; }
    }
}
template <int HD> __device__ __forceinline__ void norm_q(bf16x8 (&qf)[AttnGeo<HD>::NKS], const u32x4 (&qw)[AttnGeo<HD>::NKS], const float* __restrict__ wq, float scale, int g4) {
    typedef AttnGeo<HD> G;
    float ss = 0.f;
#pragma unroll
    for (int ks = 0; ks < G::NKS; ++ks) { const u32x4 x = qw[ks]; const float a0 = bflo(x.x), a1 = bfhi(x.x), a2 = bflo(x.y), a3 = bfhi(x.y), a4 = bflo(x.z), a5 = bfhi(x.z), a6 = bflo(x.w), a7 = bfhi(x.w);
        ss += a0 * a0 + a1 * a1 + a2 * a2 + a3 * a3 + a4 * a4 + a5 * a5 + a6 * a6 + a7 * a7; }
    ss += __shfl_xor(ss, 16); ss += __shfl_xor(ss, 32);
    const float sc = rsqrtf(ss * (1.0f / HD) + EPSF) * scale;
#pragma unroll
    for (int ks = 0; ks < G::NKS; ++ks) { const u32x4 x = qw[ks]; const float4 wa = *(const float4*)(wq + ks * 32 + g4 * 8), wb = *(const float4*)(wq + ks * 32 + g4 * 8 + 4);
        u32x4 o; o.x = cvt_pk_bf16(bflo(x.x) * sc * wa.x, bfhi(x.x) * sc * wa.y); o.y = cvt_pk_bf16(bflo(x.y) * sc * wa.z, bfhi(x.y) * sc * wa.w);
        o.z = cvt_pk_bf16(bflo(x.z) * sc * wb.x, bfhi(x.z) * sc * wb.y); o.w = cvt_pk_bf16(bflo(x.w) * sc * wb.z, bfhi(x.w) * sc * wb.w);
        qf[ks] = __builtin_bit_cast(bf16x8, o); }
}

struct BandItem { const bf16_t* qp; int rstride; int qb, g, h; size_t row0; int d; };
__device__ __forceinline__ BandItem band_decode(int it, const bf16_t* PROJ) {
    BandItem I; const int g = it >> 9, idx = it & 511, dsh = 2 * g, d = 1 << dsh, nqb = 16 >> dsh;
    I.qb = idx % nqb; int rest = idx / nqb; const int r = rest % d; rest /= d; I.h = rest & 3; const int bl = rest >> 2;
    I.g = g; I.d = d; I.row0 = (size_t)bl * SEQ + r; I.qp = PROJ + I.row0 * PS + g * 512 + I.h * 128; I.rstride = d * PS; return I;
}
__device__ __forceinline__ void attn_banded_run(LAS unsigned char* lds, const bf16_t* __restrict__ PROJ, const float* __restrict__ aqn, const float* __restrict__ akn, bf16_t* __restrict__ OG, float* __restrict__ LSE,
                                                int bx, int G_, const int tid) {
    constexpr int HD = 128; typedef AttnGeo<HD> G;
    const int w = __builtin_amdgcn_readfirstlane(tid >> 6), lane = tid & 63, lq = lane & 15, g4 = lane >> 4;
    LAS unsigned char* kl = lds; LAS unsigned char* vl = lds + 256 * G::KSTR;
    const int n = (1536 - bx + G_ - 1) / G_;
    if (n <= 0) return;
    u32x4 rk[G::NPC], rv[G::NPC], rq[G::NKS];
    { const BandItem I = band_decode(bx, PROJ); const int jb = I.qb * 128 - 128;
      issue_rows<HD>(rk, I.qp + C_K, I.rstride, jb, tid); issue_rows<HD>(rv, I.qp + C_V, I.rstride, jb, tid); issue_q<HD>(rq, I.qp + (unsigned)(I.qb * 128 + 16 * w + lq) * (unsigned)I.rstride, g4); }
    { unsigned zl = 0u; asm volatile("" : "+v"(zl));
      for (int p = tid; p < 16 * G::PPR; p += NTHR) *(LAS u32x4*)(vl + (256 + p / G::PPR) * G::VSTR + (p % G::PPR) * 16) = (u32x4){zl, zl, zl, zl}; }
#pragma unroll 1
    for (int k = 0; k < n; ++k) {
        const BandItem I = band_decode(bx + k * G_, PROJ);
        const int jbase = I.qb * 128 - 128, qi = I.qb * 128 + 16 * w + lq;
        write_k<HD>(kl, rk, jbase, akn + I.g * 128, tid);
        write_v<HD>(vl, rv, jbase, tid);
        bf16x8 qf[G::NKS];
        norm_q<HD>(qf, rq, aqn + I.g * 128, 0.08838834764831845f * 1.4426950408889634f, g4);
        __syncthreads();
        { const int kn = (k + 1 < n) ? k + 1 : k; const BandItem J = band_decode(bx + kn * G_, PROJ); const int jb = J.qb * 128 - 128;
          issue_rows<HD>(rk, J.qp + C_K, J.rstride, jb, tid); issue_rows<HD>(rv, J.qp + C_V, J.rstride, jb, tid); issue_q<HD>(rq, J.qp + (unsigned)(J.qb * 128 + 16 * w + lq) * (unsigned)J.rstride, g4); }
        f32x4 S[10];
        float NEG = -__builtin_inff(); asm volatile("" : "+v"(NEG));
#pragma unroll
        for (int t = 0; t < 9; ++t) {
            const int kt = w + t;
            if (jbase + kt * 16 >= 0) {
                f32x4 sv = (f32x4){0.f, 0.f, 0.f, 0.f};
#pragma unroll
                for (int ks = 0; ks < G::NKS; ++ks) { const bf16x8 kf = *(const LAS bf16x8*)(kl + (kt * 16 + lq) * G::KSTR + ks * 64 + g4 * 16); sv = __builtin_amdgcn_mfma_f32_16x16x32_bf16(kf, qf[ks], sv, 0, 0, 0); }
                if (t == 0) {
#pragma unroll
                    for (int r = 0; r < 4; ++r) sv[r] = (4 * g4 + r >= lq) ? sv[r] : NEG; }
                if (t == 8) {
#pragma unroll
                    for (int r = 0; r < 4; ++r) sv[r] = (4 * g4 + r <= lq) ? sv[r] : NEG; }
                S[t] = sv;
            } else S[t] = (f32x4){NEG, NEG, NEG, NEG};
        }
        S[9] = (f32x4){NEG, NEG, NEG, NEG};
        float mx = NEG;
#pragma unroll
        for (int t = 0; t < 9; ++t)
#pragma unroll
            for (int r = 0; r < 4; ++r) mx = fmaxf(mx, S[t][r]);
        mx = fmaxf(mx, __shfl_xor(mx, 16)); mx = fmaxf(mx, __shfl_xor(mx, 32));
        float l = 0.f;
#pragma unroll
        for (int t = 0; t < 10; ++t)
#pragma unroll
            for (int r = 0; r < 4; ++r) { const float pv = __builtin_amdgcn_exp2f(S[t][r] - mx); l += pv; S[t][r] = pv; }
        l += __shfl_xor(l, 16); l += __shfl_xor(l, 32);
        f32x4 O[G::NDT];
#pragma unroll
        for (int dt = 0; dt < G::NDT; ++dt) O[dt] = (f32x4){0.f, 0.f, 0.f, 0.f};
#pragma unroll
        for (int u = 0; u < 5; ++u) {
            u32x4 pw; pw.x = cvt_pk_bf16(S[2 * u][0], S[2 * u][1]); pw.y = cvt_pk_bf16(S[2 * u][2], S[2 * u][3]); pw.z = cvt_pk_bf16(S[2 * u + 1][0], S[2 * u + 1][1]); pw.w = cvt_pk_bf16(S[2 * u + 1][2], S[2 * u + 1][3]);
            const bf16x8 pb = __builtin_bit_cast(bf16x8, pw);
            const int ka = (w + 2 * u) * 16 + 4 * g4 + (lq >> 2), kb = ka + 16;
            LAS unsigned char* va = vl + ka * G::VSTR + (lane & 3) * 8; LAS unsigned char* vb = vl + kb * G::VSTR + (lane & 3) * 8;
#pragma unroll
            for (int dt = 0; dt < G::NDT; ++dt) {
                const s16x4 x = __builtin_amdgcn_ds_read_tr16_b64_v4i16((LAS s16x4*)(va + dt * 32));
                const s16x4 y = __builtin_amdgcn_ds_read_tr16_b64_v4i16((LAS s16x4*)(vb + dt * 32));
                const bf16x8 av = (bf16x8){x[0], x[1], x[2], x[3], y[0], y[1], y[2], y[3]};
                O[dt] = __builtin_amdgcn_mfma_f32_16x16x32_bf16(av, pb, O[dt], 0, 0, 0);
            }
        }
        const float inv = 1.0f / l;
        const size_t trow = I.row0 + (size_t)qi * I.d;
        bf16_t* orow = OG + trow * 1536 + I.g * 512 + I.h * 128;
#pragma unroll
        for (int dt = 0; dt < G::NDT; ++dt) { u32x2 o; o.x = cvt_pk_bf16(O[dt][0] * inv, O[dt][1] * inv); o.y = cvt_pk_bf16(O[dt][2] * inv, O[dt][3] * inv); *(u32x2*)(orow + dt * 16 + 4 * g4) = o; }
        if (g4 == 0) LSE[trow * 12 + I.g * 4 + I.h] = (mx + __builtin_amdgcn_logf(l)) * 0.6931471805599453f;
        __syncthreads();
    }
}

__device__ __forceinline__ void attn_mem_run(LAS unsigned char* lds, const bf16_t* __restrict__ PROJ, const bf16_t* __restrict__ MKV, const float* __restrict__ wq, const float* __restrict__ wk, bf16_t* __restrict__ ACT,
                                             int half, int bx, int G_, const int tid) {
    constexpr int HD = 256; typedef AttnGeo<HD> G;
    const int w = __builtin_amdgcn_readfirstlane(tid >> 6), lane = tid & 63, lq = lane & 15, g4 = lane >> 4;
    const int n = (512 - bx + G_ - 1) / G_;
    if (n <= 0) return;
#pragma unroll 1
    for (int k = 0; k < n; ++k) {
        const int idx = bx + k * G_, qb = idx & 15, h = (idx >> 4) & 3, bl = idx >> 6, b = half * 8 + bl;
        const size_t trow = (size_t)bl * SEQ + qb * 128 + 16 * w + lq;
        u32x4 rq[G::NKS];
        issue_q<HD>(rq, PROJ + trow * PS + C_MQ + h * 256, g4);
        stage_rows<HD, true>(lds, MKV + (size_t)b * 256 * DM + h * 256, DM, wk, tid);
        bf16x8 qf[G::NKS];
        norm_q<HD>(qf, rq, wq, 0.0625f * 1.4426950408889634f, g4);
        __syncthreads();
        u32x2 P[16]; float l;
        {
            f32x4 S[16];
#pragma unroll
            for (int t = 0; t < 16; ++t) {
                f32x4 sv = (f32x4){0.f, 0.f, 0.f, 0.f};
#pragma unroll
                for (int ks = 0; ks < G::NKS; ++ks) { const bf16x8 kf = *(const LAS bf16x8*)(lds + (t * 16 + lq) * G::KSTR + ks * 64 + g4 * 16); sv = __builtin_amdgcn_mfma_f32_16x16x32_bf16(kf, qf[ks], sv, 0, 0, 0); }
                S[t] = sv;
            }
            float mx = -__builtin_inff(); asm volatile("" : "+v"(mx));
#pragma unroll
            for (int t = 0; t < 16; ++t)
#pragma unroll
                for (int r = 0; r < 4; ++r) mx = fmaxf(mx, S[t][r]);
            mx = fmaxf(mx, __shfl_xor(mx, 16)); mx = fmaxf(mx, __shfl_xor(mx, 32));
            l = 0.f;
#pragma unroll
            for (int t = 0; t < 16; ++t) { const float p0 = __builtin_amdgcn_exp2f(S[t][0] - mx), p1 = __builtin_amdgcn_exp2f(S[t][1] - mx), p2 = __builtin_amdgcn_exp2f(S[t][2] - mx), p3 = __builtin_amdgcn_exp2f(S[t][3] - mx);
                l += (p0 + p1) + (p2 + p3); P[t].x = cvt_pk_bf16(p0, p1); P[t].y = cvt_pk_bf16(p2, p3); }
            l += __shfl_xor(l, 16); l += __shfl_xor(l, 32);
        }
        __syncthreads();
        stage_rows<HD, false>(lds, MKV + (size_t)b * 256 * DM + 1024 + h * 256, DM, wk, tid);
        __syncthreads();
        f32x4 O[G::NDT];
#pragma unroll
        for (int dt = 0; dt < G::NDT; ++dt) O[dt] = (f32x4){0.f, 0.f, 0.f, 0.f};
#pragma unroll
        for (int u = 0; u < 8; ++u) {
            u32x4 pw; pw.x = P[2 * u].x; pw.y = P[2 * u].y; pw.z = P[2 * u + 1].x; pw.w = P[2 * u + 1].y;
            const bf16x8 pb = __builtin_bit_cast(bf16x8, pw);
            const int ka = (2 * u) * 16 + 4 * g4 + (lq >> 2), kb = ka + 16;
            LAS unsigned char* va = lds + ka * G::VSTR + (lane & 3) * 8; LAS unsigned char* vb = lds + kb * G::VSTR + (lane & 3) * 8;
#pragma unroll
            for (int dt = 0; dt < G::NDT; ++dt) {
                const s16x4 x = __builtin_amdgcn_ds_read_tr16_b64_v4i16((LAS s16x4*)(va + dt * 32));
                const s16x4 y = __builtin_amdgcn_ds_read_tr16_b64_v4i16((LAS s16x4*)(vb + dt * 32));
                const bf16x8 av = (bf16x8){x[0], x[1], x[2], x[3], y[0], y[1], y[2], y[3]};
                O[dt] = __builtin_amdgcn_mfma_f32_16x16x32_bf16(av, pb, O[dt], 0, 0, 0);
            }
        }
        const float inv = 1.0f / l;
        const bf16_t* zrow = PROJ + trow * PS + C_ZM + h * 256; bf16_t* arow = ACT + trow * ACTW + 1536 + h * 256;
#pragma unroll
        for (int dt = 0; dt < G::NDT; ++dt) { const u32x2 z = *(const u32x2*)(zrow + dt * 16 + 4 * g4);
            u32x2 o; o.x = cvt_pk_bf16(O[dt][0] * inv * siluf_(bflo(z.x)), O[dt][1] * inv * siluf_(bfhi(z.x))); o.y = cvt_pk_bf16(O[dt][2] * inv * siluf_(bflo(z.y)), O[dt][3] * inv * siluf_(bfhi(z.y)));
            *(u32x2*)(arow + dt * 16 + 4 * g4) = o; }
        __syncthreads();
    }
}

struct Args { const float* in[15]; float* out; unsigned char* ws; int lo, hi; };
enum { I_X = 0, I_MEM, I_NG, I_MNG, I_WIN, I_AQN, I_AKN, I_CW, I_WKV, I_MQN, I_MKN, I_WBA, I_WBC, I_WBM, I_WOUT };
constexpr int NPHASE = 10;

__global__ void __launch_bounds__(NTHR, 2) mega(Args a) {
    extern __shared__ __attribute__((aligned(16))) unsigned char lds_raw[];
    LAS unsigned char* lds = (LAS unsigned char*)lds_raw;
    const int G = gridDim.x, bx = blockIdx.x, wave_s = __builtin_amdgcn_readfirstlane((int)threadIdx.x >> 6);
    unsigned char* ws = a.ws;
    bf16_t* WIN = (bf16_t*)(ws + WS_WIN); bf16_t* WKV = (bf16_t*)(ws + WS_WKV); bf16_t* WBR = (bf16_t*)(ws + WS_WBR); bf16_t* WOUT = (bf16_t*)(ws + WS_WOUT);
    bf16_t* MH = (bf16_t*)(ws + WS_MH); bf16_t* MKV = (bf16_t*)(ws + WS_MKV); bf16_t* PROJ = (bf16_t*)(ws + WS_PROJ); bf16_t* OG = (bf16_t*)(ws + WS_OG);
    float* LSE = (float*)(ws + WS_LSE); bf16_t* ACT = (bf16_t*)(ws + WS_ACT); u32x4* GF = (u32x4*)(ws + WS_GF); bf16_t* MB = (bf16_t*)(ws + WS_MB);
    bf16_t* H = (bf16_t*)(ws + WS_H);

    for (int ph = a.lo; ph < a.hi; ++ph) {
        unsigned ones = ~0u; asm volatile("" : "+s"(ones));
        int tid = wave_s * 64 + (int)__builtin_amdgcn_mbcnt_hi(ones, __builtin_amdgcn_mbcnt_lo(ones, 0u)); asm volatile("" : "+v"(tid));
        const int lane = tid & 63, wave = tid >> 6;
        if (ph == 0) {
            rmsnorm_rows(a.in[I_X], a.in[I_NG], H, LDP, NTOK, bx * 8 + wave, G * 8, lane);
            rmsnorm_rows(a.in[I_MEM], a.in[I_MNG], MH, DM, 4096, bx * 8 + wave, G * 8, lane);
            constexpr int T0 = 32 * 136, T1 = T0 + 512, T2 = T1 + 128, T3 = T2 + 256, T4 = T3 + 256, T5 = T4 + 512;
            auto job = [&](int t) {
                TJob J; int ti;
                if (t < T0) { J.src = a.in[I_WIN]; J.C = PC; J.dst = WIN; J.ld = LDP; J.koff = 0; ti = t; }
                else if (t < T1) { J.src = a.in[I_WKV]; J.C = DM; J.dst = WKV; J.ld = DM; J.koff = 0; ti = t - T0; }
                else if (t < T2) { J.src = a.in[I_WBA]; J.C = DM; J.dst = WBR; J.ld = ACTW; J.koff = 0; ti = t - T1; }
                else if (t < T3) { J.src = a.in[I_WBC]; J.C = DM; J.dst = WBR; J.ld = ACTW; J.koff = 512; ti = t - T2; }
                else if (t < T4) { J.src = a.in[I_WBM]; J.C = DM; J.dst = WBR; J.ld = ACTW; J.koff = 1536; ti = t - T3; }
                else { J.src = a.in[I_WOUT]; J.C = DM; J.dst = WOUT; J.ld = DM; J.koff = 0; ti = t - T4; }
                const int nct = J.C / 128; J.r0 = (ti / nct) * 64; J.c0 = (ti % nct) * 128; return J;
            };
            if (bx < T5) {
                float4 v[4]; TJob J = job(bx); tile_load(v, J, tid);
#pragma unroll 1
                for (int t = bx; t < T5; t += G) {
                    float4 vn[4]; const int tn = (t + G < T5) ? t + G : t; const TJob Jn = job(tn); tile_load(vn, Jn, tid);
                    tile_store((LAS float*)lds, v, J, tid);
                    J = Jn;
#pragma unroll
                    for (int p = 0; p < 4; ++p) v[p] = vn[p];
                }
            }
        } else if (ph == 1 || ph == 5 || ph == 4 || ph == 8 || ph == 9) {
#ifdef PROBE_NOEPI
            const int nj = (ph == 1 || ph == 5) ? 3 : 1, njr = nj;
#else
            const int nj = (ph == 1 || ph == 5) ? 2 : 1, njr = ((REP_MASK >> ph) & 1) ? 2 * nj : nj;
#endif
#pragma unroll 1
            for (int jr = 0; jr < njr; ++jr) {
                const int j = jr >= nj ? jr - nj : jr;
                pg8::Gemm g; pg8::Epi E;
                if (ph == 4 || ph == 8) {
                    g = pg8::Gemm{ACT, WBR, HT, DM, ACTW, ACTW, ACTW}; E = pg8::Epi{5, MB, GF, nullptr, DM, 1 << 20};
                } else if (ph == 1 && j == 0) {
                    g = pg8::Gemm{MH, WKV, 4096, DM, DM, DM, DM}; E = pg8::Epi{0, MKV, nullptr, nullptr, DM, 1 << 20};
                } else if ((ph == 5 && j == 0) || ph == 9) {
                    const size_t ro = (ph == 9) ? (size_t)HT * DM : 0;
                    g = pg8::Gemm{MB, WOUT, HT, DM, DM, DM, DM}; E = pg8::Epi{4, a.out + ro, a.in[I_X] + ro, nullptr, DM, 1 << 20};
                } else {
                    const int half = (ph == 1) ? 0 : 1;
                    g = pg8::Gemm{H + (size_t)half * HT * LDP, WIN, HT, PC, DM, LDP, LDP}; E = pg8::Epi{0, PROJ, nullptr, GF, PS, PS / 256};
                    if (j == 2) E.kind = 9;
                }
                pg8::StaticOrder S; S.init(g.M, g.N, G, bx);
                pg8::gemm_phase(lds, g, S, E, tid);
            }
        } else if (ph == 2 || ph == 6) {
            const int half = (ph == 2) ? 0 : 1;
#pragma unroll 1
            for (int rep = 0; rep < REP_BAND; ++rep)
            attn_banded_run(lds, PROJ, a.in[I_AQN], a.in[I_AKN], OG, LSE, bx, G, tid);
            attn_mem_run(lds, PROJ, MKV, a.in[I_MQN], a.in[I_MKN], ACT, half, bx, G, tid);
        } else if (ph == 3 || ph == 7) {
            const int gt = bx * NTHR + tid, nth = G * NTHR;
            for (int idx = gt; idx < HT * 64; idx += nth) {
                const int row = idx >> 6, c8 = (idx & 63) * 8, h = c8 >> 7;
                const float l0 = LSE[(size_t)row * 12 + h], l1 = LSE[(size_t)row * 12 + 4 + h], l2 = LSE[(size_t)row * 12 + 8 + h];
                const float m = fmaxf(l0, fmaxf(l1, l2)); float w0 = __expf(l0 - m), w1 = __expf(l1 - m), w2 = __expf(l2 - m); const float inv = 1.0f / (w0 + w1 + w2); w0 *= inv; w1 *= inv; w2 *= inv;
                const u32x4 o0 = *(const u32x4*)(OG + (size_t)row * 1536 + c8), o1 = *(const u32x4*)(OG + (size_t)row * 1536 + 512 + c8), o2 = *(const u32x4*)(OG + (size_t)row * 1536 + 1024 + c8);
                const u32x4 z = *(const u32x4*)(PROJ + (size_t)row * PS + C_ZA + c8);
                u32x4 o;
#define CMB(k) o.k = cvt_pk_bf16((w0 * bflo(o0.k) + w1 * bflo(o1.k) + w2 * bflo(o2.k)) * siluf_(bflo(z.k)), (w0 * bfhi(o0.k) + w1 * bfhi(o1.k) + w2 * bfhi(o2.k)) * siluf_(bfhi(z.k)))
                CMB(x); CMB(y); CMB(z); CMB(w);
#undef CMB
                *(u32x4*)(ACT + (size_t)row * ACTW + c8) = o;
            }
            const float* cw = a.in[I_CW];
            for (int idx = gt; idx < HT * 128; idx += nth) {
                const int row = idx >> 7, c8 = (idx & 127) * 8, t = row & (SEQ - 1);
                const bf16_t* pr = PROJ + (size_t)row * PS;
                unsigned zl = 0u; asm volatile("" : "+v"(zl)); const u32x4 z4 = (u32x4){zl, zl, zl, zl};
                const u32x4 c0 = *(const u32x4*)(pr + C_CC + c8), v0 = *(const u32x4*)(pr + C_CV + c8);
                const u32x4 c1 = t >= 1 ? *(const u32x4*)(pr - PS + C_CC + c8) : z4, v1 = t >= 1 ? *(const u32x4*)(pr - PS + C_CV + c8) : z4;
                const u32x4 c2 = t >= 2 ? *(const u32x4*)(pr - 2 * PS + C_CC + c8) : z4, v2 = t >= 2 ? *(const u32x4*)(pr - 2 * PS + C_CV + c8) : z4;
                const u32x4 bb = *(const u32x4*)(pr + C_CB + c8), zz = *(const u32x4*)(pr + C_ZC + c8);
                const float4 wa0 = *(const float4*)(cw + c8), wb0 = *(const float4*)(cw + c8 + 4), wa1 = *(const float4*)(cw + 1024 + c8), wb1 = *(const float4*)(cw + 1024 + c8 + 4), wa2 = *(const float4*)(cw + 2048 + c8), wb2 = *(const float4*)(cw + 2048 + c8 + 4);
                u32x4 o;
#define CV1(f, k, W0, W1, W2) ((W0 * (f(c0.k) * f(v0.k)) + W1 * (f(c1.k) * f(v1.k)) + W2 * (f(c2.k) * f(v2.k))) * f(bb.k) * siluf_(f(zz.k)))
                o.x = cvt_pk_bf16(CV1(bflo, x, wa0.x, wa1.x, wa2.x), CV1(bfhi, x, wa0.y, wa1.y, wa2.y));
                o.y = cvt_pk_bf16(CV1(bflo, y, wa0.z, wa1.z, wa2.z), CV1(bfhi, y, wa0.w, wa1.w, wa2.w));
                o.z = cvt_pk_bf16(CV1(bflo, z, wb0.x, wb1.x, wb2.x), CV1(bfhi, z, wb0.y, wb1.y, wb2.y));
                o.w = cvt_pk_bf16(CV1(bflo, w, wb0.z, wb1.z, wb2.z), CV1(bfhi, w, wb0.w, wb1.w, wb2.w));
#undef CV1
                *(u32x4*)(ACT + (size_t)row * ACTW + 512 + c8) = o;
            }
        }
        if (ph + 1 < a.hi) cg::this_grid().sync();
    }
}

extern "C" void kernel_launch(void* const* d_in, const int* in_sizes, int n_in, void* d_out, int out_size, void* d_ws, size_t ws_size, hipStream_t stream) {
    static int grid = 0;
    if (grid == 0) {
        if (n_in != 15 || ws_size < WS_END) { fprintf(stderr, "kernel_launch: unexpected inputs (n_in %d, ws %zu < %zu)\n", n_in, ws_size, (size_t)WS_END); grid = -1; return; }
        int dev = 0, cus = 0, per_cu = 0;
        hipGetDevice(&dev); hipDeviceGetAttribute(&cus, hipDeviceAttributeMultiprocessorCount, dev);
        if (hipFuncSetAttribute((const void*)mega, hipFuncAttributeMaxDynamicSharedMemorySize, LDS_BYTES) != hipSuccess) { fprintf(stderr, "kernel_launch: hipFuncSetAttribute failed\n"); grid = -1; return; }
        hipOccupancyMaxActiveBlocksPerMultiprocessor(&per_cu, (const void*)mega, NTHR, LDS_BYTES);
        if (per_cu < 1) per_cu = 1;
        grid = cus * 1;
        (void)hipGetLastError();
    }
    if (grid < 0) return;
    Args a{};
    for (int i = 0; i < 15; ++i) a.in[i] = (const float*)d_in[i];
    a.out = (float*)d_out; a.ws = (unsigned char*)d_ws;
#if ONE_LAUNCH
    a.lo = 0; a.hi = NPHASE;
    void* args[] = {&a};
    hipError_t e = hipLaunchCooperativeKernel((const void*)mega, dim3(grid), dim3(NTHR), args, LDS_BYTES, stream);
    if (e != hipSuccess) fprintf(stderr, "cooperative launch failed: %s (grid %d)\n", hipGetErrorString(e), grid);
#else
    for (int ph = 0; ph < NPHASE; ++ph) { a.lo = ph; a.hi = ph + 1; hipLaunchKernelGGL(mega, dim3(grid), dim3(NTHR), LDS_BYTES, stream, a); }
#endif
}
```

```cpp
#include <hip/hip_runtime.h>
#include <hip/hip_cooperative_groups.h>
#include <cstdio>
namespace cg = cooperative_groups;

#ifndef ONE_LAUNCH
#define ONE_LAUNCH 1
#endif

#ifndef REP_MASK
#define REP_MASK 0
#endif
#define REP_BAND 1
#ifndef PG8_SP2
#define PG8_SP2 1
#endif
#define LAS __attribute__((address_space(3)))
typedef unsigned short bf16_t;
typedef short bf16x8 __attribute__((ext_vector_type(8)));
typedef short s16x4 __attribute__((ext_vector_type(4)));
typedef float f32x4 __attribute__((ext_vector_type(4)));
typedef unsigned u32x4 __attribute__((ext_vector_type(4)));
typedef unsigned u32x2 __attribute__((ext_vector_type(2)));

constexpr int DM = 2048, SEQ = 2048, NB = 16, NTOK = NB * SEQ;
constexpr int PC = 17408;
constexpr int PS = 11264;
constexpr int HT = NTOK / 2;
constexpr int C_Q = 0, C_K = 1536, C_V = 3072, C_ZA = 4608, C_CB = 5120, C_CC = 6144, C_CV = 7168, C_ZC = 8192, C_MQ = 9216, C_ZM = 10240, C_G = 11264;
constexpr int ACTW = 2560;
constexpr int LDP = 2048 + 64;
constexpr float EPSF = 1e-6f;
constexpr int NTHR = 512;
constexpr int LDS_BYTES = 149504;

constexpr size_t WS_WIN = 0;
constexpr size_t WS_WKV = WS_WIN + (size_t)PC * LDP * 2;
constexpr size_t WS_WBR = WS_WKV + (size_t)DM * DM * 2;
constexpr size_t WS_WOUT = WS_WBR + (size_t)DM * ACTW * 2;
constexpr size_t WS_MH = WS_WOUT + (size_t)DM * DM * 2;
constexpr size_t WS_MKV = WS_MH + (size_t)4096 * DM * 2;
constexpr size_t WS_PROJ = WS_MKV + (size_t)4096 * DM * 2;
constexpr size_t WS_OG = WS_PROJ + (size_t)HT * PS * 2;
constexpr size_t WS_LSE = WS_OG + (size_t)HT * 1536 * 2;
constexpr size_t WS_ACT = WS_LSE + (size_t)HT * 12 * 4;
constexpr size_t WS_GF = WS_ACT + (size_t)HT * ACTW * 2;
constexpr size_t WS_MB = WS_GF + (size_t)HT * 6144 * 2;
constexpr size_t WS_H = WS_MB + (size_t)HT * DM * 2;
constexpr size_t WS_END = WS_H + (size_t)NTOK * LDP * 2;
constexpr size_t OUT_H_OFF = (size_t)HT * DM * 4;

__device__ __forceinline__ float bflo(unsigned w) { return __uint_as_float(w << 16); }
__device__ __forceinline__ float bfhi(unsigned w) { return __uint_as_float(w & 0xffff0000u); }
typedef __bf16 bf16x2_t __attribute__((ext_vector_type(2)));
typedef float f32x2_t __attribute__((ext_vector_type(2)));
__device__ __forceinline__ unsigned cvt_pk_bf16(float lo, float hi) { f32x2_t v = {lo, hi}; bf16x2_t b = __builtin_convertvector(v, bf16x2_t); return __builtin_bit_cast(unsigned, b); }
__device__ __forceinline__ float sigmoidf_(float x) { return __builtin_amdgcn_rcpf(1.0f + __builtin_amdgcn_exp2f(x * -1.4426950408889634f)); }
__device__ __forceinline__ float siluf_(float x) { return x * __builtin_amdgcn_rcpf(1.0f + __builtin_amdgcn_exp2f(x * -1.4426950408889634f)); }

namespace pg8 {
constexpr int BM = 256, BK = 64, HALF = 128, HTB = HALF * BK * 2, STAGE_BYTES = 8 * HTB, NXCD = 8, WGM = 8;
__host__ __device__ __forceinline__ int lds_byte(int r, int c) { const int st = (r >> 4) * 2 + (c >> 5), rr = r & 15, cc = c & 31, ob = rr * 64 + cc * 2; return st * 1024 + (ob ^ (((ob >> 9) & 1) << 5)); }
__host__ __device__ __forceinline__ void stage_rc(int b, int& R, int& C) { const int st = b / 1024, sb = b % 1024, swz = sb ^ (((sb >> 9) & 1) << 5); R = (st >> 1) * 16 + swz / 64; C = (st & 1) * 32 + (swz % 64) / 2; }
__host__ __device__ __forceinline__ int perm32(int rho) { const int n = rho >> 4, i = rho & 15; return 8 * (i >> 2) + 4 * n + (i & 3); }
struct Unit { int pm, pn; };
struct Gemm { const bf16_t* A; const bf16_t* Bt; int M, N, K, lda, ldb; };
struct StaticOrder {
    int nM, nN, nwg, G, c;
    __device__ void init(int M, int N, int G_, int c_) { nM = M / BM; nN = N / BM; nwg = nM * nN; G = G_; c = c_; }
    __device__ bool next(int i, Unit& u) const {
        const long L = (long)i * G + c; if (L >= nwg) return false;
        int wgid = (int)L; { const int q = nwg / NXCD, r = nwg % NXCD, xcd = wgid % NXCD, off = wgid / NXCD; wgid = (xcd < r ? xcd * (q + 1) : r * (q + 1) + (xcd - r) * q) + off; }
        const int nig = WGM * nN, gid = wgid / nig, fm = gid * WGM, gsz = (nM - fm) < WGM ? (nM - fm) : WGM;
        u.pm = fm + ((wgid % nig) % gsz); u.pn = (wgid % nig) / gsz; return true;
    }
};

struct Epi;
template <class Epi, class Sched>
__device__ __forceinline__ void gemm_phase(LAS unsigned char* lds, const Gemm g, const Sched& S, const Epi& E, const int tid) {
    const int wid = __builtin_amdgcn_readfirstlane(tid >> 6), lane = tid & 63, wr = wid >> 2, wc = wid & 3, fr = lane & 15, fq = lane >> 4;
    const int K = g.K, nt = K / BK;
    unsigned voffA[2], voffB[2];
#pragma unroll
    for (int i = 0; i < 2; ++i) { int R, C; stage_rc(tid * 16 + i * 8192, R, C); const int Rb = 2 * (R & ~31) + (E.perm() ? perm32(R & 31) : (R & 31));
        voffA[i] = (unsigned)(R * g.lda + C) * 2u; voffB[i] = (unsigned)(Rb * g.ldb + C) * 2u; }
    const size_t kstep = (size_t)(BK * 2);
    const size_t hstepA = (size_t)HALF * g.lda * 2, hstepB = (size_t)32 * g.ldb * 2;
    const size_t tstepA = 2 * hstepA, tstepB = (size_t)BM * g.ldb * 2;
    const unsigned ldsw = (unsigned)wid * 1024u;
    const int aoff = lds_byte(wr * 64 + fr, fq * 8), boff = lds_byte(wc * 32 + fr, fq * 8);
#define PG8_SA(b, h) (((b) * 2 + (h)) * HTB)
#define PG8_SB(b, h) ((4 + (b) * 2 + (h)) * HTB)
#define PG8_STAGE(bufoff, gbase, voff) do { _Pragma("unroll") for (int _i = 0; _i < 2; ++_i) \
        __builtin_amdgcn_global_load_lds((const unsigned*)((const char*)(gbase) + (voff)[_i]), (LAS unsigned*)(lds + (bufoff) + ldsw + _i * 8192), 16, 0, 0); } while (0)
#define PG8_LDA(dst, b, h) do { _Pragma("unroll") for (int m = 0; m < 4; ++m) _Pragma("unroll") for (int k = 0; k < 2; ++k) dst[m][k] = *(const LAS bf16x8*)(lds + PG8_SA(b, h) + aoff + m * 2048 + k * 1024); } while (0)
#define PG8_LDB(dst, b, h) do { _Pragma("unroll") for (int n = 0; n < 2; ++n) _Pragma("unroll") for (int k = 0; k < 2; ++k) dst[n][k] = *(const LAS bf16x8*)(lds + PG8_SB(b, h) + boff + n * 2048 + k * 1024); } while (0)
#define PG8_MMA(ai, bj, At, Bt) do { __builtin_amdgcn_s_setprio(1); _Pragma("unroll") for (int m = 0; m < 4; ++m) _Pragma("unroll") for (int n = 0; n < 2; ++n) _Pragma("unroll") for (int k = 0; k < 2; ++k) \
        acc[ai][bj][m][n] = __builtin_amdgcn_mfma_f32_16x16x32_bf16(Bt[n][k], At[m][k], acc[ai][bj][m][n], 0, 0, 0); __builtin_amdgcn_s_setprio(0); } while (0)
#define PG8_WAIT_V(n) asm volatile("s_waitcnt vmcnt(" #n ")" ::: "memory")
#define PG8_WAIT_L(n) asm volatile("s_waitcnt lgkmcnt(" #n ")" ::: "memory")
#define PG8_BAR __builtin_amdgcn_s_barrier()
#define PG8_SCHED __builtin_amdgcn_sched_barrier(0)
    Unit cur, nxt; int ui = 0;
    if (!S.next(0, cur)) return;
    f32x4 acc[2][2][4][2];
#pragma unroll
    for (int a = 0; a < 2; ++a)
#pragma unroll
        for (int b = 0; b < 2; ++b)
#pragma unroll
            for (int m = 0; m < 4; ++m)
#pragma unroll
                for (int n = 0; n < 2; ++n) acc[a][b][m][n] = (f32x4){0.f, 0.f, 0.f, 0.f};
    bf16x8 At[4][2], B0[2][2], B1[2][2];
    const char* cA = (const char*)g.A + (size_t)cur.pm * tstepA; const char* cB = (const char*)g.Bt + (size_t)cur.pn * tstepB;
#if PG8_SP2
    PG8_STAGE(PG8_SB(0, 0), cB, voffB); PG8_STAGE(PG8_SB(0, 1), cB + hstepB, voffB); PG8_STAGE(PG8_SA(0, 0), cA, voffA); PG8_STAGE(PG8_SA(0, 1), cA + hstepA, voffA);
    if (wr == 1) PG8_BAR;
    PG8_WAIT_V(2); PG8_BAR;
    PG8_STAGE(PG8_SB(1, 0), cB + kstep, voffB); PG8_STAGE(PG8_SA(1, 0), cA + kstep, voffA); PG8_STAGE(PG8_SB(1, 1), cB + hstepB + kstep, voffB);
    PG8_WAIT_V(6); PG8_BAR;
#else
    PG8_STAGE(PG8_SB(0, 0), cB, voffB); PG8_STAGE(PG8_SA(0, 0), cA, voffA); PG8_STAGE(PG8_SB(0, 1), cB + hstepB, voffB); PG8_STAGE(PG8_SA(0, 1), cA + hstepA, voffA);
    if (wr == 1) PG8_BAR;
    PG8_WAIT_V(4); PG8_BAR;
    PG8_STAGE(PG8_SB(1, 0), cB + kstep, voffB); PG8_STAGE(PG8_SA(1, 0), cA + kstep, voffA); PG8_STAGE(PG8_SB(1, 1), cB + hstepB + kstep, voffB);
    PG8_WAIT_V(6); PG8_BAR;
#endif
    for (;;) {
        const bool has_next = S.next(ui + 1, nxt);
        const char* nA = has_next ? (const char*)g.A + (size_t)nxt.pm * tstepA : cA; const char* nB = has_next ? (const char*)g.Bt + (size_t)nxt.pn * tstepB : cB;
        for (int t = 0; t < nt; t += 2) {
            const bool last = (t == nt - 2);
            const char* a1 = cA + (size_t)(t + 1) * kstep;
            const char* a2 = last ? nA : cA + (size_t)(t + 2) * kstep; const char* b2 = last ? nB : cB + (size_t)(t + 2) * kstep;
            const char* a3 = a2 + kstep; const char* b3 = b2 + kstep;
            if (E.has_mid() && (t == 8 || t == 24)) E.mid(acc, cur, tid, t == 8 ? 0 : 1);
#if PG8_SP2
            PG8_LDB(B0, 0, 0); PG8_LDB(B1, 0, 1); PG8_SCHED; PG8_LDA(At, 0, 0); PG8_STAGE(PG8_SA(1, 1), a1 + hstepA, voffA);
            PG8_WAIT_V(8); PG8_WAIT_L(0); PG8_BAR; PG8_MMA(0, 0, At, B0); PG8_MMA(0, 1, At, B1); PG8_BAR; PG8_SCHED;
            PG8_LDA(At, 0, 1); PG8_STAGE(PG8_SB(0, 0), b2, voffB); PG8_STAGE(PG8_SB(0, 1), b2 + hstepB, voffB); PG8_STAGE(PG8_SA(0, 0), a2, voffA);
            PG8_WAIT_V(8); PG8_WAIT_L(0); PG8_BAR; PG8_MMA(1, 0, At, B0); PG8_MMA(1, 1, At, B1); PG8_BAR; PG8_SCHED;
            PG8_LDB(B0, 1, 0); PG8_LDB(B1, 1, 1); PG8_SCHED; PG8_LDA(At, 1, 0); PG8_STAGE(PG8_SA(0, 1), a2 + hstepA, voffA);
            PG8_WAIT_V(8); PG8_WAIT_L(0); PG8_BAR; PG8_MMA(0, 0, At, B0); PG8_MMA(0, 1, At, B1); PG8_BAR; PG8_SCHED;
            PG8_LDA(At, 1, 1); PG8_STAGE(PG8_SB(1, 0), b3, voffB); PG8_STAGE(PG8_SB(1, 1), b3 + hstepB, voffB); PG8_STAGE(PG8_SA(1, 0), a3, voffA);
            PG8_WAIT_V(8); PG8_WAIT_L(0); PG8_BAR; PG8_MMA(1, 0, At, B0); PG8_MMA(1, 1, At, B1); PG8_BAR; PG8_SCHED;
#else
            PG8_LDB(B0, 0, 0); PG8_SCHED; PG8_LDA(At, 0, 0); PG8_STAGE(PG8_SA(1, 1), a1 + hstepA, voffA);
            PG8_WAIT_L(8); PG8_BAR; PG8_WAIT_L(0); PG8_MMA(0, 0, At, B0); PG8_BAR; PG8_SCHED;
            PG8_LDB(B1, 0, 1); PG8_STAGE(PG8_SB(0, 0), b2, voffB);
            PG8_BAR; PG8_WAIT_L(0); PG8_MMA(0, 1, At, B1); PG8_BAR;
            PG8_LDA(At, 0, 1); PG8_STAGE(PG8_SA(0, 0), a2, voffA);
            PG8_BAR; PG8_WAIT_L(0); PG8_MMA(1, 0, At, B0); PG8_BAR; PG8_SCHED;
            PG8_STAGE(PG8_SB(0, 1), b2 + hstepB, voffB);
            PG8_WAIT_V(6); PG8_BAR; PG8_MMA(1, 1, At, B1); PG8_BAR;
            PG8_LDB(B0, 1, 0); PG8_SCHED; PG8_LDA(At, 1, 0); PG8_STAGE(PG8_SA(0, 1), a2 + hstepA, voffA);
            PG8_WAIT_L(8); PG8_BAR; PG8_WAIT_L(0); PG8_MMA(0, 0, At, B0); PG8_BAR; PG8_SCHED;
            PG8_LDB(B1, 1, 1); PG8_STAGE(PG8_SB(1, 0), b3, voffB);
            PG8_BAR; PG8_WAIT_L(0); PG8_MMA(0, 1, At, B1); PG8_BAR;
            PG8_LDA(At, 1, 1); PG8_STAGE(PG8_SA(1, 0), a3, voffA);
            PG8_BAR; PG8_WAIT_L(0); PG8_MMA(1, 0, At, B0); PG8_BAR; PG8_SCHED;
            PG8_STAGE(PG8_SB(1, 1), b3 + hstepB, voffB);
            PG8_WAIT_V(6); PG8_BAR; PG8_MMA(1, 1, At, B1); PG8_BAR;
#endif
        }
        if (wr == 0) PG8_BAR;
        E(acc, cur, wr, wc, fr, fq, tid);
        if (!has_next) break;
#pragma unroll
        for (int a = 0; a < 2; ++a)
#pragma unroll
            for (int b = 0; b < 2; ++b)
#pragma unroll
                for (int m = 0; m < 4; ++m)
#pragma unroll
                    for (int n = 0; n < 2; ++n) acc[a][b][m][n] = (f32x4){0.f, 0.f, 0.f, 0.f};
        cur = nxt; cA = nA; cB = nB; ++ui;
        if (wr == 1) PG8_BAR;
    }
    PG8_WAIT_V(0);
    PG8_BAR;
#undef PG8_SA
#undef PG8_SB
#undef PG8_STAGE
#undef PG8_LDA
#undef PG8_LDB
#undef PG8_MMA
#undef PG8_WAIT_V
#undef PG8_WAIT_L
#undef PG8_BAR
#undef PG8_SCHED
}

struct Epi {
    int kind; void* p0; const void* p1; void* p2; int ldc, gpn0;
    __device__ __forceinline__ bool perm() const { return kind != 4; }
    __device__ __forceinline__ bool has_mid() const { return kind == 5; }
    __device__ __forceinline__ void mid(f32x4 (&acc)[2][2][4][2], const Unit& u, int tid, int which) const {
        const u32x4* ga = (const u32x4*)p1 + ((size_t)(u.pm * 24 + 8 * which + u.pn) * 16) * 512 + tid; const u32x4* gb = ga + (size_t)8 * 16 * 512;
        u32x4 x[16];
#pragma unroll
        for (int i = 0; i < 16; ++i) x[i] = ga[i * 512];
        asm volatile("s_waitcnt vmcnt(0)" ::: "memory");
#pragma unroll
        for (int i = 0; i < 16; ++i) { const int ai = i >> 3, m = (i >> 1) & 3, bj = i & 1; const u32x4 y = x[i];
            acc[ai][bj][m][0] *= (f32x4){bflo(y.x), bfhi(y.x), bflo(y.y), bfhi(y.y)}; acc[ai][bj][m][1] *= (f32x4){bflo(y.z), bfhi(y.z), bflo(y.w), bfhi(y.w)}; }
        asm volatile("" ::: "memory");
#pragma unroll
        for (int i = 0; i < 16; ++i) x[i] = gb[i * 512];
        asm volatile("s_waitcnt vmcnt(0)" ::: "memory");
#pragma unroll
        for (int i = 0; i < 16; ++i) { const int ai = i >> 3, m = (i >> 1) & 3, bj = i & 1; const u32x4 y = x[i];
            acc[ai][bj][m][0] *= (f32x4){__builtin_amdgcn_rcpf(bflo(y.x)), __builtin_amdgcn_rcpf(bfhi(y.x)), __builtin_amdgcn_rcpf(bflo(y.y)), __builtin_amdgcn_rcpf(bfhi(y.y))};
            acc[ai][bj][m][1] *= (f32x4){__builtin_amdgcn_rcpf(bflo(y.z)), __builtin_amdgcn_rcpf(bfhi(y.z)), __builtin_amdgcn_rcpf(bflo(y.w)), __builtin_amdgcn_rcpf(bfhi(y.w))}; }
    }
    __device__ __forceinline__ void operator()(const f32x4 (&acc)[2][2][4][2], const Unit& u, int wr, int wc, int fr, int fq, int tid) const {
        const int row0 = u.pm * BM + wr * 64 + fr;
        if (kind == 0 && u.pn >= gpn0) {
            u32x4* gf = (u32x4*)p2 + ((size_t)(u.pm * 24 + (u.pn - gpn0)) * 16) * 512 + tid;
#pragma unroll
            for (int ai = 0; ai < 2; ++ai)
#pragma unroll
                for (int m = 0; m < 4; ++m)
#pragma unroll
                    for (int bj = 0; bj < 2; ++bj) { const f32x4 v0 = acc[ai][bj][m][0], v1 = acc[ai][bj][m][1];
                        u32x4 w; w.x = cvt_pk_bf16(sigmoidf_(v0[0]), sigmoidf_(v0[1])); w.y = cvt_pk_bf16(sigmoidf_(v0[2]), sigmoidf_(v0[3])); w.z = cvt_pk_bf16(sigmoidf_(v1[0]), sigmoidf_(v1[1])); w.w = cvt_pk_bf16(sigmoidf_(v1[2]), sigmoidf_(v1[3]));
                        gf[((ai * 4 + m) * 2 + bj) * 512] = w; }
        } else if (kind == 0) {
            bf16_t* O = (bf16_t*)p0; const int col0 = u.pn * BM + wc * 64 + 8 * fq;
#pragma unroll
            for (int ai = 0; ai < 2; ++ai)
#pragma unroll
                for (int m = 0; m < 4; ++m) { bf16_t* rowp = O + (size_t)(row0 + ai * HALF + m * 16) * ldc + col0;
#pragma unroll
                    for (int bj = 0; bj < 2; ++bj) { const f32x4 v0 = acc[ai][bj][m][0], v1 = acc[ai][bj][m][1];
                        u32x4 w; w.x = cvt_pk_bf16(v0[0], v0[1]); w.y = cvt_pk_bf16(v0[2], v0[3]); w.z = cvt_pk_bf16(v1[0], v1[1]); w.w = cvt_pk_bf16(v1[2], v1[3]);
                        *(u32x4*)(rowp + bj * 32) = w; } }
        } else if (kind == 4) {
            const float* x = (const float*)p1; float* out = (float*)p0; const int col0 = u.pn * BM + wc * 64 + 4 * fq;
#pragma unroll
            for (int am = 0; am < 4; ++am) {
                const int ai = am >> 1, mb = (am & 1) * 2;
                f32x4 xv[2][2][2];
#pragma unroll
                for (int m = 0; m < 2; ++m) { const size_t off = (size_t)(row0 + ai * HALF + (mb + m) * 16) * DM + col0;
#pragma unroll
                    for (int bj = 0; bj < 2; ++bj)
#pragma unroll
                        for (int n = 0; n < 2; ++n) xv[m][bj][n] = *(const f32x4*)(x + off + bj * 32 + n * 16); }
                asm volatile("s_waitcnt vmcnt(0)" ::: "memory");
#pragma unroll
                for (int m = 0; m < 2; ++m) { const size_t off = (size_t)(row0 + ai * HALF + (mb + m) * 16) * DM + col0;
#pragma unroll
                    for (int bj = 0; bj < 2; ++bj)
#pragma unroll
                        for (int n = 0; n < 2; ++n) *(f32x4*)(out + off + bj * 32 + n * 16) = xv[m][bj][n] + acc[ai][bj][mb + m][n]; }
                asm volatile("" ::: "memory");
            }
        } else if (kind == 5) {
            bf16_t* O = (bf16_t*)p0; const int col0 = u.pn * BM + wc * 64 + 8 * fq;
            const u32x4* gc = (const u32x4*)p1 + ((size_t)(u.pm * 24 + 16 + u.pn) * 16) * 512 + tid;
            u32x4 gy[16];
#pragma unroll
            for (int i = 0; i < 16; ++i) gy[i] = gc[i * 512];
            asm volatile("s_waitcnt vmcnt(0)" ::: "memory");
#pragma unroll
            for (int ai = 0; ai < 2; ++ai)
#pragma unroll
                for (int m = 0; m < 4; ++m) { bf16_t* rowp = O + (size_t)(row0 + ai * HALF + m * 16) * ldc + col0;
#pragma unroll
                    for (int bj = 0; bj < 2; ++bj) { const f32x4 v0 = acc[ai][bj][m][0], v1 = acc[ai][bj][m][1]; const u32x4 y = gy[(ai * 4 + m) * 2 + bj];
                        u32x4 w; w.x = cvt_pk_bf16(v0[0] * bflo(y.x), v0[1] * bfhi(y.x)); w.y = cvt_pk_bf16(v0[2] * bflo(y.y), v0[3] * bfhi(y.y)); w.z = cvt_pk_bf16(v1[0] * bflo(y.z), v1[1] * bfhi(y.z)); w.w = cvt_pk_bf16(v1[2] * bflo(y.w), v1[3] * bfhi(y.w));
                        *(u32x4*)(rowp + bj * 32) = w; } }
        }
    }
};
}

__device__ __forceinline__ void rmsnorm_rows(const float* __restrict__ x, const float* __restrict__ g, bf16_t* __restrict__ out, int ldo, int nrows, int gw, int nw, int lane) {
    for (int row = gw; row < nrows; row += nw) {
        const float4* xr = (const float4*)(x + (size_t)row * DM);
        float4 v[8]; float ss = 0.f;
#pragma unroll
        for (int i = 0; i < 4; ++i) { const int c = lane + 64 * i; v[2 * i] = xr[2 * c]; v[2 * i + 1] = xr[2 * c + 1]; }
#pragma unroll
        for (int i = 0; i < 8; ++i) ss += v[i].x * v[i].x + v[i].y * v[i].y + v[i].z * v[i].z + v[i].w * v[i].w;
#pragma unroll
        for (int o = 32; o >= 1; o >>= 1) ss += __shfl_xor(ss, o);
        const float rstd = rsqrtf(ss * (1.0f / DM) + EPSF);
#pragma unroll
        for (int i = 0; i < 4; ++i) { const int c = lane + 64 * i; const float4 ga = ((const float4*)g)[2 * c], gb = ((const float4*)g)[2 * c + 1]; const float4 a = v[2 * i], b = v[2 * i + 1];
            u32x4 w; w.x = cvt_pk_bf16(a.x * rstd * ga.x, a.y * rstd * ga.y); w.y = cvt_pk_bf16(a.z * rstd * ga.z, a.w * rstd * ga.w);
            w.z = cvt_pk_bf16(b.x * rstd * gb.x, b.y * rstd * gb.y); w.w = cvt_pk_bf16(b.z * rstd * gb.z, b.w * rstd * gb.w);
            *(u32x4*)(out + (size_t)row * ldo + c * 8) = w; }
    }
}
struct TJob { const float* src; bf16_t* dst; int C, ld, koff, r0, c0; };
__device__ __forceinline__ void tile_load(float4 (&v)[4], const TJob& J, int tid) {
#pragma unroll
    for (int p = 0; p < 4; ++p) { const int r = p * 16 + (tid >> 5), c4 = (tid & 31) * 4; v[p] = *(const float4*)(J.src + (size_t)(J.r0 + r) * J.C + J.c0 + c4); }
}
__device__ __forceinline__ void tile_store(LAS float* t  , const float4 (&v)[4], const TJob& J, int tid) {
#pragma unroll
    for (int p = 0; p < 4; ++p) { const int r = p * 16 + (tid >> 5), c4 = (tid & 31) * 4; LAS float* q = t + r * 129 + c4; q[0] = v[p].x; q[1] = v[p].y; q[2] = v[p].z; q[3] = v[p].w; }
    __syncthreads();
#pragma unroll
    for (int h = 0; h < 2; ++h) { const int c = h * 64 + (tid >> 3), rc = (tid & 7) * 8; float f[8];
#pragma unroll
        for (int j = 0; j < 8; ++j) f[j] = t[(rc + j) * 129 + c];
        u32x4 w; w.x = cvt_pk_bf16(f[0], f[1]); w.y = cvt_pk_bf16(f[2], f[3]); w.z = cvt_pk_bf16(f[4], f[5]); w.w = cvt_pk_bf16(f[6], f[7]);
        *(u32x4*)(J.dst + (size_t)(J.c0 + c) * J.ld + J.koff + J.r0 + rc) = w; }
    __syncthreads();
}

template <int HD> struct AttnGeo { static constexpr int KSTR = HD * 2 + 16, VSTR = HD * 2 + 32, PPR = HD / 8, NKS = HD / 32, NDT = HD / 16, NPC = 256 * (HD / 8) / NTHR; };

template <int HD> __device__ __forceinline__ void issue_rows(u32x4 (&r)[AttnGeo<HD>::NPC], const bf16_t* __restrict__ p, int stride, int jbase, int tid) {
    typedef AttnGeo<HD> G; constexpr int RS = NTHR / G::PPR;
    const int r0 = tid / G::PPR, pc = tid % G::PPR;
#pragma unroll
    for (int i = 0; i < G::NPC; ++i) { int j = jbase + r0 + i * RS; j = j < 0 ? 0 : j;
        r[i] = *(const u32x4*)(p + ((unsigned)j * (unsigned)stride + (unsigned)(pc * 8))); }
}
template <int HD> __device__ __forceinline__ void issue_q(u32x4 (&q)[AttnGeo<HD>::NKS], const bf16_t* __restrict__ qrow, int g4) {
#pragma unroll
    for (int ks = 0; ks < AttnGeo<HD>::NKS; ++ks) q[ks] = *(const u32x4*)(qrow + ks * 32 + g4 * 8);
}
template <int HD> __device__ __forceinline__ void write_k(LAS unsigned char* kl, const u32x4 (&r)[AttnGeo<HD>::NPC], int jbase, const float* __restrict__ wk, int tid) {
    typedef AttnGeo<HD> G; constexpr int RS = NTHR / G::PPR;
    const int r0 = tid / G::PPR, pc = tid % G::PPR;
    LAS unsigned char* base = kl + r0 * G::KSTR + pc * 16;
    const float4 wa = *(const float4*)(wk + pc * 8), wb = *(const float4*)(wk + pc * 8 + 4);
#pragma unroll
    for (int i = 0; i < G::NPC; ++i) { const u32x4 w = r[i];
        float f[8] = {bflo(w.x), bfhi(w.x), bflo(w.y), bfhi(w.y), bflo(w.z), bfhi(w.z), bflo(w.w), bfhi(w.w)};
        float ss = 0.f;
#pragma unroll
        for (int e = 0; e < 8; ++e) ss += f[e] * f[e];
#pragma unroll
        for (int o = 1; o < G::PPR; o <<= 1) ss += __shfl_xor(ss, o);
        const float rstd = (jbase + r0 + i * RS >= 0) ? rsqrtf(ss * (1.0f / HD) + EPSF) : 0.f;
        u32x4 o4; o4.x = cvt_pk_bf16(f[0] * rstd * wa.x, f[1] * rstd * wa.y); o4.y = cvt_pk_bf16(f[2] * rstd * wa.z, f[3] * rstd * wa.w);
        o4.z = cvt_pk_bf16(f[4] * rstd * wb.x, f[5] * rstd * wb.y); o4.w = cvt_pk_bf16(f[6] * rstd * wb.z, f[7] * rstd * wb.w);
        *(LAS u32x4*)(base + i * (RS * G::KSTR)) = o4;
        if (G::NPC > 8) __builtin_amdgcn_sched_barrier(0); }
}
template <int HD> __device__ __forceinline__ void write_v(LAS unsigned char* vl, const u32x4 (&r)[AttnGeo<HD>::NPC], int jbase, int tid) {
    typedef AttnGeo<HD> G; constexpr int RS = NTHR / G::PPR;
    const int r0 = tid / G::PPR, pc = tid % G::PPR;
    LAS unsigned char* base = vl + r0 * G::VSTR + pc * 16;
#pragma unroll
    for (int i = 0; i < G::NPC; ++i) { const bool ok = jbase + r0 + i * RS >= 0; u32x4 w = r[i];
        w.x = ok ? w.x : 0u; w.y = ok ? w.y : 0u; w.z = ok ? w.z : 0u; w.w = ok ? w.w : 0u;
        *(LAS u32x4*)(base + i * (RS * G::VSTR)) = w; }
}
template <int HD, bool ISK> __device__ __forceinline__ void stage_rows(LAS unsigned char* dst, const bf16_t* __restrict__ p, int stride, const float* __restrict__ wk, int tid) {
    typedef AttnGeo<HD> G; constexpr int RS = NTHR / G::PPR, STR = ISK ? G::KSTR : G::VSTR, NB = 8;
    const int r0 = tid / G::PPR, pc = tid % G::PPR;
    LAS unsigned char* base = dst + r0 * STR + pc * 16;
    float4 wa = make_float4(1.f, 1.f, 1.f, 1.f), wb = wa;
    if (ISK) { wa = *(const float4*)(wk + pc * 8); wb = *(const float4*)(wk + pc * 8 + 4); }
#pragma unroll 1
    for (int i0 = 0; i0 < G::NPC; i0 += NB) {
        u32x4 r[NB];
#pragma unroll
        for (int i = 0; i < NB; ++i) r[i] = *(const u32x4*)(p + ((unsigned)(r0 + (i0 + i) * RS) * (unsigned)stride + (unsigned)(pc * 8)));
#pragma unroll
        for (int i = 0; i < NB; ++i) { u32x4 w = r[i];
            if (ISK) {
                float f[8] = {bflo(w.x), bfhi(w.x), bflo(w.y), bfhi(w.y), bflo(w.z), bfhi(w.z), bflo(w.w), bfhi(w.w)};
                float ss = 0.f;
#pragma unroll
                for (int e = 0; e < 8; ++e) ss += f[e] * f[e];
#pragma unroll
                for (int o = 1; o < G::PPR; o <<= 1) ss += __shfl_xor(ss, o);
                const float rstd = rsqrtf(ss * (1.0f / HD) + EPSF);
                w.x = cvt_pk_bf16(f[0] * rstd * wa.x, f[1] * rstd * wa.y); w.y = cvt_pk_bf16(f[2] * rstd * wa.z, f[3] * rstd * wa.w);
                w.z = cvt_pk_bf16(f[4] * rstd * wb.x, f[5] * rstd * wb.y); w.w = cvt_pk_bf16(f[6] * rstd * wb.z, f[7] * rstd * wb.w);
            }
            *(LAS u32x4*)(base + (i0 + i) * (RS * STR)) = w; }
    }
}
template <int HD> __device__ __forceinline__ void norm_q(bf16x8 (&qf)[AttnGeo<HD>::NKS], const u32x4 (&qw)[AttnGeo<HD>::NKS], const float* __restrict__ wq, float scale, int g4) {
    typedef AttnGeo<HD> G;
    float ss = 0.f;
#pragma unroll
    for (int ks = 0; ks < G::NKS; ++ks) { const u32x4 x = qw[ks]; const float a0 = bflo(x.x), a1 = bfhi(x.x), a2 = bflo(x.y), a3 = bfhi(x.y), a4 = bflo(x.z), a5 = bfhi(x.z), a6 = bflo(x.w), a7 = bfhi(x.w);
        ss += a0 * a0 + a1 * a1 + a2 * a2 + a3 * a3 + a4 * a4 + a5 * a5 + a6 * a6 + a7 * a7; }
    ss += __shfl_xor(ss, 16); ss += __shfl_xor(ss, 32);
    const float sc = rsqrtf(ss * (1.0f / HD) + EPSF) * scale;
#pragma unroll
    for (int ks = 0; ks < G::NKS; ++ks) { const u32x4 x = qw[ks]; const float4 wa = *(const float4*)(wq + ks * 32 + g4 * 8), wb = *(const float4*)(wq + ks * 32 + g4 * 8 + 4);
        u32x4 o; o.x = cvt_pk_bf16(bflo(x.x) * sc * wa.x, bfhi(x.x) * sc * wa.y); o.y = cvt_pk_bf16(bflo(x.y) * sc * wa.z, bfhi(x.y) * sc * wa.w);
        o.z = cvt_pk_bf16(bflo(x.z) * sc * wb.x, bfhi(x.z) * sc * wb.y); o.w = cvt_pk_bf16(bflo(x.w) * sc * wb.z, bfhi(x.w) * sc * wb.w);
        qf[ks] = __builtin_bit_cast(bf16x8, o); }
}

struct BandItem { const bf16_t* qp; int rstride; int qb, g, h; size_t row0; int d; };
__device__ __forceinline__ BandItem band_decode(int it, const bf16_t* PROJ) {
    BandItem I; const int g = it >> 9, idx = it & 511, dsh = 2 * g, d = 1 << dsh, nqb = 16 >> dsh;
    I.qb = idx % nqb; int rest = idx / nqb; const int r = rest % d; rest /= d; I.h = rest & 3; const int bl = rest >> 2;
    I.g = g; I.d = d; I.row0 = (size_t)bl * SEQ + r; I.qp = PROJ + I.row0 * PS + g * 512 + I.h * 128; I.rstride = d * PS; return I;
}
__device__ __forceinline__ void attn_banded_run(LAS unsigned char* lds, const bf16_t* __restrict__ PROJ, const float* __restrict__ aqn, const float* __restrict__ akn, bf16_t* __restrict__ OG, float* __restrict__ LSE,
                                                int bx, int G_, const int tid) {
    constexpr int HD = 128; typedef AttnGeo<HD> G;
    const int w = __builtin_amdgcn_readfirstlane(tid >> 6), lane = tid & 63, lq = lane & 15, g4 = lane >> 4;
    LAS unsigned char* kl = lds; LAS unsigned char* vl = lds + 256 * G::KSTR;
    const int n = (1536 - bx + G_ - 1) / G_;
    if (n <= 0) return;
    u32x4 rk[G::NPC], rv[G::NPC], rq[G::NKS];
    { const BandItem I = band_decode(bx, PROJ); const int jb = I.qb * 128 - 128;
      issue_rows<HD>(rk, I.qp + C_K, I.rstride, jb, tid); issue_rows<HD>(rv, I.qp + C_V, I.rstride, jb, tid); issue_q<HD>(rq, I.qp + (unsigned)(I.qb * 128 + 16 * w + lq) * (unsigned)I.rstride, g4); }
    { unsigned zl = 0u; asm volatile("" : "+v"(zl));
      for (int p = tid; p < 16 * G::PPR; p += NTHR) *(LAS u32x4*)(vl + (256 + p / G::PPR) * G::VSTR + (p % G::PPR) * 16) = (u32x4){zl, zl, zl, zl}; }
#pragma unroll 1
    for (int k = 0; k < n; ++k) {
        const BandItem I = band_decode(bx + k * G_, PROJ);
        const int jbase = I.qb * 128 - 128, qi = I.qb * 128 + 16 * w + lq;
        write_k<HD>(kl, rk, jbase, akn + I.g * 128, tid);
        write_v<HD>(vl, rv, jbase, tid);
        bf16x8 qf[G::NKS];
        norm_q<HD>(qf, rq, aqn + I.g * 128, 0.08838834764831845f * 1.4426950408889634f, g4);
        __syncthreads();
        { const int kn = (k + 1 < n) ? k + 1 : k; const BandItem J = band_decode(bx + kn * G_, PROJ); const int jb = J.qb * 128 - 128;
          issue_rows<HD>(rk, J.qp + C_K, J.rstride, jb, tid); issue_rows<HD>(rv, J.qp + C_V, J.rstride, jb, tid); issue_q<HD>(rq, J.qp + (unsigned)(J.qb * 128 + 16 * w + lq) * (unsigned)J.rstride, g4); }
        f32x4 S[10];
        float NEG = -__builtin_inff(); asm volatile("" : "+v"(NEG));
#pragma unroll
        for (int t = 0; t < 9; ++t) {
            const int kt = w + t;
            if (jbase + kt * 16 >= 0) {
                f32x4 sv = (f32x4){0.f, 0.f, 0.f, 0.f};
#pragma unroll
                for (int ks = 0; ks < G::NKS; ++ks) { const bf16x8 kf = *(const LAS bf16x8*)(kl + (kt * 16 + lq) * G::KSTR + ks * 64 + g4 * 16); sv = __builtin_amdgcn_mfma_f32_16x16x32_bf16(kf, qf[ks], sv, 0, 0, 0); }
                if (t == 0) {
#pragma unroll
                    for (int r = 0; r < 4; ++r) sv[r] = (4 * g4 + r >= lq) ? sv[r] : NEG; }
                if (t == 8) {
#pragma unroll
                    for (int r = 0; r < 4; ++r) sv[r] = (4 * g4 + r <= lq) ? sv[r] : NEG; }
                S[t] = sv;
            } else S[t] = (f32x4){NEG, NEG, NEG, NEG};
        }
        S[9] = (f32x4){NEG, NEG, NEG, NEG};
        float mx = NEG;
#pragma unroll
        for (int t = 0; t < 9; ++t)
#pragma unroll
            for (int r = 0; r < 4; ++r) mx = fmaxf(mx, S[t][r]);
        mx = fmaxf(mx, __shfl_xor(mx, 16)); mx = fmaxf(mx, __shfl_xor(mx, 32));
        float l = 0.f;
#pragma unroll
        for (int t = 0; t < 10; ++t)
#pragma unroll
            for (int r = 0; r < 4; ++r) { const float pv = __builtin_amdgcn_exp2f(S[t][r] - mx); l += pv; S[t][r] = pv; }
        l += __shfl_xor(l, 16); l += __shfl_xor(l, 32);
        f32x4 O[G::NDT];
#pragma unroll
        for (int dt = 0; dt < G::NDT; ++dt) O[dt] = (f32x4){0.f, 0.f, 0.f, 0.f};
#pragma unroll
        for (int u = 0; u < 5; ++u) {
            u32x4 pw; pw.x = cvt_pk_bf16(S[2 * u][0], S[2 * u][1]); pw.y = cvt_pk_bf16(S[2 * u][2], S[2 * u][3]); pw.z = cvt_pk_bf16(S[2 * u + 1][0], S[2 * u + 1][1]); pw.w = cvt_pk_bf16(S[2 * u + 1][2], S[2 * u + 1][3]);
            const bf16x8 pb = __builtin_bit_cast(bf16x8, pw);
            const int ka = (w + 2 * u) * 16 + 4 * g4 + (lq >> 2), kb = ka + 16;
            LAS unsigned char* va = vl + ka * G::VSTR + (lane & 3) * 8; LAS unsigned char* vb = vl + kb * G::VSTR + (lane & 3) * 8;
#pragma unroll
            for (int dt = 0; dt < G::NDT; ++dt) {
                const s16x4 x = __builtin_amdgcn_ds_read_tr16_b64_v4i16((LAS s16x4*)(va + dt * 32));
                const s16x4 y = __builtin_amdgcn_ds_read_tr16_b64_v4i16((LAS s16x4*)(vb + dt * 32));
                const bf16x8 av = (bf16x8){x[0], x[1], x[2], x[3], y[0], y[1], y[2], y[3]};
                O[dt] = __builtin_amdgcn_mfma_f32_16x16x32_bf16(av, pb, O[dt], 0, 0, 0);
            }
        }
        const float inv = 1.0f / l;
        const size_t trow = I.row0 + (size_t)qi * I.d;
        bf16_t* orow = OG + trow * 1536 + I.g * 512 + I.h * 128;
#pragma unroll
        for (int dt = 0; dt < G::NDT; ++dt) { u32x2 o; o.x = cvt_pk_bf16(O[dt][0] * inv, O[dt][1] * inv); o.y = cvt_pk_bf16(O[dt][2] * inv, O[dt][3] * inv); *(u32x2*)(orow + dt * 16 + 4 * g4) = o; }
        if (g4 == 0) LSE[trow * 12 + I.g * 4 + I.h] = (mx + __builtin_amdgcn_logf(l)) * 0.6931471805599453f;
        __syncthreads();
    }
}

__device__ __forceinline__ void attn_mem_run(LAS unsigned char* lds, const bf16_t* __restrict__ PROJ, const bf16_t* __restrict__ MKV, const float* __restrict__ wq, const float* __restrict__ wk, bf16_t* __restrict__ ACT,
                                             int half, int bx, int G_, const int tid) {
    constexpr int HD = 256; typedef AttnGeo<HD> G;
    const int w = __builtin_amdgcn_readfirstlane(tid >> 6), lane = tid & 63, lq = lane & 15, g4 = lane >> 4;
    const int n = (512 - bx + G_ - 1) / G_;
    if (n <= 0) return;
#pragma unroll 1
    for (int k = 0; k < n; ++k) {
        const int idx = bx + k * G_, qb = idx & 15, h = (idx >> 4) & 3, bl = idx >> 6, b = half * 8 + bl;
        const size_t trow = (size_t)bl * SEQ + qb * 128 + 16 * w + lq;
        u32x4 rq[G::NKS];
        issue_q<HD>(rq, PROJ + trow * PS + C_MQ + h * 256, g4);
        stage_rows<HD, true>(lds, MKV + (size_t)b * 256 * DM + h * 256, DM, wk, tid);
        bf16x8 qf[G::NKS];
        norm_q<HD>(qf, rq, wq, 0.0625f * 1.4426950408889634f, g4);
        __syncthreads();
        u32x2 P[16]; float l;
        {
            f32x4 S[16];
#pragma unroll
            for (int t = 0; t < 16; ++t) {
                f32x4 sv = (f32x4){0.f, 0.f, 0.f, 0.f};
#pragma unroll
                for (int ks = 0; ks < G::NKS; ++ks) { const bf16x8 kf = *(const LAS bf16x8*)(lds + (t * 16 + lq) * G::KSTR + ks * 64 + g4 * 16); sv = __builtin_amdgcn_mfma_f32_16x16x32_bf16(kf, qf[ks], sv, 0, 0, 0); }
                S[t] = sv;
            }
            float mx = -__builtin_inff(); asm volatile("" : "+v"(mx));
#pragma unroll
            for (int t = 0; t < 16; ++t)
#pragma unroll
                for (int r = 0; r < 4; ++r) mx = fmaxf(mx, S[t][r]);
            mx = fmaxf(mx, __shfl_xor(mx, 16)); mx = fmaxf(mx, __shfl_xor(mx, 32));
            l = 0.f;
#pragma unroll
            for (int t = 0; t < 16; ++t) { const float p0 = __builtin_amdgcn_exp2f(S[t][0] - mx), p1 = __builtin_amdgcn_exp2f(S[t][1] - mx), p2 = __builtin_amdgcn_exp2f(S[t][2] - mx), p3 = __builtin_amdgcn_exp2f(S[t][3] - mx);
                l += (p0 + p1) + (p2 + p3); P[t].x = cvt_pk_bf16(p0, p1); P[t].y = cvt_pk_bf16(p2, p3); }
            l += __shfl_xor(l, 16); l += __shfl_xor(l, 32);
        }
        __syncthreads();
        stage_rows<HD, false>(lds, MKV + (size_t)b * 256 * DM + 1024 + h * 256, DM, wk, tid);
        __syncthreads();
        f32x4 O[G::NDT];
#pragma unroll
        for (int dt = 0; dt < G::NDT; ++dt) O[dt] = (f32x4){0.f, 0.f, 0.f, 0.f};
#pragma unroll
        for (int u = 0; u < 8; ++u) {
            u32x4 pw; pw.x = P[2 * u].x; pw.y = P[2 * u].y; pw.z = P[2 * u + 1].x; pw.w = P[2 * u + 1].y;
            const bf16x8 pb = __builtin_bit_cast(bf16x8, pw);
            const int ka = (2 * u) * 16 + 4 * g4 + (lq >> 2), kb = ka + 16;
            LAS unsigned char* va = lds + ka * G::VSTR + (lane & 3) * 8; LAS unsigned char* vb = lds + kb * G::VSTR + (lane & 3) * 8;
#pragma unroll
            for (int dt = 0; dt < G::NDT; ++dt) {
                const s16x4 x = __builtin_amdgcn_ds_read_tr16_b64_v4i16((LAS s16x4*)(va + dt * 32));
                const s16x4 y = __builtin_amdgcn_ds_read_tr16_b64_v4i16((LAS s16x4*)(vb + dt * 32));
                const bf16x8 av = (bf16x8){x[0], x[1], x[2], x[3], y[0], y[1], y[2], y[3]};
                O[dt] = __builtin_amdgcn_mfma_f32_16x16x32_bf16(av, pb, O[dt], 0, 0, 0);
            }
        }
        const float inv = 1.0f / l;
        const bf16_t* zrow = PROJ + trow * PS + C_ZM + h * 256; bf16_t* arow = ACT + trow * ACTW + 1536 + h * 256;
#pragma unroll
        for (int dt = 0; dt < G::NDT; ++dt) { const u32x2 z = *(const u32x2*)(zrow + dt * 16 + 4 * g4);
            u32x2 o; o.x = cvt_pk_bf16(O[dt][0] * inv * siluf_(bflo(z.x)), O[dt][1] * inv * siluf_(bfhi(z.x))); o.y = cvt_pk_bf16(O[dt][2] * inv * siluf_(bflo(z.y)), O[dt][3] * inv * siluf_(bfhi(z.y)));
            *(u32x2*)(arow + dt * 16 + 4 * g4) = o; }
        __syncthreads();
    }
}

struct Args { const float* in[15]; float* out; unsigned char* ws; int lo, hi; };
enum { I_X = 0, I_MEM, I_NG, I_MNG, I_WIN, I_AQN, I_AKN, I_CW, I_WKV, I_MQN, I_MKN, I_WBA, I_WBC, I_WBM, I_WOUT };
constexpr int NPHASE = 10;

__global__ void __launch_bounds__(NTHR, 2) mega(Args a) {
    extern __shared__ __attribute__((aligned(16))) unsigned char lds_raw[];
    LAS unsigned char* lds = (LAS unsigned char*)lds_raw;
    const int G = gridDim.x, bx = blockIdx.x, wave_s = __builtin_amdgcn_readfirstlane((int)threadIdx.x >> 6);
    unsigned char* ws = a.ws;
    bf16_t* WIN = (bf16_t*)(ws + WS_WIN); bf16_t* WKV = (bf16_t*)(ws + WS_WKV); bf16_t* WBR = (bf16_t*)(ws + WS_WBR); bf16_t* WOUT = (bf16_t*)(ws + WS_WOUT);
    bf16_t* MH = (bf16_t*)(ws + WS_MH); bf16_t* MKV = (bf16_t*)(ws + WS_MKV); bf16_t* PROJ = (bf16_t*)(ws + WS_PROJ); bf16_t* OG = (bf16_t*)(ws + WS_OG);
    float* LSE = (float*)(ws + WS_LSE); bf16_t* ACT = (bf16_t*)(ws + WS_ACT); u32x4* GF = (u32x4*)(ws + WS_GF); bf16_t* MB = (bf16_t*)(ws + WS_MB);
    bf16_t* H = (bf16_t*)(ws + WS_H);

    for (int ph = a.lo; ph < a.hi; ++ph) {
        unsigned ones = ~0u; asm volatile("" : "+s"(ones));
        int tid = wave_s * 64 + (int)__builtin_amdgcn_mbcnt_hi(ones, __builtin_amdgcn_mbcnt_lo(ones, 0u)); asm volatile("" : "+v"(tid));
        const int lane = tid & 63, wave = tid >> 6;
        if (ph == 0) {
            rmsnorm_rows(a.in[I_X], a.in[I_NG], H, LDP, NTOK, bx * 8 + wave, G * 8, lane);
            rmsnorm_rows(a.in[I_MEM], a.in[I_MNG], MH, DM, 4096, bx * 8 + wave, G * 8, lane);
            constexpr int T0 = 32 * 136, T1 = T0 + 512, T2 = T1 + 128, T3 = T2 + 256, T4 = T3 + 256, T5 = T4 + 512;
            auto job = [&](int t) {
                TJob J; int ti;
                if (t < T0) { J.src = a.in[I_WIN]; J.C = PC; J.dst = WIN; J.ld = LDP; J.koff = 0; ti = t; }
                else if (t < T1) { J.src = a.in[I_WKV]; J.C = DM; J.dst = WKV; J.ld = DM; J.koff = 0; ti = t - T0; }
                else if (t < T2) { J.src = a.in[I_WBA]; J.C = DM; J.dst = WBR; J.ld = ACTW; J.koff = 0; ti = t - T1; }
                else if (t < T3) { J.src = a.in[I_WBC]; J.C = DM; J.dst = WBR; J.ld = ACTW; J.koff = 512; ti = t - T2; }
                else if (t < T4) { J.src = a.in[I_WBM]; J.C = DM; J.dst = WBR; J.ld = ACTW; J.koff = 1536; ti = t - T3; }
                else { J.src = a.in[I_WOUT]; J.C = DM; J.dst = WOUT; J.ld = DM; J.koff = 0; ti = t - T4; }
                const int nct = J.C / 128; J.r0 = (ti / nct) * 64; J.c0 = (ti % nct) * 128; return J;
            };
            if (bx < T5) {
                float4 v[4]; TJob J = job(bx); tile_load(v, J, tid);
#pragma unroll 1
                for (int t = bx; t < T5; t += G) {
                    float4 vn[4]; const int tn = (t + G < T5) ? t + G : t; const TJob Jn = job(tn); tile_load(vn, Jn, tid);
                    tile_store((LAS float*)lds, v, J, tid);
                    J = Jn;
#pragma unroll
                    for (int p = 0; p < 4; ++p) v[p] = vn[p];
                }
            }
        } else if (ph == 1 || ph == 5 || ph == 4 || ph == 8 || ph == 9) {
#ifdef PROBE_NOEPI
            const int nj = (ph == 1 || ph == 5) ? 3 : 1, njr = nj;
#else
            const int nj = (ph == 1 || ph == 5) ? 2 : 1, njr = ((REP_MASK >> ph) & 1) ? 2 * nj : nj;
#endif
#pragma unroll 1
            for (int jr = 0; jr < njr; ++jr) {
                const int j = jr >= nj ? jr - nj : jr;
                pg8::Gemm g; pg8::Epi E;
                if (ph == 4 || ph == 8) {
                    g = pg8::Gemm{ACT, WBR, HT, DM, ACTW, ACTW, ACTW}; E = pg8::Epi{5, MB, GF, nullptr, DM, 1 << 20};
                } else if (ph == 1 && j == 0) {
                    g = pg8::Gemm{MH, WKV, 4096, DM, DM, DM, DM}; E = pg8::Epi{0, MKV, nullptr, nullptr, DM, 1 << 20};
                } else if ((ph == 5 && j == 0) || ph == 9) {
                    const size_t ro = (ph == 9) ? (size_t)HT * DM : 0;
                    g = pg8::Gemm{MB, WOUT, HT, DM, DM, DM, DM}; E = pg8::Epi{4, a.out + ro, a.in[I_X] + ro, nullptr, DM, 1 << 20};
                } else {
                    const int half = (ph == 1) ? 0 : 1;
                    g = pg8::Gemm{H + (size_t)half * HT * LDP, WIN, HT, PC, DM, LDP, LDP}; E = pg8::Epi{0, PROJ, nullptr, GF, PS, PS / 256};
                    if (j == 2) E.kind = 9;
                }
                pg8::StaticOrder S; S.init(g.M, g.N, G, bx);
                pg8::gemm_phase(lds, g, S, E, tid);
            }
        } else if (ph == 2 || ph == 6) {
            const int half = (ph == 2) ? 0 : 1;
#pragma unroll 1
            for (int rep = 0; rep < REP_BAND; ++rep)
            attn_banded_run(lds, PROJ, a.in[I_AQN], a.in[I_AKN], OG, LSE, bx, G, tid);
            attn_mem_run(lds, PROJ, MKV, a.in[I_MQN], a.in[I_MKN], ACT, half, bx, G, tid);
        } else if (ph == 3 || ph == 7) {
            const int gt = bx * NTHR + tid, nth = G * NTHR;
            for (int idx = gt; idx < HT * 64; idx += nth) {
                const int row = idx >> 6, c8 = (idx & 63) * 8, h = c8 >> 7;
                const float l0 = LSE[(size_t)row * 12 + h], l1 = LSE[(size_t)row * 12 + 4 + h], l2 = LSE[(size_t)row * 12 + 8 + h];
                const float m = fmaxf(l0, fmaxf(l1, l2)); float w0 = __expf(l0 - m), w1 = __expf(l1 - m), w2 = __expf(l2 - m); const float inv = 1.0f / (w0 + w1 + w2); w0 *= inv; w1 *= inv; w2 *= inv;
                const u32x4 o0 = *(const u32x4*)(OG + (size_t)row * 1536 + c8), o1 = *(const u32x4*)(OG + (size_t)row * 1536 + 512 + c8), o2 = *(const u32x4*)(OG + (size_t)row * 1536 + 1024 + c8);
                const u32x4 z = *(const u32x4*)(PROJ + (size_t)row * PS + C_ZA + c8);
                u32x4 o;
#define CMB(k) o.k = cvt_pk_bf16((w0 * bflo(o0.k) + w1 * bflo(o1.k) + w2 * bflo(o2.k)) * siluf_(bflo(z.k)), (w0 * bfhi(o0.k) + w1 * bfhi(o1.k) + w2 * bfhi(o2.k)) * siluf_(bfhi(z.k)))
                CMB(x); CMB(y); CMB(z); CMB(w);
#undef CMB
                *(u32x4*)(ACT + (size_t)row * ACTW + c8) = o;
            }
            const float* cw = a.in[I_CW];
            for (int idx = gt; idx < HT * 128; idx += nth) {
                const int row = idx >> 7, c8 = (idx & 127) * 8, t = row & (SEQ - 1);
                const bf16_t* pr = PROJ + (size_t)row * PS;
                unsigned zl = 0u; asm volatile("" : "+v"(zl)); const u32x4 z4 = (u32x4){zl, zl, zl, zl};
                const u32x4 c0 = *(const u32x4*)(pr + C_CC + c8), v0 = *(const u32x4*)(pr + C_CV + c8);
                const u32x4 c1 = t >= 1 ? *(const u32x4*)(pr - PS + C_CC + c8) : z4, v1 = t >= 1 ? *(const u32x4*)(pr - PS + C_CV + c8) : z4;
                const u32x4 c2 = t >= 2 ? *(const u32x4*)(pr - 2 * PS + C_CC + c8) : z4, v2 = t >= 2 ? *(const u32x4*)(pr - 2 * PS + C_CV + c8) : z4;
                const u32x4 bb = *(const u32x4*)(pr + C_CB + c8), zz = *(const u32x4*)(pr + C_ZC + c8);
                const float4 wa0 = *(const float4*)(cw + c8), wb0 = *(const float4*)(cw + c8 + 4), wa1 = *(const float4*)(cw + 1024 + c8), wb1 = *(const float4*)(cw + 1024 + c8 + 4), wa2 = *(const float4*)(cw + 2048 + c8), wb2 = *(const float4*)(cw + 2048 + c8 + 4);
                u32x4 o;
#define CV1(f, k, W0, W1, W2) ((W0 * (f(c0.k) * f(v0.k)) + W1 * (f(c1.k) * f(v1.k)) + W2 * (f(c2.k) * f(v2.k))) * f(bb.k) * siluf_(f(zz.k)))
                o.x = cvt_pk_bf16(CV1(bflo, x, wa0.x, wa1.x, wa2.x), CV1(bfhi, x, wa0.y, wa1.y, wa2.y));
                o.y = cvt_pk_bf16(CV1(bflo, y, wa0.z, wa1.z, wa2.z), CV1(bfhi, y, wa0.w, wa1.w, wa2.w));
                o.z = cvt_pk_bf16(CV1(bflo, z, wb0.x, wb1.x, wb2.x), CV1(bfhi, z, wb0.y, wb1.y, wb2.y));
                o.w = cvt_pk_bf16(CV1(bflo, w, wb0.z, wb1.z, wb2.z), CV1(bfhi, w, wb0.w, wb1.w, wb2.w));
#undef CV1
                *(u32x4*)(ACT + (size_t)row * ACTW + 512 + c8) = o;
            }
        }
        if (ph + 1 < a.hi) cg::this_grid().sync();
    }
}

extern "C" void kernel_launch(void* const* d_in, const int* in_sizes, int n_in, void* d_out, int out_size, void* d_ws, size_t ws_size, hipStream_t stream) {
    static int grid = 0;
    if (grid == 0) {
        if (n_in != 15 || ws_size < WS_END) { fprintf(stderr, "kernel_launch: unexpected inputs (n_in %d, ws %zu < %zu)\n", n_in, ws_size, (size_t)WS_END); grid = -1; return; }
        int dev = 0, cus = 0, per_cu = 0;
        hipGetDevice(&dev); hipDeviceGetAttribute(&cus, hipDeviceAttributeMultiprocessorCount, dev);
        if (hipFuncSetAttribute((const void*)mega, hipFuncAttributeMaxDynamicSharedMemorySize, LDS_BYTES) != hipSuccess) { fprintf(stderr, "kernel_launch: hipFuncSetAttribute failed\n"); grid = -1; return; }
        hipOccupancyMaxActiveBlocksPerMultiprocessor(&per_cu, (const void*)mega, NTHR, LDS_BYTES);
        if (per_cu < 1) per_cu = 1;
        grid = cus * 1;
        (void)hipGetLastError();
    }
    if (grid < 0) return;
    Args a{};
    for (int i = 0; i < 15; ++i) a.in[i] = (const float*)d_in[i];
    a.out = (float*)d_out; a.ws = (unsigned char*)d_ws;
#if ONE_LAUNCH
    a.lo = 0; a.hi = NPHASE;
    void* args[] = {&a};
    hipError_t e = hipLaunchCooperativeKernel((const void*)mega, dim3(grid), dim3(NTHR), args, LDS_BYTES, stream);
    if (e != hipSuccess) fprintf(stderr, "cooperative launch failed: %s (grid %d)\n", hipGetErrorString(e), grid);
#else
    for (int ph = 0; ph < NPHASE; ++ph) { a.lo = ph; a.hi = ph + 1; hipLaunchKernelGGL(mega, dim3(grid), dim3(NTHR), LDS_BYTES, stream, a); }
#endif
}
```

```cpp
#include <hip/hip_runtime.h>
#include <hip/hip_cooperative_groups.h>
#include <cstdio>
namespace cg = cooperative_groups;

#ifndef ONE_LAUNCH
#define ONE_LAUNCH 1
#endif

#ifndef REP_MASK
#define REP_MASK 0
#endif
#define REP_BAND 1
#define REP_MEM 1
#define REP_PREP 1
#define EXTRA_SYNCS 0
#ifndef PG8_SP2
#define PG8_SP2 1
#endif
#define LAS __attribute__((address_space(3)))
typedef unsigned short bf16_t;
typedef short bf16x8 __attribute__((ext_vector_type(8)));
typedef short s16x4 __attribute__((ext_vector_type(4)));
typedef float f32x4 __attribute__((ext_vector_type(4)));
typedef unsigned u32x4 __attribute__((ext_vector_type(4)));
typedef unsigned u32x2 __attribute__((ext_vector_type(2)));

constexpr int DM = 2048, SEQ = 2048, NB = 16, NTOK = NB * SEQ;
constexpr int PC = 17408;
constexpr int PS = 11264;
constexpr int HT = NTOK / 2;
constexpr int C_Q = 0, C_K = 1536, C_V = 3072, C_ZA = 4608, C_CB = 5120, C_CC = 6144, C_CV = 7168, C_ZC = 8192, C_MQ = 9216, C_ZM = 10240, C_G = 11264;
constexpr int ACTW = 2560;
constexpr int LDP = 2048 + 64;
constexpr float EPSF = 1e-6f;
constexpr int NTHR = 512;
constexpr int LDS_BYTES = 149504;

constexpr size_t WS_WIN = 0;
constexpr size_t WS_WKV = WS_WIN + (size_t)PC * LDP * 2;
constexpr size_t WS_WBR = WS_WKV + (size_t)DM * DM * 2;
constexpr size_t WS_WOUT = WS_WBR + (size_t)DM * ACTW * 2;
constexpr size_t WS_MH = WS_WOUT + (size_t)DM * DM * 2;
constexpr size_t WS_MKV = WS_MH + (size_t)4096 * DM * 2;
constexpr size_t WS_PROJ = WS_MKV + (size_t)4096 * DM * 2;
constexpr size_t WS_OG = WS_PROJ + (size_t)HT * PS * 2;
constexpr size_t WS_LSE = WS_OG + (size_t)HT * 1536 * 2;
constexpr size_t WS_ACT = WS_LSE + (size_t)HT * 12 * 4;
constexpr size_t WS_GF = WS_ACT + (size_t)HT * ACTW * 2;
constexpr size_t WS_MB = WS_GF + (size_t)HT * 6144 * 2;
constexpr size_t WS_H = WS_MB + (size_t)HT * DM * 2;
constexpr size_t WS_BAR = WS_H + (size_t)NTOK * LDP * 2;
constexpr size_t WS_END = WS_BAR + 16384;
constexpr size_t OUT_H_OFF = (size_t)HT * DM * 4;

__device__ __forceinline__ float bflo(unsigned w) { return __uint_as_float(w << 16); }
__device__ __forceinline__ float bfhi(unsigned w) { return __uint_as_float(w & 0xffff0000u); }
typedef __bf16 bf16x2_t __attribute__((ext_vector_type(2)));
typedef float f32x2_t __attribute__((ext_vector_type(2)));
__device__ __forceinline__ unsigned cvt_pk_bf16(float lo, float hi) { f32x2_t v = {lo, hi}; bf16x2_t b = __builtin_convertvector(v, bf16x2_t); return __builtin_bit_cast(unsigned, b); }
__device__ __forceinline__ float sigmoidf_(float x) { return __builtin_amdgcn_rcpf(1.0f + __builtin_amdgcn_exp2f(x * -1.4426950408889634f)); }
__device__ __forceinline__ float siluf_(float x) { return x * __builtin_amdgcn_rcpf(1.0f + __builtin_amdgcn_exp2f(x * -1.4426950408889634f)); }

namespace pg8 {
constexpr int BM = 256, BK = 64, HALF = 128, HTB = HALF * BK * 2, STAGE_BYTES = 8 * HTB, NXCD = 8, WGM = 8;
__host__ __device__ __forceinline__ int lds_byte(int r, int c) { const int st = (r >> 4) * 2 + (c >> 5), rr = r & 15, cc = c & 31, ob = rr * 64 + cc * 2; return st * 1024 + (ob ^ (((ob >> 9) & 1) << 5)); }
__host__ __device__ __forceinline__ void stage_rc(int b, int& R, int& C) { const int st = b / 1024, sb = b % 1024, swz = sb ^ (((sb >> 9) & 1) << 5); R = (st >> 1) * 16 + swz / 64; C = (st & 1) * 32 + (swz % 64) / 2; }
__host__ __device__ __forceinline__ int perm32(int rho) { const int n = rho >> 4, i = rho & 15; return 8 * (i >> 2) + 4 * n + (i & 3); }
struct Unit { int pm, pn; };
struct Gemm { const bf16_t* A; const bf16_t* Bt; int M, N, K, lda, ldb; };
struct StaticOrder {
    int nM, nN, nwg, G, c;
    __device__ void init(int M, int N, int G_, int c_) { nM = M / BM; nN = N / BM; nwg = nM * nN; G = G_; c = c_; }
    __device__ bool next(int i, Unit& u) const {
        const long L = (long)i * G + c; if (L >= nwg) return false;
        int wgid = (int)L; { const int q = nwg / NXCD, r = nwg % NXCD, xcd = wgid % NXCD, off = wgid / NXCD; wgid = (xcd < r ? xcd * (q + 1) : r * (q + 1) + (xcd - r) * q) + off; }
        const int nig = WGM * nN, gid = wgid / nig, fm = gid * WGM, gsz = (nM - fm) < WGM ? (nM - fm) : WGM;
        u.pm = fm + ((wgid % nig) % gsz); u.pn = (wgid % nig) / gsz; return true;
    }
};

struct Epi;
template <class Epi, class Sched>
__device__ __forceinline__ void gemm_phase(LAS unsigned char* lds, const Gemm g, const Sched& S, const Epi& E, const int tid) {
    const int wid = __builtin_amdgcn_readfirstlane(tid >> 6), lane = tid & 63, wr = wid >> 2, wc = wid & 3, fr = lane & 15, fq = lane >> 4;
    const int K = g.K, nt = K / BK;
    unsigned voffA[2], voffB[2];
#pragma unroll
    for (int i = 0; i < 2; ++i) { int R, C; stage_rc(tid * 16 + i * 8192, R, C); const int Rb = 2 * (R & ~31) + (E.perm() ? perm32(R & 31) : (R & 31));
        voffA[i] = (unsigned)(R * g.lda + C) * 2u; voffB[i] = (unsigned)(Rb * g.ldb + C) * 2u; }
    const size_t kstep = (size_t)(BK * 2);
    const size_t hstepA = (size_t)HALF * g.lda * 2, hstepB = (size_t)32 * g.ldb * 2;
    const size_t tstepA = 2 * hstepA, tstepB = (size_t)BM * g.ldb * 2;
    const unsigned ldsw = (unsigned)wid * 1024u;
    const int aoff = lds_byte(wr * 64 + fr, fq * 8), boff = lds_byte(wc * 32 + fr, fq * 8);
#define PG8_SA(b, h) (((b) * 2 + (h)) * HTB)
#define PG8_SB(b, h) ((4 + (b) * 2 + (h)) * HTB)
#define PG8_STAGE(bufoff, gbase, voff) do { _Pragma("unroll") for (int _i = 0; _i < 2; ++_i) \
        __builtin_amdgcn_global_load_lds((const unsigned*)((const char*)(gbase) + (voff)[_i]), (LAS unsigned*)(lds + (bufoff) + ldsw + _i * 8192), 16, 0, 0); } while (0)
#define PG8_LDA(dst, b, h) do { _Pragma("unroll") for (int m = 0; m < 4; ++m) _Pragma("unroll") for (int k = 0; k < 2; ++k) dst[m][k] = *(const LAS bf16x8*)(lds + PG8_SA(b, h) + aoff + m * 2048 + k * 1024); } while (0)
#define PG8_LDB(dst, b, h) do { _Pragma("unroll") for (int n = 0; n < 2; ++n) _Pragma("unroll") for (int k = 0; k < 2; ++k) dst[n][k] = *(const LAS bf16x8*)(lds + PG8_SB(b, h) + boff + n * 2048 + k * 1024); } while (0)
#define PG8_MMA(ai, bj, At, Bt) do { __builtin_amdgcn_s_setprio(1); _Pragma("unroll") for (int m = 0; m < 4; ++m) _Pragma("unroll") for (int n = 0; n < 2; ++n) _Pragma("unroll") for (int k = 0; k < 2; ++k) \
        acc[ai][bj][m][n] = __builtin_amdgcn_mfma_f32_16x16x32_bf16(Bt[n][k], At[m][k], acc[ai][bj][m][n], 0, 0, 0); __builtin_amdgcn_s_setprio(0); } while (0)
#define PG8_WAIT_V(n) asm volatile("s_waitcnt vmcnt(" #n ")" ::: "memory")
#define PG8_WAIT_L(n) asm volatile("s_waitcnt lgkmcnt(" #n ")" ::: "memory")
#define PG8_BAR __builtin_amdgcn_s_barrier()
#define PG8_SCHED __builtin_amdgcn_sched_barrier(0)
    Unit cur, nxt; int ui = 0;
    if (!S.next(0, cur)) return;
    f32x4 acc[2][2][4][2];
#pragma unroll
    for (int a = 0; a < 2; ++a)
#pragma unroll
        for (int b = 0; b < 2; ++b)
#pragma unroll
            for (int m = 0; m < 4; ++m)
#pragma unroll
                for (int n = 0; n < 2; ++n) acc[a][b][m][n] = (f32x4){0.f, 0.f, 0.f, 0.f};
    bf16x8 At[4][2], B0[2][2], B1[2][2];
    const char* cA = (const char*)g.A + (size_t)cur.pm * tstepA; const char* cB = (const char*)g.Bt + (size_t)cur.pn * tstepB;
#if PG8_SP2
    PG8_STAGE(PG8_SB(0, 0), cB, voffB); PG8_STAGE(PG8_SB(0, 1), cB + hstepB, voffB); PG8_STAGE(PG8_SA(0, 0), cA, voffA); PG8_STAGE(PG8_SA(0, 1), cA + hstepA, voffA);
    if (wr == 1) PG8_BAR;
    PG8_WAIT_V(2); PG8_BAR;
    PG8_STAGE(PG8_SB(1, 0), cB + kstep, voffB); PG8_STAGE(PG8_SA(1, 0), cA + kstep, voffA); PG8_STAGE(PG8_SB(1, 1), cB + hstepB + kstep, voffB);
    PG8_WAIT_V(6); PG8_BAR;
#else
    PG8_STAGE(PG8_SB(0, 0), cB, voffB); PG8_STAGE(PG8_SA(0, 0), cA, voffA); PG8_STAGE(PG8_SB(0, 1), cB + hstepB, voffB); PG8_STAGE(PG8_SA(0, 1), cA + hstepA, voffA);
    if (wr == 1) PG8_BAR;
    PG8_WAIT_V(4); PG8_BAR;
    PG8_STAGE(PG8_SB(1, 0), cB + kstep, voffB); PG8_STAGE(PG8_SA(1, 0), cA + kstep, voffA); PG8_STAGE(PG8_SB(1, 1), cB + hstepB + kstep, voffB);
    PG8_WAIT_V(6); PG8_BAR;
#endif
    for (;;) {
        const bool has_next = S.next(ui + 1, nxt);
        const char* nA = has_next ? (const char*)g.A + (size_t)nxt.pm * tstepA : cA; const char* nB = has_next ? (const char*)g.Bt + (size_t)nxt.pn * tstepB : cB;
        for (int t = 0; t < nt; t += 2) {
            const bool last = (t == nt - 2);
            const char* a1 = cA + (size_t)(t + 1) * kstep;
            const char* a2 = last ? nA : cA + (size_t)(t + 2) * kstep; const char* b2 = last ? nB : cB + (size_t)(t + 2) * kstep;
            const char* a3 = a2 + kstep; const char* b3 = b2 + kstep;
            if (E.has_mid() && (t == 8 || t == 24)) E.mid(acc, cur, tid, t == 8 ? 0 : 1);
#if PG8_SP2
            PG8_LDB(B0, 0, 0); PG8_LDB(B1, 0, 1); PG8_SCHED; PG8_LDA(At, 0, 0); PG8_STAGE(PG8_SA(1, 1), a1 + hstepA, voffA);
            PG8_WAIT_V(8); PG8_WAIT_L(0); PG8_BAR; PG8_MMA(0, 0, At, B0); PG8_MMA(0, 1, At, B1); PG8_BAR; PG8_SCHED;
            PG8_LDA(At, 0, 1); PG8_STAGE(PG8_SB(0, 0), b2, voffB); PG8_STAGE(PG8_SB(0, 1), b2 + hstepB, voffB); PG8_STAGE(PG8_SA(0, 0), a2, voffA);
            PG8_WAIT_V(8); PG8_WAIT_L(0); PG8_BAR; PG8_MMA(1, 0, At, B0); PG8_MMA(1, 1, At, B1); PG8_BAR; PG8_SCHED;
            PG8_LDB(B0, 1, 0); PG8_LDB(B1, 1, 1); PG8_SCHED; PG8_LDA(At, 1, 0); PG8_STAGE(PG8_SA(0, 1), a2 + hstepA, voffA);
            PG8_WAIT_V(8); PG8_WAIT_L(0); PG8_BAR; PG8_MMA(0, 0, At, B0); PG8_MMA(0, 1, At, B1); PG8_BAR; PG8_SCHED;
            PG8_LDA(At, 1, 1); PG8_STAGE(PG8_SB(1, 0), b3, voffB); PG8_STAGE(PG8_SB(1, 1), b3 + hstepB, voffB); PG8_STAGE(PG8_SA(1, 0), a3, voffA);
            PG8_WAIT_V(8); PG8_WAIT_L(0); PG8_BAR; PG8_MMA(1, 0, At, B0); PG8_MMA(1, 1, At, B1); PG8_BAR; PG8_SCHED;
#else
            PG8_LDB(B0, 0, 0); PG8_SCHED; PG8_LDA(At, 0, 0); PG8_STAGE(PG8_SA(1, 1), a1 + hstepA, voffA);
            PG8_WAIT_L(8); PG8_BAR; PG8_WAIT_L(0); PG8_MMA(0, 0, At, B0); PG8_BAR; PG8_SCHED;
            PG8_LDB(B1, 0, 1); PG8_STAGE(PG8_SB(0, 0), b2, voffB);
            PG8_BAR; PG8_WAIT_L(0); PG8_MMA(0, 1, At, B1); PG8_BAR;
            PG8_LDA(At, 0, 1); PG8_STAGE(PG8_SA(0, 0), a2, voffA);
            PG8_BAR; PG8_WAIT_L(0); PG8_MMA(1, 0, At, B0); PG8_BAR; PG8_SCHED;
            PG8_STAGE(PG8_SB(0, 1), b2 + hstepB, voffB);
            PG8_WAIT_V(6); PG8_BAR; PG8_MMA(1, 1, At, B1); PG8_BAR;
            PG8_LDB(B0, 1, 0); PG8_SCHED; PG8_LDA(At, 1, 0); PG8_STAGE(PG8_SA(0, 1), a2 + hstepA, voffA);
            PG8_WAIT_L(8); PG8_BAR; PG8_WAIT_L(0); PG8_MMA(0, 0, At, B0); PG8_BAR; PG8_SCHED;
            PG8_LDB(B1, 1, 1); PG8_STAGE(PG8_SB(1, 0), b3, voffB);
            PG8_BAR; PG8_WAIT_L(0); PG8_MMA(0, 1, At, B1); PG8_BAR;
            PG8_LDA(At, 1, 1); PG8_STAGE(PG8_SA(1, 0), a3, voffA);
            PG8_BAR; PG8_WAIT_L(0); PG8_MMA(1, 0, At, B0); PG8_BAR; PG8_SCHED;
            PG8_STAGE(PG8_SB(1, 1), b3 + hstepB, voffB);
            PG8_WAIT_V(6); PG8_BAR; PG8_MMA(1, 1, At, B1); PG8_BAR;
#endif
        }
        if (wr == 0) PG8_BAR;
        E(acc, cur, wr, wc, fr, fq, tid);
        if (!has_next) break;
#pragma unroll
        for (int a = 0; a < 2; ++a)
#pragma unroll
            for (int b = 0; b < 2; ++b)
#pragma unroll
                for (int m = 0; m < 4; ++m)
#pragma unroll
                    for (int n = 0; n < 2; ++n) acc[a][b][m][n] = (f32x4){0.f, 0.f, 0.f, 0.f};
        cur = nxt; cA = nA; cB = nB; ++ui;
        if (wr == 1) PG8_BAR;
    }
    PG8_WAIT_V(0);
    PG8_BAR;
#undef PG8_SA
#undef PG8_SB
#undef PG8_STAGE
#undef PG8_LDA
#undef PG8_LDB
#undef PG8_MMA
#undef PG8_WAIT_V
#undef PG8_WAIT_L
#undef PG8_BAR
#undef PG8_SCHED
}

struct Epi {
    int kind; void* p0; const void* p1; void* p2; int ldc, gpn0;
    __device__ __forceinline__ bool perm() const { return kind != 4; }
    __device__ __forceinline__ bool has_mid() const { return kind == 5; }
    __device__ __forceinline__ void mid(f32x4 (&acc)[2][2][4][2], const Unit& u, int tid, int which) const {
        const u32x4* ga = (const u32x4*)p1 + ((size_t)(u.pm * 24 + 8 * which + u.pn) * 16) * 512 + tid; const u32x4* gb = ga + (size_t)8 * 16 * 512;
        u32x4 x[16];
#pragma unroll
        for (int i = 0; i < 16; ++i) x[i] = ga[i * 512];
        asm volatile("s_waitcnt vmcnt(0)" ::: "memory");
#pragma unroll
        for (int i = 0; i < 16; ++i) { const int ai = i >> 3, m = (i >> 1) & 3, bj = i & 1; const u32x4 y = x[i];
            acc[ai][bj][m][0] *= (f32x4){bflo(y.x), bfhi(y.x), bflo(y.y), bfhi(y.y)}; acc[ai][bj][m][1] *= (f32x4){bflo(y.z), bfhi(y.z), bflo(y.w), bfhi(y.w)}; }
        asm volatile("" ::: "memory");
#pragma unroll
        for (int i = 0; i < 16; ++i) x[i] = gb[i * 512];
        asm volatile("s_waitcnt vmcnt(0)" ::: "memory");
#pragma unroll
        for (int i = 0; i < 16; ++i) { const int ai = i >> 3, m = (i >> 1) & 3, bj = i & 1; const u32x4 y = x[i];
            acc[ai][bj][m][0] *= (f32x4){__builtin_amdgcn_rcpf(bflo(y.x)), __builtin_amdgcn_rcpf(bfhi(y.x)), __builtin_amdgcn_rcpf(bflo(y.y)), __builtin_amdgcn_rcpf(bfhi(y.y))};
            acc[ai][bj][m][1] *= (f32x4){__builtin_amdgcn_rcpf(bflo(y.z)), __builtin_amdgcn_rcpf(bfhi(y.z)), __builtin_amdgcn_rcpf(bflo(y.w)), __builtin_amdgcn_rcpf(bfhi(y.w))}; }
    }
    __device__ __forceinline__ void operator()(const f32x4 (&acc)[2][2][4][2], const Unit& u, int wr, int wc, int fr, int fq, int tid) const {
        const int row0 = u.pm * BM + wr * 64 + fr;
        if (kind == 0 && u.pn >= gpn0) {
            u32x4* gf = (u32x4*)p2 + ((size_t)(u.pm * 24 + (u.pn - gpn0)) * 16) * 512 + tid;
#pragma unroll
            for (int ai = 0; ai < 2; ++ai)
#pragma unroll
                for (int m = 0; m < 4; ++m)
#pragma unroll
                    for (int bj = 0; bj < 2; ++bj) { const f32x4 v0 = acc[ai][bj][m][0], v1 = acc[ai][bj][m][1];
                        u32x4 w; w.x = cvt_pk_bf16(sigmoidf_(v0[0]), sigmoidf_(v0[1])); w.y = cvt_pk_bf16(sigmoidf_(v0[2]), sigmoidf_(v0[3])); w.z = cvt_pk_bf16(sigmoidf_(v1[0]), sigmoidf_(v1[1])); w.w = cvt_pk_bf16(sigmoidf_(v1[2]), sigmoidf_(v1[3]));
                        gf[((ai * 4 + m) * 2 + bj) * 512] = w; }
        } else if (kind == 0) {
            bf16_t* O = (bf16_t*)p0; const int col0 = u.pn * BM + wc * 64 + 8 * fq;
#pragma unroll
            for (int ai = 0; ai < 2; ++ai)
#pragma unroll
                for (int m = 0; m < 4; ++m) { bf16_t* rowp = O + (size_t)(row0 + ai * HALF + m * 16) * ldc + col0;
#pragma unroll
                    for (int bj = 0; bj < 2; ++bj) { const f32x4 v0 = acc[ai][bj][m][0], v1 = acc[ai][bj][m][1];
                        u32x4 w; w.x = cvt_pk_bf16(v0[0], v0[1]); w.y = cvt_pk_bf16(v0[2], v0[3]); w.z = cvt_pk_bf16(v1[0], v1[1]); w.w = cvt_pk_bf16(v1[2], v1[3]);
                        *(u32x4*)(rowp + bj * 32) = w; } }
        } else if (kind == 4) {
            const float* x = (const float*)p1; float* out = (float*)p0; const int col0 = u.pn * BM + wc * 64 + 4 * fq;
#pragma unroll
            for (int am = 0; am < 4; ++am) {
                const int ai = am >> 1, mb = (am & 1) * 2;
                f32x4 xv[2][2][2];
#pragma unroll
                for (int m = 0; m < 2; ++m) { const size_t off = (size_t)(row0 + ai * HALF + (mb + m) * 16) * DM + col0;
#pragma unroll
                    for (int bj = 0; bj < 2; ++bj)
#pragma unroll
                        for (int n = 0; n < 2; ++n) xv[m][bj][n] = *(const f32x4*)(x + off + bj * 32 + n * 16); }
                asm volatile("s_waitcnt vmcnt(0)" ::: "memory");
#pragma unroll
                for (int m = 0; m < 2; ++m) { const size_t off = (size_t)(row0 + ai * HALF + (mb + m) * 16) * DM + col0;
#pragma unroll
                    for (int bj = 0; bj < 2; ++bj)
#pragma unroll
                        for (int n = 0; n < 2; ++n) *(f32x4*)(out + off + bj * 32 + n * 16) = xv[m][bj][n] + acc[ai][bj][mb + m][n]; }
                asm volatile("" ::: "memory");
            }
        } else if (kind == 5) {
            bf16_t* O = (bf16_t*)p0; const int col0 = u.pn * BM + wc * 64 + 8 * fq;
            const u32x4* gc = (const u32x4*)p1 + ((size_t)(u.pm * 24 + 16 + u.pn) * 16) * 512 + tid;
            u32x4 gy[16];
#pragma unroll
            for (int i = 0; i < 16; ++i) gy[i] = gc[i * 512];
            asm volatile("s_waitcnt vmcnt(0)" ::: "memory");
#pragma unroll
            for (int ai = 0; ai < 2; ++ai)
#pragma unroll
                for (int m = 0; m < 4; ++m) { bf16_t* rowp = O + (size_t)(row0 + ai * HALF + m * 16) * ldc + col0;
#pragma unroll
                    for (int bj = 0; bj < 2; ++bj) { const f32x4 v0 = acc[ai][bj][m][0], v1 = acc[ai][bj][m][1]; const u32x4 y = gy[(ai * 4 + m) * 2 + bj];
                        u32x4 w; w.x = cvt_pk_bf16(v0[0] * bflo(y.x), v0[1] * bfhi(y.x)); w.y = cvt_pk_bf16(v0[2] * bflo(y.y), v0[3] * bfhi(y.y)); w.z = cvt_pk_bf16(v1[0] * bflo(y.z), v1[1] * bfhi(y.z)); w.w = cvt_pk_bf16(v1[2] * bflo(y.w), v1[3] * bfhi(y.w));
                        *(u32x4*)(rowp + bj * 32) = w; } }
        }
    }
};
}

__device__ __forceinline__ void rmsnorm_rows(const float* __restrict__ x, const float* __restrict__ g, bf16_t* __restrict__ out, int ldo, int nrows, int gw, int nw, int lane) {
    for (int row = gw; row < nrows; row += nw) {
        const float4* xr = (const float4*)(x + (size_t)row * DM);
        float4 v[8]; float ss = 0.f;
#pragma unroll
        for (int i = 0; i < 4; ++i) { const int c = lane + 64 * i; v[2 * i] = xr[2 * c]; v[2 * i + 1] = xr[2 * c + 1]; }
#pragma unroll
        for (int i = 0; i < 8; ++i) ss += v[i].x * v[i].x + v[i].y * v[i].y + v[i].z * v[i].z + v[i].w * v[i].w;
#pragma unroll
        for (int o = 32; o >= 1; o >>= 1) ss += __shfl_xor(ss, o);
        const float rstd = rsqrtf(ss * (1.0f / DM) + EPSF);
#pragma unroll
        for (int i = 0; i < 4; ++i) { const int c = lane + 64 * i; const float4 ga = ((const float4*)g)[2 * c], gb = ((const float4*)g)[2 * c + 1]; const float4 a = v[2 * i], b = v[2 * i + 1];
            u32x4 w; w.x = cvt_pk_bf16(a.x * rstd * ga.x, a.y * rstd * ga.y); w.y = cvt_pk_bf16(a.z * rstd * ga.z, a.w * rstd * ga.w);
            w.z = cvt_pk_bf16(b.x * rstd * gb.x, b.y * rstd * gb.y); w.w = cvt_pk_bf16(b.z * rstd * gb.z, b.w * rstd * gb.w);
            *(u32x4*)(out + (size_t)row * ldo + c * 8) = w; }
    }
}
struct TJob { const float* src; bf16_t* dst; int C, ld, koff, r0, c0; };
__device__ __forceinline__ void tile_load(float4 (&v)[4], const TJob& J, int tid) {
#pragma unroll
    for (int p = 0; p < 4; ++p) { const int r = p * 16 + (tid >> 5), c4 = (tid & 31) * 4; v[p] = *(const float4*)(J.src + (size_t)(J.r0 + r) * J.C + J.c0 + c4); }
}
__device__ __forceinline__ void tile_store(LAS float* t  , const float4 (&v)[4], const TJob& J, int tid) {
#pragma unroll
    for (int p = 0; p < 4; ++p) { const int r = p * 16 + (tid >> 5), c4 = (tid & 31) * 4; LAS float* q = t + r * 129 + c4; q[0] = v[p].x; q[1] = v[p].y; q[2] = v[p].z; q[3] = v[p].w; }
    __syncthreads();
#pragma unroll
    for (int h = 0; h < 2; ++h) { const int c = h * 64 + (tid >> 3), rc = (tid & 7) * 8; float f[8];
#pragma unroll
        for (int j = 0; j < 8; ++j) f[j] = t[(rc + j) * 129 + c];
        u32x4 w; w.x = cvt_pk_bf16(f[0], f[1]); w.y = cvt_pk_bf16(f[2], f[3]); w.z = cvt_pk_bf16(f[4], f[5]); w.w = cvt_pk_bf16(f[6], f[7]);
        *(u32x4*)(J.dst + (size_t)(J.c0 + c) * J.ld + J.koff + J.r0 + rc) = w; }
    __syncthreads();
}

template <int HD> struct AttnGeo { static constexpr int KSTR = HD * 2 + 16, VSTR = HD * 2 + 32, PPR = HD / 8, NKS = HD / 32, NDT = HD / 16, NPC = 256 * (HD / 8) / NTHR; };

template <int HD> __device__ __forceinline__ void issue_rows(u32x4 (&r)[AttnGeo<HD>::NPC], const bf16_t* __restrict__ p, int stride, int jbase, int tid) {
    typedef AttnGeo<HD> G; constexpr int RS = NTHR / G::PPR;
    const int r0 = tid / G::PPR, pc = tid % G::PPR;
#pragma unroll
    for (int i = 0; i < G::NPC; ++i) { int j = jbase + r0 + i * RS; j = j < 0 ? 0 : j;
        r[i] = *(const u32x4*)(p + ((unsigned)j * (unsigned)stride + (unsigned)(pc * 8))); }
}
template <int HD> __device__ __forceinline__ void issue_q(u32x4 (&q)[AttnGeo<HD>::NKS], const bf16_t* __restrict__ qrow, int g4) {
#pragma unroll
    for (int ks = 0; ks < AttnGeo<HD>::NKS; ++ks) q[ks] = *(const u32x4*)(qrow + ks * 32 + g4 * 8);
}
template <int HD> __device__ __forceinline__ void write_k(LAS unsigned char* kl, const u32x4 (&r)[AttnGeo<HD>::NPC], int jbase, const float* __restrict__ wk, int tid) {
    typedef AttnGeo<HD> G; constexpr int RS = NTHR / G::PPR;
    const int r0 = tid / G::PPR, pc = tid % G::PPR;
    LAS unsigned char* base = kl + r0 * G::KSTR + pc * 16;
    const float4 wa = *(const float4*)(wk + pc * 8), wb = *(const float4*)(wk + pc * 8 + 4);
#pragma unroll
    for (int i = 0; i < G::NPC; ++i) { const u32x4 w = r[i];
        float f[8] = {bflo(w.x), bfhi(w.x), bflo(w.y), bfhi(w.y), bflo(w.z), bfhi(w.z), bflo(w.w), bfhi(w.w)};
        float ss = 0.f;
#pragma unroll
        for (int e = 0; e < 8; ++e) ss += f[e] * f[e];
#pragma unroll
        for (int o = 1; o < G::PPR; o <<= 1) ss += __shfl_xor(ss, o);
        const float rstd = (jbase + r0 + i * RS >= 0) ? rsqrtf(ss * (1.0f / HD) + EPSF) : 0.f;
        u32x4 o4; o4.x = cvt_pk_bf16(f[0] * rstd * wa.x, f[1] * rstd * wa.y); o4.y = cvt_pk_bf16(f[2] * rstd * wa.z, f[3] * rstd * wa.w);
        o4.z = cvt_pk_bf16(f[4] * rstd * wb.x, f[5] * rstd * wb.y); o4.w = cvt_pk_bf16(f[6] * rstd * wb.z, f[7] * rstd * wb.w);
        *(LAS u32x4*)(base + i * (RS * G::KSTR)) = o4;
        if (G::NPC > 8) __builtin_amdgcn_sched_barrier(0); }
}
template <int HD> __device__ __forceinline__ void write_v(LAS unsigned char* vl, const u32x4 (&r)[AttnGeo<HD>::NPC], int jbase, int tid) {
    typedef AttnGeo<HD> G; constexpr int RS = NTHR / G::PPR;
    const int r0 = tid / G::PPR, pc = tid % G::PPR;
    LAS unsigned char* base = vl + r0 * G::VSTR + pc * 16;
#pragma unroll
    for (int i = 0; i < G::NPC; ++i) { const bool ok = jbase + r0 + i * RS >= 0; u32x4 w = r[i];
        w.x = ok ? w.x : 0u; w.y = ok ? w.y : 0u; w.z = ok ? w.z : 0u; w.w = ok ? w.w : 0u;
        *(LAS u32x4*)(base + i * (RS * G::VSTR)) = w; }
}
template <int HD, bool ISK> __device__ __forceinline__ void stage_rows(LAS unsigned char* dst, const bf16_t* __restrict__ p, int stride, const float* __restrict__ wk, int tid) {
    typedef AttnGeo<HD> G; constexpr int RS = NTHR / G::PPR, STR = ISK ? G::KSTR : G::VSTR, NB = 8;
    const int r0 = tid / G::PPR, pc = tid % G::PPR;
    LAS unsigned char* base = dst + r0 * STR + pc * 16;
    float4 wa = make_float4(1.f, 1.f, 1.f, 1.f), wb = wa;
    if (ISK) { wa = *(const float4*)(wk + pc * 8); wb = *(const float4*)(wk + pc * 8 + 4); }
#pragma unroll 1
    for (int i0 = 0; i0 < G::NPC; i0 += NB) {
        u32x4 r[NB];
#pragma unroll
        for (int i = 0; i < NB; ++i) r[i] = *(const u32x4*)(p + ((unsigned)(r0 + (i0 + i) * RS) * (unsigned)stride + (unsigned)(pc * 8)));
#pragma unroll
        for (int i = 0; i < NB; ++i) { u32x4 w = r[i];
            if (ISK) {
                float f[8] = {bflo(w.x), bfhi(w.x), bflo(w.y), bfhi(w.y), bflo(w.z), bfhi(w.z), bflo(w.w), bfhi(w.w)};
                float ss = 0.f;
#pragma unroll
                for (int e = 0; e < 8; ++e) ss += f[e] * f[e];
#pragma unroll
                for (int o = 1; o < G::PPR; o <<= 1) ss += __shfl_xor(ss, o);
                const float rstd = rsqrtf(ss * (1.0f / HD) + EPSF);
                w.x = cvt_pk_bf16(f[0] * rstd * wa.x, f[1] * rstd * wa.y); w.y = cvt_pk_bf16(f[2] * rstd * wa.z, f[3] * rstd * wa.w);
                w.z = cvt_pk_bf16(f[4] * rstd * wb.x, f[5] * rstd * wb.y); w.w = cvt_pk_bf16(f[6] * rstd * wb.z, f[7] * rstd * wb.w);
            }
            *(LAS u32x4*)(base + (i0 + i) * (RS * STR)) = w; }
    }
}
template <int HD> __device__ __forceinline__ void norm_q(bf16x8 (&qf)[AttnGeo<HD>::NKS], const u32x4 (&qw)[AttnGeo<HD>::NKS], const float* __restrict__ wq, float scale, int g4) {
    typedef AttnGeo<HD> G;
    float ss = 0.f;
#pragma unroll
    for (int ks = 0; ks < G::NKS; ++ks) { const u32x4 x = qw[ks]; const float a0 = bflo(x.x), a1 = bfhi(x.x), a2 = bflo(x.y), a3 = bfhi(x.y), a4 = bflo(x.z), a5 = bfhi(x.z), a6 = bflo(x.w), a7 = bfhi(x.w);
        ss += a0 * a0 + a1 * a1 + a2 * a2 + a3 * a3 + a4 * a4 + a5 * a5 + a6 * a6 + a7 * a7; }
    ss += __shfl_xor(ss, 16); ss += __shfl_xor(ss, 32);
    const float sc = rsqrtf(ss * (1.0f / HD) + EPSF) * scale;
#pragma unroll
    for (int ks = 0; ks < G::NKS; ++ks) { const u32x4 x = qw[ks]; const float4 wa = *(const float4*)(wq + ks * 32 + g4 * 8), wb = *(const float4*)(wq + ks * 32 + g4 * 8 + 4);
        u32x4 o; o.x = cvt_pk_bf16(bflo(x.x) * sc * wa.x, bfhi(x.x) * sc * wa.y); o.y = cvt_pk_bf16(bflo(x.y) * sc * wa.z, bfhi(x.y) * sc * wa.w);
        o.z = cvt_pk_bf16(bflo(x.z) * sc * wb.x, bfhi(x.z) * sc * wb.y); o.w = cvt_pk_bf16(bflo(x.w) * sc * wb.z, bfhi(x.w) * sc * wb.w);
        qf[ks] = __builtin_bit_cast(bf16x8, o); }
}

struct BandItem { const bf16_t* qp; int rstride; int qb, g, h; size_t row0; int d; };
__device__ __forceinline__ BandItem band_decode(int it, const bf16_t* PROJ) {
    BandItem I; const int g = it >> 9, idx = it & 511, dsh = 2 * g, d = 1 << dsh, nqb = 16 >> dsh;
    I.qb = idx % nqb; int rest = idx / nqb; const int r = rest % d; rest /= d; I.h = rest & 3; const int bl = rest >> 2;
    I.g = g; I.d = d; I.row0 = (size_t)bl * SEQ + r; I.qp = PROJ + I.row0 * PS + g * 512 + I.h * 128; I.rstride = d * PS; return I;
}
__device__ __forceinline__ void attn_banded_run(LAS unsigned char* lds, const bf16_t* __restrict__ PROJ, const float* __restrict__ aqn, const float* __restrict__ akn, bf16_t* __restrict__ OG, float* __restrict__ LSE,
                                                int bx, int G_, const int tid) {
    constexpr int HD = 128; typedef AttnGeo<HD> G;
    const int w = __builtin_amdgcn_readfirstlane(tid >> 6), lane = tid & 63, lq = lane & 15, g4 = lane >> 4;
    LAS unsigned char* kl = lds; LAS unsigned char* vl = lds + 256 * G::KSTR;
    const int n = (1536 - bx + G_ - 1) / G_;
    if (n <= 0) return;
    u32x4 rk[G::NPC], rv[G::NPC], rq[G::NKS];
    { const BandItem I = band_decode(bx, PROJ); const int jb = I.qb * 128 - 128;
      issue_rows<HD>(rk, I.qp + C_K, I.rstride, jb, tid); issue_rows<HD>(rv, I.qp + C_V, I.rstride, jb, tid); issue_q<HD>(rq, I.qp + (unsigned)(I.qb * 128 + 16 * w + lq) * (unsigned)I.rstride, g4); }
    { unsigned zl = 0u; asm volatile("" : "+v"(zl));
      for (int p = tid; p < 16 * G::PPR; p += NTHR) *(LAS u32x4*)(vl + (256 + p / G::PPR) * G::VSTR + (p % G::PPR) * 16) = (u32x4){zl, zl, zl, zl}; }
#pragma unroll 1
    for (int k = 0; k < n; ++k) {
        const BandItem I = band_decode(bx + k * G_, PROJ);
        const int jbase = I.qb * 128 - 128, qi = I.qb * 128 + 16 * w + lq;
        write_k<HD>(kl, rk, jbase, akn + I.g * 128, tid);
        write_v<HD>(vl, rv, jbase, tid);
        bf16x8 qf[G::NKS];
        norm_q<HD>(qf, rq, aqn + I.g * 128, 0.08838834764831845f * 1.4426950408889634f, g4);
        __syncthreads();
        { const int kn = (k + 1 < n) ? k + 1 : k; const BandItem J = band_decode(bx + kn * G_, PROJ); const int jb = J.qb * 128 - 128;
          issue_rows<HD>(rk, J.qp + C_K, J.rstride, jb, tid); issue_rows<HD>(rv, J.qp + C_V, J.rstride, jb, tid); issue_q<HD>(rq, J.qp + (unsigned)(J.qb * 128 + 16 * w + lq) * (unsigned)J.rstride, g4); }
        f32x4 S[10];
        float NEG = -__builtin_inff(); asm volatile("" : "+v"(NEG));
#pragma unroll
        for (int t = 0; t < 9; ++t) {
            const int kt = w + t;
            if (jbase + kt * 16 >= 0) {
                f32x4 sv = (f32x4){0.f, 0.f, 0.f, 0.f};
#pragma unroll
                for (int ks = 0; ks < G::NKS; ++ks) { const bf16x8 kf = *(const LAS bf16x8*)(kl + (kt * 16 + lq) * G::KSTR + ks * 64 + g4 * 16); sv = __builtin_amdgcn_mfma_f32_16x16x32_bf16(kf, qf[ks], sv, 0, 0, 0); }
                if (t == 0) {
#pragma unroll
                    for (int r = 0; r < 4; ++r) sv[r] = (4 * g4 + r >= lq) ? sv[r] : NEG; }
                if (t == 8) {
#pragma unroll
                    for (int r = 0; r < 4; ++r) sv[r] = (4 * g4 + r <= lq) ? sv[r] : NEG; }
                S[t] = sv;
            } else S[t] = (f32x4){NEG, NEG, NEG, NEG};
        }
        S[9] = (f32x4){NEG, NEG, NEG, NEG};
        float mx = NEG;
#pragma unroll
        for (int t = 0; t < 9; ++t)
#pragma unroll
            for (int r = 0; r < 4; ++r) mx = fmaxf(mx, S[t][r]);
        mx = fmaxf(mx, __shfl_xor(mx, 16)); mx = fmaxf(mx, __shfl_xor(mx, 32));
        float l = 0.f;
#pragma unroll
        for (int t = 0; t < 10; ++t)
#pragma unroll
            for (int r = 0; r < 4; ++r) { const float pv = __builtin_amdgcn_exp2f(S[t][r] - mx); l += pv; S[t][r] = pv; }
        l += __shfl_xor(l, 16); l += __shfl_xor(l, 32);
        f32x4 O[G::NDT];
#pragma unroll
        for (int dt = 0; dt < G::NDT; ++dt) O[dt] = (f32x4){0.f, 0.f, 0.f, 0.f};
#pragma unroll
        for (int u = 0; u < 5; ++u) {
            u32x4 pw; pw.x = cvt_pk_bf16(S[2 * u][0], S[2 * u][1]); pw.y = cvt_pk_bf16(S[2 * u][2], S[2 * u][3]); pw.z = cvt_pk_bf16(S[2 * u + 1][0], S[2 * u + 1][1]); pw.w = cvt_pk_bf16(S[2 * u + 1][2], S[2 * u + 1][3]);
            const bf16x8 pb = __builtin_bit_cast(bf16x8, pw);
            const int ka = (w + 2 * u) * 16 + 4 * g4 + (lq >> 2), kb = ka + 16;
            LAS unsigned char* va = vl + ka * G::VSTR + (lane & 3) * 8; LAS unsigned char* vb = vl + kb * G::VSTR + (lane & 3) * 8;
#pragma unroll
            for (int dt = 0; dt < G::NDT; ++dt) {
                const s16x4 x = __builtin_amdgcn_ds_read_tr16_b64_v4i16((LAS s16x4*)(va + dt * 32));
                const s16x4 y = __builtin_amdgcn_ds_read_tr16_b64_v4i16((LAS s16x4*)(vb + dt * 32));
                const bf16x8 av = (bf16x8){x[0], x[1], x[2], x[3], y[0], y[1], y[2], y[3]};
                O[dt] = __builtin_amdgcn_mfma_f32_16x16x32_bf16(av, pb, O[dt], 0, 0, 0);
            }
        }
        const float inv = 1.0f / l;
        const size_t trow = I.row0 + (size_t)qi * I.d;
        bf16_t* orow = OG + trow * 1536 + I.g * 512 + I.h * 128;
#pragma unroll
        for (int dt = 0; dt < G::NDT; ++dt) { u32x2 o; o.x = cvt_pk_bf16(O[dt][0] * inv, O[dt][1] * inv); o.y = cvt_pk_bf16(O[dt][2] * inv, O[dt][3] * inv); *(u32x2*)(orow + dt * 16 + 4 * g4) = o; }
        if (g4 == 0) LSE[trow * 12 + I.g * 4 + I.h] = (mx + __builtin_amdgcn_logf(l)) * 0.6931471805599453f;
        __syncthreads();
    }
}

__device__ __forceinline__ void attn_mem_run(LAS unsigned char* lds, const bf16_t* __restrict__ PROJ, const bf16_t* __restrict__ MKV, const float* __restrict__ wq, const float* __restrict__ wk, bf16_t* __restrict__ ACT,
                                             int half, int bx, int G_, const int tid) {
    constexpr int HD = 256; typedef AttnGeo<HD> G;
    const int w = __builtin_amdgcn_readfirstlane(tid >> 6), lane = tid & 63, lq = lane & 15, g4 = lane >> 4;
    const int n = (512 - bx + G_ - 1) / G_;
    if (n <= 0) return;
#pragma unroll 1
    for (int k = 0; k < n; ++k) {
        const int idx = bx + k * G_, qb = idx & 15, h = (idx >> 4) & 3, bl = idx >> 6, b = half * 8 + bl;
        const size_t trow = (size_t)bl * SEQ + qb * 128 + 16 * w + lq;
        u32x4 rq[G::NKS];
        issue_q<HD>(rq, PROJ + trow * PS + C_MQ + h * 256, g4);
        stage_rows<HD, true>(lds, MKV + (size_t)b * 256 * DM + h * 256, DM, wk, tid);
        bf16x8 qf[G::NKS];
        norm_q<HD>(qf, rq, wq, 0.0625f * 1.4426950408889634f, g4);
        __syncthreads();
        u32x2 P[16]; float l;
        {
            f32x4 S[16];
#pragma unroll
            for (int t = 0; t < 16; ++t) {
                f32x4 sv = (f32x4){0.f, 0.f, 0.f, 0.f};
#pragma unroll
                for (int ks = 0; ks < G::NKS; ++ks) { const bf16x8 kf = *(const LAS bf16x8*)(lds + (t * 16 + lq) * G::KSTR + ks * 64 + g4 * 16); sv = __builtin_amdgcn_mfma_f32_16x16x32_bf16(kf, qf[ks], sv, 0, 0, 0); }
                S[t] = sv;
            }
            float mx = -__builtin_inff(); asm volatile("" : "+v"(mx));
#pragma unroll
            for (int t = 0; t < 16; ++t)
#pragma unroll
                for (int r = 0; r < 4; ++r) mx = fmaxf(mx, S[t][r]);
            mx = fmaxf(mx, __shfl_xor(mx, 16)); mx = fmaxf(mx, __shfl_xor(mx, 32));
            l = 0.f;
#pragma unroll
            for (int t = 0; t < 16; ++t) { const float p0 = __builtin_amdgcn_exp2f(S[t][0] - mx), p1 = __builtin_amdgcn_exp2f(S[t][1] - mx), p2 = __builtin_amdgcn_exp2f(S[t][2] - mx), p3 = __builtin_amdgcn_exp2f(S[t][3] - mx);
                l += (p0 + p1) + (p2 + p3); P[t].x = cvt_pk_bf16(p0, p1); P[t].y = cvt_pk_bf16(p2, p3); }
            l += __shfl_xor(l, 16); l += __shfl_xor(l, 32);
        }
        __syncthreads();
        stage_rows<HD, false>(lds, MKV + (size_t)b * 256 * DM + 1024 + h * 256, DM, wk, tid);
        __syncthreads();
        f32x4 O[G::NDT];
#pragma unroll
        for (int dt = 0; dt < G::NDT; ++dt) O[dt] = (f32x4){0.f, 0.f, 0.f, 0.f};
#pragma unroll
        for (int u = 0; u < 8; ++u) {
            u32x4 pw; pw.x = P[2 * u].x; pw.y = P[2 * u].y; pw.z = P[2 * u + 1].x; pw.w = P[2 * u + 1].y;
            const bf16x8 pb = __builtin_bit_cast(bf16x8, pw);
            const int ka = (2 * u) * 16 + 4 * g4 + (lq >> 2), kb = ka + 16;
            LAS unsigned char* va = lds + ka * G::VSTR + (lane & 3) * 8; LAS unsigned char* vb = lds + kb * G::VSTR + (lane & 3) * 8;
#pragma unroll
            for (int dt = 0; dt < G::NDT; ++dt) {
                const s16x4 x = __builtin_amdgcn_ds_read_tr16_b64_v4i16((LAS s16x4*)(va + dt * 32));
                const s16x4 y = __builtin_amdgcn_ds_read_tr16_b64_v4i16((LAS s16x4*)(vb + dt * 32));
                const bf16x8 av = (bf16x8){x[0], x[1], x[2], x[3], y[0], y[1], y[2], y[3]};
                O[dt] = __builtin_amdgcn_mfma_f32_16x16x32_bf16(av, pb, O[dt], 0, 0, 0);
            }
        }
        const float inv = 1.0f / l;
        const bf16_t* zrow = PROJ + trow * PS + C_ZM + h * 256; bf16_t* arow = ACT + trow * ACTW + 1536 + h * 256;
#pragma unroll
        for (int dt = 0; dt < G::NDT; ++dt) { const u32x2 z = *(const u32x2*)(zrow + dt * 16 + 4 * g4);
            u32x2 o; o.x = cvt_pk_bf16(O[dt][0] * inv * siluf_(bflo(z.x)), O[dt][1] * inv * siluf_(bfhi(z.x))); o.y = cvt_pk_bf16(O[dt][2] * inv * siluf_(bflo(z.y)), O[dt][3] * inv * siluf_(bfhi(z.y)));
            *(u32x2*)(arow + dt * 16 + 4 * g4) = o; }
        __syncthreads();
    }
}

#define XB_TMO      128
#define XB_XCNT(j)  (256  + 64 * (j))
#define XB_XSUB(j)  (1280 + 64 * (j))
#define XB_XGEN(j)  (2304 + 64 * (j))
#define XB_TOP      3328
#define XB_TOPGEN   3392
#define XCD_BAR_WORDS 3456
#define XB_SPIN_CAP (1u << 22)
__device__ __forceinline__ unsigned xb_ld(unsigned* p)              { return __hip_atomic_load(p, __ATOMIC_RELAXED, __HIP_MEMORY_SCOPE_AGENT); }
__device__ __forceinline__ unsigned xb_add(unsigned* p, unsigned v) { return __hip_atomic_fetch_add(p, v, __ATOMIC_RELAXED, __HIP_MEMORY_SCOPE_AGENT); }
__device__ __forceinline__ unsigned xb_xcc_id() { return (unsigned)__builtin_amdgcn_s_getreg((3 << 11) | 20) & 0xFu; }
#define XB_SPIN(cond, bar) do { unsigned _sp = 0; while (cond) { __builtin_amdgcn_s_sleep(1); \
    if ((++_sp & 255u) == 0u) { if (xb_ld(&(bar)[XB_TMO])) break; if (_sp > XB_SPIN_CAP) { atomicAdd(&(bar)[XB_TMO], 1u); break; } } } } while (0)
__device__ __forceinline__ void xcd_barrier_complete(unsigned* bar, unsigned x, unsigned& nloc, unsigned& nx) {
    const unsigned G = gridDim.x;
    unsigned sum, cnt, mine, sp = 0u;
    for (;;) {
        sum = 0u; cnt = 0u; mine = 0u;
#pragma unroll
        for (unsigned j = 0; j < 16; ++j) { const unsigned c = xb_ld(&bar[XB_XCNT(j)]); sum += c; cnt += (c > 0u) ? 1u : 0u; mine = (j == x) ? c : mine; }
        if (sum == G) break;
        __builtin_amdgcn_s_sleep(1);
        if ((++sp & 255u) == 0u) { if (xb_ld(&bar[XB_TMO])) break; if (sp > XB_SPIN_CAP) { atomicAdd(&bar[XB_TMO], 1u); break; } }
    }
    nloc = mine > 0u ? mine : 1u; nx = cnt > 0u ? cnt : 1u;
}
__device__ __forceinline__ void xcd_barrier(unsigned* bar, volatile LAS unsigned* st, bool leader_thread) {
    asm volatile("s_waitcnt vmcnt(0)" ::: "memory");
    __syncthreads();
    if (leader_thread) {
        const unsigned x = xb_xcc_id();
        __builtin_amdgcn_s_waitcnt(0);
        unsigned nloc = st[0], nx = st[1];
        if (nloc == 0u) { xcd_barrier_complete(bar, x, nloc, nx); st[0] = nloc; st[1] = nx; }
        const unsigned old = xb_add(&bar[XB_XSUB(x)], 1u);
        const unsigned gen = old / nloc;
        if (old + 1u == (gen + 1u) * nloc) {
            __builtin_amdgcn_fence(__ATOMIC_RELEASE, "agent");
            asm volatile("s_waitcnt vmcnt(0)" ::: "memory");
            const unsigned og = xb_add(&bar[XB_TOP], 1u);
            const unsigned tg = og / nx;
            if (og + 1u == (tg + 1u) * nx) xb_add(&bar[XB_TOPGEN], 1u);
            else XB_SPIN(xb_ld(&bar[XB_TOPGEN]) == tg, bar);
            __builtin_amdgcn_fence(__ATOMIC_ACQUIRE, "agent");
            xb_add(&bar[XB_XGEN(x)], 1u);
            asm volatile("s_waitcnt vmcnt(0)" ::: "memory");
        } else {
            XB_SPIN(xb_ld(&bar[XB_XGEN(x)]) == gen, bar);
            __builtin_amdgcn_fence(__ATOMIC_ACQUIRE, "agent");
            asm volatile("s_waitcnt vmcnt(0)" ::: "memory");
        }
    }
    __syncthreads();
}

struct Args { const float* in[15]; float* out; unsigned char* ws; int lo, hi; };
enum { I_X = 0, I_MEM, I_NG, I_MNG, I_WIN, I_AQN, I_AKN, I_CW, I_WKV, I_MQN, I_MKN, I_WBA, I_WBC, I_WBM, I_WOUT };
constexpr int NPHASE = 10;

__global__ void __launch_bounds__(NTHR, 2) mega(Args a) {
    extern __shared__ __attribute__((aligned(16))) unsigned char lds_raw[];
    LAS unsigned char* lds = (LAS unsigned char*)lds_raw;
    const int G = gridDim.x, bx = blockIdx.x, wave_s = __builtin_amdgcn_readfirstlane((int)threadIdx.x >> 6);
    typedef const __attribute__((address_space(4))) Args* KArgs;
    const int ph_lo = a.lo, ph_hi = a.hi;
    volatile LAS unsigned* xst = (volatile LAS unsigned*)(lds + LDS_BYTES - 16);
    if (ph_hi - ph_lo > 1) {
        if (threadIdx.x == 0) { xst[0] = 0u; xst[1] = 0u; (void)xb_add(&((unsigned*)(a.ws + WS_BAR))[XB_XCNT(xb_xcc_id())], 1u); }
        __syncthreads();
    }
    for (int ph = ph_lo; ph < ph_hi; ++ph) {
        KArgs A = (KArgs)__builtin_amdgcn_kernarg_segment_ptr(); asm volatile("" : "+s"(A));
        unsigned char* ws = A->ws;
        bf16_t* WIN = (bf16_t*)(ws + WS_WIN); bf16_t* WKV = (bf16_t*)(ws + WS_WKV); bf16_t* WBR = (bf16_t*)(ws + WS_WBR); bf16_t* WOUT = (bf16_t*)(ws + WS_WOUT);
        bf16_t* MH = (bf16_t*)(ws + WS_MH); bf16_t* MKV = (bf16_t*)(ws + WS_MKV); bf16_t* PROJ = (bf16_t*)(ws + WS_PROJ); bf16_t* OG = (bf16_t*)(ws + WS_OG);
        float* LSE = (float*)(ws + WS_LSE); bf16_t* ACT = (bf16_t*)(ws + WS_ACT); u32x4* GF = (u32x4*)(ws + WS_GF); bf16_t* MB = (bf16_t*)(ws + WS_MB);
        bf16_t* H = (bf16_t*)(ws + WS_H);
        unsigned ones = ~0u; asm volatile("" : "+s"(ones));
        int tid = wave_s * 64 + (int)__builtin_amdgcn_mbcnt_hi(ones, __builtin_amdgcn_mbcnt_lo(ones, 0u)); asm volatile("" : "+v"(tid));
        const int lane = tid & 63, wave = tid >> 6;
        if (ph == 0) {
#pragma unroll 1
            for (int rep = 0; rep < REP_PREP; ++rep) {
            rmsnorm_rows(A->in[I_X], A->in[I_NG], H, LDP, NTOK, bx * 8 + wave, G * 8, lane);
            rmsnorm_rows(A->in[I_MEM], A->in[I_MNG], MH, DM, 4096, bx * 8 + wave, G * 8, lane);
            constexpr int T0 = 32 * 136, T1 = T0 + 512, T2 = T1 + 128, T3 = T2 + 256, T4 = T3 + 256, T5 = T4 + 512;
            auto job = [&](int t) {
                TJob J; int ti;
                if (t < T0) { J.src = A->in[I_WIN]; J.C = PC; J.dst = WIN; J.ld = LDP; J.koff = 0; ti = t; }
                else if (t < T1) { J.src = A->in[I_WKV]; J.C = DM; J.dst = WKV; J.ld = DM; J.koff = 0; ti = t - T0; }
                else if (t < T2) { J.src = A->in[I_WBA]; J.C = DM; J.dst = WBR; J.ld = ACTW; J.koff = 0; ti = t - T1; }
                else if (t < T3) { J.src = A->in[I_WBC]; J.C = DM; J.dst = WBR; J.ld = ACTW; J.koff = 512; ti = t - T2; }
                else if (t < T4) { J.src = A->in[I_WBM]; J.C = DM; J.dst = WBR; J.ld = ACTW; J.koff = 1536; ti = t - T3; }
                else { J.src = A->in[I_WOUT]; J.C = DM; J.dst = WOUT; J.ld = DM; J.koff = 0; ti = t - T4; }
                const int nct = J.C / 128; J.r0 = (ti / nct) * 64; J.c0 = (ti % nct) * 128; return J;
            };
            if (bx < T5) {
                float4 v[4]; TJob J = job(bx); tile_load(v, J, tid);
#pragma unroll 1
                for (int t = bx; t < T5; t += G) {
                    float4 vn[4]; const int tn = (t + G < T5) ? t + G : t; const TJob Jn = job(tn); tile_load(vn, Jn, tid);
                    tile_store((LAS float*)lds, v, J, tid);
                    J = Jn;
#pragma unroll
                    for (int p = 0; p < 4; ++p) v[p] = vn[p];
                }
            }
            }
        } else if (ph == 1 || ph == 5 || ph == 4 || ph == 8 || ph == 9) {
#ifdef PROBE_NOEPI
            const int nj = (ph == 1 || ph == 5) ? 3 : 1, njr = nj;
#else
            const int nj = (ph == 1 || ph == 5) ? 2 : 1, njr = ((REP_MASK >> ph) & 1) ? 2 * nj : nj;
#endif
#pragma unroll 1
            for (int jr = 0; jr < njr; ++jr) {
                const int j = jr >= nj ? jr - nj : jr;
                pg8::Gemm g; pg8::Epi E;
                if (ph == 4 || ph == 8) {
                    g = pg8::Gemm{ACT, WBR, HT, DM, ACTW, ACTW, ACTW}; E = pg8::Epi{5, MB, GF, nullptr, DM, 1 << 20};
                } else if (ph == 1 && j == 0) {
                    g = pg8::Gemm{MH, WKV, 4096, DM, DM, DM, DM}; E = pg8::Epi{0, MKV, nullptr, nullptr, DM, 1 << 20};
                } else if ((ph == 5 && j == 0) || ph == 9) {
                    const size_t ro = (ph == 9) ? (size_t)HT * DM : 0;
                    g = pg8::Gemm{MB, WOUT, HT, DM, DM, DM, DM}; E = pg8::Epi{4, A->out + ro, A->in[I_X] + ro, nullptr, DM, 1 << 20};
                } else {
                    const int half = (ph == 1) ? 0 : 1;
                    g = pg8::Gemm{H + (size_t)half * HT * LDP, WIN, HT, PC, DM, LDP, LDP}; E = pg8::Epi{0, PROJ, nullptr, GF, PS, PS / 256};
                    if (j == 2) E.kind = 9;
                }
                pg8::StaticOrder S; S.init(g.M, g.N, G, bx);
                unsigned ones2 = ~0u; asm volatile("" : "+s"(ones2));
                int tidj = wave_s * 64 + (int)__builtin_amdgcn_mbcnt_hi(ones2, __builtin_amdgcn_mbcnt_lo(ones2, 0u)); asm volatile("" : "+v"(tidj));
                pg8::gemm_phase(lds, g, S, E, tidj);
            }
        } else if (ph == 2 || ph == 6) {
            const int half = (ph == 2) ? 0 : 1;
#pragma unroll 1
            for (int rep = 0; rep < REP_BAND; ++rep)
            attn_banded_run(lds, PROJ, A->in[I_AQN], A->in[I_AKN], OG, LSE, bx, G, tid);
#pragma unroll 1
            for (int rep = 0; rep < REP_MEM; ++rep)
            attn_mem_run(lds, PROJ, MKV, A->in[I_MQN], A->in[I_MKN], ACT, half, bx, G, tid);
        } else if (ph == 3 || ph == 7) {
            const int gt = bx * NTHR + tid, nth = G * NTHR;
            for (int idx = gt; idx < HT * 64; idx += nth) {
                const int row = idx >> 6, c8 = (idx & 63) * 8, h = c8 >> 7;
                const float l0 = LSE[(size_t)row * 12 + h], l1 = LSE[(size_t)row * 12 + 4 + h], l2 = LSE[(size_t)row * 12 + 8 + h];
                const float m = fmaxf(l0, fmaxf(l1, l2)); float w0 = __expf(l0 - m), w1 = __expf(l1 - m), w2 = __expf(l2 - m); const float inv = 1.0f / (w0 + w1 + w2); w0 *= inv; w1 *= inv; w2 *= inv;
                const u32x4 o0 = *(const u32x4*)(OG + (size_t)row * 1536 + c8), o1 = *(const u32x4*)(OG + (size_t)row * 1536 + 512 + c8), o2 = *(const u32x4*)(OG + (size_t)row * 1536 + 1024 + c8);
                const u32x4 z = *(const u32x4*)(PROJ + (size_t)row * PS + C_ZA + c8);
                u32x4 o;
#define CMB(k) o.k = cvt_pk_bf16((w0 * bflo(o0.k) + w1 * bflo(o1.k) + w2 * bflo(o2.k)) * siluf_(bflo(z.k)), (w0 * bfhi(o0.k) + w1 * bfhi(o1.k) + w2 * bfhi(o2.k)) * siluf_(bfhi(z.k)))
                CMB(x); CMB(y); CMB(z); CMB(w);
#undef CMB
                *(u32x4*)(ACT + (size_t)row * ACTW + c8) = o;
            }
            const float* cw = A->in[I_CW];
            for (int idx = gt; idx < HT * 128; idx += nth) {
                const int row = idx >> 7, c8 = (idx & 127) * 8, t = row & (SEQ - 1);
                const bf16_t* pr = PROJ + (size_t)row * PS;
                unsigned zl = 0u; asm volatile("" : "+v"(zl)); const u32x4 z4 = (u32x4){zl, zl, zl, zl};
                const u32x4 c0 = *(const u32x4*)(pr + C_CC + c8), v0 = *(const u32x4*)(pr + C_CV + c8);
                const u32x4 c1 = t >= 1 ? *(const u32x4*)(pr - PS + C_CC + c8) : z4, v1 = t >= 1 ? *(const u32x4*)(pr - PS + C_CV + c8) : z4;
                const u32x4 c2 = t >= 2 ? *(const u32x4*)(pr - 2 * PS + C_CC + c8) : z4, v2 = t >= 2 ? *(const u32x4*)(pr - 2 * PS + C_CV + c8) : z4;
                const u32x4 bb = *(const u32x4*)(pr + C_CB + c8), zz = *(const u32x4*)(pr + C_ZC + c8);
                const float4 wa0 = *(const float4*)(cw + c8), wb0 = *(const float4*)(cw + c8 + 4), wa1 = *(const float4*)(cw + 1024 + c8), wb1 = *(const float4*)(cw + 1024 + c8 + 4), wa2 = *(const float4*)(cw + 2048 + c8), wb2 = *(const float4*)(cw + 2048 + c8 + 4);
                u32x4 o;
#define CV1(f, k, W0, W1, W2) ((W0 * (f(c0.k) * f(v0.k)) + W1 * (f(c1.k) * f(v1.k)) + W2 * (f(c2.k) * f(v2.k))) * f(bb.k) * siluf_(f(zz.k)))
                o.x = cvt_pk_bf16(CV1(bflo, x, wa0.x, wa1.x, wa2.x), CV1(bfhi, x, wa0.y, wa1.y, wa2.y));
                o.y = cvt_pk_bf16(CV1(bflo, y, wa0.z, wa1.z, wa2.z), CV1(bfhi, y, wa0.w, wa1.w, wa2.w));
                o.z = cvt_pk_bf16(CV1(bflo, z, wb0.x, wb1.x, wb2.x), CV1(bfhi, z, wb0.y, wb1.y, wb2.y));
                o.w = cvt_pk_bf16(CV1(bflo, w, wb0.z, wb1.z, wb2.z), CV1(bfhi, w, wb0.w, wb1.w, wb2.w));
#undef CV1
                *(u32x4*)(ACT + (size_t)row * ACTW + 512 + c8) = o;
            }
        }
        if (ph + 1 < ph_hi) {
            if (ph == 0) cg::this_grid().sync();
            else xcd_barrier((unsigned*)(A->ws + WS_BAR), xst, tid == 0);
        }
        if (ph == 0 && ph_hi - ph_lo > 1) { for (int e = 0; e < EXTRA_SYNCS; ++e) cg::this_grid().sync(); }
    }
}

extern "C" void kernel_launch(void* const* d_in, const int* in_sizes, int n_in, void* d_out, int out_size, void* d_ws, size_t ws_size, hipStream_t stream) {
    static int grid = 0;
    if (grid == 0) {
        if (n_in != 15 || ws_size < WS_END) { fprintf(stderr, "kernel_launch: unexpected inputs (n_in %d, ws %zu < %zu)\n", n_in, ws_size, (size_t)WS_END); grid = -1; return; }
        int dev = 0, cus = 0, per_cu = 0;
        hipGetDevice(&dev); hipDeviceGetAttribute(&cus, hipDeviceAttributeMultiprocessorCount, dev);
        if (hipFuncSetAttribute((const void*)mega, hipFuncAttributeMaxDynamicSharedMemorySize, LDS_BYTES) != hipSuccess) { fprintf(stderr, "kernel_launch: hipFuncSetAttribute failed\n"); grid = -1; return; }
        hipOccupancyMaxActiveBlocksPerMultiprocessor(&per_cu, (const void*)mega, NTHR, LDS_BYTES);
        if (per_cu < 1) per_cu = 1;
        grid = cus * 1;
        (void)hipGetLastError();
    }
    if (grid < 0) return;
    Args a{};
    for (int i = 0; i < 15; ++i) a.in[i] = (const float*)d_in[i];
    a.out = (float*)d_out; a.ws = (unsigned char*)d_ws;
#if ONE_LAUNCH
    (void)hipMemsetAsync((unsigned char*)d_ws + WS_BAR, 0, 16384, stream);
    a.lo = 0; a.hi = NPHASE;
    void* args[] = {&a};
    hipError_t e = hipLaunchCooperativeKernel((const void*)mega, dim3(grid), dim3(NTHR), args, LDS_BYTES, stream);
    if (e != hipSuccess) fprintf(stderr, "cooperative launch failed: %s (grid %d)\n", hipGetErrorString(e), grid);
#else
    for (int ph = 0; ph < NPHASE; ++ph) { a.lo = ph; a.hi = ph + 1; hipLaunchKernelGGL(mega, dim3(grid), dim3(NTHR), LDS_BYTES, stream, a); }
#endif
}
```

```cpp
#include <hip/hip_runtime.h>
#include <hip/hip_cooperative_groups.h>
#include <cstdio>
namespace cg = cooperative_groups;

#ifndef ONE_LAUNCH
#define ONE_LAUNCH 1
#endif

#ifndef REP_MASK
#define REP_MASK 0
#endif
#define REP_BAND 1
#define REP_MEM 1
#define REP_PREP 1
#define EXTRA_SYNCS 0
#ifndef PG8_SP2
#define PG8_SP2 1
#endif
#define LAS __attribute__((address_space(3)))
typedef unsigned short bf16_t;
typedef short bf16x8 __attribute__((ext_vector_type(8)));
typedef short s16x4 __attribute__((ext_vector_type(4)));
typedef float f32x4 __attribute__((ext_vector_type(4)));
typedef unsigned u32x4 __attribute__((ext_vector_type(4)));
typedef unsigned u32x2 __attribute__((ext_vector_type(2)));

constexpr int DM = 2048, SEQ = 2048, NB = 16, NTOK = NB * SEQ;
constexpr int PC = 17408;
constexpr int PS = 11264;
constexpr int HT = NTOK / 2;
constexpr int C_Q = 0, C_K = 1536, C_V = 3072, C_ZA = 4608, C_CB = 5120, C_CC = 6144, C_CV = 7168, C_ZC = 8192, C_MQ = 9216, C_ZM = 10240, C_G = 11264;
constexpr int ACTW = 2560;
constexpr int LDP = 2048 + 64;
constexpr float EPSF = 1e-6f;
constexpr int NTHR = 512;
constexpr int LDS_BYTES = 149504;

constexpr size_t WS_WIN = 0;
constexpr size_t WS_WKV = WS_WIN + (size_t)PC * LDP * 2;
constexpr size_t WS_WBR = WS_WKV + (size_t)DM * DM * 2;
constexpr size_t WS_WOUT = WS_WBR + (size_t)DM * ACTW * 2;
constexpr size_t WS_MH = WS_WOUT + (size_t)DM * DM * 2;
constexpr size_t WS_MKV = WS_MH + (size_t)4096 * DM * 2;
constexpr size_t WS_PROJ = WS_MKV + (size_t)4096 * DM * 2;
constexpr size_t WS_OG = WS_PROJ + (size_t)HT * PS * 2;
constexpr size_t WS_LSE = WS_OG + (size_t)HT * 1536 * 2;
constexpr size_t WS_ACT = WS_LSE + (size_t)HT * 12 * 4;
constexpr size_t WS_GF = WS_ACT + (size_t)HT * ACTW * 2;
constexpr size_t WS_MB = WS_GF + (size_t)HT * 6144 * 2;
constexpr size_t WS_H = WS_MB + (size_t)HT * DM * 2;
constexpr size_t WS_BAR = WS_H + (size_t)NTOK * LDP * 2;
constexpr size_t WS_END = WS_BAR + 16384;
constexpr size_t OUT_H_OFF = (size_t)HT * DM * 4;

__device__ __forceinline__ float bflo(unsigned w) { return __uint_as_float(w << 16); }
__device__ __forceinline__ float bfhi(unsigned w) { return __uint_as_float(w & 0xffff0000u); }
typedef __bf16 bf16x2_t __attribute__((ext_vector_type(2)));
typedef float f32x2_t __attribute__((ext_vector_type(2)));
__device__ __forceinline__ unsigned cvt_pk_bf16(float lo, float hi) { f32x2_t v = {lo, hi}; bf16x2_t b = __builtin_convertvector(v, bf16x2_t); return __builtin_bit_cast(unsigned, b); }
__device__ __forceinline__ float sigmoidf_(float x) { return __builtin_amdgcn_rcpf(1.0f + __builtin_amdgcn_exp2f(x * -1.4426950408889634f)); }
__device__ __forceinline__ float siluf_(float x) { return x * __builtin_amdgcn_rcpf(1.0f + __builtin_amdgcn_exp2f(x * -1.4426950408889634f)); }

namespace pg8 {
constexpr int BM = 256, BK = 64, HALF = 128, HTB = HALF * BK * 2, STAGE_BYTES = 8 * HTB, NXCD = 8, WGM = 8;
__host__ __device__ __forceinline__ int lds_byte(int r, int c) { const int st = (r >> 4) * 2 + (c >> 5), rr = r & 15, cc = c & 31, ob = rr * 64 + cc * 2; return st * 1024 + (ob ^ (((ob >> 9) & 1) << 5)); }
__host__ __device__ __forceinline__ void stage_rc(int b, int& R, int& C) { const int st = b / 1024, sb = b % 1024, swz = sb ^ (((sb >> 9) & 1) << 5); R = (st >> 1) * 16 + swz / 64; C = (st & 1) * 32 + (swz % 64) / 2; }
__host__ __device__ __forceinline__ int perm32(int rho) { const int n = rho >> 4, i = rho & 15; return 8 * (i >> 2) + 4 * n + (i & 3); }
struct Unit { int pm, pn; };
struct Gemm { const bf16_t* A; const bf16_t* Bt; int M, N, K, lda, ldb; };
struct StaticOrder {
    int nM, nN, nwg, G, c;
    __device__ void init(int M, int N, int G_, int c_) { nM = M / BM; nN = N / BM; nwg = nM * nN; G = G_; c = c_; }
    __device__ bool next(int i, Unit& u) const {
        const long L = (long)i * G + c; if (L >= nwg) return false;
        int wgid = (int)L; { const int q = nwg / NXCD, r = nwg % NXCD, xcd = wgid % NXCD, off = wgid / NXCD; wgid = (xcd < r ? xcd * (q + 1) : r * (q + 1) + (xcd - r) * q) + off; }
        const int nig = WGM * nN, gid = wgid / nig, fm = gid * WGM, gsz = (nM - fm) < WGM ? (nM - fm) : WGM;
        u.pm = fm + ((wgid % nig) % gsz); u.pn = (wgid % nig) / gsz; return true;
    }
};

struct Epi;
template <class Epi, class Sched>
__device__ __forceinline__ void gemm_phase(LAS unsigned char* lds, const Gemm g, const Sched& S, const Epi& E, const int tid) {
    const int wid = __builtin_amdgcn_readfirstlane(tid >> 6), lane = tid & 63, wr = wid >> 2, wc = wid & 3, fr = lane & 15, fq = lane >> 4;
    const int K = g.K, nt = K / BK;
    unsigned voffA[2], voffB[2];
#pragma unroll
    for (int i = 0; i < 2; ++i) { int R, C; stage_rc(tid * 16 + i * 8192, R, C); const int Rb = 2 * (R & ~31) + (E.perm() ? perm32(R & 31) : (R & 31));
        voffA[i] = (unsigned)(R * g.lda + C) * 2u; voffB[i] = (unsigned)(Rb * g.ldb + C) * 2u; }
    const size_t kstep = (size_t)(BK * 2);
    const size_t hstepA = (size_t)HALF * g.lda * 2, hstepB = (size_t)32 * g.ldb * 2;
    const size_t tstepA = 2 * hstepA, tstepB = (size_t)BM * g.ldb * 2;
    const unsigned ldsw = (unsigned)wid * 1024u;
    const int aoff = lds_byte(wr * 64 + fr, fq * 8), boff = lds_byte(wc * 32 + fr, fq * 8);
#define PG8_SA(b, h) (((b) * 2 + (h)) * HTB)
#define PG8_SB(b, h) ((4 + (b) * 2 + (h)) * HTB)
#define PG8_STAGE(bufoff, gbase, voff) do { _Pragma("unroll") for (int _i = 0; _i < 2; ++_i) \
        __builtin_amdgcn_global_load_lds((const unsigned*)((const char*)(gbase) + (voff)[_i]), (LAS unsigned*)(lds + (bufoff) + ldsw + _i * 8192), 16, 0, 0); } while (0)
#define PG8_LDA(dst, b, h) do { _Pragma("unroll") for (int m = 0; m < 4; ++m) _Pragma("unroll") for (int k = 0; k < 2; ++k) dst[m][k] = *(const LAS bf16x8*)(lds + PG8_SA(b, h) + aoff + m * 2048 + k * 1024); } while (0)
#define PG8_LDB(dst, b, h) do { _Pragma("unroll") for (int n = 0; n < 2; ++n) _Pragma("unroll") for (int k = 0; k < 2; ++k) dst[n][k] = *(const LAS bf16x8*)(lds + PG8_SB(b, h) + boff + n * 2048 + k * 1024); } while (0)
#define PG8_MMA(ai, bj, At, Bt) do { __builtin_amdgcn_s_setprio(1); _Pragma("unroll") for (int m = 0; m < 4; ++m) _Pragma("unroll") for (int n = 0; n < 2; ++n) _Pragma("unroll") for (int k = 0; k < 2; ++k) \
        acc[ai][bj][m][n] = __builtin_amdgcn_mfma_f32_16x16x32_bf16(Bt[n][k], At[m][k], acc[ai][bj][m][n], 0, 0, 0); __builtin_amdgcn_s_setprio(0); } while (0)
#define PG8_WAIT_V(n) asm volatile("s_waitcnt vmcnt(" #n ")" ::: "memory")
#define PG8_WAIT_L(n) asm volatile("s_waitcnt lgkmcnt(" #n ")" ::: "memory")
#define PG8_BAR __builtin_amdgcn_s_barrier()
#define PG8_SCHED __builtin_amdgcn_sched_barrier(0)
    Unit cur, nxt; int ui = 0;
    if (!S.next(0, cur)) return;
    f32x4 acc[2][2][4][2];
#pragma unroll
    for (int a = 0; a < 2; ++a)
#pragma unroll
        for (int b = 0; b < 2; ++b)
#pragma unroll
            for (int m = 0; m < 4; ++m)
#pragma unroll
                for (int n = 0; n < 2; ++n) acc[a][b][m][n] = (f32x4){0.f, 0.f, 0.f, 0.f};
    bf16x8 At[4][2], B0[2][2], B1[2][2];
    const char* cA = (const char*)g.A + (size_t)cur.pm * tstepA; const char* cB = (const char*)g.Bt + (size_t)cur.pn * tstepB;
#if PG8_SP2
    PG8_STAGE(PG8_SB(0, 0), cB, voffB); PG8_STAGE(PG8_SB(0, 1), cB + hstepB, voffB); PG8_STAGE(PG8_SA(0, 0), cA, voffA); PG8_STAGE(PG8_SA(0, 1), cA + hstepA, voffA);
    if (wr == 1) PG8_BAR;
    PG8_WAIT_V(2); PG8_BAR;
    PG8_STAGE(PG8_SB(1, 0), cB + kstep, voffB); PG8_STAGE(PG8_SA(1, 0), cA + kstep, voffA); PG8_STAGE(PG8_SB(1, 1), cB + hstepB + kstep, voffB);
    PG8_WAIT_V(6); PG8_BAR;
#else
    PG8_STAGE(PG8_SB(0, 0), cB, voffB); PG8_STAGE(PG8_SA(0, 0), cA, voffA); PG8_STAGE(PG8_SB(0, 1), cB + hstepB, voffB); PG8_STAGE(PG8_SA(0, 1), cA + hstepA, voffA);
    if (wr == 1) PG8_BAR;
    PG8_WAIT_V(4); PG8_BAR;
    PG8_STAGE(PG8_SB(1, 0), cB + kstep, voffB); PG8_STAGE(PG8_SA(1, 0), cA + kstep, voffA); PG8_STAGE(PG8_SB(1, 1), cB + hstepB + kstep, voffB);
    PG8_WAIT_V(6); PG8_BAR;
#endif
    for (;;) {
        const bool has_next = S.next(ui + 1, nxt);
        const char* nA = has_next ? (const char*)g.A + (size_t)nxt.pm * tstepA : cA; const char* nB = has_next ? (const char*)g.Bt + (size_t)nxt.pn * tstepB : cB;
        for (int t = 0; t < nt; t += 2) {
            const bool last = (t == nt - 2);
            const char* a1 = cA + (size_t)(t + 1) * kstep;
            const char* a2 = last ? nA : cA + (size_t)(t + 2) * kstep; const char* b2 = last ? nB : cB + (size_t)(t + 2) * kstep;
            const char* a3 = a2 + kstep; const char* b3 = b2 + kstep;
            if (E.has_mid() && (t == 8 || t == 24)) E.mid(acc, cur, tid, t == 8 ? 0 : 1);
#if PG8_SP2
            PG8_LDB(B0, 0, 0); PG8_LDB(B1, 0, 1); PG8_SCHED; PG8_LDA(At, 0, 0); PG8_STAGE(PG8_SA(1, 1), a1 + hstepA, voffA);
            PG8_WAIT_V(8); PG8_WAIT_L(0); PG8_BAR; PG8_MMA(0, 0, At, B0); PG8_MMA(0, 1, At, B1); PG8_BAR; PG8_SCHED;
            PG8_LDA(At, 0, 1); PG8_STAGE(PG8_SB(0, 0), b2, voffB); PG8_STAGE(PG8_SB(0, 1), b2 + hstepB, voffB); PG8_STAGE(PG8_SA(0, 0), a2, voffA);
            PG8_WAIT_V(8); PG8_WAIT_L(0); PG8_BAR; PG8_MMA(1, 0, At, B0); PG8_MMA(1, 1, At, B1); PG8_BAR; PG8_SCHED;
            PG8_LDB(B0, 1, 0); PG8_LDB(B1, 1, 1); PG8_SCHED; PG8_LDA(At, 1, 0); PG8_STAGE(PG8_SA(0, 1), a2 + hstepA, voffA);
            PG8_WAIT_V(8); PG8_WAIT_L(0); PG8_BAR; PG8_MMA(0, 0, At, B0); PG8_MMA(0, 1, At, B1); PG8_BAR; PG8_SCHED;
            PG8_LDA(At, 1, 1); PG8_STAGE(PG8_SB(1, 0), b3, voffB); PG8_STAGE(PG8_SB(1, 1), b3 + hstepB, voffB); PG8_STAGE(PG8_SA(1, 0), a3, voffA);
            PG8_WAIT_V(8); PG8_WAIT_L(0); PG8_BAR; PG8_MMA(1, 0, At, B0); PG8_MMA(1, 1, At, B1); PG8_BAR; PG8_SCHED;
#else
            PG8_LDB(B0, 0, 0); PG8_SCHED; PG8_LDA(At, 0, 0); PG8_STAGE(PG8_SA(1, 1), a1 + hstepA, voffA);
            PG8_WAIT_L(8); PG8_BAR; PG8_WAIT_L(0); PG8_MMA(0, 0, At, B0); PG8_BAR; PG8_SCHED;
            PG8_LDB(B1, 0, 1); PG8_STAGE(PG8_SB(0, 0), b2, voffB);
            PG8_BAR; PG8_WAIT_L(0); PG8_MMA(0, 1, At, B1); PG8_BAR;
            PG8_LDA(At, 0, 1); PG8_STAGE(PG8_SA(0, 0), a2, voffA);
            PG8_BAR; PG8_WAIT_L(0); PG8_MMA(1, 0, At, B0); PG8_BAR; PG8_SCHED;
            PG8_STAGE(PG8_SB(0, 1), b2 + hstepB, voffB);
            PG8_WAIT_V(6); PG8_BAR; PG8_MMA(1, 1, At, B1); PG8_BAR;
            PG8_LDB(B0, 1, 0); PG8_SCHED; PG8_LDA(At, 1, 0); PG8_STAGE(PG8_SA(0, 1), a2 + hstepA, voffA);
            PG8_WAIT_L(8); PG8_BAR; PG8_WAIT_L(0); PG8_MMA(0, 0, At, B0); PG8_BAR; PG8_SCHED;
            PG8_LDB(B1, 1, 1); PG8_STAGE(PG8_SB(1, 0), b3, voffB);
            PG8_BAR; PG8_WAIT_L(0); PG8_MMA(0, 1, At, B1); PG8_BAR;
            PG8_LDA(At, 1, 1); PG8_STAGE(PG8_SA(1, 0), a3, voffA);
            PG8_BAR; PG8_WAIT_L(0); PG8_MMA(1, 0, At, B0); PG8_BAR; PG8_SCHED;
            PG8_STAGE(PG8_SB(1, 1), b3 + hstepB, voffB);
            PG8_WAIT_V(6); PG8_BAR; PG8_MMA(1, 1, At, B1); PG8_BAR;
#endif
        }
        if (wr == 0) PG8_BAR;
        E(acc, cur, wr, wc, fr, fq, tid);
        if (!has_next) break;
#pragma unroll
        for (int a = 0; a < 2; ++a)
#pragma unroll
            for (int b = 0; b < 2; ++b)
#pragma unroll
                for (int m = 0; m < 4; ++m)
#pragma unroll
                    for (int n = 0; n < 2; ++n) acc[a][b][m][n] = (f32x4){0.f, 0.f, 0.f, 0.f};
        cur = nxt; cA = nA; cB = nB; ++ui;
        if (wr == 1) PG8_BAR;
    }
    PG8_WAIT_V(0);
    PG8_BAR;
#undef PG8_SA
#undef PG8_SB
#undef PG8_STAGE
#undef PG8_LDA
#undef PG8_LDB
#undef PG8_MMA
#undef PG8_WAIT_V
#undef PG8_WAIT_L
#undef PG8_BAR
#undef PG8_SCHED
}

struct Epi {
    int kind; void* p0; const void* p1; void* p2; int ldc, gpn0;
    __device__ __forceinline__ bool perm() const { return kind != 4; }
    __device__ __forceinline__ bool has_mid() const { return kind == 5; }
    __device__ __forceinline__ void mid(f32x4 (&acc)[2][2][4][2], const Unit& u, int tid, int which) const {
        const u32x4* ga = (const u32x4*)p1 + ((size_t)(u.pm * 24 + 8 * which + u.pn) * 16) * 512 + tid; const u32x4* gb = ga + (size_t)8 * 16 * 512;
        u32x4 x[16];
#pragma unroll
        for (int i = 0; i < 16; ++i) x[i] = ga[i * 512];
        asm volatile("s_waitcnt vmcnt(0)" ::: "memory");
#pragma unroll
        for (int i = 0; i < 16; ++i) { const int ai = i >> 3, m = (i >> 1) & 3, bj = i & 1; const u32x4 y = x[i];
            acc[ai][bj][m][0] *= (f32x4){bflo(y.x), bfhi(y.x), bflo(y.y), bfhi(y.y)}; acc[ai][bj][m][1] *= (f32x4){bflo(y.z), bfhi(y.z), bflo(y.w), bfhi(y.w)}; }
        asm volatile("" ::: "memory");
#pragma unroll
        for (int i = 0; i < 16; ++i) x[i] = gb[i * 512];
        asm volatile("s_waitcnt vmcnt(0)" ::: "memory");
#pragma unroll
        for (int i = 0; i < 16; ++i) { const int ai = i >> 3, m = (i >> 1) & 3, bj = i & 1; const u32x4 y = x[i];
            acc[ai][bj][m][0] *= (f32x4){__builtin_amdgcn_rcpf(bflo(y.x)), __builtin_amdgcn_rcpf(bfhi(y.x)), __builtin_amdgcn_rcpf(bflo(y.y)), __builtin_amdgcn_rcpf(bfhi(y.y))};
            acc[ai][bj][m][1] *= (f32x4){__builtin_amdgcn_rcpf(bflo(y.z)), __builtin_amdgcn_rcpf(bfhi(y.z)), __builtin_amdgcn_rcpf(bflo(y.w)), __builtin_amdgcn_rcpf(bfhi(y.w))}; }
    }
    __device__ __forceinline__ void operator()(const f32x4 (&acc)[2][2][4][2], const Unit& u, int wr, int wc, int fr, int fq, int tid) const {
        const int row0 = u.pm * BM + wr * 64 + fr;
        if (kind == 0 && u.pn >= gpn0) {
            u32x4* gf = (u32x4*)p2 + ((size_t)(u.pm * 24 + (u.pn - gpn0)) * 16) * 512 + tid;
#pragma unroll
            for (int ai = 0; ai < 2; ++ai)
#pragma unroll
                for (int m = 0; m < 4; ++m)
#pragma unroll
                    for (int bj = 0; bj < 2; ++bj) { const f32x4 v0 = acc[ai][bj][m][0], v1 = acc[ai][bj][m][1];
                        u32x4 w; w.x = cvt_pk_bf16(sigmoidf_(v0[0]), sigmoidf_(v0[1])); w.y = cvt_pk_bf16(sigmoidf_(v0[2]), sigmoidf_(v0[3])); w.z = cvt_pk_bf16(sigmoidf_(v1[0]), sigmoidf_(v1[1])); w.w = cvt_pk_bf16(sigmoidf_(v1[2]), sigmoidf_(v1[3]));
                        __builtin_nontemporal_store(w, &gf[((ai * 4 + m) * 2 + bj) * 512]); }
        } else if (kind == 0) {
            bf16_t* O = (bf16_t*)p0; const int col0 = u.pn * BM + wc * 64 + 8 * fq;
#pragma unroll
            for (int ai = 0; ai < 2; ++ai)
#pragma unroll
                for (int m = 0; m < 4; ++m) { bf16_t* rowp = O + (size_t)(row0 + ai * HALF + m * 16) * ldc + col0;
#pragma unroll
                    for (int bj = 0; bj < 2; ++bj) { const f32x4 v0 = acc[ai][bj][m][0], v1 = acc[ai][bj][m][1];
                        u32x4 w; w.x = cvt_pk_bf16(v0[0], v0[1]); w.y = cvt_pk_bf16(v0[2], v0[3]); w.z = cvt_pk_bf16(v1[0], v1[1]); w.w = cvt_pk_bf16(v1[2], v1[3]);
                        __builtin_nontemporal_store(w, (u32x4*)(rowp + bj * 32)); } }
        } else if (kind == 4) {
            const float* x = (const float*)p1; float* out = (float*)p0; const int col0 = u.pn * BM + wc * 64 + 4 * fq;
#pragma unroll
            for (int am = 0; am < 4; ++am) {
                const int ai = am >> 1, mb = (am & 1) * 2;
                f32x4 xv[2][2][2];
#pragma unroll
                for (int m = 0; m < 2; ++m) { const size_t off = (size_t)(row0 + ai * HALF + (mb + m) * 16) * DM + col0;
#pragma unroll
                    for (int bj = 0; bj < 2; ++bj)
#pragma unroll
                        for (int n = 0; n < 2; ++n) xv[m][bj][n] = *(const f32x4*)(x + off + bj * 32 + n * 16); }
                asm volatile("s_waitcnt vmcnt(0)" ::: "memory");
#pragma unroll
                for (int m = 0; m < 2; ++m) { const size_t off = (size_t)(row0 + ai * HALF + (mb + m) * 16) * DM + col0;
#pragma unroll
                    for (int bj = 0; bj < 2; ++bj)
#pragma unroll
                        for (int n = 0; n < 2; ++n) *(f32x4*)(out + off + bj * 32 + n * 16) = xv[m][bj][n] + acc[ai][bj][mb + m][n]; }
                asm volatile("" ::: "memory");
            }
        } else if (kind == 5) {
            bf16_t* O = (bf16_t*)p0; const int col0 = u.pn * BM + wc * 64 + 8 * fq;
            const u32x4* gc = (const u32x4*)p1 + ((size_t)(u.pm * 24 + 16 + u.pn) * 16) * 512 + tid;
            u32x4 gy[16];
#pragma unroll
            for (int i = 0; i < 16; ++i) gy[i] = gc[i * 512];
            asm volatile("s_waitcnt vmcnt(0)" ::: "memory");
#pragma unroll
            for (int ai = 0; ai < 2; ++ai)
#pragma unroll
                for (int m = 0; m < 4; ++m) { bf16_t* rowp = O + (size_t)(row0 + ai * HALF + m * 16) * ldc + col0;
#pragma unroll
                    for (int bj = 0; bj < 2; ++bj) { const f32x4 v0 = acc[ai][bj][m][0], v1 = acc[ai][bj][m][1]; const u32x4 y = gy[(ai * 4 + m) * 2 + bj];
                        u32x4 w; w.x = cvt_pk_bf16(v0[0] * bflo(y.x), v0[1] * bfhi(y.x)); w.y = cvt_pk_bf16(v0[2] * bflo(y.y), v0[3] * bfhi(y.y)); w.z = cvt_pk_bf16(v1[0] * bflo(y.z), v1[1] * bfhi(y.z)); w.w = cvt_pk_bf16(v1[2] * bflo(y.w), v1[3] * bfhi(y.w));
                        *(u32x4*)(rowp + bj * 32) = w; } }
        }
    }
};
}

__device__ __forceinline__ void rmsnorm_rows(const float* __restrict__ x, const float* __restrict__ g, bf16_t* __restrict__ out, int ldo, int nrows, int gw, int nw, int lane) {
    for (int row = gw; row < nrows; row += nw) {
        const float4* xr = (const float4*)(x + (size_t)row * DM);
        float4 v[8]; float ss = 0.f;
#pragma unroll
        for (int i = 0; i < 4; ++i) { const int c = lane + 64 * i; v[2 * i] = xr[2 * c]; v[2 * i + 1] = xr[2 * c + 1]; }
#pragma unroll
        for (int i = 0; i < 8; ++i) ss += v[i].x * v[i].x + v[i].y * v[i].y + v[i].z * v[i].z + v[i].w * v[i].w;
#pragma unroll
        for (int o = 32; o >= 1; o >>= 1) ss += __shfl_xor(ss, o);
        const float rstd = rsqrtf(ss * (1.0f / DM) + EPSF);
#pragma unroll
        for (int i = 0; i < 4; ++i) { const int c = lane + 64 * i; const float4 ga = ((const float4*)g)[2 * c], gb = ((const float4*)g)[2 * c + 1]; const float4 a = v[2 * i], b = v[2 * i + 1];
            u32x4 w; w.x = cvt_pk_bf16(a.x * rstd * ga.x, a.y * rstd * ga.y); w.y = cvt_pk_bf16(a.z * rstd * ga.z, a.w * rstd * ga.w);
            w.z = cvt_pk_bf16(b.x * rstd * gb.x, b.y * rstd * gb.y); w.w = cvt_pk_bf16(b.z * rstd * gb.z, b.w * rstd * gb.w);
            *(u32x4*)(out + (size_t)row * ldo + c * 8) = w; }
    }
}
struct TJob { const float* src; bf16_t* dst; int C, ld, koff, r0, c0; };
__device__ __forceinline__ void tile_load(float4 (&v)[4], const TJob& J, int tid) {
#pragma unroll
    for (int p = 0; p < 4; ++p) { const int r = p * 16 + (tid >> 5), c4 = (tid & 31) * 4; v[p] = *(const float4*)(J.src + (size_t)(J.r0 + r) * J.C + J.c0 + c4); }
}
__device__ __forceinline__ void tile_store(LAS float* t  , const float4 (&v)[4], const TJob& J, int tid) {
#pragma unroll
    for (int p = 0; p < 4; ++p) { const int r = p * 16 + (tid >> 5), c4 = (tid & 31) * 4; LAS float* q = t + r * 129 + c4; q[0] = v[p].x; q[1] = v[p].y; q[2] = v[p].z; q[3] = v[p].w; }
    __syncthreads();
#pragma unroll
    for (int h = 0; h < 2; ++h) { const int c = h * 64 + (tid >> 3), rc = (tid & 7) * 8; float f[8];
#pragma unroll
        for (int j = 0; j < 8; ++j) f[j] = t[(rc + j) * 129 + c];
        u32x4 w; w.x = cvt_pk_bf16(f[0], f[1]); w.y = cvt_pk_bf16(f[2], f[3]); w.z = cvt_pk_bf16(f[4], f[5]); w.w = cvt_pk_bf16(f[6], f[7]);
        *(u32x4*)(J.dst + (size_t)(J.c0 + c) * J.ld + J.koff + J.r0 + rc) = w; }
    __syncthreads();
}

template <int HD> struct AttnGeo { static constexpr int KSTR = HD * 2 + 16, VSTR = HD * 2 + 32, PPR = HD / 8, NKS = HD / 32, NDT = HD / 16, NPC = 256 * (HD / 8) / NTHR; };

template <int HD> __device__ __forceinline__ void issue_rows(u32x4 (&r)[AttnGeo<HD>::NPC], const bf16_t* __restrict__ p, int stride, int jbase, int tid) {
    typedef AttnGeo<HD> G; constexpr int RS = NTHR / G::PPR;
    const int r0 = tid / G::PPR, pc = tid % G::PPR;
#pragma unroll
    for (int i = 0; i < G::NPC; ++i) { int j = jbase + r0 + i * RS; j = j < 0 ? 0 : j;
        r[i] = *(const u32x4*)(p + ((unsigned)j * (unsigned)stride + (unsigned)(pc * 8))); }
}
template <int HD> __device__ __forceinline__ void issue_q(u32x4 (&q)[AttnGeo<HD>::NKS], const bf16_t* __restrict__ qrow, int g4) {
#pragma unroll
    for (int ks = 0; ks < AttnGeo<HD>::NKS; ++ks) q[ks] = *(const u32x4*)(qrow + ks * 32 + g4 * 8);
}
template <int HD> __device__ __forceinline__ void write_k(LAS unsigned char* kl, const u32x4 (&r)[AttnGeo<HD>::NPC], int jbase, const float* __restrict__ wk, int tid) {
    typedef AttnGeo<HD> G; constexpr int RS = NTHR / G::PPR;
    const int r0 = tid / G::PPR, pc = tid % G::PPR;
    LAS unsigned char* base = kl + r0 * G::KSTR + pc * 16;
    const float4 wa = *(const float4*)(wk + pc * 8), wb = *(const float4*)(wk + pc * 8 + 4);
#pragma unroll
    for (int i = 0; i < G::NPC; ++i) { const u32x4 w = r[i];
        float f[8] = {bflo(w.x), bfhi(w.x), bflo(w.y), bfhi(w.y), bflo(w.z), bfhi(w.z), bflo(w.w), bfhi(w.w)};
        float ss = 0.f;
#pragma unroll
        for (int e = 0; e < 8; ++e) ss += f[e] * f[e];
#pragma unroll
        for (int o = 1; o < G::PPR; o <<= 1) ss += __shfl_xor(ss, o);
        const float rstd = (jbase + r0 + i * RS >= 0) ? rsqrtf(ss * (1.0f / HD) + EPSF) : 0.f;
        u32x4 o4; o4.x = cvt_pk_bf16(f[0] * rstd * wa.x, f[1] * rstd * wa.y); o4.y = cvt_pk_bf16(f[2] * rstd * wa.z, f[3] * rstd * wa.w);
        o4.z = cvt_pk_bf16(f[4] * rstd * wb.x, f[5] * rstd * wb.y); o4.w = cvt_pk_bf16(f[6] * rstd * wb.z, f[7] * rstd * wb.w);
        *(LAS u32x4*)(base + i * (RS * G::KSTR)) = o4;
        if (G::NPC > 8) __builtin_amdgcn_sched_barrier(0); }
}
template <int HD> __device__ __forceinline__ void write_v(LAS unsigned char* vl, const u32x4 (&r)[AttnGeo<HD>::NPC], int jbase, int tid) {
    typedef AttnGeo<HD> G; constexpr int RS = NTHR / G::PPR;
    const int r0 = tid / G::PPR, pc = tid % G::PPR;
    LAS unsigned char* base = vl + r0 * G::VSTR + pc * 16;
#pragma unroll
    for (int i = 0; i < G::NPC; ++i) { const bool ok = jbase + r0 + i * RS >= 0; u32x4 w = r[i];
        w.x = ok ? w.x : 0u; w.y = ok ? w.y : 0u; w.z = ok ? w.z : 0u; w.w = ok ? w.w : 0u;
        *(LAS u32x4*)(base + i * (RS * G::VSTR)) = w; }
}
template <int HD, bool ISK> __device__ __forceinline__ void stage_rows(LAS unsigned char* dst, const bf16_t* __restrict__ p, int stride, const float* __restrict__ wk, int tid) {
    typedef AttnGeo<HD> G; constexpr int RS = NTHR / G::PPR, STR = ISK ? G::KSTR : G::VSTR, NB = 8;
    const int r0 = tid / G::PPR, pc = tid % G::PPR;
    LAS unsigned char* base = dst + r0 * STR + pc * 16;
    float4 wa = make_float4(1.f, 1.f, 1.f, 1.f), wb = wa;
    if (ISK) { wa = *(const float4*)(wk + pc * 8); wb = *(const float4*)(wk + pc * 8 + 4); }
#pragma unroll 1
    for (int i0 = 0; i0 < G::NPC; i0 += NB) {
        u32x4 r[NB];
#pragma unroll
        for (int i = 0; i < NB; ++i) r[i] = *(const u32x4*)(p + ((unsigned)(r0 + (i0 + i) * RS) * (unsigned)stride + (unsigned)(pc * 8)));
#pragma unroll
        for (int i = 0; i < NB; ++i) { u32x4 w = r[i];
            if (ISK) {
                float f[8] = {bflo(w.x), bfhi(w.x), bflo(w.y), bfhi(w.y), bflo(w.z), bfhi(w.z), bflo(w.w), bfhi(w.w)};
                float ss = 0.f;
#pragma unroll
                for (int e = 0; e < 8; ++e) ss += f[e] * f[e];
#pragma unroll
                for (int o = 1; o < G::PPR; o <<= 1) ss += __shfl_xor(ss, o);
                const float rstd = rsqrtf(ss * (1.0f / HD) + EPSF);
                w.x = cvt_pk_bf16(f[0] * rstd * wa.x, f[1] * rstd * wa.y); w.y = cvt_pk_bf16(f[2] * rstd * wa.z, f[3] * rstd * wa.w);
                w.z = cvt_pk_bf16(f[4] * rstd * wb.x, f[5] * rstd * wb.y); w.w = cvt_pk_bf16(f[6] * rstd * wb.z, f[7] * rstd * wb.w);
            }
            *(LAS u32x4*)(base + (i0 + i) * (RS * STR)) = w; }
    }
}
template <int HD> __device__ __forceinline__ void norm_q(bf16x8 (&qf)[AttnGeo<HD>::NKS], const u32x4 (&qw)[AttnGeo<HD>::NKS], const float* __restrict__ wq, float scale, int g4) {
    typedef AttnGeo<HD> G;
    float ss = 0.f;
#pragma unroll
    for (int ks = 0; ks < G::NKS; ++ks) { const u32x4 x = qw[ks]; const float a0 = bflo(x.x), a1 = bfhi(x.x), a2 = bflo(x.y), a3 = bfhi(x.y), a4 = bflo(x.z), a5 = bfhi(x.z), a6 = bflo(x.w), a7 = bfhi(x.w);
        ss += a0 * a0 + a1 * a1 + a2 * a2 + a3 * a3 + a4 * a4 + a5 * a5 + a6 * a6 + a7 * a7; }
    ss += __shfl_xor(ss, 16); ss += __shfl_xor(ss, 32);
    const float sc = rsqrtf(ss * (1.0f / HD) + EPSF) * scale;
#pragma unroll
    for (int ks = 0; ks < G::NKS; ++ks) { const u32x4 x = qw[ks]; const float4 wa = *(const float4*)(wq + ks * 32 + g4 * 8), wb = *(const float4*)(wq + ks * 32 + g4 * 8 + 4);
        u32x4 o; o.x = cvt_pk_bf16(bflo(x.x) * sc * wa.x, bfhi(x.x) * sc * wa.y); o.y = cvt_pk_bf16(bflo(x.y) * sc * wa.z, bfhi(x.y) * sc * wa.w);
        o.z = cvt_pk_bf16(bflo(x.z) * sc * wb.x, bfhi(x.z) * sc * wb.y); o.w = cvt_pk_bf16(bflo(x.w) * sc * wb.z, bfhi(x.w) * sc * wb.w);
        qf[ks] = __builtin_bit_cast(bf16x8, o); }
}

struct BandItem { const bf16_t* qp; int rstride; int qb, g, h; size_t row0; int d; };
__device__ __forceinline__ BandItem band_decode(int it, const bf16_t* PROJ) {
    BandItem I; const int g = it >> 9, idx = it & 511, dsh = 2 * g, d = 1 << dsh, nqb = 16 >> dsh;
    I.qb = idx % nqb; int rest = idx / nqb; const int r = rest % d; rest /= d; I.h = rest & 3; const int bl = rest >> 2;
    I.g = g; I.d = d; I.row0 = (size_t)bl * SEQ + r; I.qp = PROJ + I.row0 * PS + g * 512 + I.h * 128; I.rstride = d * PS; return I;
}
__device__ __forceinline__ void attn_banded_run(LAS unsigned char* lds, const bf16_t* __restrict__ PROJ, const float* __restrict__ aqn, const float* __restrict__ akn, bf16_t* __restrict__ OG, float* __restrict__ LSE,
                                                int bx, int G_, const int tid) {
    constexpr int HD = 128; typedef AttnGeo<HD> G;
    const int w = __builtin_amdgcn_readfirstlane(tid >> 6), lane = tid & 63, lq = lane & 15, g4 = lane >> 4;
    LAS unsigned char* kl = lds; LAS unsigned char* vl = lds + 256 * G::KSTR;
    const int n = (1536 - bx + G_ - 1) / G_;
    if (n <= 0) return;
    u32x4 rk[G::NPC], rv[G::NPC], rq[G::NKS];
    { const BandItem I = band_decode(bx, PROJ); const int jb = I.qb * 128 - 128;
      issue_rows<HD>(rk, I.qp + C_K, I.rstride, jb, tid); issue_rows<HD>(rv, I.qp + C_V, I.rstride, jb, tid); issue_q<HD>(rq, I.qp + (unsigned)(I.qb * 128 + 16 * w + lq) * (unsigned)I.rstride, g4); }
    { unsigned zl = 0u; asm volatile("" : "+v"(zl));
      for (int p = tid; p < 16 * G::PPR; p += NTHR) *(LAS u32x4*)(vl + (256 + p / G::PPR) * G::VSTR + (p % G::PPR) * 16) = (u32x4){zl, zl, zl, zl}; }
#pragma unroll 1
    for (int k = 0; k < n; ++k) {
        const BandItem I = band_decode(bx + k * G_, PROJ);
        const int jbase = I.qb * 128 - 128, qi = I.qb * 128 + 16 * w + lq;
        write_k<HD>(kl, rk, jbase, akn + I.g * 128, tid);
        write_v<HD>(vl, rv, jbase, tid);
        bf16x8 qf[G::NKS];
        norm_q<HD>(qf, rq, aqn + I.g * 128, 0.08838834764831845f * 1.4426950408889634f, g4);
        __syncthreads();
        { const int kn = (k + 1 < n) ? k + 1 : k; const BandItem J = band_decode(bx + kn * G_, PROJ); const int jb = J.qb * 128 - 128;
          issue_rows<HD>(rk, J.qp + C_K, J.rstride, jb, tid); issue_rows<HD>(rv, J.qp + C_V, J.rstride, jb, tid); issue_q<HD>(rq, J.qp + (unsigned)(J.qb * 128 + 16 * w + lq) * (unsigned)J.rstride, g4); }
        f32x4 S[10];
        float NEG = -__builtin_inff(); asm volatile("" : "+v"(NEG));
#pragma unroll
        for (int t = 0; t < 9; ++t) {
            const int kt = w + t;
            if (jbase + kt * 16 >= 0) {
                f32x4 sv = (f32x4){0.f, 0.f, 0.f, 0.f};
#pragma unroll
                for (int ks = 0; ks < G::NKS; ++ks) { const bf16x8 kf = *(const LAS bf16x8*)(kl + (kt * 16 + lq) * G::KSTR + ks * 64 + g4 * 16); sv = __builtin_amdgcn_mfma_f32_16x16x32_bf16(kf, qf[ks], sv, 0, 0, 0); }
                if (t == 0) {
#pragma unroll
                    for (int r = 0; r < 4; ++r) sv[r] = (4 * g4 + r >= lq) ? sv[r] : NEG; }
                if (t == 8) {
#pragma unroll
                    for (int r = 0; r < 4; ++r) sv[r] = (4 * g4 + r <= lq) ? sv[r] : NEG; }
                S[t] = sv;
            } else S[t] = (f32x4){NEG, NEG, NEG, NEG};
        }
        S[9] = (f32x4){NEG, NEG, NEG, NEG};
        float mx = NEG;
#pragma unroll
        for (int t = 0; t < 9; ++t)
#pragma unroll
            for (int r = 0; r < 4; ++r) mx = fmaxf(mx, S[t][r]);
        mx = fmaxf(mx, __shfl_xor(mx, 16)); mx = fmaxf(mx, __shfl_xor(mx, 32));
        float l = 0.f;
#pragma unroll
        for (int t = 0; t < 10; ++t)
#pragma unroll
            for (int r = 0; r < 4; ++r) { const float pv = __builtin_amdgcn_exp2f(S[t][r] - mx); l += pv; S[t][r] = pv; }
        l += __shfl_xor(l, 16); l += __shfl_xor(l, 32);
        f32x4 O[G::NDT];
#pragma unroll
        for (int dt = 0; dt < G::NDT; ++dt) O[dt] = (f32x4){0.f, 0.f, 0.f, 0.f};
#pragma unroll
        for (int u = 0; u < 5; ++u) {
            u32x4 pw; pw.x = cvt_pk_bf16(S[2 * u][0], S[2 * u][1]); pw.y = cvt_pk_bf16(S[2 * u][2], S[2 * u][3]); pw.z = cvt_pk_bf16(S[2 * u + 1][0], S[2 * u + 1][1]); pw.w = cvt_pk_bf16(S[2 * u + 1][2], S[2 * u + 1][3]);
            const bf16x8 pb = __builtin_bit_cast(bf16x8, pw);
            const int ka = (w + 2 * u) * 16 + 4 * g4 + (lq >> 2), kb = ka + 16;
            LAS unsigned char* va = vl + ka * G::VSTR + (lane & 3) * 8; LAS unsigned char* vb = vl + kb * G::VSTR + (lane & 3) * 8;
#pragma unroll
            for (int dt = 0; dt < G::NDT; ++dt) {
                const s16x4 x = __builtin_amdgcn_ds_read_tr16_b64_v4i16((LAS s16x4*)(va + dt * 32));
                const s16x4 y = __builtin_amdgcn_ds_read_tr16_b64_v4i16((LAS s16x4*)(vb + dt * 32));
                const bf16x8 av = (bf16x8){x[0], x[1], x[2], x[3], y[0], y[1], y[2], y[3]};
                O[dt] = __builtin_amdgcn_mfma_f32_16x16x32_bf16(av, pb, O[dt], 0, 0, 0);
            }
        }
        const float inv = 1.0f / l;
        const size_t trow = I.row0 + (size_t)qi * I.d;
        bf16_t* orow = OG + trow * 1536 + I.g * 512 + I.h * 128;
#pragma unroll
        for (int dt = 0; dt < G::NDT; ++dt) { u32x2 o; o.x = cvt_pk_bf16(O[dt][0] * inv, O[dt][1] * inv); o.y = cvt_pk_bf16(O[dt][2] * inv, O[dt][3] * inv); *(u32x2*)(orow + dt * 16 + 4 * g4) = o; }
        if (g4 == 0) LSE[trow * 12 + I.g * 4 + I.h] = (mx + __builtin_amdgcn_logf(l)) * 0.6931471805599453f;
        __syncthreads();
    }
}

__device__ __forceinline__ void attn_mem_run(LAS unsigned char* lds, const bf16_t* __restrict__ PROJ, const bf16_t* __restrict__ MKV, const float* __restrict__ wq, const float* __restrict__ wk, bf16_t* __restrict__ ACT,
                                             int half, int bx, int G_, const int tid) {
    constexpr int HD = 256; typedef AttnGeo<HD> G;
    const int w = __builtin_amdgcn_readfirstlane(tid >> 6), lane = tid & 63, lq = lane & 15, g4 = lane >> 4;
    const int n = (512 - bx + G_ - 1) / G_;
    if (n <= 0) return;
#pragma unroll 1
    for (int k = 0; k < n; ++k) {
        const int idx = bx + k * G_, qb = idx & 15, h = (idx >> 4) & 3, bl = idx >> 6, b = half * 8 + bl;
        const size_t trow = (size_t)bl * SEQ + qb * 128 + 16 * w + lq;
        u32x4 rq[G::NKS];
        issue_q<HD>(rq, PROJ + trow * PS + C_MQ + h * 256, g4);
        stage_rows<HD, true>(lds, MKV + (size_t)b * 256 * DM + h * 256, DM, wk, tid);
        bf16x8 qf[G::NKS];
        norm_q<HD>(qf, rq, wq, 0.0625f * 1.4426950408889634f, g4);
        __syncthreads();
        u32x2 P[16]; float l;
        {
            f32x4 S[16];
#pragma unroll
            for (int t = 0; t < 16; ++t) {
                f32x4 sv = (f32x4){0.f, 0.f, 0.f, 0.f};
#pragma unroll
                for (int ks = 0; ks < G::NKS; ++ks) { const bf16x8 kf = *(const LAS bf16x8*)(lds + (t * 16 + lq) * G::KSTR + ks * 64 + g4 * 16); sv = __builtin_amdgcn_mfma_f32_16x16x32_bf16(kf, qf[ks], sv, 0, 0, 0); }
                S[t] = sv;
            }
            float mx = -__builtin_inff(); asm volatile("" : "+v"(mx));
#pragma unroll
            for (int t = 0; t < 16; ++t)
#pragma unroll
                for (int r = 0; r < 4; ++r) mx = fmaxf(mx, S[t][r]);
            mx = fmaxf(mx, __shfl_xor(mx, 16)); mx = fmaxf(mx, __shfl_xor(mx, 32));
            l = 0.f;
#pragma unroll
            for (int t = 0; t < 16; ++t) { const float p0 = __builtin_amdgcn_exp2f(S[t][0] - mx), p1 = __builtin_amdgcn_exp2f(S[t][1] - mx), p2 = __builtin_amdgcn_exp2f(S[t][2] - mx), p3 = __builtin_amdgcn_exp2f(S[t][3] - mx);
                l += (p0 + p1) + (p2 + p3); P[t].x = cvt_pk_bf16(p0, p1); P[t].y = cvt_pk_bf16(p2, p3); }
            l += __shfl_xor(l, 16); l += __shfl_xor(l, 32);
        }
        __syncthreads();
        stage_rows<HD, false>(lds, MKV + (size_t)b * 256 * DM + 1024 + h * 256, DM, wk, tid);
        __syncthreads();
        f32x4 O[G::NDT];
#pragma unroll
        for (int dt = 0; dt < G::NDT; ++dt) O[dt] = (f32x4){0.f, 0.f, 0.f, 0.f};
#pragma unroll
        for (int u = 0; u < 8; ++u) {
            u32x4 pw; pw.x = P[2 * u].x; pw.y = P[2 * u].y; pw.z = P[2 * u + 1].x; pw.w = P[2 * u + 1].y;
            const bf16x8 pb = __builtin_bit_cast(bf16x8, pw);
            const int ka = (2 * u) * 16 + 4 * g4 + (lq >> 2), kb = ka + 16;
            LAS unsigned char* va = lds + ka * G::VSTR + (lane & 3) * 8; LAS unsigned char* vb = lds + kb * G::VSTR + (lane & 3) * 8;
#pragma unroll
            for (int dt = 0; dt < G::NDT; ++dt) {
                const s16x4 x = __builtin_amdgcn_ds_read_tr16_b64_v4i16((LAS s16x4*)(va + dt * 32));
                const s16x4 y = __builtin_amdgcn_ds_read_tr16_b64_v4i16((LAS s16x4*)(vb + dt * 32));
                const bf16x8 av = (bf16x8){x[0], x[1], x[2], x[3], y[0], y[1], y[2], y[3]};
                O[dt] = __builtin_amdgcn_mfma_f32_16x16x32_bf16(av, pb, O[dt], 0, 0, 0);
            }
        }
        const float inv = 1.0f / l;
        const bf16_t* zrow = PROJ + trow * PS + C_ZM + h * 256; bf16_t* arow = ACT + trow * ACTW + 1536 + h * 256;
#pragma unroll
        for (int dt = 0; dt < G::NDT; ++dt) { const u32x2 z = *(const u32x2*)(zrow + dt * 16 + 4 * g4);
            u32x2 o; o.x = cvt_pk_bf16(O[dt][0] * inv * siluf_(bflo(z.x)), O[dt][1] * inv * siluf_(bfhi(z.x))); o.y = cvt_pk_bf16(O[dt][2] * inv * siluf_(bflo(z.y)), O[dt][3] * inv * siluf_(bfhi(z.y)));
            *(u32x2*)(arow + dt * 16 + 4 * g4) = o; }
        __syncthreads();
    }
}

#define XB_TMO      128
#define XB_XCNT(j)  (256  + 64 * (j))
#define XB_XSUB(j)  (1280 + 64 * (j))
#define XB_XGEN(j)  (2304 + 64 * (j))
#define XB_TOP      3328
#define XB_TOPGEN   3392
#define XCD_BAR_WORDS 3456
#define XB_SPIN_CAP (1u << 22)
__device__ __forceinline__ unsigned xb_ld(unsigned* p)              { return __hip_atomic_load(p, __ATOMIC_RELAXED, __HIP_MEMORY_SCOPE_AGENT); }
__device__ __forceinline__ unsigned xb_add(unsigned* p, unsigned v) { return __hip_atomic_fetch_add(p, v, __ATOMIC_RELAXED, __HIP_MEMORY_SCOPE_AGENT); }
__device__ __forceinline__ unsigned xb_xcc_id() { return (unsigned)__builtin_amdgcn_s_getreg((3 << 11) | 20) & 0xFu; }
#define XB_SPIN(cond, bar) do { unsigned _sp = 0; while (cond) { __builtin_amdgcn_s_sleep(1); \
    if ((++_sp & 255u) == 0u) { if (xb_ld(&(bar)[XB_TMO])) break; if (_sp > XB_SPIN_CAP) { atomicAdd(&(bar)[XB_TMO], 1u); break; } } } } while (0)
__device__ __forceinline__ void xcd_barrier_complete(unsigned* bar, unsigned x, unsigned& nloc, unsigned& nx) {
    const unsigned G = gridDim.x;
    unsigned sum, cnt, mine, sp = 0u;
    for (;;) {
        sum = 0u; cnt = 0u; mine = 0u;
#pragma unroll
        for (unsigned j = 0; j < 16; ++j) { const unsigned c = xb_ld(&bar[XB_XCNT(j)]); sum += c; cnt += (c > 0u) ? 1u : 0u; mine = (j == x) ? c : mine; }
        if (sum == G) break;
        __builtin_amdgcn_s_sleep(1);
        if ((++sp & 255u) == 0u) { if (xb_ld(&bar[XB_TMO])) break; if (sp > XB_SPIN_CAP) { atomicAdd(&bar[XB_TMO], 1u); break; } }
    }
    nloc = mine > 0u ? mine : 1u; nx = cnt > 0u ? cnt : 1u;
}
__device__ __forceinline__ void xcd_barrier(unsigned* bar, volatile LAS unsigned* st, bool leader_thread) {
    asm volatile("s_waitcnt vmcnt(0)" ::: "memory");
    __syncthreads();
    if (leader_thread) {
        const unsigned x = xb_xcc_id();
        __builtin_amdgcn_s_waitcnt(0);
        unsigned nloc = st[0], nx = st[1];
        if (nloc == 0u) { xcd_barrier_complete(bar, x, nloc, nx); st[0] = nloc; st[1] = nx; }
        const unsigned old = xb_add(&bar[XB_XSUB(x)], 1u);
        const unsigned gen = old / nloc;
        if (old + 1u == (gen + 1u) * nloc) {
            __builtin_amdgcn_fence(__ATOMIC_RELEASE, "agent");
            asm volatile("s_waitcnt vmcnt(0)" ::: "memory");
            const unsigned og = xb_add(&bar[XB_TOP], 1u);
            const unsigned tg = og / nx;
            if (og + 1u == (tg + 1u) * nx) xb_add(&bar[XB_TOPGEN], 1u);
            else XB_SPIN(xb_ld(&bar[XB_TOPGEN]) == tg, bar);
            __builtin_amdgcn_fence(__ATOMIC_ACQUIRE, "agent");
            xb_add(&bar[XB_XGEN(x)], 1u);
            asm volatile("s_waitcnt vmcnt(0)" ::: "memory");
        } else {
            XB_SPIN(xb_ld(&bar[XB_XGEN(x)]) == gen, bar);
            __builtin_amdgcn_fence(__ATOMIC_ACQUIRE, "agent");
            asm volatile("s_waitcnt vmcnt(0)" ::: "memory");
        }
    }
    __syncthreads();
}

struct Args { const float* in[15]; float* out; unsigned char* ws; int lo, hi; };
enum { I_X = 0, I_MEM, I_NG, I_MNG, I_WIN, I_AQN, I_AKN, I_CW, I_WKV, I_MQN, I_MKN, I_WBA, I_WBC, I_WBM, I_WOUT };
constexpr int NPHASE = 10;

__global__ void __launch_bounds__(NTHR, 2) mega(Args a) {
    extern __shared__ __attribute__((aligned(16))) unsigned char lds_raw[];
    LAS unsigned char* lds = (LAS unsigned char*)lds_raw;
    const int G = gridDim.x, bx = blockIdx.x, wave_s = __builtin_amdgcn_readfirstlane((int)threadIdx.x >> 6);
    typedef const __attribute__((address_space(4))) Args* KArgs;
    const int ph_lo = a.lo, ph_hi = a.hi;
    volatile LAS unsigned* xst = (volatile LAS unsigned*)(lds + LDS_BYTES - 16);
    if (ph_hi - ph_lo > 1) {
        if (threadIdx.x == 0) { xst[0] = 0u; xst[1] = 0u; (void)xb_add(&((unsigned*)(a.ws + WS_BAR))[XB_XCNT(xb_xcc_id())], 1u); }
        __syncthreads();
    }
    for (int ph = ph_lo; ph < ph_hi; ++ph) {
        KArgs A = (KArgs)__builtin_amdgcn_kernarg_segment_ptr(); asm volatile("" : "+s"(A));
        unsigned char* ws = A->ws;
        bf16_t* WIN = (bf16_t*)(ws + WS_WIN); bf16_t* WKV = (bf16_t*)(ws + WS_WKV); bf16_t* WBR = (bf16_t*)(ws + WS_WBR); bf16_t* WOUT = (bf16_t*)(ws + WS_WOUT);
        bf16_t* MH = (bf16_t*)(ws + WS_MH); bf16_t* MKV = (bf16_t*)(ws + WS_MKV); bf16_t* PROJ = (bf16_t*)(ws + WS_PROJ); bf16_t* OG = (bf16_t*)(ws + WS_OG);
        float* LSE = (float*)(ws + WS_LSE); bf16_t* ACT = (bf16_t*)(ws + WS_ACT); u32x4* GF = (u32x4*)(ws + WS_GF); bf16_t* MB = (bf16_t*)(ws + WS_MB);
        bf16_t* H = (bf16_t*)(ws + WS_H);
        unsigned ones = ~0u; asm volatile("" : "+s"(ones));
        int tid = wave_s * 64 + (int)__builtin_amdgcn_mbcnt_hi(ones, __builtin_amdgcn_mbcnt_lo(ones, 0u)); asm volatile("" : "+v"(tid));
        const int lane = tid & 63, wave = tid >> 6;
        if (ph == 0) {
#pragma unroll 1
            for (int rep = 0; rep < REP_PREP; ++rep) {
            rmsnorm_rows(A->in[I_X], A->in[I_NG], H, LDP, NTOK, bx * 8 + wave, G * 8, lane);
            rmsnorm_rows(A->in[I_MEM], A->in[I_MNG], MH, DM, 4096, bx * 8 + wave, G * 8, lane);
            constexpr int T0 = 32 * 136, T1 = T0 + 512, T2 = T1 + 128, T3 = T2 + 256, T4 = T3 + 256, T5 = T4 + 512;
            auto job = [&](int t) {
                TJob J; int ti;
                if (t < T0) { J.src = A->in[I_WIN]; J.C = PC; J.dst = WIN; J.ld = LDP; J.koff = 0; ti = t; }
                else if (t < T1) { J.src = A->in[I_WKV]; J.C = DM; J.dst = WKV; J.ld = DM; J.koff = 0; ti = t - T0; }
                else if (t < T2) { J.src = A->in[I_WBA]; J.C = DM; J.dst = WBR; J.ld = ACTW; J.koff = 0; ti = t - T1; }
                else if (t < T3) { J.src = A->in[I_WBC]; J.C = DM; J.dst = WBR; J.ld = ACTW; J.koff = 512; ti = t - T2; }
                else if (t < T4) { J.src = A->in[I_WBM]; J.C = DM; J.dst = WBR; J.ld = ACTW; J.koff = 1536; ti = t - T3; }
                else { J.src = A->in[I_WOUT]; J.C = DM; J.dst = WOUT; J.ld = DM; J.koff = 0; ti = t - T4; }
                const int nct = J.C / 128; J.r0 = (ti / nct) * 64; J.c0 = (ti % nct) * 128; return J;
            };
            if (bx < T5) {
                float4 v[4]; TJob J = job(bx); tile_load(v, J, tid);
#pragma unroll 1
                for (int t = bx; t < T5; t += G) {
                    float4 vn[4]; const int tn = (t + G < T5) ? t + G : t; const TJob Jn = job(tn); tile_load(vn, Jn, tid);
                    tile_store((LAS float*)lds, v, J, tid);
                    J = Jn;
#pragma unroll
                    for (int p = 0; p < 4; ++p) v[p] = vn[p];
                }
            }
            }
        } else if (ph == 1 || ph == 5 || ph == 4 || ph == 8 || ph == 9) {
#ifdef PROBE_NOEPI
            const int nj = (ph == 1 || ph == 5) ? 3 : 1, njr = nj;
#else
            const int nj = (ph == 1 || ph == 5) ? 2 : 1, njr = ((REP_MASK >> ph) & 1) ? 2 * nj : nj;
#endif
#pragma unroll 1
            for (int jr = 0; jr < njr; ++jr) {
                const int j = jr >= nj ? jr - nj : jr;
                pg8::Gemm g; pg8::Epi E;
                if (ph == 4 || ph == 8) {
                    g = pg8::Gemm{ACT, WBR, HT, DM, ACTW, ACTW, ACTW}; E = pg8::Epi{5, MB, GF, nullptr, DM, 1 << 20};
                } else if (ph == 1 && j == 0) {
                    g = pg8::Gemm{MH, WKV, 4096, DM, DM, DM, DM}; E = pg8::Epi{0, MKV, nullptr, nullptr, DM, 1 << 20};
                } else if ((ph == 5 && j == 0) || ph == 9) {
                    const size_t ro = (ph == 9) ? (size_t)HT * DM : 0;
                    g = pg8::Gemm{MB, WOUT, HT, DM, DM, DM, DM}; E = pg8::Epi{4, A->out + ro, A->in[I_X] + ro, nullptr, DM, 1 << 20};
                } else {
                    const int half = (ph == 1) ? 0 : 1;
                    g = pg8::Gemm{H + (size_t)half * HT * LDP, WIN, HT, PC, DM, LDP, LDP}; E = pg8::Epi{0, PROJ, nullptr, GF, PS, PS / 256};
                    if (j == 2) E.kind = 9;
                }
                pg8::StaticOrder S; S.init(g.M, g.N, G, bx);
                unsigned ones2 = ~0u; asm volatile("" : "+s"(ones2));
                int tidj = wave_s * 64 + (int)__builtin_amdgcn_mbcnt_hi(ones2, __builtin_amdgcn_mbcnt_lo(ones2, 0u)); asm volatile("" : "+v"(tidj));
                pg8::gemm_phase(lds, g, S, E, tidj);
            }
        } else if (ph == 2 || ph == 6) {
            const int half = (ph == 2) ? 0 : 1;
#pragma unroll 1
            for (int rep = 0; rep < REP_BAND; ++rep)
            attn_banded_run(lds, PROJ, A->in[I_AQN], A->in[I_AKN], OG, LSE, bx, G, tid);
#pragma unroll 1
            for (int rep = 0; rep < REP_MEM; ++rep)
            attn_mem_run(lds, PROJ, MKV, A->in[I_MQN], A->in[I_MKN], ACT, half, bx, G, tid);
        } else if (ph == 3 || ph == 7) {
            const int gt = bx * NTHR + tid, nth = G * NTHR;
            for (int idx = gt; idx < HT * 64; idx += nth) {
                const int row = idx >> 6, c8 = (idx & 63) * 8, h = c8 >> 7;
                const float l0 = LSE[(size_t)row * 12 + h], l1 = LSE[(size_t)row * 12 + 4 + h], l2 = LSE[(size_t)row * 12 + 8 + h];
                const float m = fmaxf(l0, fmaxf(l1, l2)); float w0 = __expf(l0 - m), w1 = __expf(l1 - m), w2 = __expf(l2 - m); const float inv = 1.0f / (w0 + w1 + w2); w0 *= inv; w1 *= inv; w2 *= inv;
                const u32x4 o0 = *(const u32x4*)(OG + (size_t)row * 1536 + c8), o1 = *(const u32x4*)(OG + (size_t)row * 1536 + 512 + c8), o2 = *(const u32x4*)(OG + (size_t)row * 1536 + 1024 + c8);
                const u32x4 z = *(const u32x4*)(PROJ + (size_t)row * PS + C_ZA + c8);
                u32x4 o;
#define CMB(k) o.k = cvt_pk_bf16((w0 * bflo(o0.k) + w1 * bflo(o1.k) + w2 * bflo(o2.k)) * siluf_(bflo(z.k)), (w0 * bfhi(o0.k) + w1 * bfhi(o1.k) + w2 * bfhi(o2.k)) * siluf_(bfhi(z.k)))
                CMB(x); CMB(y); CMB(z); CMB(w);
#undef CMB
                *(u32x4*)(ACT + (size_t)row * ACTW + c8) = o;
            }
            const float* cw = A->in[I_CW];
            for (int idx = gt; idx < HT * 128; idx += nth) {
                const int row = idx >> 7, c8 = (idx & 127) * 8, t = row & (SEQ - 1);
                const bf16_t* pr = PROJ + (size_t)row * PS;
                unsigned zl = 0u; asm volatile("" : "+v"(zl)); const u32x4 z4 = (u32x4){zl, zl, zl, zl};
                const u32x4 c0 = *(const u32x4*)(pr + C_CC + c8), v0 = *(const u32x4*)(pr + C_CV + c8);
                const u32x4 c1 = t >= 1 ? *(const u32x4*)(pr - PS + C_CC + c8) : z4, v1 = t >= 1 ? *(const u32x4*)(pr - PS + C_CV + c8) : z4;
                const u32x4 c2 = t >= 2 ? *(const u32x4*)(pr - 2 * PS + C_CC + c8) : z4, v2 = t >= 2 ? *(const u32x4*)(pr - 2 * PS + C_CV + c8) : z4;
                const u32x4 bb = *(const u32x4*)(pr + C_CB + c8), zz = *(const u32x4*)(pr + C_ZC + c8);
                const float4 wa0 = *(const float4*)(cw + c8), wb0 = *(const float4*)(cw + c8 + 4), wa1 = *(const float4*)(cw + 1024 + c8), wb1 = *(const float4*)(cw + 1024 + c8 + 4), wa2 = *(const float4*)(cw + 2048 + c8), wb2 = *(const float4*)(cw + 2048 + c8 + 4);
                u32x4 o;
#define CV1(f, k, W0, W1, W2) ((W0 * (f(c0.k) * f(v0.k)) + W1 * (f(c1.k) * f(v1.k)) + W2 * (f(c2.k) * f(v2.k))) * f(bb.k) * siluf_(f(zz.k)))
                o.x = cvt_pk_bf16(CV1(bflo, x, wa0.x, wa1.x, wa2.x), CV1(bfhi, x, wa0.y, wa1.y, wa2.y));
                o.y = cvt_pk_bf16(CV1(bflo, y, wa0.z, wa1.z, wa2.z), CV1(bfhi, y, wa0.w, wa1.w, wa2.w));
                o.z = cvt_pk_bf16(CV1(bflo, z, wb0.x, wb1.x, wb2.x), CV1(bfhi, z, wb0.y, wb1.y, wb2.y));
                o.w = cvt_pk_bf16(CV1(bflo, w, wb0.z, wb1.z, wb2.z), CV1(bfhi, w, wb0.w, wb1.w, wb2.w));
#undef CV1
                *(u32x4*)(ACT + (size_t)row * ACTW + 512 + c8) = o;
            }
        }
        if (ph + 1 < ph_hi) {
            if (ph == 0) cg::this_grid().sync();
            else xcd_barrier((unsigned*)(A->ws + WS_BAR), xst, tid == 0);
        }
        if (ph == 0 && ph_hi - ph_lo > 1) { for (int e = 0; e < EXTRA_SYNCS; ++e) cg::this_grid().sync(); }
    }
}

extern "C" void kernel_launch(void* const* d_in, const int* in_sizes, int n_in, void* d_out, int out_size, void* d_ws, size_t ws_size, hipStream_t stream) {
    static int grid = 0;
    if (grid == 0) {
        if (n_in != 15 || ws_size < WS_END) { fprintf(stderr, "kernel_launch: unexpected inputs (n_in %d, ws %zu < %zu)\n", n_in, ws_size, (size_t)WS_END); grid = -1; return; }
        int dev = 0, cus = 0, per_cu = 0;
        hipGetDevice(&dev); hipDeviceGetAttribute(&cus, hipDeviceAttributeMultiprocessorCount, dev);
        if (hipFuncSetAttribute((const void*)mega, hipFuncAttributeMaxDynamicSharedMemorySize, LDS_BYTES) != hipSuccess) { fprintf(stderr, "kernel_launch: hipFuncSetAttribute failed\n"); grid = -1; return; }
        hipOccupancyMaxActiveBlocksPerMultiprocessor(&per_cu, (const void*)mega, NTHR, LDS_BYTES);
        if (per_cu < 1) per_cu = 1;
        grid = cus * 1;
        (void)hipGetLastError();
    }
    if (grid < 0) return;
    Args a{};
    for (int i = 0; i < 15; ++i) a.in[i] = (const float*)d_in[i];
    a.out = (float*)d_out; a.ws = (unsigned char*)d_ws;
#if ONE_LAUNCH
    (void)hipMemsetAsync((unsigned char*)d_ws + WS_BAR, 0, 16384, stream);
    a.lo = 0; a.hi = NPHASE;
    void* args[] = {&a};
    hipError_t e = hipLaunchCooperativeKernel((const void*)mega, dim3(grid), dim3(NTHR), args, LDS_BYTES, stream);
    if (e != hipSuccess) fprintf(stderr, "cooperative launch failed: %s (grid %d)\n", hipGetErrorString(e), grid);
#else
    for (int ph = 0; ph < NPHASE; ++ph) { a.lo = ph; a.hi = ph + 1; hipLaunchKernelGGL(mega, dim3(grid), dim3(NTHR), LDS_BYTES, stream, a); }
#endif
}
```

```cpp
#include <hip/hip_runtime.h>
#include <hip/hip_cooperative_groups.h>
#include <cstdio>
namespace cg = cooperative_groups;

#ifndef ONE_LAUNCH
#define ONE_LAUNCH 1
#endif

#ifndef REP_MASK
#define REP_MASK 0
#endif
#define GEMM1_STAGGER_US 0
#define REP_BAND 1
#define REP_MEM 1
#define REP_PREP 1
#define EXTRA_SYNCS 0
#ifndef PG8_SP2
#define PG8_SP2 1
#endif
#define LAS __attribute__((address_space(3)))
typedef unsigned short bf16_t;
typedef short bf16x8 __attribute__((ext_vector_type(8)));
typedef short s16x4 __attribute__((ext_vector_type(4)));
typedef float f32x4 __attribute__((ext_vector_type(4)));
typedef unsigned u32x4 __attribute__((ext_vector_type(4)));
typedef unsigned u32x2 __attribute__((ext_vector_type(2)));
typedef int i32x8 __attribute__((ext_vector_type(8)));
typedef int i32x4 __attribute__((ext_vector_type(4)));
typedef short s16x16 __attribute__((ext_vector_type(16)));

constexpr int DM = 2048, SEQ = 2048, NB = 16, NTOK = NB * SEQ;
constexpr int PC = 17408;
constexpr int PS = 11264;
constexpr int HT = NTOK / 2;
constexpr int C_Q = 0, C_K = 1536, C_V = 3072, C_ZA = 4608, C_CB = 5120, C_CC = 6144, C_CV = 7168, C_ZC = 8192, C_MQ = 9216, C_ZM = 10240, C_G = 11264;
constexpr int ACTW = 2560;
constexpr int LDP = 2048 + 64;
constexpr float EPSF = 1e-6f;
constexpr int NTHR = 512;
constexpr int LDS_BYTES = 149504;

constexpr size_t WS_WIN = 0;
constexpr size_t WS_WKV = WS_WIN + (size_t)PC * LDP * 2;
constexpr size_t WS_WBR = WS_WKV + (size_t)DM * DM * 2;
constexpr size_t WS_WOUT = WS_WBR + (size_t)DM * ACTW * 2;
constexpr size_t WS_MH = WS_WOUT + (size_t)DM * DM * 2;
constexpr size_t WS_MKV = WS_MH + (size_t)4096 * DM * 2;
constexpr size_t WS_PROJ = WS_MKV + (size_t)4096 * DM * 2;
constexpr size_t WS_OG = WS_PROJ + (size_t)HT * PS * 2;
constexpr size_t WS_LSE = WS_OG + (size_t)HT * 1536 * 2;
constexpr size_t WS_ACT = WS_LSE + (size_t)HT * 12 * 4;
constexpr size_t WS_GF = WS_ACT + (size_t)HT * ACTW * 2;
constexpr size_t WS_MB = WS_GF + (size_t)HT * 6144;
constexpr size_t WS_MB2 = WS_MB + (size_t)HT * DM * 2;
constexpr size_t WS_H = WS_MB2 + (size_t)HT * DM * 2;
constexpr size_t WS_BAR = WS_H + (size_t)NTOK * LDP * 2;
constexpr size_t WS_END = WS_BAR + 16384;
constexpr size_t OUT_H_OFF = (size_t)HT * DM * 4;

__device__ __forceinline__ float bflo(unsigned w) { return __uint_as_float(w << 16); }
__device__ __forceinline__ float bfhi(unsigned w) { return __uint_as_float(w & 0xffff0000u); }
typedef __bf16 bf16x2_t __attribute__((ext_vector_type(2)));
typedef float f32x2_t __attribute__((ext_vector_type(2)));
__device__ __forceinline__ unsigned cvt_pk_bf16(float lo, float hi) { f32x2_t v = {lo, hi}; bf16x2_t b = __builtin_convertvector(v, bf16x2_t); return __builtin_bit_cast(unsigned, b); }
__device__ __forceinline__ float shx(float v, int mask, int lane) { return __int_as_float(__builtin_amdgcn_ds_bpermute(((lane ^ mask) & 63) << 2, __float_as_int(v))); }
__device__ __forceinline__ u32x4 xchg8_dpp(const u32x4 snd) {
    u32x4 r; r.x = (unsigned)__builtin_amdgcn_mov_dpp((int)snd.x, 0x128, 0xf, 0xf, true); r.y = (unsigned)__builtin_amdgcn_mov_dpp((int)snd.y, 0x128, 0xf, 0xf, true);
    r.z = (unsigned)__builtin_amdgcn_mov_dpp((int)snd.z, 0x128, 0xf, 0xf, true); r.w = (unsigned)__builtin_amdgcn_mov_dpp((int)snd.w, 0x128, 0xf, 0xf, true); return r;
}
__device__ __forceinline__ float sigmoidf_(float x) { return __builtin_amdgcn_rcpf(1.0f + __builtin_amdgcn_exp2f(x * -1.4426950408889634f)); }
__device__ __forceinline__ float siluf_(float x) { return x * __builtin_amdgcn_rcpf(1.0f + __builtin_amdgcn_exp2f(x * -1.4426950408889634f)); }

namespace pg8 {
constexpr int BM = 256, BK = 64, HALF = 128, HTB = HALF * BK * 2, STAGE_BYTES = 8 * HTB, NXCD = 8, WGM = 8;
__host__ __device__ __forceinline__ int lds_byte(int r, int c) { const int st = (r >> 4) * 2 + (c >> 5), rr = r & 15, cc = c & 31, ob = rr * 64 + cc * 2; return st * 1024 + (ob ^ (((ob >> 9) & 1) << 5)); }
__host__ __device__ __forceinline__ void stage_rc(int b, int& R, int& C) { const int st = b / 1024, sb = b % 1024, swz = sb ^ (((sb >> 9) & 1) << 5); R = (st >> 1) * 16 + swz / 64; C = (st & 1) * 32 + (swz % 64) / 2; }
__host__ __device__ __forceinline__ int perm32(int rho) { const int n = rho >> 4, i = rho & 15; return 8 * (i >> 2) + 4 * n + (i & 3); }
struct Unit { int pm, pn; };
struct Gemm { const bf16_t* A; const bf16_t* Bt; int M, N, K, lda, ldb, f8; };
struct StaticOrder {
    int nM, nN, nwg, G, c;
    __device__ void init(int M, int N, int G_, int c_) { nM = M / BM; nN = N / BM; nwg = nM * nN; G = G_; c = c_; }
    __device__ bool next(int i, Unit& u) const {
        const long L = (long)i * G + c; if (L >= nwg) return false;
        int wgid = (int)L; { const int q = nwg / NXCD, r = nwg % NXCD, xcd = wgid % NXCD, off = wgid / NXCD; wgid = (xcd < r ? xcd * (q + 1) : r * (q + 1) + (xcd - r) * q) + off; }
        const int nig = WGM * nN, gid = wgid / nig, fm = gid * WGM, gsz = (nM - fm) < WGM ? (nM - fm) : WGM;
        u.pm = fm + ((wgid % nig) % gsz); u.pn = (wgid % nig) / gsz; return true;
    }
};

struct Epi;
template <bool F8, class Epi, class Sched>
__device__ __forceinline__ void gemm_phase(LAS unsigned char* lds, const Gemm g, const Sched& S, const Epi& E, const int tid) {
    const int wid = __builtin_amdgcn_readfirstlane(tid >> 6), lane = tid & 63, wr = wid >> 2, wc = wid & 3, fr = lane & 15, fq = lane >> 4;
    const int K = g.K, nt = K / BK;
    unsigned voffA[2], voffB[2];
#pragma unroll
    for (int i = 0; i < 2; ++i) { int R, C; stage_rc(tid * 16 + i * 8192, R, C); const int Rb = 2 * (R & ~31) + (E.perm() ? perm32(R & 31) : (R & 31));
        voffA[i] = (unsigned)(R * g.lda + C) * 2u; voffB[i] = (unsigned)(Rb * g.ldb + C) * 2u; }
    const size_t kstep = (size_t)(BK * 2);
    const size_t hstepA = (size_t)HALF * g.lda * 2, hstepB = (size_t)32 * g.ldb * 2;
    const size_t tstepA = 2 * hstepA, tstepB = (size_t)BM * g.ldb * 2;
    const unsigned ldsw = (unsigned)wid * 1024u;
    const int aoff = lds_byte(wr * 64 + fr, fq * 8), boff = lds_byte(wc * 32 + fr, fq * 8);
#define PG8_SA(b, h) (((b) * 2 + (h)) * HTB)
#define PG8_SB(b, h) ((4 + (b) * 2 + (h)) * HTB)
#define PG8_STAGE(bufoff, gbase, voff) do { _Pragma("unroll") for (int _i = 0; _i < 2; ++_i) \
        __builtin_amdgcn_global_load_lds((const unsigned*)((const char*)(gbase) + (voff)[_i]), (LAS unsigned*)(lds + (bufoff) + ldsw + _i * 8192), 16, 0, 0); } while (0)
#define PG8_LD8(p) __builtin_shufflevector(*(const LAS i32x4*)(p), *(const LAS i32x4*)((p) + 1024), 0, 1, 2, 3, 4, 5, 6, 7)
#define PG8_LDA(dst, b, h) do { _Pragma("unroll") for (int m = 0; m < 4; ++m) dst[m] = PG8_LD8(lds + PG8_SA(b, h) + aoff + m * 2048); } while (0)
#define PG8_LDB(dst, b, h) do { _Pragma("unroll") for (int n = 0; n < 2; ++n) dst[n] = PG8_LD8(lds + PG8_SB(b, h) + boff + n * 2048); } while (0)
#define PG8_LO(v) __builtin_bit_cast(bf16x8, __builtin_shufflevector(v, v, 0, 1, 2, 3))
#define PG8_HI(v) __builtin_bit_cast(bf16x8, __builtin_shufflevector(v, v, 4, 5, 6, 7))
#define PG8_MMA(ai, bj, At, Bt) do { __builtin_amdgcn_s_setprio(1); \
        if constexpr (F8) { _Pragma("unroll") for (int m = 0; m < 4; ++m) _Pragma("unroll") for (int n = 0; n < 2; ++n) \
            asm volatile("v_mfma_scale_f32_16x16x128_f8f6f4 %0, %1, %2, %0, %3, %3 op_sel_hi:[0,0,0]" : "+v"(acc[ai][bj][m][n]) : "v"(Bt[n]), "v"(At[m]), "v"(mxs)); } \
        else { _Pragma("unroll") for (int m = 0; m < 4; ++m) _Pragma("unroll") for (int n = 0; n < 2; ++n) { \
            acc[ai][bj][m][n] = __builtin_amdgcn_mfma_f32_16x16x32_bf16(PG8_LO(Bt[n]), PG8_LO(At[m]), acc[ai][bj][m][n], 0, 0, 0); \
            acc[ai][bj][m][n] = __builtin_amdgcn_mfma_f32_16x16x32_bf16(PG8_HI(Bt[n]), PG8_HI(At[m]), acc[ai][bj][m][n], 0, 0, 0); } } \
        __builtin_amdgcn_s_setprio(0); } while (0)
#define PG8_WAIT_V(n) asm volatile("s_waitcnt vmcnt(" #n ")" ::: "memory")
#define PG8_WAIT_L(n) asm volatile("s_waitcnt lgkmcnt(" #n ")" ::: "memory")
#define PG8_BAR __builtin_amdgcn_s_barrier()
#define PG8_SCHED __builtin_amdgcn_sched_barrier(0)
    Unit cur, nxt; int ui = 0;
    if (!S.next(0, cur)) return;
    int mxs = 0x7f7f7f7f; if constexpr (F8) asm volatile("" : "+v"(mxs));
    f32x4 acc[2][2][4][2];
#pragma unroll
    for (int a = 0; a < 2; ++a)
#pragma unroll
        for (int b = 0; b < 2; ++b)
#pragma unroll
            for (int m = 0; m < 4; ++m)
#pragma unroll
                for (int n = 0; n < 2; ++n) acc[a][b][m][n] = (f32x4){0.f, 0.f, 0.f, 0.f};
    i32x8 At[4], B0[2], B1[2];
    const char* cA = (const char*)g.A + (size_t)cur.pm * tstepA; const char* cB = (const char*)g.Bt + (size_t)cur.pn * tstepB;
#if PG8_SP2
    PG8_STAGE(PG8_SB(0, 0), cB, voffB); PG8_STAGE(PG8_SB(0, 1), cB + hstepB, voffB); PG8_STAGE(PG8_SA(0, 0), cA, voffA); PG8_STAGE(PG8_SA(0, 1), cA + hstepA, voffA);
    if (wr == 1) PG8_BAR;
    PG8_WAIT_V(2); PG8_BAR;
    PG8_STAGE(PG8_SB(1, 0), cB + kstep, voffB); PG8_STAGE(PG8_SA(1, 0), cA + kstep, voffA); PG8_STAGE(PG8_SB(1, 1), cB + hstepB + kstep, voffB);
    PG8_WAIT_V(6); PG8_BAR;
#else
    PG8_STAGE(PG8_SB(0, 0), cB, voffB); PG8_STAGE(PG8_SA(0, 0), cA, voffA); PG8_STAGE(PG8_SB(0, 1), cB + hstepB, voffB); PG8_STAGE(PG8_SA(0, 1), cA + hstepA, voffA);
    if (wr == 1) PG8_BAR;
    PG8_WAIT_V(4); PG8_BAR;
    PG8_STAGE(PG8_SB(1, 0), cB + kstep, voffB); PG8_STAGE(PG8_SA(1, 0), cA + kstep, voffA); PG8_STAGE(PG8_SB(1, 1), cB + hstepB + kstep, voffB);
    PG8_WAIT_V(6); PG8_BAR;
#endif
    for (;;) {
        const bool has_next = S.next(ui + 1, nxt);
        const char* nA = has_next ? (const char*)g.A + (size_t)nxt.pm * tstepA : cA; const char* nB = has_next ? (const char*)g.Bt + (size_t)nxt.pn * tstepB : cB;
        for (int t = 0; t < nt; t += 2) {
            const bool last = (t == nt - 2);
            const char* a1 = cA + (size_t)(t + 1) * kstep;
            const char* a2 = last ? nA : cA + (size_t)(t + 2) * kstep; const char* b2 = last ? nB : cB + (size_t)(t + 2) * kstep;
            const char* a3 = a2 + kstep; const char* b3 = b2 + kstep;
            if constexpr (!F8) { if (E.has_mid() && (t == 8 || t == 24)) E.mid(acc, cur, tid, t == 8 ? 0 : 1); }
#if PG8_SP2
            PG8_LDB(B0, 0, 0); PG8_LDB(B1, 0, 1); PG8_SCHED; PG8_LDA(At, 0, 0); PG8_STAGE(PG8_SA(1, 1), a1 + hstepA, voffA);
            PG8_WAIT_V(8); PG8_WAIT_L(0); PG8_BAR; PG8_MMA(0, 0, At, B0); PG8_MMA(0, 1, At, B1); PG8_BAR; PG8_SCHED;
            PG8_LDA(At, 0, 1); PG8_STAGE(PG8_SB(0, 0), b2, voffB); PG8_STAGE(PG8_SB(0, 1), b2 + hstepB, voffB); PG8_STAGE(PG8_SA(0, 0), a2, voffA);
            PG8_WAIT_V(8); PG8_WAIT_L(0); PG8_BAR; PG8_MMA(1, 0, At, B0); PG8_MMA(1, 1, At, B1); PG8_BAR; PG8_SCHED;
            PG8_LDB(B0, 1, 0); PG8_LDB(B1, 1, 1); PG8_SCHED; PG8_LDA(At, 1, 0); PG8_STAGE(PG8_SA(0, 1), a2 + hstepA, voffA);
            PG8_WAIT_V(8); PG8_WAIT_L(0); PG8_BAR; PG8_MMA(0, 0, At, B0); PG8_MMA(0, 1, At, B1); PG8_BAR; PG8_SCHED;
            PG8_LDA(At, 1, 1); PG8_STAGE(PG8_SB(1, 0), b3, voffB); PG8_STAGE(PG8_SB(1, 1), b3 + hstepB, voffB); PG8_STAGE(PG8_SA(1, 0), a3, voffA);
            PG8_WAIT_V(8); PG8_WAIT_L(0); PG8_BAR; PG8_MMA(1, 0, At, B0); PG8_MMA(1, 1, At, B1); PG8_BAR; PG8_SCHED;
#else
            PG8_LDB(B0, 0, 0); PG8_SCHED; PG8_LDA(At, 0, 0); PG8_STAGE(PG8_SA(1, 1), a1 + hstepA, voffA);
            PG8_WAIT_L(8); PG8_BAR; PG8_WAIT_L(0); PG8_MMA(0, 0, At, B0); PG8_BAR; PG8_SCHED;
            PG8_LDB(B1, 0, 1); PG8_STAGE(PG8_SB(0, 0), b2, voffB);
            PG8_BAR; PG8_WAIT_L(0); PG8_MMA(0, 1, At, B1); PG8_BAR;
            PG8_LDA(At, 0, 1); PG8_STAGE(PG8_SA(0, 0), a2, voffA);
            PG8_BAR; PG8_WAIT_L(0); PG8_MMA(1, 0, At, B0); PG8_BAR; PG8_SCHED;
            PG8_STAGE(PG8_SB(0, 1), b2 + hstepB, voffB);
            PG8_WAIT_V(6); PG8_BAR; PG8_MMA(1, 1, At, B1); PG8_BAR;
            PG8_LDB(B0, 1, 0); PG8_SCHED; PG8_LDA(At, 1, 0); PG8_STAGE(PG8_SA(0, 1), a2 + hstepA, voffA);
            PG8_WAIT_L(8); PG8_BAR; PG8_WAIT_L(0); PG8_MMA(0, 0, At, B0); PG8_BAR; PG8_SCHED;
            PG8_LDB(B1, 1, 1); PG8_STAGE(PG8_SB(1, 0), b3, voffB);
            PG8_BAR; PG8_WAIT_L(0); PG8_MMA(0, 1, At, B1); PG8_BAR;
            PG8_LDA(At, 1, 1); PG8_STAGE(PG8_SA(1, 0), a3, voffA);
            PG8_BAR; PG8_WAIT_L(0); PG8_MMA(1, 0, At, B0); PG8_BAR; PG8_SCHED;
            PG8_STAGE(PG8_SB(1, 1), b3 + hstepB, voffB);
            PG8_WAIT_V(6); PG8_BAR; PG8_MMA(1, 1, At, B1); PG8_BAR;
#endif
        }
        if (wr == 0) PG8_BAR;
        if constexpr (F8) {
            asm volatile("s_nop 15\n\ts_nop 15"
                         : "+v"(acc[1][0][0][0]), "+v"(acc[1][0][0][1]), "+v"(acc[1][0][1][0]), "+v"(acc[1][0][1][1]), "+v"(acc[1][0][2][0]), "+v"(acc[1][0][2][1]), "+v"(acc[1][0][3][0]), "+v"(acc[1][0][3][1]),
                           "+v"(acc[1][1][0][0]), "+v"(acc[1][1][0][1]), "+v"(acc[1][1][1][0]), "+v"(acc[1][1][1][1]), "+v"(acc[1][1][2][0]), "+v"(acc[1][1][2][1]), "+v"(acc[1][1][3][0]), "+v"(acc[1][1][3][1]));
            E.k0(acc, cur, wr, wc, fr, fq, tid);
        } else E(acc, cur, wr, wc, fr, fq, tid);
        if (!has_next) break;
#pragma unroll
        for (int a = 0; a < 2; ++a)
#pragma unroll
            for (int b = 0; b < 2; ++b)
#pragma unroll
                for (int m = 0; m < 4; ++m)
#pragma unroll
                    for (int n = 0; n < 2; ++n) acc[a][b][m][n] = (f32x4){0.f, 0.f, 0.f, 0.f};
        cur = nxt; cA = nA; cB = nB; ++ui;
        if (wr == 1) PG8_BAR;
    }
    PG8_WAIT_V(0);
    PG8_BAR;
#undef PG8_SA
#undef PG8_SB
#undef PG8_STAGE
#undef PG8_LDA
#undef PG8_LDB
#undef PG8_MMA
#undef PG8_LD8
#undef PG8_LO
#undef PG8_HI
#undef PG8_WAIT_V
#undef PG8_WAIT_L
#undef PG8_BAR
#undef PG8_SCHED
}

struct Epi {
    int kind; void* p0; const void* p1; void* p2; int ldc, gpn0; float gscale; int split, off0, off1, gpn1, gb0, gb1;
    __device__ __forceinline__ bool perm() const { return kind != 4; }
    __device__ __forceinline__ bool has_mid() const { return kind == 5; }
    __device__ __forceinline__ void mid(f32x4 (&acc)[2][2][4][2], const Unit& u, int tid, int which) const {
        const u32x2* ga = (const u32x2*)p1 + ((size_t)(u.pm * 24 + 8 * which + u.pn) * 16) * 512 + tid; const u32x2* gb = ga + (size_t)8 * 16 * 512;
        u32x2 x[16], y[16];
#pragma unroll
        for (int i = 0; i < 16; ++i) { x[i] = ga[i * 512]; y[i] = gb[i * 512]; }
        asm volatile("s_waitcnt vmcnt(0)" ::: "memory");
#pragma unroll
        for (int i = 0; i < 16; ++i) { const int ai = i >> 3, m = (i >> 1) & 3, bj = i & 1; const u32x2 a = x[i], b = y[i];
#define QR(wa, wb, sh) __builtin_amdgcn_exp2f(((float)(((wb) >> (sh)) & 0xffu) - (float)(((wa) >> (sh)) & 0xffu)) * 0.03125f)
            acc[ai][bj][m][0] *= (f32x4){QR(a.x, b.x, 0), QR(a.x, b.x, 8), QR(a.x, b.x, 16), QR(a.x, b.x, 24)};
            acc[ai][bj][m][1] *= (f32x4){QR(a.y, b.y, 0), QR(a.y, b.y, 8), QR(a.y, b.y, 16), QR(a.y, b.y, 24)};
#undef QR
        }
    }
    __device__ __forceinline__ void gate(const f32x4 (&acc)[2][2][4][2], const Unit& u, int tid) const {
            const int gi = (u.pn < gpn1) ? gb0 + (u.pn - gpn0) : gb1 + (u.pn - gpn1);
            u32x2* gf = (u32x2*)p2 + ((size_t)(u.pm * 24 + gi) * 16) * 512 + tid;
            const float nls = -1.4426950408889634f * gscale;
#pragma unroll
            for (int ai = 0; ai < 2; ++ai)
#pragma unroll
                for (int m = 0; m < 4; ++m)
#pragma unroll
                    for (int bj = 0; bj < 2; ++bj) { const f32x4 v0 = acc[ai][bj][m][0], v1 = acc[ai][bj][m][1];
#define QF(v) (__builtin_amdgcn_logf(1.0f + __builtin_amdgcn_exp2f((v) * nls)) * 32.0f)
#define QP(a, b, c, d) __builtin_amdgcn_cvt_pk_u8_f32(QF(d), 3, __builtin_amdgcn_cvt_pk_u8_f32(QF(c), 2, __builtin_amdgcn_cvt_pk_u8_f32(QF(b), 1, __builtin_amdgcn_cvt_pk_u8_f32(QF(a), 0, 0u))))
                        u32x2 w; w.x = QP(v0[0], v0[1], v0[2], v0[3]); w.y = QP(v1[0], v1[1], v1[2], v1[3]);
#undef QP
#undef QF
                        __builtin_nontemporal_store(w, &gf[((ai * 4 + m) * 2 + bj) * 512]); }
    }
    __device__ __forceinline__ void k0store(const f32x4 (&acc)[2][2][4][2], const Unit& u, int wr, int wc, int fr, int fq) const {
        const bool lo = fr < 8;
        const int row0 = u.pm * BM + wr * 64 + (fr & 7);
        bf16_t* O = (bf16_t*)p0; const int col0 = ((u.pn < split) ? off0 + u.pn * BM : off1 + (u.pn - split) * BM) + wc * 64 + 8 * fq + (lo ? 0 : 32); const float sc = gscale;
#pragma unroll
        for (int ai = 0; ai < 2; ++ai)
#pragma unroll
            for (int m = 0; m < 4; ++m) { bf16_t* rowp = O + (size_t)(row0 + ai * HALF + m * 16) * ldc + col0;
                const f32x4 a0 = acc[ai][0][m][0] * sc, a1 = acc[ai][0][m][1] * sc, b0 = acc[ai][1][m][0] * sc, b1 = acc[ai][1][m][1] * sc;
                u32x4 w0, w1; w0.x = cvt_pk_bf16(a0[0], a0[1]); w0.y = cvt_pk_bf16(a0[2], a0[3]); w0.z = cvt_pk_bf16(a1[0], a1[1]); w0.w = cvt_pk_bf16(a1[2], a1[3]);
                w1.x = cvt_pk_bf16(b0[0], b0[1]); w1.y = cvt_pk_bf16(b0[2], b0[3]); w1.z = cvt_pk_bf16(b1[0], b1[1]); w1.w = cvt_pk_bf16(b1[2], b1[3]);
                const u32x4 snd = lo ? w1 : w0; u32x4 rcv;
                rcv.x = (unsigned)__builtin_amdgcn_mov_dpp((int)snd.x, 0x128, 0xf, 0xf, true); rcv.y = (unsigned)__builtin_amdgcn_mov_dpp((int)snd.y, 0x128, 0xf, 0xf, true);
                rcv.z = (unsigned)__builtin_amdgcn_mov_dpp((int)snd.z, 0x128, 0xf, 0xf, true); rcv.w = (unsigned)__builtin_amdgcn_mov_dpp((int)snd.w, 0x128, 0xf, 0xf, true);
                const u32x4 sa = lo ? w0 : rcv, sb = lo ? rcv : w1;
                __builtin_nontemporal_store(sa, (u32x4*)rowp);
                __builtin_nontemporal_store(sb, (u32x4*)(rowp + (size_t)8 * ldc)); }
    }
    __device__ __forceinline__ void k0(const f32x4 (&acc)[2][2][4][2], const Unit& u, int wr, int wc, int fr, int fq, int tid) const {
        if (u.pn >= gpn0) gate(acc, u, tid); else k0store(acc, u, wr, wc, fr, fq);
    }
    __device__ __forceinline__ void operator()(const f32x4 (&acc)[2][2][4][2], const Unit& u, int wr, int wc, int fr, int fq, int tid) const {
        const int row0 = u.pm * BM + wr * 64 + fr;
        if (kind == 0 && u.pn >= gpn0) {
            gate(acc, u, tid);
        } else if (kind == 0) {
            k0store(acc, u, wr, wc, fr, fq);
        } else if (kind == 4) {
            const float* x = (const float*)p1; float* out = (float*)p0; const int col0 = u.pn * BM + wc * 64 + 4 * fq;
#pragma unroll
            for (int ai = 0; ai < 2; ++ai) {
                f32x4 xv[4][2][2];
#pragma unroll
                for (int m = 0; m < 4; ++m) { const size_t off = (size_t)(row0 + ai * HALF + m * 16) * DM + col0;
#pragma unroll
                    for (int bj = 0; bj < 2; ++bj)
#pragma unroll
                        for (int n = 0; n < 2; ++n) xv[m][bj][n] = *(const f32x4*)(x + off + bj * 32 + n * 16); }
                asm volatile("s_waitcnt vmcnt(0)" ::: "memory");
#pragma unroll
                for (int m = 0; m < 4; ++m) { const size_t off = (size_t)(row0 + ai * HALF + m * 16) * DM + col0;
#pragma unroll
                    for (int bj = 0; bj < 2; ++bj)
#pragma unroll
                        for (int n = 0; n < 2; ++n) *(f32x4*)(out + off + bj * 32 + n * 16) = xv[m][bj][n] + acc[ai][bj][m][n]; }
                asm volatile("" ::: "memory");
            }
        } else if (kind == 5) {
            bf16_t* O = (bf16_t*)p0; const int col0 = u.pn * BM + wc * 64 + 8 * fq;
            const u32x2* gc = (const u32x2*)p1 + ((size_t)(u.pm * 24 + 16 + u.pn) * 16) * 512 + tid;
            u32x2 gy[16];
#pragma unroll
            for (int i = 0; i < 16; ++i) gy[i] = gc[i * 512];
            asm volatile("s_waitcnt vmcnt(0)" ::: "memory");
#pragma unroll
            for (int ai = 0; ai < 2; ++ai)
#pragma unroll
                for (int m = 0; m < 4; ++m) { bf16_t* rowp = O + (size_t)(row0 + ai * HALF + m * 16) * ldc + col0;
#pragma unroll
                    for (int bj = 0; bj < 2; ++bj) { const f32x4 v0 = acc[ai][bj][m][0], v1 = acc[ai][bj][m][1]; const u32x2 y = gy[(ai * 4 + m) * 2 + bj];
#define QS(wv, sh) __builtin_amdgcn_exp2f((float)(((wv) >> (sh)) & 0xffu) * -0.03125f)
                        u32x4 w; w.x = cvt_pk_bf16(v0[0] * QS(y.x, 0), v0[1] * QS(y.x, 8)); w.y = cvt_pk_bf16(v0[2] * QS(y.x, 16), v0[3] * QS(y.x, 24));
                        w.z = cvt_pk_bf16(v1[0] * QS(y.y, 0), v1[1] * QS(y.y, 8)); w.w = cvt_pk_bf16(v1[2] * QS(y.y, 16), v1[3] * QS(y.y, 24));
#undef QS
                        *(u32x4*)(rowp + bj * 32) = w; } }
        }
    }
};
}

__device__ __forceinline__ unsigned pk4_fp8(float a, float b, float c, float d) { int w = __builtin_amdgcn_cvt_pk_fp8_f32(a, b, 0, false); w = __builtin_amdgcn_cvt_pk_fp8_f32(c, d, w, true); return (unsigned)w; }
__device__ __forceinline__ void rmsnorm_rows(const float* __restrict__ x, const float* __restrict__ g, bf16_t* __restrict__ out, int ldo, unsigned char* __restrict__ out8, int nrows, int gw, int nw, int lane) {
    for (int row = gw; row < nrows; row += nw) {
        const float4* xr = (const float4*)(x + (size_t)row * DM);
        float4 v[8]; float ss = 0.f;
#pragma unroll
        for (int i = 0; i < 4; ++i) { const int c = lane + 64 * i; v[2 * i] = xr[2 * c]; v[2 * i + 1] = xr[2 * c + 1]; }
#pragma unroll
        for (int i = 0; i < 8; ++i) ss += v[i].x * v[i].x + v[i].y * v[i].y + v[i].z * v[i].z + v[i].w * v[i].w;
#pragma unroll
        for (int o = 32; o >= 1; o >>= 1) ss += shx(ss, o, lane);
        const float rstd = rsqrtf(ss * (1.0f / DM) + EPSF);
#pragma unroll
        for (int i = 0; i < 4; ++i) { const int c = lane + 64 * i; const float4 ga = ((const float4*)g)[2 * c], gb = ((const float4*)g)[2 * c + 1]; const float4 a = v[2 * i], b = v[2 * i + 1];
            u32x4 w; w.x = cvt_pk_bf16(a.x * rstd * ga.x, a.y * rstd * ga.y); w.y = cvt_pk_bf16(a.z * rstd * ga.z, a.w * rstd * ga.w);
            w.z = cvt_pk_bf16(b.x * rstd * gb.x, b.y * rstd * gb.y); w.w = cvt_pk_bf16(b.z * rstd * gb.z, b.w * rstd * gb.w);
            *(u32x4*)(out + (size_t)row * ldo + c * 8) = w;
            if (out8) { u32x2 q; q.x = pk4_fp8(a.x * rstd * ga.x, a.y * rstd * ga.y, a.z * rstd * ga.z, a.w * rstd * ga.w); q.y = pk4_fp8(b.x * rstd * gb.x, b.y * rstd * gb.y, b.z * rstd * gb.z, b.w * rstd * gb.w);
                        *(u32x2*)(out8 + (size_t)row * DM + c * 8) = q; } }
    }
}
struct TJob { const float* src; bf16_t* dst; int C, ld, koff, r0, c0, dc, f8; };
__device__ __forceinline__ void tile_load(float4 (&v)[4], const TJob& J, int tid) {
#pragma unroll
    for (int p = 0; p < 4; ++p) { const int r = p * 16 + (tid >> 5), c4 = (tid & 31) * 4; v[p] = *(const float4*)(J.src + (size_t)(J.r0 + r) * J.C + J.c0 + c4); }
}
__device__ __forceinline__ void tile_store(LAS float* t  , const float4 (&v)[4], const TJob& J, int tid) {
#pragma unroll
    for (int p = 0; p < 4; ++p) { const int r = p * 16 + (tid >> 5), c4 = (tid & 31) * 4; LAS float* q = t + r * 129 + c4; q[0] = v[p].x; q[1] = v[p].y; q[2] = v[p].z; q[3] = v[p].w; }
    __syncthreads();
#pragma unroll
    for (int h = 0; h < 2; ++h) { const int c = h * 64 + (tid >> 3), rc = (tid & 7) * 8; float f[8];
#pragma unroll
        for (int j = 0; j < 8; ++j) f[j] = t[(rc + j) * 129 + c];
        if (J.f8) { u32x2 q; q.x = pk4_fp8(f[0] * 64.f, f[1] * 64.f, f[2] * 64.f, f[3] * 64.f); q.y = pk4_fp8(f[4] * 64.f, f[5] * 64.f, f[6] * 64.f, f[7] * 64.f);
                    *(u32x2*)((unsigned char*)J.dst + (size_t)(J.dc + c) * J.ld + J.r0 + rc) = q; }
        else { u32x4 w; w.x = cvt_pk_bf16(f[0], f[1]); w.y = cvt_pk_bf16(f[2], f[3]); w.z = cvt_pk_bf16(f[4], f[5]); w.w = cvt_pk_bf16(f[6], f[7]);
               *(u32x4*)(J.dst + (size_t)(J.dc + c) * J.ld + J.koff + J.r0 + rc) = w; } }
    __syncthreads();
}

struct PrepPtrs { const float* win; const float* wkv; const float* wba; const float* wbc; const float* wbm; const float* wout; bf16_t* WIN; bf16_t* WKV; bf16_t* WBR; bf16_t* WOUT; unsigned char* WG8; };
constexpr int PT0 = 512, PT1 = PT0 + 32 * 136, PT2 = PT1 + 128, PT3 = PT2 + 256, PT4 = PT3 + 256, PT5 = PT4 + 512;
__device__ __forceinline__ TJob prep_job(int t, const PrepPtrs P) {
    TJob J; int ti;
    if (t < PT0) { J.src = P.wkv; J.C = DM; J.dst = P.WKV; J.ld = DM; J.koff = 0; ti = t; }
    else if (t < PT1) { J.src = P.win; J.C = PC; J.dst = P.WIN; J.ld = LDP; J.koff = 0; ti = t - PT0; }
    else if (t < PT2) { J.src = P.wba; J.C = DM; J.dst = P.WBR; J.ld = ACTW; J.koff = 0; ti = t - PT1; }
    else if (t < PT3) { J.src = P.wbc; J.C = DM; J.dst = P.WBR; J.ld = ACTW; J.koff = 512; ti = t - PT2; }
    else if (t < PT4) { J.src = P.wbm; J.C = DM; J.dst = P.WBR; J.ld = ACTW; J.koff = 1536; ti = t - PT3; }
    else { J.src = P.wout; J.C = DM; J.dst = P.WOUT; J.ld = DM; J.koff = 0; ti = t - PT4; }
    const int nct = J.C / 128; J.r0 = (ti / nct) * 64; J.c0 = (ti % nct) * 128; J.dc = J.c0; J.f8 = 0;
    if (t >= PT0 && t < PT1) {
        const int c = J.c0;
        if (c < 5120) { J.f8 = 1; J.dc = c; }
        else if (c < 9216) { J.dc = c - 5120; }
        else if (c < 11264) { J.f8 = 1; J.dc = 5120 + (c - 9216); }
        else if (c < 13312) { J.f8 = 1; J.dc = 7168 + (c - 11264); }
        else if (c < 15360) { J.dc = 4096 + (c - 13312); }
        else { J.f8 = 1; J.dc = 9216 + (c - 15360); }
        if (J.f8) { J.dst = (bf16_t*)P.WG8; J.ld = DM; }
    }
    return J;
}

template <int HD> struct AttnGeo { static constexpr int KSTR = HD * 2 + 16, VSTR = HD * 2 + 32, PPR = HD / 8, NKS = HD / 32, NDT = HD / 16, NPC = 256 * (HD / 8) / NTHR; };

template <int HD> __device__ __forceinline__ void issue_rows(u32x4 (&r)[AttnGeo<HD>::NPC], const bf16_t* __restrict__ p, int stride, int jbase, int tid) {
    typedef AttnGeo<HD> G; constexpr int RS = NTHR / G::PPR;
    const int r0 = tid / G::PPR, pc = tid % G::PPR;
#pragma unroll
    for (int i = 0; i < G::NPC; ++i) { int j = jbase + r0 + i * RS; j = j < 0 ? 0 : j;
        r[i] = *(const u32x4*)(p + ((unsigned)j * (unsigned)stride + (unsigned)(pc * 8))); }
}
template <int HD> __device__ __forceinline__ void issue_q(u32x4 (&q)[AttnGeo<HD>::NKS], const bf16_t* __restrict__ qrow, int g4) {
#pragma unroll
    for (int ks = 0; ks < AttnGeo<HD>::NKS; ++ks) q[ks] = *(const u32x4*)(qrow + ks * 32 + g4 * 8);
}
template <int HD> __device__ __forceinline__ void write_k(LAS unsigned char* kl, const u32x4 (&r)[AttnGeo<HD>::NPC], int jbase, const float* __restrict__ wk, int tid) {
    typedef AttnGeo<HD> G; constexpr int RS = NTHR / G::PPR;
    const int r0 = tid / G::PPR, pc = tid % G::PPR;
    LAS unsigned char* base = kl + r0 * G::KSTR + pc * 16;
    const float4 wa = *(const float4*)(wk + pc * 8), wb = *(const float4*)(wk + pc * 8 + 4);
#pragma unroll
    for (int i = 0; i < G::NPC; ++i) { const u32x4 w = r[i];
        float f[8] = {bflo(w.x), bfhi(w.x), bflo(w.y), bfhi(w.y), bflo(w.z), bfhi(w.z), bflo(w.w), bfhi(w.w)};
        float ss = 0.f;
#pragma unroll
        for (int e = 0; e < 8; ++e) ss += f[e] * f[e];
#pragma unroll
        for (int o = 1; o < G::PPR; o <<= 1) ss += shx(ss, o, tid);
        const float rstd = (jbase + r0 + i * RS >= 0) ? rsqrtf(ss * (1.0f / HD) + EPSF) : 0.f;
        u32x4 o4; o4.x = cvt_pk_bf16(f[0] * rstd * wa.x, f[1] * rstd * wa.y); o4.y = cvt_pk_bf16(f[2] * rstd * wa.z, f[3] * rstd * wa.w);
        o4.z = cvt_pk_bf16(f[4] * rstd * wb.x, f[5] * rstd * wb.y); o4.w = cvt_pk_bf16(f[6] * rstd * wb.z, f[7] * rstd * wb.w);
        *(LAS u32x4*)(base + i * (RS * G::KSTR)) = o4;
        if (G::NPC > 8) __builtin_amdgcn_sched_barrier(0); }
}
template <int HD> __device__ __forceinline__ void write_v(LAS unsigned char* vl, const u32x4 (&r)[AttnGeo<HD>::NPC], int jbase, int tid) {
    typedef AttnGeo<HD> G; constexpr int RS = NTHR / G::PPR;
    const int r0 = tid / G::PPR, pc = tid % G::PPR;
    LAS unsigned char* base = vl + r0 * G::VSTR + pc * 16;
#pragma unroll
    for (int i = 0; i < G::NPC; ++i) { const bool ok = jbase + r0 + i * RS >= 0; u32x4 w = r[i];
        w.x = ok ? w.x : 0u; w.y = ok ? w.y : 0u; w.z = ok ? w.z : 0u; w.w = ok ? w.w : 0u;
        *(LAS u32x4*)(base + i * (RS * G::VSTR)) = w; }
}
template <int HD, bool ISK> __device__ __forceinline__ void stage_rows(LAS unsigned char* dst, const bf16_t* __restrict__ p, int stride, const float* __restrict__ wk, int tid) {
    typedef AttnGeo<HD> G; constexpr int RS = NTHR / G::PPR, STR = ISK ? G::KSTR : G::VSTR, NB = ISK ? 8 : 16;
    const int r0 = tid / G::PPR, pc = tid % G::PPR;
    LAS unsigned char* base = dst + r0 * STR + pc * 16;
    float4 wa = make_float4(1.f, 1.f, 1.f, 1.f), wb = wa;
    if (ISK) { wa = *(const float4*)(wk + pc * 8); wb = *(const float4*)(wk + pc * 8 + 4); }
#pragma unroll 1
    for (int i0 = 0; i0 < G::NPC; i0 += NB) {
        u32x4 r[NB];
        unsigned boff = (unsigned)(r0 + i0 * RS) * (unsigned)stride + (unsigned)(pc * 8); asm volatile("" : "+v"(boff));
#pragma unroll
        for (int i = 0; i < NB; ++i) r[i] = *(const u32x4*)(p + (boff + (unsigned)(i * RS) * (unsigned)stride));
#pragma unroll
        for (int i = 0; i < NB; ++i) { u32x4 w = r[i];
            if (ISK) {
                float f[8] = {bflo(w.x), bfhi(w.x), bflo(w.y), bfhi(w.y), bflo(w.z), bfhi(w.z), bflo(w.w), bfhi(w.w)};
                float ss = 0.f;
#pragma unroll
                for (int e = 0; e < 8; ++e) ss += f[e] * f[e];
#pragma unroll
                for (int o = 1; o < G::PPR; o <<= 1) ss += shx(ss, o, tid);
                const float rstd = rsqrtf(ss * (1.0f / HD) + EPSF);
                w.x = cvt_pk_bf16(f[0] * rstd * wa.x, f[1] * rstd * wa.y); w.y = cvt_pk_bf16(f[2] * rstd * wa.z, f[3] * rstd * wa.w);
                w.z = cvt_pk_bf16(f[4] * rstd * wb.x, f[5] * rstd * wb.y); w.w = cvt_pk_bf16(f[6] * rstd * wb.z, f[7] * rstd * wb.w);
            }
            *(LAS u32x4*)(base + (i0 + i) * (RS * STR)) = w;
            if (ISK) __builtin_amdgcn_sched_barrier(0); }
    }
}
template <int HD> __device__ __forceinline__ void norm_q(bf16x8 (&qf)[AttnGeo<HD>::NKS], const u32x4 (&qw)[AttnGeo<HD>::NKS], const float* __restrict__ wq, float scale, int g4, int lane16) {
    typedef AttnGeo<HD> G;
    float ss = 0.f;
#pragma unroll
    for (int ks = 0; ks < G::NKS; ++ks) { const u32x4 x = qw[ks]; const float a0 = bflo(x.x), a1 = bfhi(x.x), a2 = bflo(x.y), a3 = bfhi(x.y), a4 = bflo(x.z), a5 = bfhi(x.z), a6 = bflo(x.w), a7 = bfhi(x.w);
        ss += a0 * a0 + a1 * a1 + a2 * a2 + a3 * a3 + a4 * a4 + a5 * a5 + a6 * a6 + a7 * a7; }
    ss += shx(ss, 16, lane16); ss += shx(ss, 32, lane16);
    const float sc = rsqrtf(ss * (1.0f / HD) + EPSF) * scale;
#pragma unroll
    for (int ks = 0; ks < G::NKS; ++ks) { const u32x4 x = qw[ks]; const float4 wa = *(const float4*)(wq + ks * 32 + g4 * 8), wb = *(const float4*)(wq + ks * 32 + g4 * 8 + 4);
        u32x4 o; o.x = cvt_pk_bf16(bflo(x.x) * sc * wa.x, bfhi(x.x) * sc * wa.y); o.y = cvt_pk_bf16(bflo(x.y) * sc * wa.z, bfhi(x.y) * sc * wa.w);
        o.z = cvt_pk_bf16(bflo(x.z) * sc * wb.x, bfhi(x.z) * sc * wb.y); o.w = cvt_pk_bf16(bflo(x.w) * sc * wb.z, bfhi(x.w) * sc * wb.w);
        qf[ks] = __builtin_bit_cast(bf16x8, o); }
}

__device__ __forceinline__ int band_item(int bx, int k, int G_) { return (G_ == 256) ? ((k >> 1) * 512 + 64 * (bx & 7) + (bx >> 3) + 32 * (k & 1)) : (bx + k * G_); }
__device__ __forceinline__ int mem_item(int bx, int k, int G_) { return (G_ == 256) ? (64 * (bx & 7) + (bx >> 3) + 32 * k) : (bx + k * G_); }
struct BandItem { const bf16_t* qp; int rstride; int qb, g, h; size_t row0; int d; };
__device__ __forceinline__ BandItem band_decode(int it, const bf16_t* PROJ) {
    BandItem I; const int g = it >> 9, idx = it & 511, dsh = 2 * g, d = 1 << dsh, nqb = 16 >> dsh;
    I.qb = idx % nqb; int rest = idx / nqb; const int r = rest % d; rest /= d; I.h = rest & 3; const int bl = rest >> 2;
    I.g = g; I.d = d; I.row0 = (size_t)bl * SEQ + r; I.qp = PROJ + I.row0 * PS + g * 512 + I.h * 128; I.rstride = d * PS; return I;
}
__device__ __forceinline__ void attn_banded_run(LAS unsigned char* lds, const bf16_t* __restrict__ PROJ, const float* __restrict__ aqn, const float* __restrict__ akn, bf16_t* __restrict__ OG, float* __restrict__ LSE,
                                                int bx, int G_, const int tid) {
    constexpr int HD = 128; typedef AttnGeo<HD> G;
    const int w = __builtin_amdgcn_readfirstlane(tid >> 6), lane = tid & 63, lq = lane & 15, g4 = lane >> 4;
    LAS unsigned char* kl = lds; LAS unsigned char* vl = lds + 256 * G::KSTR;
    const int n = (1536 - bx + G_ - 1) / G_;
    if (n <= 0) return;
    u32x4 rk[G::NPC], rv[G::NPC], rq[G::NKS];
    { const BandItem I = band_decode(band_item(bx, 0, G_), PROJ); const int jb = I.qb * 128 - 128;
      issue_rows<HD>(rk, I.qp + C_K, I.rstride, jb, tid); issue_rows<HD>(rv, I.qp + C_V, I.rstride, jb, tid); issue_q<HD>(rq, I.qp + (unsigned)(I.qb * 128 + 16 * w + lq) * (unsigned)I.rstride, g4); }
    { unsigned zl = 0u; asm volatile("" : "+v"(zl));
      for (int p = tid; p < 16 * G::PPR; p += NTHR) *(LAS u32x4*)(vl + (256 + p / G::PPR) * G::VSTR + (p % G::PPR) * 16) = (u32x4){zl, zl, zl, zl}; }
#pragma unroll 1
    for (int k = 0; k < n; ++k) {
        const BandItem I = band_decode(band_item(bx, k, G_), PROJ);
        const int jbase = I.qb * 128 - 128, qi = I.qb * 128 + 16 * w + lq;
        write_k<HD>(kl, rk, jbase, akn + I.g * 128, tid);
        write_v<HD>(vl, rv, jbase, tid);
        bf16x8 qf[G::NKS];
        norm_q<HD>(qf, rq, aqn + I.g * 128, 0.08838834764831845f * 1.4426950408889634f, g4, lane);
        __syncthreads();
        { const int kn = (k + 1 < n) ? k + 1 : k; const BandItem J = band_decode(band_item(bx, kn, G_), PROJ); const int jb = J.qb * 128 - 128;
          issue_rows<HD>(rk, J.qp + C_K, J.rstride, jb, tid); issue_rows<HD>(rv, J.qp + C_V, J.rstride, jb, tid); issue_q<HD>(rq, J.qp + (unsigned)(J.qb * 128 + 16 * w + lq) * (unsigned)J.rstride, g4); }
        f32x4 S[10];
        float NEG = -__builtin_inff(); asm volatile("" : "+v"(NEG));
#pragma unroll
        for (int t = 0; t < 9; ++t) {
            const int kt = w + t;
            if (jbase + kt * 16 >= 0) {
                f32x4 sv = (f32x4){0.f, 0.f, 0.f, 0.f};
#pragma unroll
                for (int ks = 0; ks < G::NKS; ++ks) { const bf16x8 kf = *(const LAS bf16x8*)(kl + (kt * 16 + lq) * G::KSTR + ks * 64 + g4 * 16); sv = __builtin_amdgcn_mfma_f32_16x16x32_bf16(kf, qf[ks], sv, 0, 0, 0); }
                if (t == 0) {
#pragma unroll
                    for (int r = 0; r < 4; ++r) sv[r] = (4 * g4 + r >= lq) ? sv[r] : NEG; }
                if (t == 8) {
#pragma unroll
                    for (int r = 0; r < 4; ++r) sv[r] = (4 * g4 + r <= lq) ? sv[r] : NEG; }
                S[t] = sv;
            } else S[t] = (f32x4){NEG, NEG, NEG, NEG};
        }
        S[9] = (f32x4){NEG, NEG, NEG, NEG};
        float mx = NEG;
#pragma unroll
        for (int t = 0; t < 9; ++t)
#pragma unroll
            for (int r = 0; r < 4; ++r) mx = fmaxf(mx, S[t][r]);
        mx = fmaxf(mx, shx(mx, 16, lane)); mx = fmaxf(mx, shx(mx, 32, lane));
        float l = 0.f;
#pragma unroll
        for (int t = 0; t < 10; ++t)
#pragma unroll
            for (int r = 0; r < 4; ++r) { const float pv = __builtin_amdgcn_exp2f(S[t][r] - mx); l += pv; S[t][r] = pv; }
        l += shx(l, 16, lane); l += shx(l, 32, lane);
        f32x4 O[G::NDT];
#pragma unroll
        for (int dt = 0; dt < G::NDT; ++dt) O[dt] = (f32x4){0.f, 0.f, 0.f, 0.f};
#pragma unroll
        for (int u = 0; u < 5; ++u) {
            u32x4 pw; pw.x = cvt_pk_bf16(S[2 * u][0], S[2 * u][1]); pw.y = cvt_pk_bf16(S[2 * u][2], S[2 * u][3]); pw.z = cvt_pk_bf16(S[2 * u + 1][0], S[2 * u + 1][1]); pw.w = cvt_pk_bf16(S[2 * u + 1][2], S[2 * u + 1][3]);
            const bf16x8 pb = __builtin_bit_cast(bf16x8, pw);
            const int ka = (w + 2 * u) * 16 + 4 * g4 + (lq >> 2), kb = ka + 16;
            LAS unsigned char* va = vl + ka * G::VSTR + (lane & 3) * 8; LAS unsigned char* vb = vl + kb * G::VSTR + (lane & 3) * 8;
#pragma unroll
            for (int dt = 0; dt < G::NDT; ++dt) {
                const s16x4 x = __builtin_amdgcn_ds_read_tr16_b64_v4i16((LAS s16x4*)(va + dt * 32));
                const s16x4 y = __builtin_amdgcn_ds_read_tr16_b64_v4i16((LAS s16x4*)(vb + dt * 32));
                const bf16x8 av = (bf16x8){x[0], x[1], x[2], x[3], y[0], y[1], y[2], y[3]};
                O[dt] = __builtin_amdgcn_mfma_f32_16x16x32_bf16(av, pb, O[dt], 0, 0, 0);
            }
        }
        const float inv = 1.0f / l;
        const size_t trow = I.row0 + (size_t)qi * I.d;
        bf16_t* orow = OG + trow * 1536 + I.g * 512 + I.h * 128;
        {
            u32x4 ch[G::NDT / 2];
#pragma unroll
            for (int dp = 0; dp < G::NDT / 2; ++dp) {
                const unsigned ax = cvt_pk_bf16(O[2 * dp][0] * inv, O[2 * dp][1] * inv), ay = cvt_pk_bf16(O[2 * dp][2] * inv, O[2 * dp][3] * inv);
                const unsigned bx_ = cvt_pk_bf16(O[2 * dp + 1][0] * inv, O[2 * dp + 1][1] * inv), by_ = cvt_pk_bf16(O[2 * dp + 1][2] * inv, O[2 * dp + 1][3] * inv);
                const u32x2 r0 = __builtin_amdgcn_permlane16_swap(ax, bx_, false, false), r1 = __builtin_amdgcn_permlane16_swap(ay, by_, false, false);
                ch[dp] = (u32x4){r0[0], r1[0], r0[1], r1[1]}; }
            const bool lo = lq < 8; const int dbase = (g4 & 1) ? 16 + 4 * (g4 - 1) : 4 * g4;
            bf16_t* orow8 = OG + (I.row0 + (size_t)(I.qb * 128 + 16 * w + (lq & 7)) * I.d) * 1536 + I.g * 512 + I.h * 128 + dbase + (lo ? 0 : 32);
#pragma unroll
            for (int pp = 0; pp < G::NDT / 4; ++pp) {
                const u32x4 w0 = ch[2 * pp], w1 = ch[2 * pp + 1], rcv = xchg8_dpp(lo ? w1 : w0);
                *(u32x4*)(orow8 + pp * 64) = lo ? w0 : rcv;
                *(u32x4*)(orow8 + (size_t)8 * I.d * 1536 + pp * 64) = lo ? rcv : w1; }
        }
        if (g4 == 0) LSE[trow * 12 + I.g * 4 + I.h] = (mx + __builtin_amdgcn_logf(l)) * 0.6931471805599453f;
        __syncthreads();
    }
}

__device__ __forceinline__ void attn_mem_run(LAS unsigned char* lds, const bf16_t* __restrict__ PROJ, const bf16_t* __restrict__ MKV, const float* __restrict__ wq, const float* __restrict__ wk, bf16_t* __restrict__ ACT,
                                             int half, int bx, int G_, const int tid) {
    constexpr int HD = 256; typedef AttnGeo<HD> G;
    const int w = __builtin_amdgcn_readfirstlane(tid >> 6), lane = tid & 63, lq = lane & 15, g4 = lane >> 4;
    const int n = (512 - bx + G_ - 1) / G_;
    if (n <= 0) return;
#pragma unroll 1
    for (int k = 0; k < n; ++k) {
        const int idx = mem_item(bx, k, G_), qb = idx & 15, h = (idx >> 4) & 3, bl = idx >> 6, b = half * 8 + bl;
        const size_t trow = (size_t)bl * SEQ + qb * 128 + 16 * w + lq;
        u32x4 rq[G::NKS];
        issue_q<HD>(rq, PROJ + trow * PS + C_MQ + h * 256, g4);
        stage_rows<HD, true>(lds, MKV + (size_t)b * 256 * DM + h * 256, DM, wk, tid);
        bf16x8 qf[G::NKS];
        norm_q<HD>(qf, rq, wq, 0.0625f * 1.4426950408889634f, g4, lane);
        __syncthreads();
        u32x2 P[16]; float l;
        {
            f32x4 S[16];
#pragma unroll
            for (int t = 0; t < 16; ++t) {
                f32x4 sv = (f32x4){0.f, 0.f, 0.f, 0.f};
#pragma unroll
                for (int ks = 0; ks < G::NKS; ++ks) { const bf16x8 kf = *(const LAS bf16x8*)(lds + (t * 16 + lq) * G::KSTR + ks * 64 + g4 * 16); sv = __builtin_amdgcn_mfma_f32_16x16x32_bf16(kf, qf[ks], sv, 0, 0, 0); }
                S[t] = sv;
            }
            float mx = -__builtin_inff(); asm volatile("" : "+v"(mx));
#pragma unroll
            for (int t = 0; t < 16; ++t)
#pragma unroll
                for (int r = 0; r < 4; ++r) mx = fmaxf(mx, S[t][r]);
            mx = fmaxf(mx, shx(mx, 16, lane)); mx = fmaxf(mx, shx(mx, 32, lane));
            l = 0.f;
#pragma unroll
            for (int t = 0; t < 16; ++t) { const float p0 = __builtin_amdgcn_exp2f(S[t][0] - mx), p1 = __builtin_amdgcn_exp2f(S[t][1] - mx), p2 = __builtin_amdgcn_exp2f(S[t][2] - mx), p3 = __builtin_amdgcn_exp2f(S[t][3] - mx);
                l += (p0 + p1) + (p2 + p3); P[t].x = cvt_pk_bf16(p0, p1); P[t].y = cvt_pk_bf16(p2, p3); }
            l += shx(l, 16, lane); l += shx(l, 32, lane);
        }
        __syncthreads();
        stage_rows<HD, false>(lds, MKV + (size_t)b * 256 * DM + 1024 + h * 256, DM, wk, tid);
        __syncthreads();
        f32x4 O[G::NDT];
#pragma unroll
        for (int dt = 0; dt < G::NDT; ++dt) O[dt] = (f32x4){0.f, 0.f, 0.f, 0.f};
#pragma unroll
        for (int u = 0; u < 8; ++u) {
            u32x4 pw; pw.x = P[2 * u].x; pw.y = P[2 * u].y; pw.z = P[2 * u + 1].x; pw.w = P[2 * u + 1].y;
            const bf16x8 pb = __builtin_bit_cast(bf16x8, pw);
            const int ka = (2 * u) * 16 + 4 * g4 + (lq >> 2), kb = ka + 16;
            LAS unsigned char* va = lds + ka * G::VSTR + (lane & 3) * 8; LAS unsigned char* vb = lds + kb * G::VSTR + (lane & 3) * 8;
#pragma unroll
            for (int dt = 0; dt < G::NDT; ++dt) {
                const s16x4 x = __builtin_amdgcn_ds_read_tr16_b64_v4i16((LAS s16x4*)(va + dt * 32));
                const s16x4 y = __builtin_amdgcn_ds_read_tr16_b64_v4i16((LAS s16x4*)(vb + dt * 32));
                const bf16x8 av = (bf16x8){x[0], x[1], x[2], x[3], y[0], y[1], y[2], y[3]};
                O[dt] = __builtin_amdgcn_mfma_f32_16x16x32_bf16(av, pb, O[dt], 0, 0, 0);
            }
        }
        const float inv = 1.0f / l;
        const bf16_t* zrow = PROJ + trow * PS + C_ZM + h * 256; bf16_t* arow = ACT + trow * ACTW + 1536 + h * 256;
#pragma unroll
        for (int dp = 0; dp < G::NDT / 2; ++dp) {
            float va[4], vb[4];
#pragma unroll
            for (int j = 0; j < 4; ++j) { const u32x2 r = __builtin_amdgcn_permlane16_swap(__float_as_uint(O[2 * dp][j]), __float_as_uint(O[2 * dp + 1][j]), false, false); va[j] = __uint_as_float(r[0]); vb[j] = __uint_as_float(r[1]); }
            const int dofs = (g4 & 1) ? (2 * dp + 1) * 16 + 4 * (g4 - 1) : (2 * dp) * 16 + 4 * g4;
            const u32x4 z = *(const u32x4*)(zrow + dofs);
            u32x4 o; o.x = cvt_pk_bf16(va[0] * inv * siluf_(bflo(z.x)), va[1] * inv * siluf_(bfhi(z.x))); o.y = cvt_pk_bf16(va[2] * inv * siluf_(bflo(z.y)), va[3] * inv * siluf_(bfhi(z.y)));
            o.z = cvt_pk_bf16(vb[0] * inv * siluf_(bflo(z.z)), vb[1] * inv * siluf_(bfhi(z.z))); o.w = cvt_pk_bf16(vb[2] * inv * siluf_(bflo(z.w)), vb[3] * inv * siluf_(bfhi(z.w)));
            *(u32x4*)(arow + dofs) = o; }
        __syncthreads();
    }
}

#define XB_TMO      128
#define XB_XCNT(j)  (256  + 64 * (j))
#define XB_XSUB(j)  (1280 + 64 * (j))
#define XB_XGEN(j)  (2304 + 64 * (j))
#define XB_TOP      3328
#define XB_TOPGEN   3392
#define XCD_BAR_WORDS 3456
#define XB_SPIN_CAP (1u << 22)
__device__ __forceinline__ unsigned xb_ld(unsigned* p)              { return __hip_atomic_load(p, __ATOMIC_RELAXED, __HIP_MEMORY_SCOPE_AGENT); }
__device__ __forceinline__ unsigned xb_add(unsigned* p, unsigned v) { return __hip_atomic_fetch_add(p, v, __ATOMIC_RELAXED, __HIP_MEMORY_SCOPE_AGENT); }
__device__ __forceinline__ unsigned xb_xcc_id() { return (unsigned)__builtin_amdgcn_s_getreg((3 << 11) | 20) & 0xFu; }
#define XB_SPIN(cond, bar) do { unsigned _sp = 0; while (cond) { __builtin_amdgcn_s_sleep(1); \
    if ((++_sp & 255u) == 0u) { if (xb_ld(&(bar)[XB_TMO])) break; if (_sp > XB_SPIN_CAP) { atomicAdd(&(bar)[XB_TMO], 1u); break; } } } } while (0)
__device__ __forceinline__ void xcd_barrier_complete(unsigned* bar, unsigned x, unsigned& nloc, unsigned& nx) {
    const unsigned G = gridDim.x;
    unsigned sum, cnt, mine, sp = 0u;
    for (;;) {
        sum = 0u; cnt = 0u; mine = 0u;
#pragma unroll
        for (unsigned j = 0; j < 16; ++j) { const unsigned c = xb_ld(&bar[XB_XCNT(j)]); sum += c; cnt += (c > 0u) ? 1u : 0u; mine = (j == x) ? c : mine; }
        if (sum == G) break;
        __builtin_amdgcn_s_sleep(1);
        if ((++sp & 255u) == 0u) { if (xb_ld(&bar[XB_TMO])) break; if (sp > XB_SPIN_CAP) { atomicAdd(&bar[XB_TMO], 1u); break; } }
    }
    nloc = mine > 0u ? mine : 1u; nx = cnt > 0u ? cnt : 1u;
}
__device__ __forceinline__ void xcd_barrier(unsigned* bar, volatile LAS unsigned* st, bool leader_thread) {
    asm volatile("s_waitcnt vmcnt(0)" ::: "memory");
    __syncthreads();
    if (leader_thread) {
        const unsigned x = xb_xcc_id();
        __builtin_amdgcn_s_waitcnt(0);
        unsigned nloc = st[0], nx = st[1];
        if (nloc == 0u) { xcd_barrier_complete(bar, x, nloc, nx); st[0] = nloc; st[1] = nx; }
        const unsigned old = xb_add(&bar[XB_XSUB(x)], 1u);
        const unsigned gen = old / nloc;
        if (old + 1u == (gen + 1u) * nloc) {
            __builtin_amdgcn_fence(__ATOMIC_RELEASE, "agent");
            asm volatile("s_waitcnt vmcnt(0)" ::: "memory");
            const unsigned og = xb_add(&bar[XB_TOP], 1u);
            const unsigned tg = og / nx;
            if (og + 1u == (tg + 1u) * nx) xb_add(&bar[XB_TOPGEN], 1u);
            else XB_SPIN(xb_ld(&bar[XB_TOPGEN]) == tg, bar);
            __builtin_amdgcn_fence(__ATOMIC_ACQUIRE, "agent");
            xb_add(&bar[XB_XGEN(x)], 1u);
            asm volatile("s_waitcnt vmcnt(0)" ::: "memory");
        } else {
            XB_SPIN(xb_ld(&bar[XB_XGEN(x)]) == gen, bar);
            __builtin_amdgcn_fence(__ATOMIC_ACQUIRE, "agent");
            asm volatile("s_waitcnt vmcnt(0)" ::: "memory");
        }
    }
    __syncthreads();
}

struct Args { const float* in[15]; float* out; unsigned char* ws; int lo, hi; };
enum { I_X = 0, I_MEM, I_NG, I_MNG, I_WIN, I_AQN, I_AKN, I_CW, I_WKV, I_MQN, I_MKN, I_WBA, I_WBC, I_WBM, I_WOUT };
constexpr int NPHASE = 11;

__global__ void __launch_bounds__(NTHR, 2) mega(Args a) {
    extern __shared__ __attribute__((aligned(16))) unsigned char lds_raw[];
    LAS unsigned char* lds = (LAS unsigned char*)lds_raw;
    const int G = gridDim.x, bx = blockIdx.x, wave_s = __builtin_amdgcn_readfirstlane((int)threadIdx.x >> 6);
    typedef const __attribute__((address_space(4))) Args* KArgs;
    const int ph_lo = a.lo, ph_hi = a.hi;
    if (a.lo < 0) cg::this_grid().sync();
    volatile LAS unsigned* xst = (volatile LAS unsigned*)(lds + LDS_BYTES - 16);
    if (ph_hi - ph_lo > 1) {
        if (threadIdx.x == 0) { xst[0] = 0u; xst[1] = 0u; (void)xb_add(&((unsigned*)(a.ws + WS_BAR))[XB_XCNT(xb_xcc_id())], 1u); }
        __syncthreads();
    }
    for (int ph = ph_lo; ph < ph_hi; ++ph) {
        KArgs A = (KArgs)__builtin_amdgcn_kernarg_segment_ptr(); asm volatile("" : "+s"(A));
        unsigned char* ws = A->ws;
        bf16_t* WIN = (bf16_t*)(ws + WS_WIN); bf16_t* WKV = (bf16_t*)(ws + WS_WKV); bf16_t* WBR = (bf16_t*)(ws + WS_WBR); bf16_t* WOUT = (bf16_t*)(ws + WS_WOUT);
        bf16_t* MH = (bf16_t*)(ws + WS_MH); bf16_t* MKV = (bf16_t*)(ws + WS_MKV); bf16_t* PROJ = (bf16_t*)(ws + WS_PROJ); bf16_t* OG = (bf16_t*)(ws + WS_OG);
        float* LSE = (float*)(ws + WS_LSE); bf16_t* ACT = (bf16_t*)(ws + WS_ACT); u32x2* GF = (u32x2*)(ws + WS_GF); bf16_t* MB = (bf16_t*)(ws + WS_MB);
        bf16_t* H = (bf16_t*)(ws + WS_H);
        unsigned char* H8 = (unsigned char*)A->out;
        unsigned char* WG8 = (unsigned char*)WIN + (size_t)6144 * LDP * 2;
#define MAKE_TID(name) unsigned name##_m = ~0u; asm volatile("" : "+s"(name##_m)); int name = wave_s * 64 + (int)__builtin_amdgcn_mbcnt_hi(name##_m, __builtin_amdgcn_mbcnt_lo(name##_m, 0u)); asm volatile("" : "+v"(name))
        if (ph == 1 || ph == 2 || ph == 5 || ph == 6 || ph == 9 || ph == 10) {
            const int nj = (ph == 9 || ph == 2 || ph == 5) ? 2 : 1, njr = ((REP_MASK >> ph) & 1) ? 2 * nj : nj;
#pragma unroll 1
            for (int jr = 0; jr < njr; ++jr) {
                const int j = jr >= nj ? jr - nj : jr;
                bf16_t* MB2 = (bf16_t*)(ws + WS_MB2);
                int what;
                int half;
                const int swp = (bx >> 3) & 1;
                u32x2* GF2 = (u32x2*)((unsigned char*)A->out + OUT_H_OFF);
                if (ph == 1) { what = 0; half = 0; }
                else if (ph == 2) { what = (j == 0) ? 1 : 4; half = 0; }
                else if (ph == 5) { what = ((j == 0) != (swp != 0)) ? 2 : 4; half = (what == 2) ? 0 : 1; }
                else if (ph == 6) { what = 1; half = 1; }
                else if (ph == 9) { what = ((j == 0) != (swp != 0)) ? 3 : 2; half = (what == 3) ? 0 : 1; }
                else { what = 3; half = 1; }
                pg8::Gemm g; pg8::Epi E;
                if (what == 2) {
                    g = pg8::Gemm{ACT, WBR, HT, DM, ACTW, ACTW, ACTW, 0}; E = pg8::Epi{5, half ? MB2 : MB, half ? GF2 : GF, nullptr, DM, 1 << 20, 1.0f, 1 << 20, 0, 0, 1 << 20, 0, 0};
                } else if (what == 0) {
                    g = pg8::Gemm{MH, WKV, 4096, DM, DM, DM, DM, 0}; E = pg8::Epi{0, MKV, nullptr, nullptr, DM, 1 << 20, 1.0f, 1 << 20, 0, 0, 1 << 20, 0, 0};
                } else if (what == 3) {
                    const size_t ro = half ? (size_t)HT * DM : 0;
                    g = pg8::Gemm{half ? MB2 : MB, WOUT, HT, DM, DM, DM, DM, 0}; E = pg8::Epi{4, A->out + ro, A->in[I_X] + ro, nullptr, DM, 1 << 20, 1.0f, 1 << 20, 0, 0, 1 << 20, 0, 0};
                } else if (what == 1) {
                    g = pg8::Gemm{H + (size_t)half * HT * LDP, WIN, HT, 6144, DM, LDP, LDP, 0};
                    E = pg8::Epi{0, PROJ, nullptr, half ? GF2 : GF, PS, 16, 1.0f, 1 << 20, C_CB, 0, 1 << 20, 8, 0};
                } else {
                    g = pg8::Gemm{(const bf16_t*)(H8 + (size_t)half * HT * DM), (const bf16_t*)WG8, HT, PS, DM / 2, DM / 2, DM / 2, 1};
                    E = pg8::Epi{0, PROJ, nullptr, half ? GF2 : GF, PS, 28, 1.0f / 64.0f, 20, 0, C_MQ, 36, 0, 16};
                }
                if (GEMM1_STAGGER_US > 0 && g.N == PS) {
                    const unsigned long long t0 = __builtin_amdgcn_s_memrealtime(), dl = (unsigned long long)(((bx >> 3) & 3) * GEMM1_STAGGER_US * 100);
                    while (__builtin_amdgcn_s_memrealtime() - t0 < dl) __builtin_amdgcn_s_sleep(8);
                }
                pg8::StaticOrder S; S.init(g.M, g.N, G, bx);
                unsigned ones2 = ~0u; asm volatile("" : "+s"(ones2));
                int tidj = wave_s * 64 + (int)__builtin_amdgcn_mbcnt_hi(ones2, __builtin_amdgcn_mbcnt_lo(ones2, 0u)); asm volatile("" : "+v"(tidj));
                if (g.f8) pg8::gemm_phase<true>(lds, g, S, E, tidj); else pg8::gemm_phase<false>(lds, g, S, E, tidj);
            }
        }
        if (ph == 0 || ph == 1) {
            MAKE_TID(tid);
            const int lane = tid & 63, wave = tid >> 6;
            if (ph == 0) rmsnorm_rows(A->in[I_MEM], A->in[I_MNG], MH, DM, nullptr, 4096, bx * 8 + wave, G * 8, lane);
            else rmsnorm_rows(A->in[I_X], A->in[I_NG], H, LDP, H8, NTOK, bx * 8 + wave, G * 8, lane);
            const PrepPtrs PP{A->in[I_WIN], A->in[I_WKV], A->in[I_WBA], A->in[I_WBC], A->in[I_WBM], A->in[I_WOUT], WIN, WKV, WBR, WOUT, WG8};
            constexpr int T0 = PT0, T5 = PT5;
            const int tb = (ph == 0) ? 0 : T0, te = (ph == 0) ? T0 : T5;
            if (tb + bx < te) {
                float4 v[4]; TJob J = prep_job(tb + bx, PP); tile_load(v, J, tid);
#pragma unroll 1
                for (int t = tb + bx; t < te; t += G) {
                    float4 vn[4]; const int tn = (t + G < te) ? t + G : t; const TJob Jn = prep_job(tn, PP); tile_load(vn, Jn, tid);
                    tile_store((LAS float*)lds, v, J, tid);
                    J = Jn;
#pragma unroll
                    for (int p = 0; p < 4; ++p) v[p] = vn[p];
                }
            }
        } else if (ph == 3 || ph == 7) {
            const int half = (ph == 3) ? 0 : 1;
            MAKE_TID(tid);
#pragma unroll 1
            for (int rep = 0; rep < REP_BAND; ++rep)
            attn_banded_run(lds, PROJ, A->in[I_AQN], A->in[I_AKN], OG, LSE, bx, G, tid);
#pragma unroll 1
            for (int rep = 0; rep < REP_MEM; ++rep)
            attn_mem_run(lds, PROJ, MKV, A->in[I_MQN], A->in[I_MKN], ACT, half, bx, G, tid);
        } else if (ph == 4 || ph == 8) {
            MAKE_TID(tid);
            const int gt = bx * NTHR + tid, nth = G * NTHR;
            for (int idx = gt; idx < HT * 64; idx += nth) {
                const int row = idx >> 6, c8 = (idx & 63) * 8, h = c8 >> 7;
                const float l0 = LSE[(size_t)row * 12 + h], l1 = LSE[(size_t)row * 12 + 4 + h], l2 = LSE[(size_t)row * 12 + 8 + h];
                const float m = fmaxf(l0, fmaxf(l1, l2)); float w0 = __expf(l0 - m), w1 = __expf(l1 - m), w2 = __expf(l2 - m); const float inv = 1.0f / (w0 + w1 + w2); w0 *= inv; w1 *= inv; w2 *= inv;
                const u32x4 o0 = *(const u32x4*)(OG + (size_t)row * 1536 + c8), o1 = *(const u32x4*)(OG + (size_t)row * 1536 + 512 + c8), o2 = *(const u32x4*)(OG + (size_t)row * 1536 + 1024 + c8);
                const u32x4 z = *(const u32x4*)(PROJ + (size_t)row * PS + C_ZA + c8);
                u32x4 o;
#define CMB(k) o.k = cvt_pk_bf16((w0 * bflo(o0.k) + w1 * bflo(o1.k) + w2 * bflo(o2.k)) * siluf_(bflo(z.k)), (w0 * bfhi(o0.k) + w1 * bfhi(o1.k) + w2 * bfhi(o2.k)) * siluf_(bfhi(z.k)))
                CMB(x); CMB(y); CMB(z); CMB(w);
#undef CMB
                *(u32x4*)(ACT + (size_t)row * ACTW + c8) = o;
            }
            const float* cw = A->in[I_CW];
            for (int idx = gt; idx < HT * 128; idx += nth) {
                const int row = idx >> 7, c8 = (idx & 127) * 8, t = row & (SEQ - 1);
                const bf16_t* pr = PROJ + (size_t)row * PS;
                unsigned zl = 0u; asm volatile("" : "+v"(zl)); const u32x4 z4 = (u32x4){zl, zl, zl, zl};
                const u32x4 c0 = *(const u32x4*)(pr + C_CC + c8), v0 = *(const u32x4*)(pr + C_CV + c8);
                const u32x4 c1 = t >= 1 ? *(const u32x4*)(pr - PS + C_CC + c8) : z4, v1 = t >= 1 ? *(const u32x4*)(pr - PS + C_CV + c8) : z4;
                const u32x4 c2 = t >= 2 ? *(const u32x4*)(pr - 2 * PS + C_CC + c8) : z4, v2 = t >= 2 ? *(const u32x4*)(pr - 2 * PS + C_CV + c8) : z4;
                const u32x4 bb = *(const u32x4*)(pr + C_CB + c8), zz = *(const u32x4*)(pr + C_ZC + c8);
                const float4 wa0 = *(const float4*)(cw + c8), wb0 = *(const float4*)(cw + c8 + 4), wa1 = *(const float4*)(cw + 1024 + c8), wb1 = *(const float4*)(cw + 1024 + c8 + 4), wa2 = *(const float4*)(cw + 2048 + c8), wb2 = *(const float4*)(cw + 2048 + c8 + 4);
                u32x4 o;
#define CV1(f, k, W0, W1, W2) ((W0 * (f(c0.k) * f(v0.k)) + W1 * (f(c1.k) * f(v1.k)) + W2 * (f(c2.k) * f(v2.k))) * f(bb.k) * siluf_(f(zz.k)))
                o.x = cvt_pk_bf16(CV1(bflo, x, wa0.x, wa1.x, wa2.x), CV1(bfhi, x, wa0.y, wa1.y, wa2.y));
                o.y = cvt_pk_bf16(CV1(bflo, y, wa0.z, wa1.z, wa2.z), CV1(bfhi, y, wa0.w, wa1.w, wa2.w));
                o.z = cvt_pk_bf16(CV1(bflo, z, wb0.x, wb1.x, wb2.x), CV1(bfhi, z, wb0.y, wb1.y, wb2.y));
                o.w = cvt_pk_bf16(CV1(bflo, w, wb0.z, wb1.z, wb2.z), CV1(bfhi, w, wb0.w, wb1.w, wb2.w));
#undef CV1
                *(u32x4*)(ACT + (size_t)row * ACTW + 512 + c8) = o;
            }
        }
        if (ph + 1 < ph_hi) {
            { MAKE_TID(tb_); xcd_barrier((unsigned*)(A->ws + WS_BAR), xst, tb_ == 0); }
        }
        if (ph == 0 && ph_hi - ph_lo > 1) { for (int e = 0; e < EXTRA_SYNCS; ++e) cg::this_grid().sync(); }
    }
}

extern "C" void kernel_launch(void* const* d_in, const int* in_sizes, int n_in, void* d_out, int out_size, void* d_ws, size_t ws_size, hipStream_t stream) {
    static int grid = 0;
    if (grid == 0) {
        if (n_in != 15 || ws_size < WS_END) { fprintf(stderr, "kernel_launch: unexpected inputs (n_in %d, ws %zu < %zu)\n", n_in, ws_size, (size_t)WS_END); grid = -1; return; }
        int dev = 0, cus = 0, per_cu = 0;
        hipGetDevice(&dev); hipDeviceGetAttribute(&cus, hipDeviceAttributeMultiprocessorCount, dev);
        if (hipFuncSetAttribute((const void*)mega, hipFuncAttributeMaxDynamicSharedMemorySize, LDS_BYTES) != hipSuccess) { fprintf(stderr, "kernel_launch: hipFuncSetAttribute failed\n"); grid = -1; return; }
        hipOccupancyMaxActiveBlocksPerMultiprocessor(&per_cu, (const void*)mega, NTHR, LDS_BYTES);
        if (per_cu < 1) per_cu = 1;
        grid = cus * 1;
        (void)hipGetLastError();
    }
    if (grid < 0) return;
    Args a{};
    for (int i = 0; i < 15; ++i) a.in[i] = (const float*)d_in[i];
    a.out = (float*)d_out; a.ws = (unsigned char*)d_ws;
#if ONE_LAUNCH
    (void)hipMemsetAsync((unsigned char*)d_ws + WS_BAR, 0, 16384, stream);
    a.lo = 0; a.hi = NPHASE;
    void* args[] = {&a};
    hipError_t e = hipLaunchCooperativeKernel((const void*)mega, dim3(grid), dim3(NTHR), args, LDS_BYTES, stream);
    if (e != hipSuccess) fprintf(stderr, "cooperative launch failed: %s (grid %d)\n", hipGetErrorString(e), grid);
#else
    for (int ph = 0; ph < NPHASE; ++ph) { a.lo = ph; a.hi = ph + 1; hipLaunchKernelGGL(mega, dim3(grid), dim3(NTHR), LDS_BYTES, stream, a); }
#endif
}
```

```cpp
#include <hip/hip_runtime.h>
#include <hip/hip_cooperative_groups.h>
#include <cstdio>
namespace cg = cooperative_groups;

#ifndef ONE_LAUNCH
#define ONE_LAUNCH 1
#endif

#ifndef REP_MASK
#define REP_MASK 0
#endif
#define GEMM1_STAGGER_US 0
#define REP_BAND 1
#define REP_MEM 1
#define REP_PREP 1
#define EXTRA_SYNCS 0
#ifndef PG8_SP2
#define PG8_SP2 1
#endif
#define LAS __attribute__((address_space(3)))
typedef unsigned short bf16_t;
typedef short bf16x8 __attribute__((ext_vector_type(8)));
typedef short s16x4 __attribute__((ext_vector_type(4)));
typedef float f32x4 __attribute__((ext_vector_type(4)));
typedef unsigned u32x4 __attribute__((ext_vector_type(4)));
typedef unsigned u32x2 __attribute__((ext_vector_type(2)));
typedef int i32x8 __attribute__((ext_vector_type(8)));
typedef int i32x4 __attribute__((ext_vector_type(4)));
typedef short s16x16 __attribute__((ext_vector_type(16)));

constexpr int DM = 2048, SEQ = 2048, NB = 16, NTOK = NB * SEQ;
constexpr int PC = 17408;
constexpr int PS = 11264;
constexpr int HT = NTOK / 2;
constexpr int C_Q = 0, C_K = 1536, C_V = 3072, C_ZA = 4608, C_CB = 5120, C_CC = 6144, C_CV = 7168, C_ZC = 8192, C_MQ = 9216, C_ZM = 10240, C_G = 11264;
constexpr int ACTW = 2560;
constexpr int LDP = 2048 + 64;
constexpr float EPSF = 1e-6f;
constexpr int NTHR = 512;
constexpr int LDS_BYTES = 149504;

constexpr size_t WS_WIN = 0;
constexpr size_t WS_WKV = WS_WIN + (size_t)PC * LDP * 2;
constexpr size_t WS_WBR = WS_WKV + (size_t)DM * DM * 2;
constexpr size_t WS_WOUT = WS_WBR + (size_t)DM * ACTW * 2;
constexpr size_t WS_MH = WS_WOUT + (size_t)DM * DM * 2;
constexpr size_t WS_MKV = WS_MH + (size_t)4096 * DM * 2;
constexpr size_t WS_PROJ = WS_MKV + (size_t)4096 * DM * 2;
constexpr size_t WS_OG = WS_PROJ + (size_t)HT * PS * 2;
constexpr size_t WS_LSE = WS_OG + (size_t)HT * 1536 * 2;
constexpr size_t WS_ACT = WS_LSE + (size_t)HT * 12 * 4;
constexpr size_t WS_GF = WS_ACT + (size_t)HT * ACTW * 2;
constexpr size_t WS_MB = WS_GF + (size_t)HT * 6144;
constexpr size_t WS_MB2 = WS_MB + (size_t)HT * DM * 2;
constexpr size_t WS_H = WS_MB2 + (size_t)HT * DM * 2;
constexpr size_t WS_BAR = WS_H + (size_t)NTOK * LDP * 2;
constexpr size_t WS_END = WS_BAR + 16384;
constexpr size_t OUT_H_OFF = (size_t)HT * DM * 4;

__device__ __forceinline__ float bflo(unsigned w) { return __uint_as_float(w << 16); }
__device__ __forceinline__ float bfhi(unsigned w) { return __uint_as_float(w & 0xffff0000u); }
typedef __bf16 bf16x2_t __attribute__((ext_vector_type(2)));
typedef float f32x2_t __attribute__((ext_vector_type(2)));
__device__ __forceinline__ unsigned cvt_pk_bf16(float lo, float hi) { f32x2_t v = {lo, hi}; bf16x2_t b = __builtin_convertvector(v, bf16x2_t); return __builtin_bit_cast(unsigned, b); }
__device__ __forceinline__ float shx(float v, int mask, int lane) { return __int_as_float(__builtin_amdgcn_ds_bpermute(((lane ^ mask) & 63) << 2, __float_as_int(v))); }
__device__ __forceinline__ float sigmoidf_(float x) { return __builtin_amdgcn_rcpf(1.0f + __builtin_amdgcn_exp2f(x * -1.4426950408889634f)); }
__device__ __forceinline__ float siluf_(float x) { return x * __builtin_amdgcn_rcpf(1.0f + __builtin_amdgcn_exp2f(x * -1.4426950408889634f)); }

namespace pg8 {
constexpr int BM = 256, BK = 64, HALF = 128, HTB = HALF * BK * 2, STAGE_BYTES = 8 * HTB, NXCD = 8, WGM = 8;
__host__ __device__ __forceinline__ int lds_byte(int r, int c) { const int st = (r >> 4) * 2 + (c >> 5), rr = r & 15, cc = c & 31, ob = rr * 64 + cc * 2; return st * 1024 + (ob ^ (((ob >> 9) & 1) << 5)); }
__host__ __device__ __forceinline__ void stage_rc(int b, int& R, int& C) { const int st = b / 1024, sb = b % 1024, swz = sb ^ (((sb >> 9) & 1) << 5); R = (st >> 1) * 16 + swz / 64; C = (st & 1) * 32 + (swz % 64) / 2; }
__host__ __device__ __forceinline__ int perm32(int rho) { const int n = rho >> 4, i = rho & 15; return 8 * (i >> 2) + 4 * n + (i & 3); }
struct Unit { int pm, pn; };
struct Gemm { const bf16_t* A; const bf16_t* Bt; int M, N, K, lda, ldb, f8; };
struct StaticOrder {
    int nM, nN, nwg, G, c;
    __device__ void init(int M, int N, int G_, int c_) { nM = M / BM; nN = N / BM; nwg = nM * nN; G = G_; c = c_; }
    __device__ bool next(int i, Unit& u) const {
        const long L = (long)i * G + c; if (L >= nwg) return false;
        int wgid = (int)L; { const int q = nwg / NXCD, r = nwg % NXCD, xcd = wgid % NXCD, off = wgid / NXCD; wgid = (xcd < r ? xcd * (q + 1) : r * (q + 1) + (xcd - r) * q) + off; }
        const int nig = WGM * nN, gid = wgid / nig, fm = gid * WGM, gsz = (nM - fm) < WGM ? (nM - fm) : WGM;
        u.pm = fm + ((wgid % nig) % gsz); u.pn = (wgid % nig) / gsz; return true;
    }
};

struct Epi;
template <bool F8, class Epi, class Sched>
__device__ __forceinline__ void gemm_phase(LAS unsigned char* lds, const Gemm g, const Sched& S, const Epi& E, const int tid) {
    const int wid = __builtin_amdgcn_readfirstlane(tid >> 6), lane = tid & 63, wr = wid >> 2, wc = wid & 3, fr = lane & 15, fq = lane >> 4;
    const int K = g.K, nt = K / BK;
    unsigned voffA[2], voffB[2];
#pragma unroll
    for (int i = 0; i < 2; ++i) { int R, C; stage_rc(tid * 16 + i * 8192, R, C); const int Rb = 2 * (R & ~31) + (E.perm() ? perm32(R & 31) : (R & 31));
        voffA[i] = (unsigned)(R * g.lda + C) * 2u; voffB[i] = (unsigned)(Rb * g.ldb + C) * 2u; }
    const size_t kstep = (size_t)(BK * 2);
    const size_t hstepA = (size_t)HALF * g.lda * 2, hstepB = (size_t)32 * g.ldb * 2;
    const size_t tstepA = 2 * hstepA, tstepB = (size_t)BM * g.ldb * 2;
    const unsigned ldsw = (unsigned)wid * 1024u;
    const int aoff = lds_byte(wr * 64 + fr, fq * 8), boff = lds_byte(wc * 32 + fr, fq * 8);
#define PG8_SA(b, h) (((b) * 2 + (h)) * HTB)
#define PG8_SB(b, h) ((4 + (b) * 2 + (h)) * HTB)
#define PG8_STAGE(bufoff, gbase, voff) do { _Pragma("unroll") for (int _i = 0; _i < 2; ++_i) \
        __builtin_amdgcn_global_load_lds((const unsigned*)((const char*)(gbase) + (voff)[_i]), (LAS unsigned*)(lds + (bufoff) + ldsw + _i * 8192), 16, 0, 0); } while (0)
#define PG8_LD8(p) __builtin_shufflevector(*(const LAS i32x4*)(p), *(const LAS i32x4*)((p) + 1024), 0, 1, 2, 3, 4, 5, 6, 7)
#define PG8_LDA(dst, b, h) do { _Pragma("unroll") for (int m = 0; m < 4; ++m) dst[m] = PG8_LD8(lds + PG8_SA(b, h) + aoff + m * 2048); } while (0)
#define PG8_LDB(dst, b, h) do { _Pragma("unroll") for (int n = 0; n < 2; ++n) dst[n] = PG8_LD8(lds + PG8_SB(b, h) + boff + n * 2048); } while (0)
#define PG8_LO(v) __builtin_bit_cast(bf16x8, __builtin_shufflevector(v, v, 0, 1, 2, 3))
#define PG8_HI(v) __builtin_bit_cast(bf16x8, __builtin_shufflevector(v, v, 4, 5, 6, 7))
#define PG8_MMA(ai, bj, At, Bt) do { __builtin_amdgcn_s_setprio(1); \
        if constexpr (F8) { _Pragma("unroll") for (int m = 0; m < 4; ++m) _Pragma("unroll") for (int n = 0; n < 2; ++n) \
            asm volatile("v_mfma_scale_f32_16x16x128_f8f6f4 %0, %1, %2, %0, %3, %3 op_sel_hi:[0,0,0]" : "+v"(acc[ai][bj][m][n]) : "v"(Bt[n]), "v"(At[m]), "v"(mxs)); } \
        else { _Pragma("unroll") for (int m = 0; m < 4; ++m) _Pragma("unroll") for (int n = 0; n < 2; ++n) { \
            acc[ai][bj][m][n] = __builtin_amdgcn_mfma_f32_16x16x32_bf16(PG8_LO(Bt[n]), PG8_LO(At[m]), acc[ai][bj][m][n], 0, 0, 0); \
            acc[ai][bj][m][n] = __builtin_amdgcn_mfma_f32_16x16x32_bf16(PG8_HI(Bt[n]), PG8_HI(At[m]), acc[ai][bj][m][n], 0, 0, 0); } } \
        __builtin_amdgcn_s_setprio(0); } while (0)
#define PG8_WAIT_V(n) asm volatile("s_waitcnt vmcnt(" #n ")" ::: "memory")
#define PG8_WAIT_L(n) asm volatile("s_waitcnt lgkmcnt(" #n ")" ::: "memory")
#define PG8_BAR __builtin_amdgcn_s_barrier()
#define PG8_SCHED __builtin_amdgcn_sched_barrier(0)
    Unit cur, nxt; int ui = 0;
    if (!S.next(0, cur)) return;
    int mxs = 0x7f7f7f7f; if constexpr (F8) asm volatile("" : "+v"(mxs));
    f32x4 acc[2][2][4][2];
#pragma unroll
    for (int a = 0; a < 2; ++a)
#pragma unroll
        for (int b = 0; b < 2; ++b)
#pragma unroll
            for (int m = 0; m < 4; ++m)
#pragma unroll
                for (int n = 0; n < 2; ++n) acc[a][b][m][n] = (f32x4){0.f, 0.f, 0.f, 0.f};
    i32x8 At[4], B0[2], B1[2];
    const char* cA = (const char*)g.A + (size_t)cur.pm * tstepA; const char* cB = (const char*)g.Bt + (size_t)cur.pn * tstepB;
#if PG8_SP2
    PG8_STAGE(PG8_SB(0, 0), cB, voffB); PG8_STAGE(PG8_SB(0, 1), cB + hstepB, voffB); PG8_STAGE(PG8_SA(0, 0), cA, voffA); PG8_STAGE(PG8_SA(0, 1), cA + hstepA, voffA);
    if (wr == 1) PG8_BAR;
    PG8_WAIT_V(2); PG8_BAR;
    PG8_STAGE(PG8_SB(1, 0), cB + kstep, voffB); PG8_STAGE(PG8_SA(1, 0), cA + kstep, voffA); PG8_STAGE(PG8_SB(1, 1), cB + hstepB + kstep, voffB);
    PG8_WAIT_V(6); PG8_BAR;
#else
    PG8_STAGE(PG8_SB(0, 0), cB, voffB); PG8_STAGE(PG8_SA(0, 0), cA, voffA); PG8_STAGE(PG8_SB(0, 1), cB + hstepB, voffB); PG8_STAGE(PG8_SA(0, 1), cA + hstepA, voffA);
    if (wr == 1) PG8_BAR;
    PG8_WAIT_V(4); PG8_BAR;
    PG8_STAGE(PG8_SB(1, 0), cB + kstep, voffB); PG8_STAGE(PG8_SA(1, 0), cA + kstep, voffA); PG8_STAGE(PG8_SB(1, 1), cB + hstepB + kstep, voffB);
    PG8_WAIT_V(6); PG8_BAR;
#endif
    for (;;) {
        const bool has_next = S.next(ui + 1, nxt);
        const char* nA = has_next ? (const char*)g.A + (size_t)nxt.pm * tstepA : cA; const char* nB = has_next ? (const char*)g.Bt + (size_t)nxt.pn * tstepB : cB;
        for (int t = 0; t < nt; t += 2) {
            const bool last = (t == nt - 2);
            const char* a1 = cA + (size_t)(t + 1) * kstep;
            const char* a2 = last ? nA : cA + (size_t)(t + 2) * kstep; const char* b2 = last ? nB : cB + (size_t)(t + 2) * kstep;
            const char* a3 = a2 + kstep; const char* b3 = b2 + kstep;
            if constexpr (!F8) { if (E.has_mid() && (t == 8 || t == 24)) E.mid(acc, cur, tid, t == 8 ? 0 : 1); }
#if PG8_SP2
            PG8_LDB(B0, 0, 0); PG8_LDB(B1, 0, 1); PG8_SCHED; PG8_LDA(At, 0, 0); PG8_STAGE(PG8_SA(1, 1), a1 + hstepA, voffA);
            PG8_WAIT_V(8); PG8_WAIT_L(0); PG8_BAR; PG8_MMA(0, 0, At, B0); PG8_MMA(0, 1, At, B1); PG8_BAR; PG8_SCHED;
            PG8_LDA(At, 0, 1); PG8_STAGE(PG8_SB(0, 0), b2, voffB); PG8_STAGE(PG8_SB(0, 1), b2 + hstepB, voffB); PG8_STAGE(PG8_SA(0, 0), a2, voffA);
            PG8_WAIT_V(8); PG8_WAIT_L(0); PG8_BAR; PG8_MMA(1, 0, At, B0); PG8_MMA(1, 1, At, B1); PG8_BAR; PG8_SCHED;
            PG8_LDB(B0, 1, 0); PG8_LDB(B1, 1, 1); PG8_SCHED; PG8_LDA(At, 1, 0); PG8_STAGE(PG8_SA(0, 1), a2 + hstepA, voffA);
            PG8_WAIT_V(8); PG8_WAIT_L(0); PG8_BAR; PG8_MMA(0, 0, At, B0); PG8_MMA(0, 1, At, B1); PG8_BAR; PG8_SCHED;
            PG8_LDA(At, 1, 1); PG8_STAGE(PG8_SB(1, 0), b3, voffB); PG8_STAGE(PG8_SB(1, 1), b3 + hstepB, voffB); PG8_STAGE(PG8_SA(1, 0), a3, voffA);
            PG8_WAIT_V(8); PG8_WAIT_L(0); PG8_BAR; PG8_MMA(1, 0, At, B0); PG8_MMA(1, 1, At, B1); PG8_BAR; PG8_SCHED;
#else
            PG8_LDB(B0, 0, 0); PG8_SCHED; PG8_LDA(At, 0, 0); PG8_STAGE(PG8_SA(1, 1), a1 + hstepA, voffA);
            PG8_WAIT_L(8); PG8_BAR; PG8_WAIT_L(0); PG8_MMA(0, 0, At, B0); PG8_BAR; PG8_SCHED;
            PG8_LDB(B1, 0, 1); PG8_STAGE(PG8_SB(0, 0), b2, voffB);
            PG8_BAR; PG8_WAIT_L(0); PG8_MMA(0, 1, At, B1); PG8_BAR;
            PG8_LDA(At, 0, 1); PG8_STAGE(PG8_SA(0, 0), a2, voffA);
            PG8_BAR; PG8_WAIT_L(0); PG8_MMA(1, 0, At, B0); PG8_BAR; PG8_SCHED;
            PG8_STAGE(PG8_SB(0, 1), b2 + hstepB, voffB);
            PG8_WAIT_V(6); PG8_BAR; PG8_MMA(1, 1, At, B1); PG8_BAR;
            PG8_LDB(B0, 1, 0); PG8_SCHED; PG8_LDA(At, 1, 0); PG8_STAGE(PG8_SA(0, 1), a2 + hstepA, voffA);
            PG8_WAIT_L(8); PG8_BAR; PG8_WAIT_L(0); PG8_MMA(0, 0, At, B0); PG8_BAR; PG8_SCHED;
            PG8_LDB(B1, 1, 1); PG8_STAGE(PG8_SB(1, 0), b3, voffB);
            PG8_BAR; PG8_WAIT_L(0); PG8_MMA(0, 1, At, B1); PG8_BAR;
            PG8_LDA(At, 1, 1); PG8_STAGE(PG8_SA(1, 0), a3, voffA);
            PG8_BAR; PG8_WAIT_L(0); PG8_MMA(1, 0, At, B0); PG8_BAR; PG8_SCHED;
            PG8_STAGE(PG8_SB(1, 1), b3 + hstepB, voffB);
            PG8_WAIT_V(6); PG8_BAR; PG8_MMA(1, 1, At, B1); PG8_BAR;
#endif
        }
        if (wr == 0) PG8_BAR;
        if constexpr (F8) {
            asm volatile("s_nop 15\n\ts_nop 15"
                         : "+v"(acc[1][0][0][0]), "+v"(acc[1][0][0][1]), "+v"(acc[1][0][1][0]), "+v"(acc[1][0][1][1]), "+v"(acc[1][0][2][0]), "+v"(acc[1][0][2][1]), "+v"(acc[1][0][3][0]), "+v"(acc[1][0][3][1]),
                           "+v"(acc[1][1][0][0]), "+v"(acc[1][1][0][1]), "+v"(acc[1][1][1][0]), "+v"(acc[1][1][1][1]), "+v"(acc[1][1][2][0]), "+v"(acc[1][1][2][1]), "+v"(acc[1][1][3][0]), "+v"(acc[1][1][3][1]));
            E.k0(acc, cur, wr, wc, fr, fq, tid);
        } else E(acc, cur, wr, wc, fr, fq, tid);
        if (!has_next) break;
#pragma unroll
        for (int a = 0; a < 2; ++a)
#pragma unroll
            for (int b = 0; b < 2; ++b)
#pragma unroll
                for (int m = 0; m < 4; ++m)
#pragma unroll
                    for (int n = 0; n < 2; ++n) acc[a][b][m][n] = (f32x4){0.f, 0.f, 0.f, 0.f};
        cur = nxt; cA = nA; cB = nB; ++ui;
        if (wr == 1) PG8_BAR;
    }
    PG8_WAIT_V(0);
    PG8_BAR;
#undef PG8_SA
#undef PG8_SB
#undef PG8_STAGE
#undef PG8_LDA
#undef PG8_LDB
#undef PG8_MMA
#undef PG8_LD8
#undef PG8_LO
#undef PG8_HI
#undef PG8_WAIT_V
#undef PG8_WAIT_L
#undef PG8_BAR
#undef PG8_SCHED
}

struct Epi {
    int kind; void* p0; const void* p1; void* p2; int ldc, gpn0; float gscale; int split, off0, off1, gpn1, gb0, gb1;
    __device__ __forceinline__ bool perm() const { return kind != 4; }
    __device__ __forceinline__ bool has_mid() const { return kind == 5; }
    __device__ __forceinline__ void mid(f32x4 (&acc)[2][2][4][2], const Unit& u, int tid, int which) const {
        const u32x2* ga = (const u32x2*)p1 + ((size_t)(u.pm * 24 + 8 * which + u.pn) * 16) * 512 + tid; const u32x2* gb = ga + (size_t)8 * 16 * 512;
        u32x2 x[16], y[16];
#pragma unroll
        for (int i = 0; i < 16; ++i) { x[i] = ga[i * 512]; y[i] = gb[i * 512]; }
        asm volatile("s_waitcnt vmcnt(0)" ::: "memory");
#pragma unroll
        for (int i = 0; i < 16; ++i) { const int ai = i >> 3, m = (i >> 1) & 3, bj = i & 1; const u32x2 a = x[i], b = y[i];
#define QR(wa, wb, sh) __builtin_amdgcn_exp2f(((float)(((wb) >> (sh)) & 0xffu) - (float)(((wa) >> (sh)) & 0xffu)) * 0.03125f)
            acc[ai][bj][m][0] *= (f32x4){QR(a.x, b.x, 0), QR(a.x, b.x, 8), QR(a.x, b.x, 16), QR(a.x, b.x, 24)};
            acc[ai][bj][m][1] *= (f32x4){QR(a.y, b.y, 0), QR(a.y, b.y, 8), QR(a.y, b.y, 16), QR(a.y, b.y, 24)};
#undef QR
        }
    }
    __device__ __forceinline__ void gate(const f32x4 (&acc)[2][2][4][2], const Unit& u, int tid) const {
            const int gi = (u.pn < gpn1) ? gb0 + (u.pn - gpn0) : gb1 + (u.pn - gpn1);
            u32x2* gf = (u32x2*)p2 + ((size_t)(u.pm * 24 + gi) * 16) * 512 + tid;
            const float nls = -1.4426950408889634f * gscale;
#pragma unroll
            for (int ai = 0; ai < 2; ++ai)
#pragma unroll
                for (int m = 0; m < 4; ++m)
#pragma unroll
                    for (int bj = 0; bj < 2; ++bj) { const f32x4 v0 = acc[ai][bj][m][0], v1 = acc[ai][bj][m][1];
#define QF(v) (__builtin_amdgcn_logf(1.0f + __builtin_amdgcn_exp2f((v) * nls)) * 32.0f)
#define QP(a, b, c, d) __builtin_amdgcn_cvt_pk_u8_f32(QF(d), 3, __builtin_amdgcn_cvt_pk_u8_f32(QF(c), 2, __builtin_amdgcn_cvt_pk_u8_f32(QF(b), 1, __builtin_amdgcn_cvt_pk_u8_f32(QF(a), 0, 0u))))
                        u32x2 w; w.x = QP(v0[0], v0[1], v0[2], v0[3]); w.y = QP(v1[0], v1[1], v1[2], v1[3]);
#undef QP
#undef QF
                        __builtin_nontemporal_store(w, &gf[((ai * 4 + m) * 2 + bj) * 512]); }
    }
    __device__ __forceinline__ void k0store(const f32x4 (&acc)[2][2][4][2], const Unit& u, int wr, int wc, int fr, int fq) const {
        const bool lo = fr < 8;
        const int row0 = u.pm * BM + wr * 64 + (fr & 7);
        bf16_t* O = (bf16_t*)p0; const int col0 = ((u.pn < split) ? off0 + u.pn * BM : off1 + (u.pn - split) * BM) + wc * 64 + 8 * fq + (lo ? 0 : 32); const float sc = gscale;
#pragma unroll
        for (int ai = 0; ai < 2; ++ai)
#pragma unroll
            for (int m = 0; m < 4; ++m) { bf16_t* rowp = O + (size_t)(row0 + ai * HALF + m * 16) * ldc + col0;
                const f32x4 a0 = acc[ai][0][m][0] * sc, a1 = acc[ai][0][m][1] * sc, b0 = acc[ai][1][m][0] * sc, b1 = acc[ai][1][m][1] * sc;
                u32x4 w0, w1; w0.x = cvt_pk_bf16(a0[0], a0[1]); w0.y = cvt_pk_bf16(a0[2], a0[3]); w0.z = cvt_pk_bf16(a1[0], a1[1]); w0.w = cvt_pk_bf16(a1[2], a1[3]);
                w1.x = cvt_pk_bf16(b0[0], b0[1]); w1.y = cvt_pk_bf16(b0[2], b0[3]); w1.z = cvt_pk_bf16(b1[0], b1[1]); w1.w = cvt_pk_bf16(b1[2], b1[3]);
                const u32x4 snd = lo ? w1 : w0; u32x4 rcv;
                rcv.x = (unsigned)__builtin_amdgcn_mov_dpp((int)snd.x, 0x128, 0xf, 0xf, true); rcv.y = (unsigned)__builtin_amdgcn_mov_dpp((int)snd.y, 0x128, 0xf, 0xf, true);
                rcv.z = (unsigned)__builtin_amdgcn_mov_dpp((int)snd.z, 0x128, 0xf, 0xf, true); rcv.w = (unsigned)__builtin_amdgcn_mov_dpp((int)snd.w, 0x128, 0xf, 0xf, true);
                const u32x4 sa = lo ? w0 : rcv, sb = lo ? rcv : w1;
                __builtin_nontemporal_store(sa, (u32x4*)rowp);
                __builtin_nontemporal_store(sb, (u32x4*)(rowp + (size_t)8 * ldc)); }
    }
    __device__ __forceinline__ void k0(const f32x4 (&acc)[2][2][4][2], const Unit& u, int wr, int wc, int fr, int fq, int tid) const {
        if (u.pn >= gpn0) gate(acc, u, tid); else k0store(acc, u, wr, wc, fr, fq);
    }
    __device__ __forceinline__ void operator()(const f32x4 (&acc)[2][2][4][2], const Unit& u, int wr, int wc, int fr, int fq, int tid) const {
        const int row0 = u.pm * BM + wr * 64 + fr;
        if (kind == 0 && u.pn >= gpn0) {
            gate(acc, u, tid);
        } else if (kind == 0) {
            k0store(acc, u, wr, wc, fr, fq);
        } else if (kind == 4) {
            const float* x = (const float*)p1; float* out = (float*)p0; const int col0 = u.pn * BM + wc * 64 + 4 * fq;
#pragma unroll
            for (int ai = 0; ai < 2; ++ai) {
                f32x4 xv[4][2][2];
#pragma unroll
                for (int m = 0; m < 4; ++m) { const size_t off = (size_t)(row0 + ai * HALF + m * 16) * DM + col0;
#pragma unroll
                    for (int bj = 0; bj < 2; ++bj)
#pragma unroll
                        for (int n = 0; n < 2; ++n) xv[m][bj][n] = *(const f32x4*)(x + off + bj * 32 + n * 16); }
                asm volatile("s_waitcnt vmcnt(0)" ::: "memory");
#pragma unroll
                for (int m = 0; m < 4; ++m) { const size_t off = (size_t)(row0 + ai * HALF + m * 16) * DM + col0;
#pragma unroll
                    for (int bj = 0; bj < 2; ++bj)
#pragma unroll
                        for (int n = 0; n < 2; ++n) *(f32x4*)(out + off + bj * 32 + n * 16) = xv[m][bj][n] + acc[ai][bj][m][n]; }
                asm volatile("" ::: "memory");
            }
        } else if (kind == 5) {
            bf16_t* O = (bf16_t*)p0; const int col0 = u.pn * BM + wc * 64 + 8 * fq;
            const u32x2* gc = (const u32x2*)p1 + ((size_t)(u.pm * 24 + 16 + u.pn) * 16) * 512 + tid;
            u32x2 gy[16];
#pragma unroll
            for (int i = 0; i < 16; ++i) gy[i] = gc[i * 512];
            asm volatile("s_waitcnt vmcnt(0)" ::: "memory");
#pragma unroll
            for (int ai = 0; ai < 2; ++ai)
#pragma unroll
                for (int m = 0; m < 4; ++m) { bf16_t* rowp = O + (size_t)(row0 + ai * HALF + m * 16) * ldc + col0;
#pragma unroll
                    for (int bj = 0; bj < 2; ++bj) { const f32x4 v0 = acc[ai][bj][m][0], v1 = acc[ai][bj][m][1]; const u32x2 y = gy[(ai * 4 + m) * 2 + bj];
#define QS(wv, sh) __builtin_amdgcn_exp2f((float)(((wv) >> (sh)) & 0xffu) * -0.03125f)
                        u32x4 w; w.x = cvt_pk_bf16(v0[0] * QS(y.x, 0), v0[1] * QS(y.x, 8)); w.y = cvt_pk_bf16(v0[2] * QS(y.x, 16), v0[3] * QS(y.x, 24));
                        w.z = cvt_pk_bf16(v1[0] * QS(y.y, 0), v1[1] * QS(y.y, 8)); w.w = cvt_pk_bf16(v1[2] * QS(y.y, 16), v1[3] * QS(y.y, 24));
#undef QS
                        *(u32x4*)(rowp + bj * 32) = w; } }
        }
    }
};
}

__device__ __forceinline__ unsigned pk4_fp8(float a, float b, float c, float d) { int w = __builtin_amdgcn_cvt_pk_fp8_f32(a, b, 0, false); w = __builtin_amdgcn_cvt_pk_fp8_f32(c, d, w, true); return (unsigned)w; }
__device__ __forceinline__ void rmsnorm_rows(const float* __restrict__ x, const float* __restrict__ g, bf16_t* __restrict__ out, int ldo, unsigned char* __restrict__ out8, int nrows, int gw, int nw, int lane) {
    for (int row = gw; row < nrows; row += nw) {
        const float4* xr = (const float4*)(x + (size_t)row * DM);
        float4 v[8]; float ss = 0.f;
#pragma unroll
        for (int i = 0; i < 4; ++i) { const int c = lane + 64 * i; v[2 * i] = xr[2 * c]; v[2 * i + 1] = xr[2 * c + 1]; }
#pragma unroll
        for (int i = 0; i < 8; ++i) ss += v[i].x * v[i].x + v[i].y * v[i].y + v[i].z * v[i].z + v[i].w * v[i].w;
#pragma unroll
        for (int o = 32; o >= 1; o >>= 1) ss += shx(ss, o, lane);
        const float rstd = rsqrtf(ss * (1.0f / DM) + EPSF);
#pragma unroll
        for (int i = 0; i < 4; ++i) { const int c = lane + 64 * i; const float4 ga = ((const float4*)g)[2 * c], gb = ((const float4*)g)[2 * c + 1]; const float4 a = v[2 * i], b = v[2 * i + 1];
            u32x4 w; w.x = cvt_pk_bf16(a.x * rstd * ga.x, a.y * rstd * ga.y); w.y = cvt_pk_bf16(a.z * rstd * ga.z, a.w * rstd * ga.w);
            w.z = cvt_pk_bf16(b.x * rstd * gb.x, b.y * rstd * gb.y); w.w = cvt_pk_bf16(b.z * rstd * gb.z, b.w * rstd * gb.w);
            *(u32x4*)(out + (size_t)row * ldo + c * 8) = w;
            if (out8) { u32x2 q; q.x = pk4_fp8(a.x * rstd * ga.x, a.y * rstd * ga.y, a.z * rstd * ga.z, a.w * rstd * ga.w); q.y = pk4_fp8(b.x * rstd * gb.x, b.y * rstd * gb.y, b.z * rstd * gb.z, b.w * rstd * gb.w);
                        *(u32x2*)(out8 + (size_t)row * DM + c * 8) = q; } }
    }
}
struct TJob { const float* src; bf16_t* dst; int C, ld, koff, r0, c0, dc, f8; };
__device__ __forceinline__ void tile_load(float4 (&v)[4], const TJob& J, int tid) {
#pragma unroll
    for (int p = 0; p < 4; ++p) { const int r = p * 16 + (tid >> 5), c4 = (tid & 31) * 4; v[p] = *(const float4*)(J.src + (size_t)(J.r0 + r) * J.C + J.c0 + c4); }
}
__device__ __forceinline__ void tile_store(LAS float* t  , const float4 (&v)[4], const TJob& J, int tid) {
#pragma unroll
    for (int p = 0; p < 4; ++p) { const int r = p * 16 + (tid >> 5), c4 = (tid & 31) * 4; LAS float* q = t + r * 129 + c4; q[0] = v[p].x; q[1] = v[p].y; q[2] = v[p].z; q[3] = v[p].w; }
    __syncthreads();
#pragma unroll
    for (int h = 0; h < 2; ++h) { const int c = h * 64 + (tid >> 3), rc = (tid & 7) * 8; float f[8];
#pragma unroll
        for (int j = 0; j < 8; ++j) f[j] = t[(rc + j) * 129 + c];
        if (J.f8) { u32x2 q; q.x = pk4_fp8(f[0] * 64.f, f[1] * 64.f, f[2] * 64.f, f[3] * 64.f); q.y = pk4_fp8(f[4] * 64.f, f[5] * 64.f, f[6] * 64.f, f[7] * 64.f);
                    *(u32x2*)((unsigned char*)J.dst + (size_t)(J.dc + c) * J.ld + J.r0 + rc) = q; }
        else { u32x4 w; w.x = cvt_pk_bf16(f[0], f[1]); w.y = cvt_pk_bf16(f[2], f[3]); w.z = cvt_pk_bf16(f[4], f[5]); w.w = cvt_pk_bf16(f[6], f[7]);
               *(u32x4*)(J.dst + (size_t)(J.dc + c) * J.ld + J.koff + J.r0 + rc) = w; } }
    __syncthreads();
}

struct PrepPtrs { const float* win; const float* wkv; const float* wba; const float* wbc; const float* wbm; const float* wout; bf16_t* WIN; bf16_t* WKV; bf16_t* WBR; bf16_t* WOUT; unsigned char* WG8; };
constexpr int PT0 = 512, PT1 = PT0 + 32 * 136, PT2 = PT1 + 128, PT3 = PT2 + 256, PT4 = PT3 + 256, PT5 = PT4 + 512;
__device__ __forceinline__ TJob prep_job(int t, const PrepPtrs P) {
    TJob J; int ti;
    if (t < PT0) { J.src = P.wkv; J.C = DM; J.dst = P.WKV; J.ld = DM; J.koff = 0; ti = t; }
    else if (t < PT1) { J.src = P.win; J.C = PC; J.dst = P.WIN; J.ld = LDP; J.koff = 0; ti = t - PT0; }
    else if (t < PT2) { J.src = P.wba; J.C = DM; J.dst = P.WBR; J.ld = ACTW; J.koff = 0; ti = t - PT1; }
    else if (t < PT3) { J.src = P.wbc; J.C = DM; J.dst = P.WBR; J.ld = ACTW; J.koff = 512; ti = t - PT2; }
    else if (t < PT4) { J.src = P.wbm; J.C = DM; J.dst = P.WBR; J.ld = ACTW; J.koff = 1536; ti = t - PT3; }
    else { J.src = P.wout; J.C = DM; J.dst = P.WOUT; J.ld = DM; J.koff = 0; ti = t - PT4; }
    const int nct = J.C / 128; J.r0 = (ti / nct) * 64; J.c0 = (ti % nct) * 128; J.dc = J.c0; J.f8 = 0;
    if (t >= PT0 && t < PT1) {
        const int c = J.c0;
        if (c < 5120) { J.f8 = 1; J.dc = c; }
        else if (c < 9216) { J.dc = c - 5120; }
        else if (c < 11264) { J.f8 = 1; J.dc = 5120 + (c - 9216); }
        else if (c < 13312) { J.f8 = 1; J.dc = 7168 + (c - 11264); }
        else if (c < 15360) { J.dc = 4096 + (c - 13312); }
        else { J.f8 = 1; J.dc = 9216 + (c - 15360); }
        if (J.f8) { J.dst = (bf16_t*)P.WG8; J.ld = DM; }
    }
    return J;
}

template <int HD> struct AttnGeo { static constexpr int KSTR = HD * 2 + 16, VSTR = HD * 2 + 32, PPR = HD / 8, NKS = HD / 32, NDT = HD / 16, NPC = 256 * (HD / 8) / NTHR; };

template <int HD> __device__ __forceinline__ void issue_rows(u32x4 (&r)[AttnGeo<HD>::NPC], const bf16_t* __restrict__ p, int stride, int jbase, int tid) {
    typedef AttnGeo<HD> G; constexpr int RS = NTHR / G::PPR;
    const int r0 = tid / G::PPR, pc = tid % G::PPR;
#pragma unroll
    for (int i = 0; i < G::NPC; ++i) { int j = jbase + r0 + i * RS; j = j < 0 ? 0 : j;
        r[i] = *(const u32x4*)(p + ((unsigned)j * (unsigned)stride + (unsigned)(pc * 8))); }
}
template <int HD> __device__ __forceinline__ void issue_q(u32x4 (&q)[AttnGeo<HD>::NKS], const bf16_t* __restrict__ qrow, int g4) {
#pragma unroll
    for (int ks = 0; ks < AttnGeo<HD>::NKS; ++ks) q[ks] = *(const u32x4*)(qrow + ks * 32 + g4 * 8);
}
template <int HD> __device__ __forceinline__ void write_k(LAS unsigned char* kl, const u32x4 (&r)[AttnGeo<HD>::NPC], int jbase, const float* __restrict__ wk, int tid) {
    typedef AttnGeo<HD> G; constexpr int RS = NTHR / G::PPR;
    const int r0 = tid / G::PPR, pc = tid % G::PPR;
    LAS unsigned char* base = kl + r0 * G::KSTR + pc * 16;
    const float4 wa = *(const float4*)(wk + pc * 8), wb = *(const float4*)(wk + pc * 8 + 4);
#pragma unroll
    for (int i = 0; i < G::NPC; ++i) { const u32x4 w = r[i];
        float f[8] = {bflo(w.x), bfhi(w.x), bflo(w.y), bfhi(w.y), bflo(w.z), bfhi(w.z), bflo(w.w), bfhi(w.w)};
        float ss = 0.f;
#pragma unroll
        for (int e = 0; e < 8; ++e) ss += f[e] * f[e];
#pragma unroll
        for (int o = 1; o < G::PPR; o <<= 1) ss += shx(ss, o, tid);
        const float rstd = (jbase + r0 + i * RS >= 0) ? rsqrtf(ss * (1.0f / HD) + EPSF) : 0.f;
        u32x4 o4; o4.x = cvt_pk_bf16(f[0] * rstd * wa.x, f[1] * rstd * wa.y); o4.y = cvt_pk_bf16(f[2] * rstd * wa.z, f[3] * rstd * wa.w);
        o4.z = cvt_pk_bf16(f[4] * rstd * wb.x, f[5] * rstd * wb.y); o4.w = cvt_pk_bf16(f[6] * rstd * wb.z, f[7] * rstd * wb.w);
        *(LAS u32x4*)(base + i * (RS * G::KSTR)) = o4;
        if (G::NPC > 8) __builtin_amdgcn_sched_barrier(0); }
}
template <int HD> __device__ __forceinline__ void write_v(LAS unsigned char* vl, const u32x4 (&r)[AttnGeo<HD>::NPC], int jbase, int tid) {
    typedef AttnGeo<HD> G; constexpr int RS = NTHR / G::PPR;
    const int r0 = tid / G::PPR, pc = tid % G::PPR;
    LAS unsigned char* base = vl + r0 * G::VSTR + pc * 16;
#pragma unroll
    for (int i = 0; i < G::NPC; ++i) { const bool ok = jbase + r0 + i * RS >= 0; u32x4 w = r[i];
        w.x = ok ? w.x : 0u; w.y = ok ? w.y : 0u; w.z = ok ? w.z : 0u; w.w = ok ? w.w : 0u;
        *(LAS u32x4*)(base + i * (RS * G::VSTR)) = w; }
}
template <int HD, bool ISK> __device__ __forceinline__ void stage_rows(LAS unsigned char* dst, const bf16_t* __restrict__ p, int stride, const float* __restrict__ wk, int tid) {
    typedef AttnGeo<HD> G; constexpr int RS = NTHR / G::PPR, STR = ISK ? G::KSTR : G::VSTR, NB = ISK ? 8 : 16;
    const int r0 = tid / G::PPR, pc = tid % G::PPR;
    LAS unsigned char* base = dst + r0 * STR + pc * 16;
    float4 wa = make_float4(1.f, 1.f, 1.f, 1.f), wb = wa;
    if (ISK) { wa = *(const float4*)(wk + pc * 8); wb = *(const float4*)(wk + pc * 8 + 4); }
#pragma unroll 1
    for (int i0 = 0; i0 < G::NPC; i0 += NB) {
        u32x4 r[NB];
        unsigned boff = (unsigned)(r0 + i0 * RS) * (unsigned)stride + (unsigned)(pc * 8); asm volatile("" : "+v"(boff));
#pragma unroll
        for (int i = 0; i < NB; ++i) r[i] = *(const u32x4*)(p + (boff + (unsigned)(i * RS) * (unsigned)stride));
#pragma unroll
        for (int i = 0; i < NB; ++i) { u32x4 w = r[i];
            if (ISK) {
                float f[8] = {bflo(w.x), bfhi(w.x), bflo(w.y), bfhi(w.y), bflo(w.z), bfhi(w.z), bflo(w.w), bfhi(w.w)};
                float ss = 0.f;
#pragma unroll
                for (int e = 0; e < 8; ++e) ss += f[e] * f[e];
#pragma unroll
                for (int o = 1; o < G::PPR; o <<= 1) ss += shx(ss, o, tid);
                const float rstd = rsqrtf(ss * (1.0f / HD) + EPSF);
                w.x = cvt_pk_bf16(f[0] * rstd * wa.x, f[1] * rstd * wa.y); w.y = cvt_pk_bf16(f[2] * rstd * wa.z, f[3] * rstd * wa.w);
                w.z = cvt_pk_bf16(f[4] * rstd * wb.x, f[5] * rstd * wb.y); w.w = cvt_pk_bf16(f[6] * rstd * wb.z, f[7] * rstd * wb.w);
            }
            *(LAS u32x4*)(base + (i0 + i) * (RS * STR)) = w;
            if (ISK) __builtin_amdgcn_sched_barrier(0); }
    }
}
template <int HD> __device__ __forceinline__ void norm_q(bf16x8 (&qf)[AttnGeo<HD>::NKS], const u32x4 (&qw)[AttnGeo<HD>::NKS], const float* __restrict__ wq, float scale, int g4, int lane16) {
    typedef AttnGeo<HD> G;
    float ss = 0.f;
#pragma unroll
    for (int ks = 0; ks < G::NKS; ++ks) { const u32x4 x = qw[ks]; const float a0 = bflo(x.x), a1 = bfhi(x.x), a2 = bflo(x.y), a3 = bfhi(x.y), a4 = bflo(x.z), a5 = bfhi(x.z), a6 = bflo(x.w), a7 = bfhi(x.w);
        ss += a0 * a0 + a1 * a1 + a2 * a2 + a3 * a3 + a4 * a4 + a5 * a5 + a6 * a6 + a7 * a7; }
    ss += shx(ss, 16, lane16); ss += shx(ss, 32, lane16);
    const float sc = rsqrtf(ss * (1.0f / HD) + EPSF) * scale;
#pragma unroll
    for (int ks = 0; ks < G::NKS; ++ks) { const u32x4 x = qw[ks]; const float4 wa = *(const float4*)(wq + ks * 32 + g4 * 8), wb = *(const float4*)(wq + ks * 32 + g4 * 8 + 4);
        u32x4 o; o.x = cvt_pk_bf16(bflo(x.x) * sc * wa.x, bfhi(x.x) * sc * wa.y); o.y = cvt_pk_bf16(bflo(x.y) * sc * wa.z, bfhi(x.y) * sc * wa.w);
        o.z = cvt_pk_bf16(bflo(x.z) * sc * wb.x, bfhi(x.z) * sc * wb.y); o.w = cvt_pk_bf16(bflo(x.w) * sc * wb.z, bfhi(x.w) * sc * wb.w);
        qf[ks] = __builtin_bit_cast(bf16x8, o); }
}

__device__ __forceinline__ int band_item(int bx, int k, int G_) { return (G_ == 256) ? ((k >> 1) * 512 + 64 * (bx & 7) + (bx >> 3) + 32 * (k & 1)) : (bx + k * G_); }
__device__ __forceinline__ int mem_item(int bx, int k, int G_) { return (G_ == 256) ? (64 * (bx & 7) + (bx >> 3) + 32 * k) : (bx + k * G_); }
struct BandItem { const bf16_t* qp; int rstride; int qb, g, h; size_t row0; int d; };
__device__ __forceinline__ BandItem band_decode(int it, const bf16_t* PROJ) {
    BandItem I; const int g = it >> 9, idx = it & 511, dsh = 2 * g, d = 1 << dsh, nqb = 16 >> dsh;
    I.qb = idx % nqb; int rest = idx / nqb; const int r = rest % d; rest /= d; I.h = rest & 3; const int bl = rest >> 2;
    I.g = g; I.d = d; I.row0 = (size_t)bl * SEQ + r; I.qp = PROJ + I.row0 * PS + g * 512 + I.h * 128; I.rstride = d * PS; return I;
}
__device__ __forceinline__ void attn_banded_run(LAS unsigned char* lds, const bf16_t* __restrict__ PROJ, const float* __restrict__ aqn, const float* __restrict__ akn, bf16_t* __restrict__ OG, float* __restrict__ LSE,
                                                int bx, int G_, const int tid) {
    constexpr int HD = 128; typedef AttnGeo<HD> G;
    const int w = __builtin_amdgcn_readfirstlane(tid >> 6), lane = tid & 63, lq = lane & 15, g4 = lane >> 4;
    LAS unsigned char* kl = lds; LAS unsigned char* vl = lds + 256 * G::KSTR;
    const int n = (1536 - bx + G_ - 1) / G_;
    if (n <= 0) return;
    u32x4 rk[G::NPC], rv[G::NPC], rq[G::NKS];
    { const BandItem I = band_decode(band_item(bx, 0, G_), PROJ); const int jb = I.qb * 128 - 128;
      issue_rows<HD>(rk, I.qp + C_K, I.rstride, jb, tid); issue_rows<HD>(rv, I.qp + C_V, I.rstride, jb, tid); issue_q<HD>(rq, I.qp + (unsigned)(I.qb * 128 + 16 * w + lq) * (unsigned)I.rstride, g4); }
    { unsigned zl = 0u; asm volatile("" : "+v"(zl));
      for (int p = tid; p < 16 * G::PPR; p += NTHR) *(LAS u32x4*)(vl + (256 + p / G::PPR) * G::VSTR + (p % G::PPR) * 16) = (u32x4){zl, zl, zl, zl}; }
#pragma unroll 1
    for (int k = 0; k < n; ++k) {
        const BandItem I = band_decode(band_item(bx, k, G_), PROJ);
        const int jbase = I.qb * 128 - 128, qi = I.qb * 128 + 16 * w + lq;
        write_k<HD>(kl, rk, jbase, akn + I.g * 128, tid);
        write_v<HD>(vl, rv, jbase, tid);
        bf16x8 qf[G::NKS];
        norm_q<HD>(qf, rq, aqn + I.g * 128, 0.08838834764831845f * 1.4426950408889634f, g4, lane);
        __syncthreads();
        { const int kn = (k + 1 < n) ? k + 1 : k; const BandItem J = band_decode(band_item(bx, kn, G_), PROJ); const int jb = J.qb * 128 - 128;
          issue_rows<HD>(rk, J.qp + C_K, J.rstride, jb, tid); issue_rows<HD>(rv, J.qp + C_V, J.rstride, jb, tid); issue_q<HD>(rq, J.qp + (unsigned)(J.qb * 128 + 16 * w + lq) * (unsigned)J.rstride, g4); }
        f32x4 S[10];
        float NEG = -__builtin_inff(); asm volatile("" : "+v"(NEG));
#pragma unroll
        for (int t = 0; t < 9; ++t) {
            const int kt = w + t;
            if (jbase + kt * 16 >= 0) {
                f32x4 sv = (f32x4){0.f, 0.f, 0.f, 0.f};
#pragma unroll
                for (int ks = 0; ks < G::NKS; ++ks) { const bf16x8 kf = *(const LAS bf16x8*)(kl + (kt * 16 + lq) * G::KSTR + ks * 64 + g4 * 16); sv = __builtin_amdgcn_mfma_f32_16x16x32_bf16(kf, qf[ks], sv, 0, 0, 0); }
                if (t == 0) {
#pragma unroll
                    for (int r = 0; r < 4; ++r) sv[r] = (4 * g4 + r >= lq) ? sv[r] : NEG; }
                if (t == 8) {
#pragma unroll
                    for (int r = 0; r < 4; ++r) sv[r] = (4 * g4 + r <= lq) ? sv[r] : NEG; }
                S[t] = sv;
            } else S[t] = (f32x4){NEG, NEG, NEG, NEG};
        }
        S[9] = (f32x4){NEG, NEG, NEG, NEG};
        float mx = NEG;
#pragma unroll
        for (int t = 0; t < 9; ++t)
#pragma unroll
            for (int r = 0; r < 4; ++r) mx = fmaxf(mx, S[t][r]);
        mx = fmaxf(mx, shx(mx, 16, lane)); mx = fmaxf(mx, shx(mx, 32, lane));
        float l = 0.f;
#pragma unroll
        for (int t = 0; t < 10; ++t)
#pragma unroll
            for (int r = 0; r < 4; ++r) { const float pv = __builtin_amdgcn_exp2f(S[t][r] - mx); l += pv; S[t][r] = pv; }
        l += shx(l, 16, lane); l += shx(l, 32, lane);
        f32x4 O[G::NDT];
#pragma unroll
        for (int dt = 0; dt < G::NDT; ++dt) O[dt] = (f32x4){0.f, 0.f, 0.f, 0.f};
#pragma unroll
        for (int u = 0; u < 5; ++u) {
            u32x4 pw; pw.x = cvt_pk_bf16(S[2 * u][0], S[2 * u][1]); pw.y = cvt_pk_bf16(S[2 * u][2], S[2 * u][3]); pw.z = cvt_pk_bf16(S[2 * u + 1][0], S[2 * u + 1][1]); pw.w = cvt_pk_bf16(S[2 * u + 1][2], S[2 * u + 1][3]);
            const bf16x8 pb = __builtin_bit_cast(bf16x8, pw);
            const int ka = (w + 2 * u) * 16 + 4 * g4 + (lq >> 2), kb = ka + 16;
            LAS unsigned char* va = vl + ka * G::VSTR + (lane & 3) * 8; LAS unsigned char* vb = vl + kb * G::VSTR + (lane & 3) * 8;
#pragma unroll
            for (int dt = 0; dt < G::NDT; ++dt) {
                const s16x4 x = __builtin_amdgcn_ds_read_tr16_b64_v4i16((LAS s16x4*)(va + dt * 32));
                const s16x4 y = __builtin_amdgcn_ds_read_tr16_b64_v4i16((LAS s16x4*)(vb + dt * 32));
                const bf16x8 av = (bf16x8){x[0], x[1], x[2], x[3], y[0], y[1], y[2], y[3]};
                O[dt] = __builtin_amdgcn_mfma_f32_16x16x32_bf16(av, pb, O[dt], 0, 0, 0);
            }
        }
        const float inv = 1.0f / l;
        const size_t trow = I.row0 + (size_t)qi * I.d;
        bf16_t* orow = OG + trow * 1536 + I.g * 512 + I.h * 128;
#pragma unroll
        for (int dp = 0; dp < G::NDT / 2; ++dp) {
            const unsigned ax = cvt_pk_bf16(O[2 * dp][0] * inv, O[2 * dp][1] * inv), ay = cvt_pk_bf16(O[2 * dp][2] * inv, O[2 * dp][3] * inv);
            const unsigned bx_ = cvt_pk_bf16(O[2 * dp + 1][0] * inv, O[2 * dp + 1][1] * inv), by_ = cvt_pk_bf16(O[2 * dp + 1][2] * inv, O[2 * dp + 1][3] * inv);
            const u32x2 r0 = __builtin_amdgcn_permlane16_swap(ax, bx_, false, false), r1 = __builtin_amdgcn_permlane16_swap(ay, by_, false, false);
            const u32x4 wv = (u32x4){r0[0], r1[0], r0[1], r1[1]};
            *(u32x4*)(orow + ((g4 & 1) ? (2 * dp + 1) * 16 + 4 * (g4 - 1) : (2 * dp) * 16 + 4 * g4)) = wv; }
        if (g4 == 0) LSE[trow * 12 + I.g * 4 + I.h] = (mx + __builtin_amdgcn_logf(l)) * 0.6931471805599453f;
        __syncthreads();
    }
}

__device__ __forceinline__ void attn_mem_run(LAS unsigned char* lds, const bf16_t* __restrict__ PROJ, const bf16_t* __restrict__ MKV, const float* __restrict__ wq, const float* __restrict__ wk, bf16_t* __restrict__ ACT,
                                             int half, int bx, int G_, const int tid) {
    constexpr int HD = 256; typedef AttnGeo<HD> G;
    const int w = __builtin_amdgcn_readfirstlane(tid >> 6), lane = tid & 63, lq = lane & 15, g4 = lane >> 4;
    const int n = (512 - bx + G_ - 1) / G_;
    if (n <= 0) return;
#pragma unroll 1
    for (int k = 0; k < n; ++k) {
        const int idx = mem_item(bx, k, G_), qb = idx & 15, h = (idx >> 4) & 3, bl = idx >> 6, b = half * 8 + bl;
        const size_t trow = (size_t)bl * SEQ + qb * 128 + 16 * w + lq;
        u32x4 rq[G::NKS];
        issue_q<HD>(rq, PROJ + trow * PS + C_MQ + h * 256, g4);
        stage_rows<HD, true>(lds, MKV + (size_t)b * 256 * DM + h * 256, DM, wk, tid);
        bf16x8 qf[G::NKS];
        norm_q<HD>(qf, rq, wq, 0.0625f * 1.4426950408889634f, g4, lane);
        __syncthreads();
        u32x2 P[16]; float l;
        {
            f32x4 S[16];
#pragma unroll
            for (int t = 0; t < 16; ++t) {
                f32x4 sv = (f32x4){0.f, 0.f, 0.f, 0.f};
#pragma unroll
                for (int ks = 0; ks < G::NKS; ++ks) { const bf16x8 kf = *(const LAS bf16x8*)(lds + (t * 16 + lq) * G::KSTR + ks * 64 + g4 * 16); sv = __builtin_amdgcn_mfma_f32_16x16x32_bf16(kf, qf[ks], sv, 0, 0, 0); }
                S[t] = sv;
            }
            float mx = -__builtin_inff(); asm volatile("" : "+v"(mx));
#pragma unroll
            for (int t = 0; t < 16; ++t)
#pragma unroll
                for (int r = 0; r < 4; ++r) mx = fmaxf(mx, S[t][r]);
            mx = fmaxf(mx, shx(mx, 16, lane)); mx = fmaxf(mx, shx(mx, 32, lane));
            l = 0.f;
#pragma unroll
            for (int t = 0; t < 16; ++t) { const float p0 = __builtin_amdgcn_exp2f(S[t][0] - mx), p1 = __builtin_amdgcn_exp2f(S[t][1] - mx), p2 = __builtin_amdgcn_exp2f(S[t][2] - mx), p3 = __builtin_amdgcn_exp2f(S[t][3] - mx);
                l += (p0 + p1) + (p2 + p3); P[t].x = cvt_pk_bf16(p0, p1); P[t].y = cvt_pk_bf16(p2, p3); }
            l += shx(l, 16, lane); l += shx(l, 32, lane);
        }
        __syncthreads();
        stage_rows<HD, false>(lds, MKV + (size_t)b * 256 * DM + 1024 + h * 256, DM, wk, tid);
        __syncthreads();
        f32x4 O[G::NDT];
#pragma unroll
        for (int dt = 0; dt < G::NDT; ++dt) O[dt] = (f32x4){0.f, 0.f, 0.f, 0.f};
#pragma unroll
        for (int u = 0; u < 8; ++u) {
            u32x4 pw; pw.x = P[2 * u].x; pw.y = P[2 * u].y; pw.z = P[2 * u + 1].x; pw.w = P[2 * u + 1].y;
            const bf16x8 pb = __builtin_bit_cast(bf16x8, pw);
            const int ka = (2 * u) * 16 + 4 * g4 + (lq >> 2), kb = ka + 16;
            LAS unsigned char* va = lds + ka * G::VSTR + (lane & 3) * 8; LAS unsigned char* vb = lds + kb * G::VSTR + (lane & 3) * 8;
#pragma unroll
            for (int dt = 0; dt < G::NDT; ++dt) {
                const s16x4 x = __builtin_amdgcn_ds_read_tr16_b64_v4i16((LAS s16x4*)(va + dt * 32));
                const s16x4 y = __builtin_amdgcn_ds_read_tr16_b64_v4i16((LAS s16x4*)(vb + dt * 32));
                const bf16x8 av = (bf16x8){x[0], x[1], x[2], x[3], y[0], y[1], y[2], y[3]};
                O[dt] = __builtin_amdgcn_mfma_f32_16x16x32_bf16(av, pb, O[dt], 0, 0, 0);
            }
        }
        const float inv = 1.0f / l;
        const bf16_t* zrow = PROJ + trow * PS + C_ZM + h * 256; bf16_t* arow = ACT + trow * ACTW + 1536 + h * 256;
#pragma unroll
        for (int dp = 0; dp < G::NDT / 2; ++dp) {
            float va[4], vb[4];
#pragma unroll
            for (int j = 0; j < 4; ++j) { const u32x2 r = __builtin_amdgcn_permlane16_swap(__float_as_uint(O[2 * dp][j]), __float_as_uint(O[2 * dp + 1][j]), false, false); va[j] = __uint_as_float(r[0]); vb[j] = __uint_as_float(r[1]); }
            const int dofs = (g4 & 1) ? (2 * dp + 1) * 16 + 4 * (g4 - 1) : (2 * dp) * 16 + 4 * g4;
            const u32x4 z = *(const u32x4*)(zrow + dofs);
            u32x4 o; o.x = cvt_pk_bf16(va[0] * inv * siluf_(bflo(z.x)), va[1] * inv * siluf_(bfhi(z.x))); o.y = cvt_pk_bf16(va[2] * inv * siluf_(bflo(z.y)), va[3] * inv * siluf_(bfhi(z.y)));
            o.z = cvt_pk_bf16(vb[0] * inv * siluf_(bflo(z.z)), vb[1] * inv * siluf_(bfhi(z.z))); o.w = cvt_pk_bf16(vb[2] * inv * siluf_(bflo(z.w)), vb[3] * inv * siluf_(bfhi(z.w)));
            *(u32x4*)(arow + dofs) = o; }
        __syncthreads();
    }
}

#define XB_TMO      128
#define XB_XCNT(j)  (256  + 64 * (j))
#define XB_XSUB(j)  (1280 + 64 * (j))
#define XB_XGEN(j)  (2304 + 64 * (j))
#define XB_TOP      3328
#define XB_TOPGEN   3392
#define XCD_BAR_WORDS 3456
#define XB_SPIN_CAP (1u << 22)
__device__ __forceinline__ unsigned xb_ld(unsigned* p)              { return __hip_atomic_load(p, __ATOMIC_RELAXED, __HIP_MEMORY_SCOPE_AGENT); }
__device__ __forceinline__ unsigned xb_add(unsigned* p, unsigned v) { return __hip_atomic_fetch_add(p, v, __ATOMIC_RELAXED, __HIP_MEMORY_SCOPE_AGENT); }
__device__ __forceinline__ unsigned xb_xcc_id() { return (unsigned)__builtin_amdgcn_s_getreg((3 << 11) | 20) & 0xFu; }
#define XB_SPIN(cond, bar) do { unsigned _sp = 0; while (cond) { __builtin_amdgcn_s_sleep(1); \
    if ((++_sp & 255u) == 0u) { if (xb_ld(&(bar)[XB_TMO])) break; if (_sp > XB_SPIN_CAP) { atomicAdd(&(bar)[XB_TMO], 1u); break; } } } } while (0)
__device__ __forceinline__ void xcd_barrier_complete(unsigned* bar, unsigned x, unsigned& nloc, unsigned& nx) {
    const unsigned G = gridDim.x;
    unsigned sum, cnt, mine, sp = 0u;
    for (;;) {
        sum = 0u; cnt = 0u; mine = 0u;
#pragma unroll
        for (unsigned j = 0; j < 16; ++j) { const unsigned c = xb_ld(&bar[XB_XCNT(j)]); sum += c; cnt += (c > 0u) ? 1u : 0u; mine = (j == x) ? c : mine; }
        if (sum == G) break;
        __builtin_amdgcn_s_sleep(1);
        if ((++sp & 255u) == 0u) { if (xb_ld(&bar[XB_TMO])) break; if (sp > XB_SPIN_CAP) { atomicAdd(&bar[XB_TMO], 1u); break; } }
    }
    nloc = mine > 0u ? mine : 1u; nx = cnt > 0u ? cnt : 1u;
}
__device__ __forceinline__ void xcd_barrier(unsigned* bar, volatile LAS unsigned* st, bool leader_thread) {
    asm volatile("s_waitcnt vmcnt(0)" ::: "memory");
    __syncthreads();
    if (leader_thread) {
        const unsigned x = xb_xcc_id();
        __builtin_amdgcn_s_waitcnt(0);
        unsigned nloc = st[0], nx = st[1];
        if (nloc == 0u) { xcd_barrier_complete(bar, x, nloc, nx); st[0] = nloc; st[1] = nx; }
        const unsigned old = xb_add(&bar[XB_XSUB(x)], 1u);
        const unsigned gen = old / nloc;
        if (old + 1u == (gen + 1u) * nloc) {
            __builtin_amdgcn_fence(__ATOMIC_RELEASE, "agent");
            asm volatile("s_waitcnt vmcnt(0)" ::: "memory");
            const unsigned og = xb_add(&bar[XB_TOP], 1u);
            const unsigned tg = og / nx;
            if (og + 1u == (tg + 1u) * nx) xb_add(&bar[XB_TOPGEN], 1u);
            else XB_SPIN(xb_ld(&bar[XB_TOPGEN]) == tg, bar);
            __builtin_amdgcn_fence(__ATOMIC_ACQUIRE, "agent");
            xb_add(&bar[XB_XGEN(x)], 1u);
            asm volatile("s_waitcnt vmcnt(0)" ::: "memory");
        } else {
            XB_SPIN(xb_ld(&bar[XB_XGEN(x)]) == gen, bar);
            __builtin_amdgcn_fence(__ATOMIC_ACQUIRE, "agent");
            asm volatile("s_waitcnt vmcnt(0)" ::: "memory");
        }
    }
    __syncthreads();
}

struct Args { const float* in[15]; float* out; unsigned char* ws; int lo, hi; };
enum { I_X = 0, I_MEM, I_NG, I_MNG, I_WIN, I_AQN, I_AKN, I_CW, I_WKV, I_MQN, I_MKN, I_WBA, I_WBC, I_WBM, I_WOUT };
constexpr int NPHASE = 11;

__global__ void __launch_bounds__(NTHR, 2) mega(Args a) {
    extern __shared__ __attribute__((aligned(16))) unsigned char lds_raw[];
    LAS unsigned char* lds = (LAS unsigned char*)lds_raw;
    const int G = gridDim.x, bx = blockIdx.x, wave_s = __builtin_amdgcn_readfirstlane((int)threadIdx.x >> 6);
    typedef const __attribute__((address_space(4))) Args* KArgs;
    const int ph_lo = a.lo, ph_hi = a.hi;
    if (a.lo < 0) cg::this_grid().sync();
    volatile LAS unsigned* xst = (volatile LAS unsigned*)(lds + LDS_BYTES - 16);
    if (ph_hi - ph_lo > 1) {
        if (threadIdx.x == 0) { xst[0] = 0u; xst[1] = 0u; (void)xb_add(&((unsigned*)(a.ws + WS_BAR))[XB_XCNT(xb_xcc_id())], 1u); }
        __syncthreads();
    }
    for (int ph = ph_lo; ph < ph_hi; ++ph) {
        if (ph == 6 && ph_hi - ph_lo > 1) continue;
        KArgs A = (KArgs)__builtin_amdgcn_kernarg_segment_ptr(); asm volatile("" : "+s"(A));
        unsigned char* ws = A->ws;
        bf16_t* WIN = (bf16_t*)(ws + WS_WIN); bf16_t* WKV = (bf16_t*)(ws + WS_WKV); bf16_t* WBR = (bf16_t*)(ws + WS_WBR); bf16_t* WOUT = (bf16_t*)(ws + WS_WOUT);
        bf16_t* MH = (bf16_t*)(ws + WS_MH); bf16_t* MKV = (bf16_t*)(ws + WS_MKV); bf16_t* PROJ = (bf16_t*)(ws + WS_PROJ); bf16_t* OG = (bf16_t*)(ws + WS_OG);
        float* LSE = (float*)(ws + WS_LSE); bf16_t* ACT = (bf16_t*)(ws + WS_ACT); u32x2* GF = (u32x2*)(ws + WS_GF); bf16_t* MB = (bf16_t*)(ws + WS_MB);
        bf16_t* H = (bf16_t*)(ws + WS_H);
        unsigned char* H8 = (unsigned char*)A->out;
        unsigned char* WG8 = (unsigned char*)WIN + (size_t)6144 * LDP * 2;
#define MAKE_TID(name) unsigned name##_m = ~0u; asm volatile("" : "+s"(name##_m)); int name = wave_s * 64 + (int)__builtin_amdgcn_mbcnt_hi(name##_m, __builtin_amdgcn_mbcnt_lo(name##_m, 0u)); asm volatile("" : "+v"(name))
        if (ph == 1 || ph == 2 || ph == 5 || ph == 6 || ph == 9 || ph == 10) {
            const int nj = (ph == 5) ? ((ph_hi - ph_lo > 1) ? 3 : 2) : ((ph == 9 || ph == 2) ? 2 : 1), njr = ((REP_MASK >> ph) & 1) ? 2 * nj : nj;
#pragma unroll 1
            for (int jr = 0; jr < njr; ++jr) {
                const int j = jr >= nj ? jr - nj : jr;
                bf16_t* MB2 = (bf16_t*)(ws + WS_MB2);
                int what;
                int half;
                const int swp = (bx >> 3) & 1;
                u32x2* GF2 = (u32x2*)((unsigned char*)A->out + OUT_H_OFF);
                if (ph == 1) { what = 0; half = 0; }
                else if (ph == 2) { what = (j == 0) ? 1 : 4; half = 0; }
                else if (ph == 5) {
                    if (nj == 3) { const int o = swp ? (j == 2 ? 0 : j + 1) : j; what = (o == 0) ? 2 : (o == 1 ? 4 : 1); }
                    else what = ((j == 0) != (swp != 0)) ? 2 : 4;
                    half = (what == 2) ? 0 : 1; }
                else if (ph == 6) { what = 1; half = 1; }
                else if (ph == 9) { what = ((j == 0) != (swp != 0)) ? 3 : 2; half = (what == 3) ? 0 : 1; }
                else { what = 3; half = 1; }
                pg8::Gemm g; pg8::Epi E;
                if (what == 2) {
                    g = pg8::Gemm{ACT, WBR, HT, DM, ACTW, ACTW, ACTW, 0}; E = pg8::Epi{5, half ? MB2 : MB, half ? GF2 : GF, nullptr, DM, 1 << 20, 1.0f, 1 << 20, 0, 0, 1 << 20, 0, 0};
                } else if (what == 0) {
                    g = pg8::Gemm{MH, WKV, 4096, DM, DM, DM, DM, 0}; E = pg8::Epi{0, MKV, nullptr, nullptr, DM, 1 << 20, 1.0f, 1 << 20, 0, 0, 1 << 20, 0, 0};
                } else if (what == 3) {
                    const size_t ro = half ? (size_t)HT * DM : 0;
                    g = pg8::Gemm{half ? MB2 : MB, WOUT, HT, DM, DM, DM, DM, 0}; E = pg8::Epi{4, A->out + ro, A->in[I_X] + ro, nullptr, DM, 1 << 20, 1.0f, 1 << 20, 0, 0, 1 << 20, 0, 0};
                } else if (what == 1) {
                    g = pg8::Gemm{H + (size_t)half * HT * LDP, WIN, HT, 6144, DM, LDP, LDP, 0};
                    E = pg8::Epi{0, PROJ, nullptr, half ? GF2 : GF, PS, 16, 1.0f, 1 << 20, C_CB, 0, 1 << 20, 8, 0};
                } else {
                    g = pg8::Gemm{(const bf16_t*)(H8 + (size_t)half * HT * DM), (const bf16_t*)WG8, HT, PS, DM / 2, DM / 2, DM / 2, 1};
                    E = pg8::Epi{0, PROJ, nullptr, half ? GF2 : GF, PS, 28, 1.0f / 64.0f, 20, 0, C_MQ, 36, 0, 16};
                }
                if (GEMM1_STAGGER_US > 0 && g.N == PS) {
                    const unsigned long long t0 = __builtin_amdgcn_s_memrealtime(), dl = (unsigned long long)(((bx >> 3) & 3) * GEMM1_STAGGER_US * 100);
                    while (__builtin_amdgcn_s_memrealtime() - t0 < dl) __builtin_amdgcn_s_sleep(8);
                }
                pg8::StaticOrder S; S.init(g.M, g.N, G, bx);
                unsigned ones2 = ~0u; asm volatile("" : "+s"(ones2));
                int tidj = wave_s * 64 + (int)__builtin_amdgcn_mbcnt_hi(ones2, __builtin_amdgcn_mbcnt_lo(ones2, 0u)); asm volatile("" : "+v"(tidj));
                if (g.f8) pg8::gemm_phase<true>(lds, g, S, E, tidj); else pg8::gemm_phase<false>(lds, g, S, E, tidj);
            }
        }
        if (ph == 0 || ph == 1) {
            MAKE_TID(tid);
            const int lane = tid & 63, wave = tid >> 6;
            if (ph == 0) rmsnorm_rows(A->in[I_MEM], A->in[I_MNG], MH, DM, nullptr, 4096, bx * 8 + wave, G * 8, lane);
            else rmsnorm_rows(A->in[I_X], A->in[I_NG], H, LDP, H8, NTOK, bx * 8 + wave, G * 8, lane);
            const PrepPtrs PP{A->in[I_WIN], A->in[I_WKV], A->in[I_WBA], A->in[I_WBC], A->in[I_WBM], A->in[I_WOUT], WIN, WKV, WBR, WOUT, WG8};
            constexpr int T0 = PT0, T5 = PT5;
            const int tb = (ph == 0) ? 0 : T0, te = (ph == 0) ? T0 : T5;
            if (tb + bx < te) {
                float4 v[4]; TJob J = prep_job(tb + bx, PP); tile_load(v, J, tid);
#pragma unroll 1
                for (int t = tb + bx; t < te; t += G) {
                    float4 vn[4]; const int tn = (t + G < te) ? t + G : t; const TJob Jn = prep_job(tn, PP); tile_load(vn, Jn, tid);
                    tile_store((LAS float*)lds, v, J, tid);
                    J = Jn;
#pragma unroll
                    for (int p = 0; p < 4; ++p) v[p] = vn[p];
                }
            }
        } else if (ph == 3 || ph == 7) {
            const int half = (ph == 3) ? 0 : 1;
            MAKE_TID(tid);
#pragma unroll 1
            for (int rep = 0; rep < REP_BAND; ++rep)
            attn_banded_run(lds, PROJ, A->in[I_AQN], A->in[I_AKN], OG, LSE, bx, G, tid);
#pragma unroll 1
            for (int rep = 0; rep < REP_MEM; ++rep)
            attn_mem_run(lds, PROJ, MKV, A->in[I_MQN], A->in[I_MKN], ACT, half, bx, G, tid);
        } else if (ph == 4 || ph == 8) {
            MAKE_TID(tid);
            const int gt = bx * NTHR + tid, nth = G * NTHR;
            for (int idx = gt; idx < HT * 64; idx += nth) {
                const int row = idx >> 6, c8 = (idx & 63) * 8, h = c8 >> 7;
                const float l0 = LSE[(size_t)row * 12 + h], l1 = LSE[(size_t)row * 12 + 4 + h], l2 = LSE[(size_t)row * 12 + 8 + h];
                const float m = fmaxf(l0, fmaxf(l1, l2)); float w0 = __expf(l0 - m), w1 = __expf(l1 - m), w2 = __expf(l2 - m); const float inv = 1.0f / (w0 + w1 + w2); w0 *= inv; w1 *= inv; w2 *= inv;
                const u32x4 o0 = *(const u32x4*)(OG + (size_t)row * 1536 + c8), o1 = *(const u32x4*)(OG + (size_t)row * 1536 + 512 + c8), o2 = *(const u32x4*)(OG + (size_t)row * 1536 + 1024 + c8);
                const u32x4 z = *(const u32x4*)(PROJ + (size_t)row * PS + C_ZA + c8);
                u32x4 o;
#define CMB(k) o.k = cvt_pk_bf16((w0 * bflo(o0.k) + w1 * bflo(o1.k) + w2 * bflo(o2.k)) * siluf_(bflo(z.k)), (w0 * bfhi(o0.k) + w1 * bfhi(o1.k) + w2 * bfhi(o2.k)) * siluf_(bfhi(z.k)))
                CMB(x); CMB(y); CMB(z); CMB(w);
#undef CMB
                *(u32x4*)(ACT + (size_t)row * ACTW + c8) = o;
            }
            const float* cw = A->in[I_CW];
            for (int idx = gt; idx < HT * 128; idx += nth) {
                const int row = idx >> 7, c8 = (idx & 127) * 8, t = row & (SEQ - 1);
                const bf16_t* pr = PROJ + (size_t)row * PS;
                unsigned zl = 0u; asm volatile("" : "+v"(zl)); const u32x4 z4 = (u32x4){zl, zl, zl, zl};
                const u32x4 c0 = *(const u32x4*)(pr + C_CC + c8), v0 = *(const u32x4*)(pr + C_CV + c8);
                const u32x4 c1 = t >= 1 ? *(const u32x4*)(pr - PS + C_CC + c8) : z4, v1 = t >= 1 ? *(const u32x4*)(pr - PS + C_CV + c8) : z4;
                const u32x4 c2 = t >= 2 ? *(const u32x4*)(pr - 2 * PS + C_CC + c8) : z4, v2 = t >= 2 ? *(const u32x4*)(pr - 2 * PS + C_CV + c8) : z4;
                const u32x4 bb = *(const u32x4*)(pr + C_CB + c8), zz = *(const u32x4*)(pr + C_ZC + c8);
                const float4 wa0 = *(const float4*)(cw + c8), wb0 = *(const float4*)(cw + c8 + 4), wa1 = *(const float4*)(cw + 1024 + c8), wb1 = *(const float4*)(cw + 1024 + c8 + 4), wa2 = *(const float4*)(cw + 2048 + c8), wb2 = *(const float4*)(cw + 2048 + c8 + 4);
                u32x4 o;
#define CV1(f, k, W0, W1, W2) ((W0 * (f(c0.k) * f(v0.k)) + W1 * (f(c1.k) * f(v1.k)) + W2 * (f(c2.k) * f(v2.k))) * f(bb.k) * siluf_(f(zz.k)))
                o.x = cvt_pk_bf16(CV1(bflo, x, wa0.x, wa1.x, wa2.x), CV1(bfhi, x, wa0.y, wa1.y, wa2.y));
                o.y = cvt_pk_bf16(CV1(bflo, y, wa0.z, wa1.z, wa2.z), CV1(bfhi, y, wa0.w, wa1.w, wa2.w));
                o.z = cvt_pk_bf16(CV1(bflo, z, wb0.x, wb1.x, wb2.x), CV1(bfhi, z, wb0.y, wb1.y, wb2.y));
                o.w = cvt_pk_bf16(CV1(bflo, w, wb0.z, wb1.z, wb2.z), CV1(bfhi, w, wb0.w, wb1.w, wb2.w));
#undef CV1
                *(u32x4*)(ACT + (size_t)row * ACTW + 512 + c8) = o;
            }
        }
        if (ph + 1 < ph_hi) {
            { MAKE_TID(tb_); xcd_barrier((unsigned*)(A->ws + WS_BAR), xst, tb_ == 0); }
        }
        if (ph == 0 && ph_hi - ph_lo > 1) { for (int e = 0; e < EXTRA_SYNCS; ++e) cg::this_grid().sync(); }
    }
}

extern "C" void kernel_launch(void* const* d_in, const int* in_sizes, int n_in, void* d_out, int out_size, void* d_ws, size_t ws_size, hipStream_t stream) {
    static int grid = 0;
    if (grid == 0) {
        if (n_in != 15 || ws_size < WS_END) { fprintf(stderr, "kernel_launch: unexpected inputs (n_in %d, ws %zu < %zu)\n", n_in, ws_size, (size_t)WS_END); grid = -1; return; }
        int dev = 0, cus = 0, per_cu = 0;
        hipGetDevice(&dev); hipDeviceGetAttribute(&cus, hipDeviceAttributeMultiprocessorCount, dev);
        if (hipFuncSetAttribute((const void*)mega, hipFuncAttributeMaxDynamicSharedMemorySize, LDS_BYTES) != hipSuccess) { fprintf(stderr, "kernel_launch: hipFuncSetAttribute failed\n"); grid = -1; return; }
        hipOccupancyMaxActiveBlocksPerMultiprocessor(&per_cu, (const void*)mega, NTHR, LDS_BYTES);
        if (per_cu < 1) per_cu = 1;
        grid = cus * 1;
        (void)hipGetLastError();
    }
    if (grid < 0) return;
    Args a{};
    for (int i = 0; i < 15; ++i) a.in[i] = (const float*)d_in[i];
    a.out = (float*)d_out; a.ws = (unsigned char*)d_ws;
#if ONE_LAUNCH
    (void)hipMemsetAsync((unsigned char*)d_ws + WS_BAR, 0, 16384, stream);
    a.lo = 0; a.hi = NPHASE;
    void* args[] = {&a};
    hipError_t e = hipLaunchCooperativeKernel((const void*)mega, dim3(grid), dim3(NTHR), args, LDS_BYTES, stream);
    if (e != hipSuccess) fprintf(stderr, "cooperative launch failed: %s (grid %d)\n", hipGetErrorString(e), grid);
#else
    for (int ph = 0; ph < NPHASE; ++ph) { a.lo = ph; a.hi = ph + 1; hipLaunchKernelGGL(mega, dim3(grid), dim3(NTHR), LDS_BYTES, stream, a); }
#endif
}
```

```cpp
#include <hip/hip_runtime.h>
#include <hip/hip_cooperative_groups.h>
#include <cstdio>
namespace cg = cooperative_groups;

#ifndef ONE_LAUNCH
#define ONE_LAUNCH 1
#endif

#ifndef REP_MASK
#define REP_MASK 0
#endif
#define GEMM1_STAGGER_US 0
#define REP_BAND 1
#define REP_MEM 1
#define REP_PREP 1
#define EXTRA_SYNCS 0
#ifndef PG8_SP2
#define PG8_SP2 1
#endif
#define LAS __attribute__((address_space(3)))
typedef unsigned short bf16_t;
typedef short bf16x8 __attribute__((ext_vector_type(8)));
typedef short s16x4 __attribute__((ext_vector_type(4)));
typedef float f32x4 __attribute__((ext_vector_type(4)));
typedef unsigned u32x4 __attribute__((ext_vector_type(4)));
typedef unsigned u32x2 __attribute__((ext_vector_type(2)));
typedef int i32x8 __attribute__((ext_vector_type(8)));
typedef int i32x4 __attribute__((ext_vector_type(4)));
typedef short s16x16 __attribute__((ext_vector_type(16)));

constexpr int DM = 2048, SEQ = 2048, NB = 16, NTOK = NB * SEQ;
constexpr int PC = 17408;
constexpr int PS = 11264;
constexpr int HT = NTOK / 2;
constexpr int C_Q = 0, C_K = 1536, C_V = 3072, C_ZA = 4608, C_CB = 5120, C_CC = 6144, C_CV = 7168, C_ZC = 8192, C_MQ = 9216, C_ZM = 10240, C_G = 11264;
constexpr int ACTW = 2560;
constexpr int LDP = 2048 + 64;
constexpr float EPSF = 1e-6f;
constexpr int NTHR = 512;
constexpr int LDS_BYTES = 149504;

constexpr size_t WS_WIN = 0;
constexpr size_t WS_WKV = WS_WIN + (size_t)PC * LDP * 2;
constexpr size_t WS_WBR = WS_WKV + (size_t)DM * DM * 2;
constexpr size_t WS_WOUT = WS_WBR + (size_t)DM * ACTW * 2;
constexpr size_t WS_MH = WS_WOUT + (size_t)DM * DM * 2;
constexpr size_t WS_MKV = WS_MH + (size_t)4096 * DM * 2;
constexpr size_t WS_PROJ = WS_MKV + (size_t)4096 * DM * 2;
constexpr size_t WS_OG = WS_PROJ + (size_t)HT * PS * 2;
constexpr size_t WS_LSE = WS_OG + (size_t)HT * 1536 * 2;
constexpr size_t WS_ACT = WS_LSE + (size_t)HT * 12 * 4;
constexpr size_t WS_GF = WS_ACT + (size_t)HT * ACTW * 2;
constexpr size_t WS_MB = WS_GF + (size_t)HT * 6144;
constexpr size_t WS_MB2 = WS_MB + (size_t)HT * DM * 2;
constexpr size_t WS_H = WS_MB2 + (size_t)HT * DM * 2;
constexpr size_t WS_BAR = WS_H + (size_t)NTOK * LDP * 2;
constexpr size_t WS_END = WS_BAR + 16384;
constexpr size_t OUT_H_OFF = (size_t)HT * DM * 4;

__device__ __forceinline__ float bflo(unsigned w) { return __uint_as_float(w << 16); }
__device__ __forceinline__ float bfhi(unsigned w) { return __uint_as_float(w & 0xffff0000u); }
typedef __bf16 bf16x2_t __attribute__((ext_vector_type(2)));
typedef float f32x2_t __attribute__((ext_vector_type(2)));
__device__ __forceinline__ unsigned cvt_pk_bf16(float lo, float hi) { f32x2_t v = {lo, hi}; bf16x2_t b = __builtin_convertvector(v, bf16x2_t); return __builtin_bit_cast(unsigned, b); }
__device__ __forceinline__ float shx(float v, int mask, int lane) { return __int_as_float(__builtin_amdgcn_ds_bpermute(((lane ^ mask) & 63) << 2, __float_as_int(v))); }
__device__ __forceinline__ u32x4 xchg8_dpp(const u32x4 snd) {
    u32x4 r; r.x = (unsigned)__builtin_amdgcn_mov_dpp((int)snd.x, 0x128, 0xf, 0xf, true); r.y = (unsigned)__builtin_amdgcn_mov_dpp((int)snd.y, 0x128, 0xf, 0xf, true);
    r.z = (unsigned)__builtin_amdgcn_mov_dpp((int)snd.z, 0x128, 0xf, 0xf, true); r.w = (unsigned)__builtin_amdgcn_mov_dpp((int)snd.w, 0x128, 0xf, 0xf, true); return r;
}
__device__ __forceinline__ float sigmoidf_(float x) { return __builtin_amdgcn_rcpf(1.0f + __builtin_amdgcn_exp2f(x * -1.4426950408889634f)); }
__device__ __forceinline__ float siluf_(float x) { return x * __builtin_amdgcn_rcpf(1.0f + __builtin_amdgcn_exp2f(x * -1.4426950408889634f)); }

namespace pg8 {
constexpr int BM = 256, BK = 64, HALF = 128, HTB = HALF * BK * 2, STAGE_BYTES = 8 * HTB, NXCD = 8, WGM = 8;
__host__ __device__ __forceinline__ int lds_byte(int r, int c) { const int st = (r >> 4) * 2 + (c >> 5), rr = r & 15, cc = c & 31, ob = rr * 64 + cc * 2; return st * 1024 + (ob ^ (((ob >> 9) & 1) << 5)); }
__host__ __device__ __forceinline__ void stage_rc(int b, int& R, int& C) { const int st = b / 1024, sb = b % 1024, swz = sb ^ (((sb >> 9) & 1) << 5); R = (st >> 1) * 16 + swz / 64; C = (st & 1) * 32 + (swz % 64) / 2; }
__host__ __device__ __forceinline__ int perm32(int rho) { const int n = rho >> 4, i = rho & 15; return 8 * (i >> 2) + 4 * n + (i & 3); }
struct Unit { int pm, pn; };
struct Gemm { const bf16_t* A; const bf16_t* Bt; int M, N, K, lda, ldb, f8; };
struct StaticOrder {
    int nM, nN, nwg, G, c;
    __device__ void init(int M, int N, int G_, int c_) { nM = M / BM; nN = N / BM; nwg = nM * nN; G = G_; c = c_; }
    __device__ bool next(int i, Unit& u) const {
        const long L = (long)i * G + c; if (L >= nwg) return false;
        int wgid = (int)L; { const int q = nwg / NXCD, r = nwg % NXCD, xcd = wgid % NXCD, off = wgid / NXCD; wgid = (xcd < r ? xcd * (q + 1) : r * (q + 1) + (xcd - r) * q) + off; }
        const int nig = WGM * nN, gid = wgid / nig, fm = gid * WGM, gsz = (nM - fm) < WGM ? (nM - fm) : WGM;
        u.pm = fm + ((wgid % nig) % gsz); u.pn = (wgid % nig) / gsz; return true;
    }
};

struct Epi;
template <bool F8, class Epi, class Sched>
__device__ __forceinline__ void gemm_phase(LAS unsigned char* lds, const Gemm g, const Sched& S, const Epi& E, const int tid) {
    const int wid = __builtin_amdgcn_readfirstlane(tid >> 6), lane = tid & 63, wr = wid >> 2, wc = wid & 3, fr = lane & 15, fq = lane >> 4;
    const int K = g.K, nt = K / BK;
    unsigned voffA[2], voffB[2];
#pragma unroll
    for (int i = 0; i < 2; ++i) { int R, C; stage_rc(tid * 16 + i * 8192, R, C); const int Rb = 2 * (R & ~31) + (E.perm() ? perm32(R & 31) : (R & 31));
        voffA[i] = (unsigned)(R * g.lda + C) * 2u; voffB[i] = (unsigned)(Rb * g.ldb + C) * 2u; }
    const size_t kstep = (size_t)(BK * 2);
    const size_t hstepA = (size_t)HALF * g.lda * 2, hstepB = (size_t)32 * g.ldb * 2;
    const size_t tstepA = 2 * hstepA, tstepB = (size_t)BM * g.ldb * 2;
    const unsigned ldsw = (unsigned)wid * 1024u;
    const int aoff = lds_byte(wr * 64 + fr, fq * 8), boff = lds_byte(wc * 32 + fr, fq * 8);
#define PG8_SA(b, h) (((b) * 2 + (h)) * HTB)
#define PG8_SB(b, h) ((4 + (b) * 2 + (h)) * HTB)
#define PG8_STAGE(bufoff, gbase, voff) do { _Pragma("unroll") for (int _i = 0; _i < 2; ++_i) \
        __builtin_amdgcn_global_load_lds((const unsigned*)((const char*)(gbase) + (voff)[_i]), (LAS unsigned*)(lds + (bufoff) + ldsw + _i * 8192), 16, 0, 0); } while (0)
#define PG8_LD8(p) __builtin_shufflevector(*(const LAS i32x4*)(p), *(const LAS i32x4*)((p) + 1024), 0, 1, 2, 3, 4, 5, 6, 7)
#define PG8_LDA(dst, b, h) do { _Pragma("unroll") for (int m = 0; m < 4; ++m) dst[m] = PG8_LD8(lds + PG8_SA(b, h) + aoff + m * 2048); } while (0)
#define PG8_LDB(dst, b, h) do { _Pragma("unroll") for (int n = 0; n < 2; ++n) dst[n] = PG8_LD8(lds + PG8_SB(b, h) + boff + n * 2048); } while (0)
#define PG8_LO(v) __builtin_bit_cast(bf16x8, __builtin_shufflevector(v, v, 0, 1, 2, 3))
#define PG8_HI(v) __builtin_bit_cast(bf16x8, __builtin_shufflevector(v, v, 4, 5, 6, 7))
#define PG8_MMA(ai, bj, At, Bt) do { __builtin_amdgcn_s_setprio(1); \
        if constexpr (F8) { _Pragma("unroll") for (int m = 0; m < 4; ++m) _Pragma("unroll") for (int n = 0; n < 2; ++n) \
            asm volatile("v_mfma_scale_f32_16x16x128_f8f6f4 %0, %1, %2, %0, %3, %3 op_sel_hi:[0,0,0]" : "+v"(acc[ai][bj][m][n]) : "v"(Bt[n]), "v"(At[m]), "v"(mxs)); } \
        else { _Pragma("unroll") for (int m = 0; m < 4; ++m) _Pragma("unroll") for (int n = 0; n < 2; ++n) { \
            acc[ai][bj][m][n] = __builtin_amdgcn_mfma_f32_16x16x32_bf16(PG8_LO(Bt[n]), PG8_LO(At[m]), acc[ai][bj][m][n], 0, 0, 0); \
            acc[ai][bj][m][n] = __builtin_amdgcn_mfma_f32_16x16x32_bf16(PG8_HI(Bt[n]), PG8_HI(At[m]), acc[ai][bj][m][n], 0, 0, 0); } } \
        __builtin_amdgcn_s_setprio(0); } while (0)
#define PG8_WAIT_V(n) asm volatile("s_waitcnt vmcnt(" #n ")" ::: "memory")
#define PG8_WAIT_L(n) asm volatile("s_waitcnt lgkmcnt(" #n ")" ::: "memory")
#define PG8_BAR __builtin_amdgcn_s_barrier()
#define PG8_SCHED __builtin_amdgcn_sched_barrier(0)
    Unit cur, nxt; int ui = 0;
    if (!S.next(0, cur)) return;
    int mxs = 0x7f7f7f7f; if constexpr (F8) asm volatile("" : "+v"(mxs));
    f32x4 acc[2][2][4][2];
#pragma unroll
    for (int a = 0; a < 2; ++a)
#pragma unroll
        for (int b = 0; b < 2; ++b)
#pragma unroll
            for (int m = 0; m < 4; ++m)
#pragma unroll
                for (int n = 0; n < 2; ++n) acc[a][b][m][n] = (f32x4){0.f, 0.f, 0.f, 0.f};
    i32x8 At[4], B0[2], B1[2];
    const char* cA = (const char*)g.A + (size_t)cur.pm * tstepA; const char* cB = (const char*)g.Bt + (size_t)cur.pn * tstepB;
#if PG8_SP2
    PG8_STAGE(PG8_SB(0, 0), cB, voffB); PG8_STAGE(PG8_SB(0, 1), cB + hstepB, voffB); PG8_STAGE(PG8_SA(0, 0), cA, voffA); PG8_STAGE(PG8_SA(0, 1), cA + hstepA, voffA);
    if (wr == 1) PG8_BAR;
    PG8_WAIT_V(2); PG8_BAR;
    PG8_STAGE(PG8_SB(1, 0), cB + kstep, voffB); PG8_STAGE(PG8_SA(1, 0), cA + kstep, voffA); PG8_STAGE(PG8_SB(1, 1), cB + hstepB + kstep, voffB);
    PG8_WAIT_V(6); PG8_BAR;
#else
    PG8_STAGE(PG8_SB(0, 0), cB, voffB); PG8_STAGE(PG8_SA(0, 0), cA, voffA); PG8_STAGE(PG8_SB(0, 1), cB + hstepB, voffB); PG8_STAGE(PG8_SA(0, 1), cA + hstepA, voffA);
    if (wr == 1) PG8_BAR;
    PG8_WAIT_V(4); PG8_BAR;
    PG8_STAGE(PG8_SB(1, 0), cB + kstep, voffB); PG8_STAGE(PG8_SA(1, 0), cA + kstep, voffA); PG8_STAGE(PG8_SB(1, 1), cB + hstepB + kstep, voffB);
    PG8_WAIT_V(6); PG8_BAR;
#endif
    for (;;) {
        const bool has_next = S.next(ui + 1, nxt);
        const char* nA = has_next ? (const char*)g.A + (size_t)nxt.pm * tstepA : cA; const char* nB = has_next ? (const char*)g.Bt + (size_t)nxt.pn * tstepB : cB;
        for (int t = 0; t < nt; t += 2) {
            const bool last = (t == nt - 2);
            const char* a1 = cA + (size_t)(t + 1) * kstep;
            const char* a2 = last ? nA : cA + (size_t)(t + 2) * kstep; const char* b2 = last ? nB : cB + (size_t)(t + 2) * kstep;
            const char* a3 = a2 + kstep; const char* b3 = b2 + kstep;
            if constexpr (!F8) { if (E.has_mid() && (t == 8 || t == 24)) E.mid(acc, cur, tid, t == 8 ? 0 : 1); }
#if PG8_SP2
            PG8_LDB(B0, 0, 0); PG8_LDB(B1, 0, 1); PG8_SCHED; PG8_LDA(At, 0, 0); PG8_STAGE(PG8_SA(1, 1), a1 + hstepA, voffA);
            PG8_WAIT_V(8); PG8_WAIT_L(0); PG8_BAR; PG8_MMA(0, 0, At, B0); PG8_MMA(0, 1, At, B1); PG8_BAR; PG8_SCHED;
            PG8_LDA(At, 0, 1); PG8_STAGE(PG8_SB(0, 0), b2, voffB); PG8_STAGE(PG8_SB(0, 1), b2 + hstepB, voffB); PG8_STAGE(PG8_SA(0, 0), a2, voffA);
            PG8_WAIT_V(8); PG8_WAIT_L(0); PG8_BAR; PG8_MMA(1, 0, At, B0); PG8_MMA(1, 1, At, B1); PG8_BAR; PG8_SCHED;
            PG8_LDB(B0, 1, 0); PG8_LDB(B1, 1, 1); PG8_SCHED; PG8_LDA(At, 1, 0); PG8_STAGE(PG8_SA(0, 1), a2 + hstepA, voffA);
            PG8_WAIT_V(8); PG8_WAIT_L(0); PG8_BAR; PG8_MMA(0, 0, At, B0); PG8_MMA(0, 1, At, B1); PG8_BAR; PG8_SCHED;
            PG8_LDA(At, 1, 1); PG8_STAGE(PG8_SB(1, 0), b3, voffB); PG8_STAGE(PG8_SB(1, 1), b3 + hstepB, voffB); PG8_STAGE(PG8_SA(1, 0), a3, voffA);
            PG8_WAIT_V(8); PG8_WAIT_L(0); PG8_BAR; PG8_MMA(1, 0, At, B0); PG8_MMA(1, 1, At, B1); PG8_BAR; PG8_SCHED;
#else
            PG8_LDB(B0, 0, 0); PG8_SCHED; PG8_LDA(At, 0, 0); PG8_STAGE(PG8_SA(1, 1), a1 + hstepA, voffA);
            PG8_WAIT_L(8); PG8_BAR; PG8_WAIT_L(0); PG8_MMA(0, 0, At, B0); PG8_BAR; PG8_SCHED;
            PG8_LDB(B1, 0, 1); PG8_STAGE(PG8_SB(0, 0), b2, voffB);
            PG8_BAR; PG8_WAIT_L(0); PG8_MMA(0, 1, At, B1); PG8_BAR;
            PG8_LDA(At, 0, 1); PG8_STAGE(PG8_SA(0, 0), a2, voffA);
            PG8_BAR; PG8_WAIT_L(0); PG8_MMA(1, 0, At, B0); PG8_BAR; PG8_SCHED;
            PG8_STAGE(PG8_SB(0, 1), b2 + hstepB, voffB);
            PG8_WAIT_V(6); PG8_BAR; PG8_MMA(1, 1, At, B1); PG8_BAR;
            PG8_LDB(B0, 1, 0); PG8_SCHED; PG8_LDA(At, 1, 0); PG8_STAGE(PG8_SA(0, 1), a2 + hstepA, voffA);
            PG8_WAIT_L(8); PG8_BAR; PG8_WAIT_L(0); PG8_MMA(0, 0, At, B0); PG8_BAR; PG8_SCHED;
            PG8_LDB(B1, 1, 1); PG8_STAGE(PG8_SB(1, 0), b3, voffB);
            PG8_BAR; PG8_WAIT_L(0); PG8_MMA(0, 1, At, B1); PG8_BAR;
            PG8_LDA(At, 1, 1); PG8_STAGE(PG8_SA(1, 0), a3, voffA);
            PG8_BAR; PG8_WAIT_L(0); PG8_MMA(1, 0, At, B0); PG8_BAR; PG8_SCHED;
            PG8_STAGE(PG8_SB(1, 1), b3 + hstepB, voffB);
            PG8_WAIT_V(6); PG8_BAR; PG8_MMA(1, 1, At, B1); PG8_BAR;
#endif
        }
        if (wr == 0) PG8_BAR;
        if constexpr (F8) {
            asm volatile("s_nop 15\n\ts_nop 15"
                         : "+v"(acc[1][0][0][0]), "+v"(acc[1][0][0][1]), "+v"(acc[1][0][1][0]), "+v"(acc[1][0][1][1]), "+v"(acc[1][0][2][0]), "+v"(acc[1][0][2][1]), "+v"(acc[1][0][3][0]), "+v"(acc[1][0][3][1]),
                           "+v"(acc[1][1][0][0]), "+v"(acc[1][1][0][1]), "+v"(acc[1][1][1][0]), "+v"(acc[1][1][1][1]), "+v"(acc[1][1][2][0]), "+v"(acc[1][1][2][1]), "+v"(acc[1][1][3][0]), "+v"(acc[1][1][3][1]));
            E.k0(acc, cur, wr, wc, fr, fq, tid);
        } else E(acc, cur, wr, wc, fr, fq, tid);
        if (!has_next) break;
#pragma unroll
        for (int a = 0; a < 2; ++a)
#pragma unroll
            for (int b = 0; b < 2; ++b)
#pragma unroll
                for (int m = 0; m < 4; ++m)
#pragma unroll
                    for (int n = 0; n < 2; ++n) acc[a][b][m][n] = (f32x4){0.f, 0.f, 0.f, 0.f};
        cur = nxt; cA = nA; cB = nB; ++ui;
        if (wr == 1) PG8_BAR;
    }
    PG8_WAIT_V(0);
    PG8_BAR;
#undef PG8_SA
#undef PG8_SB
#undef PG8_STAGE
#undef PG8_LDA
#undef PG8_LDB
#undef PG8_MMA
#undef PG8_LD8
#undef PG8_LO
#undef PG8_HI
#undef PG8_WAIT_V
#undef PG8_WAIT_L
#undef PG8_BAR
#undef PG8_SCHED
}

struct Epi {
    int kind; void* p0; const void* p1; void* p2; int ldc, gpn0; float gscale; int split, off0, off1, gpn1, gb0, gb1;
    __device__ __forceinline__ bool perm() const { return kind != 4; }
    __device__ __forceinline__ bool has_mid() const { return kind == 5; }
    __device__ __forceinline__ void mid(f32x4 (&acc)[2][2][4][2], const Unit& u, int tid, int which) const {
        const u32x2* ga = (const u32x2*)p1 + ((size_t)(u.pm * 24 + 8 * which + u.pn) * 16) * 512 + tid; const u32x2* gb = ga + (size_t)8 * 16 * 512;
        u32x2 x[16], y[16];
#pragma unroll
        for (int i = 0; i < 16; ++i) { x[i] = ga[i * 512]; y[i] = gb[i * 512]; }
        asm volatile("s_waitcnt vmcnt(0)" ::: "memory");
#pragma unroll
        for (int i = 0; i < 16; ++i) { const int ai = i >> 3, m = (i >> 1) & 3, bj = i & 1; const u32x2 a = x[i], b = y[i];
#define QR(wa, wb, sh) __builtin_amdgcn_exp2f(((float)(((wb) >> (sh)) & 0xffu) - (float)(((wa) >> (sh)) & 0xffu)) * 0.03125f)
            acc[ai][bj][m][0] *= (f32x4){QR(a.x, b.x, 0), QR(a.x, b.x, 8), QR(a.x, b.x, 16), QR(a.x, b.x, 24)};
            acc[ai][bj][m][1] *= (f32x4){QR(a.y, b.y, 0), QR(a.y, b.y, 8), QR(a.y, b.y, 16), QR(a.y, b.y, 24)};
#undef QR
        }
    }
    __device__ __forceinline__ void gate(const f32x4 (&acc)[2][2][4][2], const Unit& u, int tid) const {
            const int gi = (u.pn < gpn1) ? gb0 + (u.pn - gpn0) : gb1 + (u.pn - gpn1);
            u32x2* gf = (u32x2*)p2 + ((size_t)(u.pm * 24 + gi) * 16) * 512 + tid;
            const float nls = -1.4426950408889634f * gscale;
#pragma unroll
            for (int ai = 0; ai < 2; ++ai)
#pragma unroll
                for (int m = 0; m < 4; ++m)
#pragma unroll
                    for (int bj = 0; bj < 2; ++bj) { const f32x4 v0 = acc[ai][bj][m][0], v1 = acc[ai][bj][m][1];
#define QF(v) (__builtin_amdgcn_logf(1.0f + __builtin_amdgcn_exp2f((v) * nls)) * 32.0f)
#define QP(a, b, c, d) __builtin_amdgcn_cvt_pk_u8_f32(QF(d), 3, __builtin_amdgcn_cvt_pk_u8_f32(QF(c), 2, __builtin_amdgcn_cvt_pk_u8_f32(QF(b), 1, __builtin_amdgcn_cvt_pk_u8_f32(QF(a), 0, 0u))))
                        u32x2 w; w.x = QP(v0[0], v0[1], v0[2], v0[3]); w.y = QP(v1[0], v1[1], v1[2], v1[3]);
#undef QP
#undef QF
                        __builtin_nontemporal_store(w, &gf[((ai * 4 + m) * 2 + bj) * 512]); }
    }
    __device__ __forceinline__ void k0store(const f32x4 (&acc)[2][2][4][2], const Unit& u, int wr, int wc, int fr, int fq) const {
        const bool lo = fr < 8;
        const int row0 = u.pm * BM + wr * 64 + (fr & 7);
        bf16_t* O = (bf16_t*)p0; const int col0 = ((u.pn < split) ? off0 + u.pn * BM : off1 + (u.pn - split) * BM) + wc * 64 + 8 * fq + (lo ? 0 : 32); const float sc = gscale;
#pragma unroll
        for (int ai = 0; ai < 2; ++ai)
#pragma unroll
            for (int m = 0; m < 4; ++m) { bf16_t* rowp = O + (size_t)(row0 + ai * HALF + m * 16) * ldc + col0;
                const f32x4 a0 = acc[ai][0][m][0] * sc, a1 = acc[ai][0][m][1] * sc, b0 = acc[ai][1][m][0] * sc, b1 = acc[ai][1][m][1] * sc;
                u32x4 w0, w1; w0.x = cvt_pk_bf16(a0[0], a0[1]); w0.y = cvt_pk_bf16(a0[2], a0[3]); w0.z = cvt_pk_bf16(a1[0], a1[1]); w0.w = cvt_pk_bf16(a1[2], a1[3]);
                w1.x = cvt_pk_bf16(b0[0], b0[1]); w1.y = cvt_pk_bf16(b0[2], b0[3]); w1.z = cvt_pk_bf16(b1[0], b1[1]); w1.w = cvt_pk_bf16(b1[2], b1[3]);
                const u32x4 snd = lo ? w1 : w0; u32x4 rcv;
                rcv.x = (unsigned)__builtin_amdgcn_mov_dpp((int)snd.x, 0x128, 0xf, 0xf, true); rcv.y = (unsigned)__builtin_amdgcn_mov_dpp((int)snd.y, 0x128, 0xf, 0xf, true);
                rcv.z = (unsigned)__builtin_amdgcn_mov_dpp((int)snd.z, 0x128, 0xf, 0xf, true); rcv.w = (unsigned)__builtin_amdgcn_mov_dpp((int)snd.w, 0x128, 0xf, 0xf, true);
                const u32x4 sa = lo ? w0 : rcv, sb = lo ? rcv : w1;
                __builtin_nontemporal_store(sa, (u32x4*)rowp);
                __builtin_nontemporal_store(sb, (u32x4*)(rowp + (size_t)8 * ldc)); }
    }
    __device__ __forceinline__ void k0(const f32x4 (&acc)[2][2][4][2], const Unit& u, int wr, int wc, int fr, int fq, int tid) const {
        if (u.pn >= gpn0) gate(acc, u, tid); else k0store(acc, u, wr, wc, fr, fq);
    }
    __device__ __forceinline__ void operator()(const f32x4 (&acc)[2][2][4][2], const Unit& u, int wr, int wc, int fr, int fq, int tid) const {
        const int row0 = u.pm * BM + wr * 64 + fr;
        if (kind == 0 && u.pn >= gpn0) {
            gate(acc, u, tid);
        } else if (kind == 0) {
            k0store(acc, u, wr, wc, fr, fq);
        } else if (kind == 4) {
            const float* x = (const float*)p1; float* out = (float*)p0; const int col0 = u.pn * BM + wc * 64 + 4 * fq;
#pragma unroll
            for (int ai = 0; ai < 2; ++ai) {
                f32x4 xv[4][2][2];
#pragma unroll
                for (int m = 0; m < 4; ++m) { const size_t off = (size_t)(row0 + ai * HALF + m * 16) * DM + col0;
#pragma unroll
                    for (int bj = 0; bj < 2; ++bj)
#pragma unroll
                        for (int n = 0; n < 2; ++n) xv[m][bj][n] = *(const f32x4*)(x + off + bj * 32 + n * 16); }
                asm volatile("s_waitcnt vmcnt(0)" ::: "memory");
#pragma unroll
                for (int m = 0; m < 4; ++m) { const size_t off = (size_t)(row0 + ai * HALF + m * 16) * DM + col0;
#pragma unroll
                    for (int bj = 0; bj < 2; ++bj)
#pragma unroll
                        for (int n = 0; n < 2; ++n) *(f32x4*)(out + off + bj * 32 + n * 16) = xv[m][bj][n] + acc[ai][bj][m][n]; }
                asm volatile("" ::: "memory");
            }
        } else if (kind == 5) {
            bf16_t* O = (bf16_t*)p0; const int col0 = u.pn * BM + wc * 64 + 8 * fq;
            const u32x2* gc = (const u32x2*)p1 + ((size_t)(u.pm * 24 + 16 + u.pn) * 16) * 512 + tid;
            u32x2 gy[16];
#pragma unroll
            for (int i = 0; i < 16; ++i) gy[i] = gc[i * 512];
            asm volatile("s_waitcnt vmcnt(0)" ::: "memory");
#pragma unroll
            for (int ai = 0; ai < 2; ++ai)
#pragma unroll
                for (int m = 0; m < 4; ++m) { bf16_t* rowp = O + (size_t)(row0 + ai * HALF + m * 16) * ldc + col0;
#pragma unroll
                    for (int bj = 0; bj < 2; ++bj) { const f32x4 v0 = acc[ai][bj][m][0], v1 = acc[ai][bj][m][1]; const u32x2 y = gy[(ai * 4 + m) * 2 + bj];
#define QS(wv, sh) __builtin_amdgcn_exp2f((float)(((wv) >> (sh)) & 0xffu) * -0.03125f)
                        u32x4 w; w.x = cvt_pk_bf16(v0[0] * QS(y.x, 0), v0[1] * QS(y.x, 8)); w.y = cvt_pk_bf16(v0[2] * QS(y.x, 16), v0[3] * QS(y.x, 24));
                        w.z = cvt_pk_bf16(v1[0] * QS(y.y, 0), v1[1] * QS(y.y, 8)); w.w = cvt_pk_bf16(v1[2] * QS(y.y, 16), v1[3] * QS(y.y, 24));
#undef QS
                        *(u32x4*)(rowp + bj * 32) = w; } }
        }
    }
};
}

__device__ __forceinline__ unsigned pk4_fp8(float a, float b, float c, float d) { int w = __builtin_amdgcn_cvt_pk_fp8_f32(a, b, 0, false); w = __builtin_amdgcn_cvt_pk_fp8_f32(c, d, w, true); return (unsigned)w; }
__device__ __forceinline__ void rmsnorm_rows(const float* __restrict__ x, const float* __restrict__ g, bf16_t* __restrict__ out, int ldo, unsigned char* __restrict__ out8, int nrows, int gw, int nw, int lane) {
    for (int row = gw; row < nrows; row += nw) {
        const float4* xr = (const float4*)(x + (size_t)row * DM);
        float4 v[8]; float ss = 0.f;
#pragma unroll
        for (int i = 0; i < 4; ++i) { const int c = lane + 64 * i; v[2 * i] = xr[2 * c]; v[2 * i + 1] = xr[2 * c + 1]; }
#pragma unroll
        for (int i = 0; i < 8; ++i) ss += v[i].x * v[i].x + v[i].y * v[i].y + v[i].z * v[i].z + v[i].w * v[i].w;
#pragma unroll
        for (int o = 32; o >= 1; o >>= 1) ss += shx(ss, o, lane);
        const float rstd = rsqrtf(ss * (1.0f / DM) + EPSF);
#pragma unroll
        for (int i = 0; i < 4; ++i) { const int c = lane + 64 * i; const float4 ga = ((const float4*)g)[2 * c], gb = ((const float4*)g)[2 * c + 1]; const float4 a = v[2 * i], b = v[2 * i + 1];
            u32x4 w; w.x = cvt_pk_bf16(a.x * rstd * ga.x, a.y * rstd * ga.y); w.y = cvt_pk_bf16(a.z * rstd * ga.z, a.w * rstd * ga.w);
            w.z = cvt_pk_bf16(b.x * rstd * gb.x, b.y * rstd * gb.y); w.w = cvt_pk_bf16(b.z * rstd * gb.z, b.w * rstd * gb.w);
            *(u32x4*)(out + (size_t)row * ldo + c * 8) = w;
            if (out8) { u32x2 q; q.x = pk4_fp8(a.x * rstd * ga.x, a.y * rstd * ga.y, a.z * rstd * ga.z, a.w * rstd * ga.w); q.y = pk4_fp8(b.x * rstd * gb.x, b.y * rstd * gb.y, b.z * rstd * gb.z, b.w * rstd * gb.w);
                        *(u32x2*)(out8 + (size_t)row * DM + c * 8) = q; } }
    }
}
struct TJob { const float* src; bf16_t* dst; int C, ld, koff, r0, c0, dc, f8; };
__device__ __forceinline__ void tile_load(float4 (&v)[4], const TJob& J, int tid) {
#pragma unroll
    for (int p = 0; p < 4; ++p) { const int r = p * 16 + (tid >> 5), c4 = (tid & 31) * 4; v[p] = *(const float4*)(J.src + (size_t)(J.r0 + r) * J.C + J.c0 + c4); }
}
__device__ __forceinline__ void tile_store(LAS float* t  , const float4 (&v)[4], const TJob& J, int tid) {
#pragma unroll
    for (int p = 0; p < 4; ++p) { const int r = p * 16 + (tid >> 5), c4 = (tid & 31) * 4; LAS float* q = t + r * 129 + c4; q[0] = v[p].x; q[1] = v[p].y; q[2] = v[p].z; q[3] = v[p].w; }
    __syncthreads();
#pragma unroll
    for (int h = 0; h < 2; ++h) { const int c = h * 64 + (tid >> 3), rc = (tid & 7) * 8; float f[8];
#pragma unroll
        for (int j = 0; j < 8; ++j) f[j] = t[(rc + j) * 129 + c];
        if (J.f8) { u32x2 q; q.x = pk4_fp8(f[0] * 64.f, f[1] * 64.f, f[2] * 64.f, f[3] * 64.f); q.y = pk4_fp8(f[4] * 64.f, f[5] * 64.f, f[6] * 64.f, f[7] * 64.f);
                    *(u32x2*)((unsigned char*)J.dst + (size_t)(J.dc + c) * J.ld + J.r0 + rc) = q; }
        else { u32x4 w; w.x = cvt_pk_bf16(f[0], f[1]); w.y = cvt_pk_bf16(f[2], f[3]); w.z = cvt_pk_bf16(f[4], f[5]); w.w = cvt_pk_bf16(f[6], f[7]);
               *(u32x4*)(J.dst + (size_t)(J.dc + c) * J.ld + J.koff + J.r0 + rc) = w; } }
    __syncthreads();
}

struct PrepPtrs { const float* win; const float* wkv; const float* wba; const float* wbc; const float* wbm; const float* wout; bf16_t* WIN; bf16_t* WKV; bf16_t* WBR; bf16_t* WOUT; unsigned char* WG8; };
constexpr int PT0 = 512, PT1 = PT0 + 32 * 136, PT2 = PT1 + 128, PT3 = PT2 + 256, PT4 = PT3 + 256, PT5 = PT4 + 512;
__device__ __forceinline__ TJob prep_job(int t, const PrepPtrs P) {
    TJob J; int ti;
    if (t < PT0) { J.src = P.wkv; J.C = DM; J.dst = P.WKV; J.ld = DM; J.koff = 0; ti = t; }
    else if (t < PT1) { J.src = P.win; J.C = PC; J.dst = P.WIN; J.ld = LDP; J.koff = 0; ti = t - PT0; }
    else if (t < PT2) { J.src = P.wba; J.C = DM; J.dst = P.WBR; J.ld = ACTW; J.koff = 0; ti = t - PT1; }
    else if (t < PT3) { J.src = P.wbc; J.C = DM; J.dst = P.WBR; J.ld = ACTW; J.koff = 512; ti = t - PT2; }
    else if (t < PT4) { J.src = P.wbm; J.C = DM; J.dst = P.WBR; J.ld = ACTW; J.koff = 1536; ti = t - PT3; }
    else { J.src = P.wout; J.C = DM; J.dst = P.WOUT; J.ld = DM; J.koff = 0; ti = t - PT4; }
    const int nct = J.C / 128; J.r0 = (ti / nct) * 64; J.c0 = (ti % nct) * 128; J.dc = J.c0; J.f8 = 0;
    if (t >= PT0 && t < PT1) {
        const int c = J.c0;
        if (c < 5120) { J.f8 = 1; J.dc = c; }
        else if (c < 9216) { J.dc = c - 5120; }
        else if (c < 11264) { J.f8 = 1; J.dc = 5120 + (c - 9216); }
        else if (c < 13312) { J.f8 = 1; J.dc = 7168 + (c - 11264); }
        else if (c < 15360) { J.dc = 4096 + (c - 13312); }
        else { J.f8 = 1; J.dc = 9216 + (c - 15360); }
        if (J.f8) { J.dst = (bf16_t*)P.WG8; J.ld = DM; }
    }
    return J;
}

template <int HD> struct AttnGeo { static constexpr int KSTR = HD * 2 + 16, VSTR = HD * 2 + 32, PPR = HD / 8, NKS = HD / 32, NDT = HD / 16, NPC = 256 * (HD / 8) / NTHR; };

template <int HD> __device__ __forceinline__ void issue_rows(u32x4 (&r)[AttnGeo<HD>::NPC], const bf16_t* __restrict__ p, int stride, int jbase, int tid) {
    typedef AttnGeo<HD> G; constexpr int RS = NTHR / G::PPR;
    const int r0 = tid / G::PPR, pc = tid % G::PPR;
#pragma unroll
    for (int i = 0; i < G::NPC; ++i) { int j = jbase + r0 + i * RS; j = j < 0 ? 0 : j;
        r[i] = *(const u32x4*)(p + ((unsigned)j * (unsigned)stride + (unsigned)(pc * 8))); }
}
template <int HD> __device__ __forceinline__ void issue_q(u32x4 (&q)[AttnGeo<HD>::NKS], const bf16_t* __restrict__ qrow, int g4) {
#pragma unroll
    for (int ks = 0; ks < AttnGeo<HD>::NKS; ++ks) q[ks] = *(const u32x4*)(qrow + ks * 32 + g4 * 8);
}
template <int HD> __device__ __forceinline__ void write_k(LAS unsigned char* kl, const u32x4 (&r)[AttnGeo<HD>::NPC], int jbase, const float* __restrict__ wk, int tid) {
    typedef AttnGeo<HD> G; constexpr int RS = NTHR / G::PPR;
    const int r0 = tid / G::PPR, pc = tid % G::PPR;
    LAS unsigned char* base = kl + r0 * G::KSTR + pc * 16;
    const float4 wa = *(const float4*)(wk + pc * 8), wb = *(const float4*)(wk + pc * 8 + 4);
#pragma unroll
    for (int i = 0; i < G::NPC; ++i) { const u32x4 w = r[i];
        float f[8] = {bflo(w.x), bfhi(w.x), bflo(w.y), bfhi(w.y), bflo(w.z), bfhi(w.z), bflo(w.w), bfhi(w.w)};
        float ss = 0.f;
#pragma unroll
        for (int e = 0; e < 8; ++e) ss += f[e] * f[e];
#pragma unroll
        for (int o = 1; o < G::PPR; o <<= 1) ss += shx(ss, o, tid);
        const float rstd = (jbase + r0 + i * RS >= 0) ? rsqrtf(ss * (1.0f / HD) + EPSF) : 0.f;
        u32x4 o4; o4.x = cvt_pk_bf16(f[0] * rstd * wa.x, f[1] * rstd * wa.y); o4.y = cvt_pk_bf16(f[2] * rstd * wa.z, f[3] * rstd * wa.w);
        o4.z = cvt_pk_bf16(f[4] * rstd * wb.x, f[5] * rstd * wb.y); o4.w = cvt_pk_bf16(f[6] * rstd * wb.z, f[7] * rstd * wb.w);
        *(LAS u32x4*)(base + i * (RS * G::KSTR)) = o4;
        if (G::NPC > 8) __builtin_amdgcn_sched_barrier(0); }
}
template <int HD> __device__ __forceinline__ void write_v(LAS unsigned char* vl, const u32x4 (&r)[AttnGeo<HD>::NPC], int jbase, int tid) {
    typedef AttnGeo<HD> G; constexpr int RS = NTHR / G::PPR;
    const int r0 = tid / G::PPR, pc = tid % G::PPR;
    LAS unsigned char* base = vl + r0 * G::VSTR + pc * 16;
#pragma unroll
    for (int i = 0; i < G::NPC; ++i) { const bool ok = jbase + r0 + i * RS >= 0; u32x4 w = r[i];
        w.x = ok ? w.x : 0u; w.y = ok ? w.y : 0u; w.z = ok ? w.z : 0u; w.w = ok ? w.w : 0u;
        *(LAS u32x4*)(base + i * (RS * G::VSTR)) = w; }
}
template <int HD, bool ISK> __device__ __forceinline__ void stage_rows(LAS unsigned char* dst, const bf16_t* __restrict__ p, int stride, const float* __restrict__ wk, int tid) {
    typedef AttnGeo<HD> G; constexpr int RS = NTHR / G::PPR, STR = ISK ? G::KSTR : G::VSTR, NB = ISK ? 8 : 16;
    const int r0 = tid / G::PPR, pc = tid % G::PPR;
    LAS unsigned char* base = dst + r0 * STR + pc * 16;
    float4 wa = make_float4(1.f, 1.f, 1.f, 1.f), wb = wa;
    if (ISK) { wa = *(const float4*)(wk + pc * 8); wb = *(const float4*)(wk + pc * 8 + 4); }
#pragma unroll 1
    for (int i0 = 0; i0 < G::NPC; i0 += NB) {
        u32x4 r[NB];
        unsigned boff = (unsigned)(r0 + i0 * RS) * (unsigned)stride + (unsigned)(pc * 8); asm volatile("" : "+v"(boff));
#pragma unroll
        for (int i = 0; i < NB; ++i) r[i] = *(const u32x4*)(p + (boff + (unsigned)(i * RS) * (unsigned)stride));
#pragma unroll
        for (int i = 0; i < NB; ++i) { u32x4 w = r[i];
            if (ISK) {
                float f[8] = {bflo(w.x), bfhi(w.x), bflo(w.y), bfhi(w.y), bflo(w.z), bfhi(w.z), bflo(w.w), bfhi(w.w)};
                float ss = 0.f;
#pragma unroll
                for (int e = 0; e < 8; ++e) ss += f[e] * f[e];
#pragma unroll
                for (int o = 1; o < G::PPR; o <<= 1) ss += shx(ss, o, tid);
                const float rstd = rsqrtf(ss * (1.0f / HD) + EPSF);
                w.x = cvt_pk_bf16(f[0] * rstd * wa.x, f[1] * rstd * wa.y); w.y = cvt_pk_bf16(f[2] * rstd * wa.z, f[3] * rstd * wa.w);
                w.z = cvt_pk_bf16(f[4] * rstd * wb.x, f[5] * rstd * wb.y); w.w = cvt_pk_bf16(f[6] * rstd * wb.z, f[7] * rstd * wb.w);
            }
            *(LAS u32x4*)(base + (i0 + i) * (RS * STR)) = w;
            if (ISK) __builtin_amdgcn_sched_barrier(0); }
    }
}
template <int HD> __device__ __forceinline__ void norm_q(bf16x8 (&qf)[AttnGeo<HD>::NKS], const u32x4 (&qw)[AttnGeo<HD>::NKS], const float* __restrict__ wq, float scale, int g4, int lane16) {
    typedef AttnGeo<HD> G;
    float ss = 0.f;
#pragma unroll
    for (int ks = 0; ks < G::NKS; ++ks) { const u32x4 x = qw[ks]; const float a0 = bflo(x.x), a1 = bfhi(x.x), a2 = bflo(x.y), a3 = bfhi(x.y), a4 = bflo(x.z), a5 = bfhi(x.z), a6 = bflo(x.w), a7 = bfhi(x.w);
        ss += a0 * a0 + a1 * a1 + a2 * a2 + a3 * a3 + a4 * a4 + a5 * a5 + a6 * a6 + a7 * a7; }
    ss += shx(ss, 16, lane16); ss += shx(ss, 32, lane16);
    const float sc = rsqrtf(ss * (1.0f / HD) + EPSF) * scale;
#pragma unroll
    for (int ks = 0; ks < G::NKS; ++ks) { const u32x4 x = qw[ks]; const float4 wa = *(const float4*)(wq + ks * 32 + g4 * 8), wb = *(const float4*)(wq + ks * 32 + g4 * 8 + 4);
        u32x4 o; o.x = cvt_pk_bf16(bflo(x.x) * sc * wa.x, bfhi(x.x) * sc * wa.y); o.y = cvt_pk_bf16(bflo(x.y) * sc * wa.z, bfhi(x.y) * sc * wa.w);
        o.z = cvt_pk_bf16(bflo(x.z) * sc * wb.x, bfhi(x.z) * sc * wb.y); o.w = cvt_pk_bf16(bflo(x.w) * sc * wb.z, bfhi(x.w) * sc * wb.w);
        qf[ks] = __builtin_bit_cast(bf16x8, o); }
}

__device__ __forceinline__ int band_item(int bx, int k, int G_) { return (G_ == 256) ? ((k >> 1) * 512 + 64 * (bx & 7) + (bx >> 3) + 32 * (k & 1)) : (bx + k * G_); }
__device__ __forceinline__ int mem_item(int bx, int k, int G_) { return (G_ == 256) ? (64 * (bx & 7) + (bx >> 3) + 32 * k) : (bx + k * G_); }
struct BandItem { const bf16_t* qp; int rstride; int qb, g, h; size_t row0; int d; };
__device__ __forceinline__ BandItem band_decode(int it, const bf16_t* PROJ) {
    BandItem I; const int g = it >> 9, idx = it & 511, dsh = 2 * g, d = 1 << dsh, nqb = 16 >> dsh;
    I.qb = idx % nqb; int rest = idx / nqb; const int r = rest % d; rest /= d; I.h = rest & 3; const int bl = rest >> 2;
    I.g = g; I.d = d; I.row0 = (size_t)bl * SEQ + r; I.qp = PROJ + I.row0 * PS + g * 512 + I.h * 128; I.rstride = d * PS; return I;
}
__device__ __forceinline__ void attn_banded_run(LAS unsigned char* lds, const bf16_t* __restrict__ PROJ, const float* __restrict__ aqn, const float* __restrict__ akn, bf16_t* __restrict__ OG, float* __restrict__ LSE,
                                                int bx, int G_, const int tid) {
    constexpr int HD = 128; typedef AttnGeo<HD> G;
    const int w = __builtin_amdgcn_readfirstlane(tid >> 6), lane = tid & 63, lq = lane & 15, g4 = lane >> 4;
    LAS unsigned char* kl = lds; LAS unsigned char* vl = lds + 256 * G::KSTR;
    const int n = (1536 - bx + G_ - 1) / G_;
    if (n <= 0) return;
    u32x4 rk[G::NPC], rv[G::NPC], rq[G::NKS];
    { const BandItem I = band_decode(band_item(bx, 0, G_), PROJ); const int jb = I.qb * 128 - 128;
      issue_rows<HD>(rk, I.qp + C_K, I.rstride, jb, tid); issue_rows<HD>(rv, I.qp + C_V, I.rstride, jb, tid); issue_q<HD>(rq, I.qp + (unsigned)(I.qb * 128 + 16 * w + lq) * (unsigned)I.rstride, g4); }
    { unsigned zl = 0u; asm volatile("" : "+v"(zl));
      for (int p = tid; p < 16 * G::PPR; p += NTHR) *(LAS u32x4*)(vl + (256 + p / G::PPR) * G::VSTR + (p % G::PPR) * 16) = (u32x4){zl, zl, zl, zl}; }
#pragma unroll 1
    for (int k = 0; k < n; ++k) {
        const BandItem I = band_decode(band_item(bx, k, G_), PROJ);
        const int jbase = I.qb * 128 - 128, qi = I.qb * 128 + 16 * w + lq;
        write_k<HD>(kl, rk, jbase, akn + I.g * 128, tid);
        write_v<HD>(vl, rv, jbase, tid);
        bf16x8 qf[G::NKS];
        norm_q<HD>(qf, rq, aqn + I.g * 128, 0.08838834764831845f * 1.4426950408889634f, g4, lane);
        __syncthreads();
        { const int kn = (k + 1 < n) ? k + 1 : k; const BandItem J = band_decode(band_item(bx, kn, G_), PROJ); const int jb = J.qb * 128 - 128;
          issue_rows<HD>(rk, J.qp + C_K, J.rstride, jb, tid); issue_rows<HD>(rv, J.qp + C_V, J.rstride, jb, tid); issue_q<HD>(rq, J.qp + (unsigned)(J.qb * 128 + 16 * w + lq) * (unsigned)J.rstride, g4); }
        f32x4 S[10];
        float NEG = -__builtin_inff(); asm volatile("" : "+v"(NEG));
#pragma unroll
        for (int t = 0; t < 9; ++t) {
            const int kt = w + t;
            if (jbase + kt * 16 >= 0) {
                f32x4 sv = (f32x4){0.f, 0.f, 0.f, 0.f};
#pragma unroll
                for (int ks = 0; ks < G::NKS; ++ks) { const bf16x8 kf = *(const LAS bf16x8*)(kl + (kt * 16 + lq) * G::KSTR + ks * 64 + g4 * 16); sv = __builtin_amdgcn_mfma_f32_16x16x32_bf16(kf, qf[ks], sv, 0, 0, 0); }
                if (t == 0) {
#pragma unroll
                    for (int r = 0; r < 4; ++r) sv[r] = (4 * g4 + r >= lq) ? sv[r] : NEG; }
                if (t == 8) {
#pragma unroll
                    for (int r = 0; r < 4; ++r) sv[r] = (4 * g4 + r <= lq) ? sv[r] : NEG; }
                S[t] = sv;
            } else S[t] = (f32x4){NEG, NEG, NEG, NEG};
        }
        S[9] = (f32x4){NEG, NEG, NEG, NEG};
        float mx = NEG;
#pragma unroll
        for (int t = 0; t < 9; ++t)
#pragma unroll
            for (int r = 0; r < 4; ++r) mx = fmaxf(mx, S[t][r]);
        mx = fmaxf(mx, shx(mx, 16, lane)); mx = fmaxf(mx, shx(mx, 32, lane));
        float l = 0.f;
#pragma unroll
        for (int t = 0; t < 10; ++t)
#pragma unroll
            for (int r = 0; r < 4; ++r) { const float pv = __builtin_amdgcn_exp2f(S[t][r] - mx); l += pv; S[t][r] = pv; }
        l += shx(l, 16, lane); l += shx(l, 32, lane);
        f32x4 O[G::NDT];
#pragma unroll
        for (int dt = 0; dt < G::NDT; ++dt) O[dt] = (f32x4){0.f, 0.f, 0.f, 0.f};
#pragma unroll
        for (int u = 0; u < 5; ++u) {
            u32x4 pw; pw.x = cvt_pk_bf16(S[2 * u][0], S[2 * u][1]); pw.y = cvt_pk_bf16(S[2 * u][2], S[2 * u][3]); pw.z = cvt_pk_bf16(S[2 * u + 1][0], S[2 * u + 1][1]); pw.w = cvt_pk_bf16(S[2 * u + 1][2], S[2 * u + 1][3]);
            const bf16x8 pb = __builtin_bit_cast(bf16x8, pw);
            const int ka = (w + 2 * u) * 16 + 4 * g4 + (lq >> 2), kb = ka + 16;
            LAS unsigned char* va = vl + ka * G::VSTR + (lane & 3) * 8; LAS unsigned char* vb = vl + kb * G::VSTR + (lane & 3) * 8;
#pragma unroll
            for (int dt = 0; dt < G::NDT; ++dt) {
                const s16x4 x = __builtin_amdgcn_ds_read_tr16_b64_v4i16((LAS s16x4*)(va + dt * 32));
                const s16x4 y = __builtin_amdgcn_ds_read_tr16_b64_v4i16((LAS s16x4*)(vb + dt * 32));
                const bf16x8 av = (bf16x8){x[0], x[1], x[2], x[3], y[0], y[1], y[2], y[3]};
                O[dt] = __builtin_amdgcn_mfma_f32_16x16x32_bf16(av, pb, O[dt], 0, 0, 0);
            }
        }
        const float inv = 1.0f / l;
        const size_t trow = I.row0 + (size_t)qi * I.d;
        bf16_t* orow = OG + trow * 1536 + I.g * 512 + I.h * 128;
        {
            u32x4 ch[G::NDT / 2];
#pragma unroll
            for (int dp = 0; dp < G::NDT / 2; ++dp) {
                const unsigned ax = cvt_pk_bf16(O[2 * dp][0] * inv, O[2 * dp][1] * inv), ay = cvt_pk_bf16(O[2 * dp][2] * inv, O[2 * dp][3] * inv);
                const unsigned bx_ = cvt_pk_bf16(O[2 * dp + 1][0] * inv, O[2 * dp + 1][1] * inv), by_ = cvt_pk_bf16(O[2 * dp + 1][2] * inv, O[2 * dp + 1][3] * inv);
                const u32x2 r0 = __builtin_amdgcn_permlane16_swap(ax, bx_, false, false), r1 = __builtin_amdgcn_permlane16_swap(ay, by_, false, false);
                ch[dp] = (u32x4){r0[0], r1[0], r0[1], r1[1]}; }
            const bool lo = lq < 8; const int dbase = (g4 & 1) ? 16 + 4 * (g4 - 1) : 4 * g4;
            bf16_t* orow8 = OG + (I.row0 + (size_t)(I.qb * 128 + 16 * w + (lq & 7)) * I.d) * 1536 + I.g * 512 + I.h * 128 + dbase + (lo ? 0 : 32);
#pragma unroll
            for (int pp = 0; pp < G::NDT / 4; ++pp) {
                const u32x4 w0 = ch[2 * pp], w1 = ch[2 * pp + 1], rcv = xchg8_dpp(lo ? w1 : w0);
                *(u32x4*)(orow8 + pp * 64) = lo ? w0 : rcv;
                *(u32x4*)(orow8 + (size_t)8 * I.d * 1536 + pp * 64) = lo ? rcv : w1; }
        }
        if (g4 == 0) LSE[trow * 12 + I.g * 4 + I.h] = (mx + __builtin_amdgcn_logf(l)) * 0.6931471805599453f;
        __syncthreads();
    }
}

__device__ __forceinline__ void attn_mem_run(LAS unsigned char* lds, const bf16_t* __restrict__ PROJ, const bf16_t* __restrict__ MKV, const float* __restrict__ wq, const float* __restrict__ wk, bf16_t* __restrict__ ACT,
                                             int half, int bx, int G_, const int tid) {
    constexpr int HD = 256; typedef AttnGeo<HD> G;
    const int w = __builtin_amdgcn_readfirstlane(tid >> 6), lane = tid & 63, lq = lane & 15, g4 = lane >> 4;
    const int n = (512 - bx + G_ - 1) / G_;
    if (n <= 0) return;
#pragma unroll 1
    for (int k = 0; k < n; ++k) {
        const int idx = mem_item(bx, k, G_), qb = idx & 15, h = (idx >> 4) & 3, bl = idx >> 6, b = half * 8 + bl;
        const size_t trow = (size_t)bl * SEQ + qb * 128 + 16 * w + lq;
        u32x4 rq[G::NKS];
        issue_q<HD>(rq, PROJ + trow * PS + C_MQ + h * 256, g4);
        stage_rows<HD, true>(lds, MKV + (size_t)b * 256 * DM + h * 256, DM, wk, tid);
        bf16x8 qf[G::NKS];
        norm_q<HD>(qf, rq, wq, 0.0625f * 1.4426950408889634f, g4, lane);
        __syncthreads();
        u32x2 P[16]; float l;
        {
            f32x4 S[16];
#pragma unroll
            for (int t = 0; t < 16; ++t) {
                f32x4 sv = (f32x4){0.f, 0.f, 0.f, 0.f};
#pragma unroll
                for (int ks = 0; ks < G::NKS; ++ks) { const bf16x8 kf = *(const LAS bf16x8*)(lds + (t * 16 + lq) * G::KSTR + ks * 64 + g4 * 16); sv = __builtin_amdgcn_mfma_f32_16x16x32_bf16(kf, qf[ks], sv, 0, 0, 0); }
                S[t] = sv;
            }
            float mx = -__builtin_inff(); asm volatile("" : "+v"(mx));
#pragma unroll
            for (int t = 0; t < 16; ++t)
#pragma unroll
                for (int r = 0; r < 4; ++r) mx = fmaxf(mx, S[t][r]);
            mx = fmaxf(mx, shx(mx, 16, lane)); mx = fmaxf(mx, shx(mx, 32, lane));
            l = 0.f;
#pragma unroll
            for (int t = 0; t < 16; ++t) { const float p0 = __builtin_amdgcn_exp2f(S[t][0] - mx), p1 = __builtin_amdgcn_exp2f(S[t][1] - mx), p2 = __builtin_amdgcn_exp2f(S[t][2] - mx), p3 = __builtin_amdgcn_exp2f(S[t][3] - mx);
                l += (p0 + p1) + (p2 + p3); P[t].x = cvt_pk_bf16(p0, p1); P[t].y = cvt_pk_bf16(p2, p3); }
            l += shx(l, 16, lane); l += shx(l, 32, lane);
        }
        __syncthreads();
        stage_rows<HD, false>(lds, MKV + (size_t)b * 256 * DM + 1024 + h * 256, DM, wk, tid);
        __syncthreads();
        f32x4 O[G::NDT];
#pragma unroll
        for (int dt = 0; dt < G::NDT; ++dt) O[dt] = (f32x4){0.f, 0.f, 0.f, 0.f};
#pragma unroll
        for (int u = 0; u < 8; ++u) {
            u32x4 pw; pw.x = P[2 * u].x; pw.y = P[2 * u].y; pw.z = P[2 * u + 1].x; pw.w = P[2 * u + 1].y;
            const bf16x8 pb = __builtin_bit_cast(bf16x8, pw);
            const int ka = (2 * u) * 16 + 4 * g4 + (lq >> 2), kb = ka + 16;
            LAS unsigned char* va = lds + ka * G::VSTR + (lane & 3) * 8; LAS unsigned char* vb = lds + kb * G::VSTR + (lane & 3) * 8;
#pragma unroll
            for (int dt = 0; dt < G::NDT; ++dt) {
                const s16x4 x = __builtin_amdgcn_ds_read_tr16_b64_v4i16((LAS s16x4*)(va + dt * 32));
                const s16x4 y = __builtin_amdgcn_ds_read_tr16_b64_v4i16((LAS s16x4*)(vb + dt * 32));
                const bf16x8 av = (bf16x8){x[0], x[1], x[2], x[3], y[0], y[1], y[2], y[3]};
                O[dt] = __builtin_amdgcn_mfma_f32_16x16x32_bf16(av, pb, O[dt], 0, 0, 0);
            }
        }
        const float inv = 1.0f / l;
        const bf16_t* zrow = PROJ + trow * PS + C_ZM + h * 256; bf16_t* arow = ACT + trow * ACTW + 1536 + h * 256;
#pragma unroll
        for (int dp = 0; dp < G::NDT / 2; ++dp) {
            float va[4], vb[4];
#pragma unroll
            for (int j = 0; j < 4; ++j) { const u32x2 r = __builtin_amdgcn_permlane16_swap(__float_as_uint(O[2 * dp][j]), __float_as_uint(O[2 * dp + 1][j]), false, false); va[j] = __uint_as_float(r[0]); vb[j] = __uint_as_float(r[1]); }
            const int dofs = (g4 & 1) ? (2 * dp + 1) * 16 + 4 * (g4 - 1) : (2 * dp) * 16 + 4 * g4;
            const u32x4 z = *(const u32x4*)(zrow + dofs);
            u32x4 o; o.x = cvt_pk_bf16(va[0] * inv * siluf_(bflo(z.x)), va[1] * inv * siluf_(bfhi(z.x))); o.y = cvt_pk_bf16(va[2] * inv * siluf_(bflo(z.y)), va[3] * inv * siluf_(bfhi(z.y)));
            o.z = cvt_pk_bf16(vb[0] * inv * siluf_(bflo(z.z)), vb[1] * inv * siluf_(bfhi(z.z))); o.w = cvt_pk_bf16(vb[2] * inv * siluf_(bflo(z.w)), vb[3] * inv * siluf_(bfhi(z.w)));
            *(u32x4*)(arow + dofs) = o; }
        __syncthreads();
    }
}

#define XB_TMO      128
#define XB_XCNT(j)  (256  + 64 * (j))
#define XB_XSUB(j)  (1280 + 64 * (j))
#define XB_XGEN(j)  (2304 + 64 * (j))
#define XB_TOP      3328
#define XB_TOPGEN   3392
#define XCD_BAR_WORDS 3456
#define XB_SPIN_CAP (1u << 22)
__device__ __forceinline__ unsigned xb_ld(unsigned* p)              { return __hip_atomic_load(p, __ATOMIC_RELAXED, __HIP_MEMORY_SCOPE_AGENT); }
__device__ __forceinline__ unsigned xb_add(unsigned* p, unsigned v) { return __hip_atomic_fetch_add(p, v, __ATOMIC_RELAXED, __HIP_MEMORY_SCOPE_AGENT); }
__device__ __forceinline__ unsigned xb_xcc_id() { return (unsigned)__builtin_amdgcn_s_getreg((3 << 11) | 20) & 0xFu; }
#define XB_SPIN(cond, bar) do { unsigned _sp = 0; while (cond) { __builtin_amdgcn_s_sleep(1); \
    if ((++_sp & 255u) == 0u) { if (xb_ld(&(bar)[XB_TMO])) break; if (_sp > XB_SPIN_CAP) { atomicAdd(&(bar)[XB_TMO], 1u); break; } } } } while (0)
__device__ __forceinline__ void xcd_barrier_complete(unsigned* bar, unsigned x, unsigned& nloc, unsigned& nx) {
    const unsigned G = gridDim.x;
    unsigned sum, cnt, mine, sp = 0u;
    for (;;) {
        sum = 0u; cnt = 0u; mine = 0u;
#pragma unroll
        for (unsigned j = 0; j < 16; ++j) { const unsigned c = xb_ld(&bar[XB_XCNT(j)]); sum += c; cnt += (c > 0u) ? 1u : 0u; mine = (j == x) ? c : mine; }
        if (sum == G) break;
        __builtin_amdgcn_s_sleep(1);
        if ((++sp & 255u) == 0u) { if (xb_ld(&bar[XB_TMO])) break; if (sp > XB_SPIN_CAP) { atomicAdd(&bar[XB_TMO], 1u); break; } }
    }
    nloc = mine > 0u ? mine : 1u; nx = cnt > 0u ? cnt : 1u;
}
__device__ __forceinline__ void xcd_barrier(unsigned* bar, volatile LAS unsigned* st, bool leader_thread) {
    asm volatile("s_waitcnt vmcnt(0)" ::: "memory");
    __syncthreads();
    if (leader_thread) {
        const unsigned x = xb_xcc_id();
        __builtin_amdgcn_s_waitcnt(0);
        unsigned nloc = st[0], nx = st[1];
        if (nloc == 0u) { xcd_barrier_complete(bar, x, nloc, nx); st[0] = nloc; st[1] = nx; }
        const unsigned old = xb_add(&bar[XB_XSUB(x)], 1u);
        const unsigned gen = old / nloc;
        if (old + 1u == (gen + 1u) * nloc) {
            __builtin_amdgcn_fence(__ATOMIC_RELEASE, "agent");
            asm volatile("s_waitcnt vmcnt(0)" ::: "memory");
            const unsigned og = xb_add(&bar[XB_TOP], 1u);
            const unsigned tg = og / nx;
            if (og + 1u == (tg + 1u) * nx) xb_add(&bar[XB_TOPGEN], 1u);
            else XB_SPIN(xb_ld(&bar[XB_TOPGEN]) == tg, bar);
            __builtin_amdgcn_fence(__ATOMIC_ACQUIRE, "agent");
            xb_add(&bar[XB_XGEN(x)], 1u);
            asm volatile("s_waitcnt vmcnt(0)" ::: "memory");
        } else {
            XB_SPIN(xb_ld(&bar[XB_XGEN(x)]) == gen, bar);
            __builtin_amdgcn_fence(__ATOMIC_ACQUIRE, "agent");
            asm volatile("s_waitcnt vmcnt(0)" ::: "memory");
        }
    }
    __syncthreads();
}

struct Args { const float* in[15]; float* out; unsigned char* ws; int lo, hi; };
enum { I_X = 0, I_MEM, I_NG, I_MNG, I_WIN, I_AQN, I_AKN, I_CW, I_WKV, I_MQN, I_MKN, I_WBA, I_WBC, I_WBM, I_WOUT };
constexpr int NPHASE = 11;

__global__ void __launch_bounds__(NTHR, 2) mega(Args a) {
    extern __shared__ __attribute__((aligned(16))) unsigned char lds_raw[];
    LAS unsigned char* lds = (LAS unsigned char*)lds_raw;
    const int G = gridDim.x, bx = blockIdx.x, wave_s = __builtin_amdgcn_readfirstlane((int)threadIdx.x >> 6);
    typedef const __attribute__((address_space(4))) Args* KArgs;
    const int ph_lo = a.lo, ph_hi = a.hi;
    if (a.lo < 0) cg::this_grid().sync();
    volatile LAS unsigned* xst = (volatile LAS unsigned*)(lds + LDS_BYTES - 16);
    if (ph_hi - ph_lo > 1) {
        if (threadIdx.x == 0) { xst[0] = 0u; xst[1] = 0u; (void)xb_add(&((unsigned*)(a.ws + WS_BAR))[XB_XCNT(xb_xcc_id())], 1u); }
        __syncthreads();
    }
    for (int ph = ph_lo; ph < ph_hi; ++ph) {
        if (ph == 6 && ph_hi - ph_lo > 1) continue;
        KArgs A = (KArgs)__builtin_amdgcn_kernarg_segment_ptr(); asm volatile("" : "+s"(A));
        unsigned char* ws = A->ws;
        bf16_t* WIN = (bf16_t*)(ws + WS_WIN); bf16_t* WKV = (bf16_t*)(ws + WS_WKV); bf16_t* WBR = (bf16_t*)(ws + WS_WBR); bf16_t* WOUT = (bf16_t*)(ws + WS_WOUT);
        bf16_t* MH = (bf16_t*)(ws + WS_MH); bf16_t* MKV = (bf16_t*)(ws + WS_MKV); bf16_t* PROJ = (bf16_t*)(ws + WS_PROJ); bf16_t* OG = (bf16_t*)(ws + WS_OG);
        float* LSE = (float*)(ws + WS_LSE); bf16_t* ACT = (bf16_t*)(ws + WS_ACT); u32x2* GF = (u32x2*)(ws + WS_GF); bf16_t* MB = (bf16_t*)(ws + WS_MB);
        bf16_t* H = (bf16_t*)(ws + WS_H);
        unsigned char* H8 = (unsigned char*)A->out;
        unsigned char* WG8 = (unsigned char*)WIN + (size_t)6144 * LDP * 2;
#define MAKE_TID(name) unsigned name##_m = ~0u; asm volatile("" : "+s"(name##_m)); int name = wave_s * 64 + (int)__builtin_amdgcn_mbcnt_hi(name##_m, __builtin_amdgcn_mbcnt_lo(name##_m, 0u)); asm volatile("" : "+v"(name))
        if (ph == 1 || ph == 2 || ph == 5 || ph == 6 || ph == 9 || ph == 10) {
            const int nj = (ph == 5) ? ((ph_hi - ph_lo > 1) ? 3 : 2) : ((ph == 9 || ph == 2) ? 2 : 1), njr = ((REP_MASK >> ph) & 1) ? 2 * nj : nj;
#pragma unroll 1
            for (int jr = 0; jr < njr; ++jr) {
                const int j = jr >= nj ? jr - nj : jr;
                bf16_t* MB2 = (bf16_t*)(ws + WS_MB2);
                int what;
                int half;
                const int swp = (bx >> 3) & 1;
                u32x2* GF2 = (u32x2*)((unsigned char*)A->out + OUT_H_OFF);
                if (ph == 1) { what = 0; half = 0; }
                else if (ph == 2) { what = (j == 0) ? 1 : 4; half = 0; }
                else if (ph == 5) {
                    if (nj == 3) { const int o = swp ? (j == 2 ? 0 : j + 1) : j; what = (o == 0) ? 2 : (o == 1 ? 4 : 1); }
                    else what = ((j == 0) != (swp != 0)) ? 2 : 4;
                    half = (what == 2) ? 0 : 1; }
                else if (ph == 6) { what = 1; half = 1; }
                else if (ph == 9) { what = ((j == 0) != (swp != 0)) ? 3 : 2; half = (what == 3) ? 0 : 1; }
                else { what = 3; half = 1; }
                pg8::Gemm g; pg8::Epi E;
                if (what == 2) {
                    g = pg8::Gemm{ACT, WBR, HT, DM, ACTW, ACTW, ACTW, 0}; E = pg8::Epi{5, half ? MB2 : MB, half ? GF2 : GF, nullptr, DM, 1 << 20, 1.0f, 1 << 20, 0, 0, 1 << 20, 0, 0};
                } else if (what == 0) {
                    g = pg8::Gemm{MH, WKV, 4096, DM, DM, DM, DM, 0}; E = pg8::Epi{0, MKV, nullptr, nullptr, DM, 1 << 20, 1.0f, 1 << 20, 0, 0, 1 << 20, 0, 0};
                } else if (what == 3) {
                    const size_t ro = half ? (size_t)HT * DM : 0;
                    g = pg8::Gemm{half ? MB2 : MB, WOUT, HT, DM, DM, DM, DM, 0}; E = pg8::Epi{4, A->out + ro, A->in[I_X] + ro, nullptr, DM, 1 << 20, 1.0f, 1 << 20, 0, 0, 1 << 20, 0, 0};
                } else if (what == 1) {
                    g = pg8::Gemm{H + (size_t)half * HT * LDP, WIN, HT, 6144, DM, LDP, LDP, 0};
                    E = pg8::Epi{0, PROJ, nullptr, half ? GF2 : GF, PS, 16, 1.0f, 1 << 20, C_CB, 0, 1 << 20, 8, 0};
                } else {
                    g = pg8::Gemm{(const bf16_t*)(H8 + (size_t)half * HT * DM), (const bf16_t*)WG8, HT, PS, DM / 2, DM / 2, DM / 2, 1};
                    E = pg8::Epi{0, PROJ, nullptr, half ? GF2 : GF, PS, 28, 1.0f / 64.0f, 20, 0, C_MQ, 36, 0, 16};
                }
                if (GEMM1_STAGGER_US > 0 && g.N == PS) {
                    const unsigned long long t0 = __builtin_amdgcn_s_memrealtime(), dl = (unsigned long long)(((bx >> 3) & 3) * GEMM1_STAGGER_US * 100);
                    while (__builtin_amdgcn_s_memrealtime() - t0 < dl) __builtin_amdgcn_s_sleep(8);
                }
                pg8::StaticOrder S; S.init(g.M, g.N, G, bx);
                unsigned ones2 = ~0u; asm volatile("" : "+s"(ones2));
                int tidj = wave_s * 64 + (int)__builtin_amdgcn_mbcnt_hi(ones2, __builtin_amdgcn_mbcnt_lo(ones2, 0u)); asm volatile("" : "+v"(tidj));
                if (g.f8) pg8::gemm_phase<true>(lds, g, S, E, tidj); else pg8::gemm_phase<false>(lds, g, S, E, tidj);
            }
        }
        if (ph == 0 || ph == 1) {
            MAKE_TID(tid);
            const int lane = tid & 63, wave = tid >> 6;
            if (ph == 0) rmsnorm_rows(A->in[I_MEM], A->in[I_MNG], MH, DM, nullptr, 4096, bx * 8 + wave, G * 8, lane);
            else rmsnorm_rows(A->in[I_X], A->in[I_NG], H, LDP, H8, NTOK, bx * 8 + wave, G * 8, lane);
            const PrepPtrs PP{A->in[I_WIN], A->in[I_WKV], A->in[I_WBA], A->in[I_WBC], A->in[I_WBM], A->in[I_WOUT], WIN, WKV, WBR, WOUT, WG8};
            constexpr int T0 = PT0, T5 = PT5;
            const int tb = (ph == 0) ? 0 : T0, te = (ph == 0) ? T0 : T5;
            if (tb + bx < te) {
                float4 v[4]; TJob J = prep_job(tb + bx, PP); tile_load(v, J, tid);
#pragma unroll 1
                for (int t = tb + bx; t < te; t += G) {
                    float4 vn[4]; const int tn = (t + G < te) ? t + G : t; const TJob Jn = prep_job(tn, PP); tile_load(vn, Jn, tid);
                    tile_store((LAS float*)lds, v, J, tid);
                    J = Jn;
#pragma unroll
                    for (int p = 0; p < 4; ++p) v[p] = vn[p];
                }
            }
        } else if (ph == 3 || ph == 7) {
            const int half = (ph == 3) ? 0 : 1;
            MAKE_TID(tid);
#pragma unroll 1
            for (int rep = 0; rep < REP_BAND; ++rep)
            attn_banded_run(lds, PROJ, A->in[I_AQN], A->in[I_AKN], OG, LSE, bx, G, tid);
#pragma unroll 1
            for (int rep = 0; rep < REP_MEM; ++rep)
            attn_mem_run(lds, PROJ, MKV, A->in[I_MQN], A->in[I_MKN], ACT, half, bx, G, tid);
        } else if (ph == 4 || ph == 8) {
            MAKE_TID(tid);
            const int gt = bx * NTHR + tid, nth = G * NTHR;
            for (int idx = gt; idx < HT * 64; idx += nth) {
                const int row = idx >> 6, c8 = (idx & 63) * 8, h = c8 >> 7;
                const float l0 = LSE[(size_t)row * 12 + h], l1 = LSE[(size_t)row * 12 + 4 + h], l2 = LSE[(size_t)row * 12 + 8 + h];
                const float m = fmaxf(l0, fmaxf(l1, l2)); float w0 = __expf(l0 - m), w1 = __expf(l1 - m), w2 = __expf(l2 - m); const float inv = 1.0f / (w0 + w1 + w2); w0 *= inv; w1 *= inv; w2 *= inv;
                const u32x4 o0 = *(const u32x4*)(OG + (size_t)row * 1536 + c8), o1 = *(const u32x4*)(OG + (size_t)row * 1536 + 512 + c8), o2 = *(const u32x4*)(OG + (size_t)row * 1536 + 1024 + c8);
                const u32x4 z = *(const u32x4*)(PROJ + (size_t)row * PS + C_ZA + c8);
                u32x4 o;
#define CMB(k) o.k = cvt_pk_bf16((w0 * bflo(o0.k) + w1 * bflo(o1.k) + w2 * bflo(o2.k)) * siluf_(bflo(z.k)), (w0 * bfhi(o0.k) + w1 * bfhi(o1.k) + w2 * bfhi(o2.k)) * siluf_(bfhi(z.k)))
                CMB(x); CMB(y); CMB(z); CMB(w);
#undef CMB
                *(u32x4*)(ACT + (size_t)row * ACTW + c8) = o;
            }
            const float* cw = A->in[I_CW];
            for (int idx = gt; idx < HT * 128; idx += nth) {
                const int row = idx >> 7, c8 = (idx & 127) * 8, t = row & (SEQ - 1);
                const bf16_t* pr = PROJ + (size_t)row * PS;
                unsigned zl = 0u; asm volatile("" : "+v"(zl)); const u32x4 z4 = (u32x4){zl, zl, zl, zl};
                const u32x4 c0 = *(const u32x4*)(pr + C_CC + c8), v0 = *(const u32x4*)(pr + C_CV + c8);
                const u32x4 c1 = t >= 1 ? *(const u32x4*)(pr - PS + C_CC + c8) : z4, v1 = t >= 1 ? *(const u32x4*)(pr - PS + C_CV + c8) : z4;
                const u32x4 c2 = t >= 2 ? *(const u32x4*)(pr - 2 * PS + C_CC + c8) : z4, v2 = t >= 2 ? *(const u32x4*)(pr - 2 * PS + C_CV + c8) : z4;
                const u32x4 bb = *(const u32x4*)(pr + C_CB + c8), zz = *(const u32x4*)(pr + C_ZC + c8);
                const float4 wa0 = *(const float4*)(cw + c8), wb0 = *(const float4*)(cw + c8 + 4), wa1 = *(const float4*)(cw + 1024 + c8), wb1 = *(const float4*)(cw + 1024 + c8 + 4), wa2 = *(const float4*)(cw + 2048 + c8), wb2 = *(const float4*)(cw + 2048 + c8 + 4);
                u32x4 o;
#define CV1(f, k, W0, W1, W2) ((W0 * (f(c0.k) * f(v0.k)) + W1 * (f(c1.k) * f(v1.k)) + W2 * (f(c2.k) * f(v2.k))) * f(bb.k) * siluf_(f(zz.k)))
                o.x = cvt_pk_bf16(CV1(bflo, x, wa0.x, wa1.x, wa2.x), CV1(bfhi, x, wa0.y, wa1.y, wa2.y));
                o.y = cvt_pk_bf16(CV1(bflo, y, wa0.z, wa1.z, wa2.z), CV1(bfhi, y, wa0.w, wa1.w, wa2.w));
                o.z = cvt_pk_bf16(CV1(bflo, z, wb0.x, wb1.x, wb2.x), CV1(bfhi, z, wb0.y, wb1.y, wb2.y));
                o.w = cvt_pk_bf16(CV1(bflo, w, wb0.z, wb1.z, wb2.z), CV1(bfhi, w, wb0.w, wb1.w, wb2.w));
#undef CV1
                *(u32x4*)(ACT + (size_t)row * ACTW + 512 + c8) = o;
            }
        }
        if (ph + 1 < ph_hi) {
            { MAKE_TID(tb_); xcd_barrier((unsigned*)(A->ws + WS_BAR), xst, tb_ == 0); }
        }
        if (ph == 0 && ph_hi - ph_lo > 1) { for (int e = 0; e < EXTRA_SYNCS; ++e) cg::this_grid().sync(); }
    }
}

extern "C" void kernel_launch(void* const* d_in, const int* in_sizes, int n_in, void* d_out, int out_size, void* d_ws, size_t ws_size, hipStream_t stream) {
    static int grid = 0;
    if (grid == 0) {
        if (n_in != 15 || ws_size < WS_END) { fprintf(stderr, "kernel_launch: unexpected inputs (n_in %d, ws %zu < %zu)\n", n_in, ws_size, (size_t)WS_END); grid = -1; return; }
        int dev = 0, cus = 0, per_cu = 0;
        hipGetDevice(&dev); hipDeviceGetAttribute(&cus, hipDeviceAttributeMultiprocessorCount, dev);
        if (hipFuncSetAttribute((const void*)mega, hipFuncAttributeMaxDynamicSharedMemorySize, LDS_BYTES) != hipSuccess) { fprintf(stderr, "kernel_launch: hipFuncSetAttribute failed\n"); grid = -1; return; }
        hipOccupancyMaxActiveBlocksPerMultiprocessor(&per_cu, (const void*)mega, NTHR, LDS_BYTES);
        if (per_cu < 1) per_cu = 1;
        grid = cus * 1;
        (void)hipGetLastError();
    }
    if (grid < 0) return;
    Args a{};
    for (int i = 0; i < 15; ++i) a.in[i] = (const float*)d_in[i];
    a.out = (float*)d_out; a.ws = (unsigned char*)d_ws;
#if ONE_LAUNCH
    (void)hipMemsetAsync((unsigned char*)d_ws + WS_BAR, 0, 16384, stream);
    a.lo = 0; a.hi = NPHASE;
    void* args[] = {&a};
    hipError_t e = hipLaunchCooperativeKernel((const void*)mega, dim3(grid), dim3(NTHR), args, LDS_BYTES, stream);
    if (e != hipSuccess) fprintf(stderr, "cooperative launch failed: %s (grid %d)\n", hipGetErrorString(e), grid);
#else
    for (int ph = 0; ph < NPHASE; ++ph) { a.lo = ph; a.hi = ph + 1; hipLaunchKernelGGL(mega, dim3(grid), dim3(NTHR), LDS_BYTES, stream, a); }
#endif
}
```

```cpp
#include <hip/hip_runtime.h>
#include <hip/hip_cooperative_groups.h>
#include <cstdio>
namespace cg = cooperative_groups;

#ifndef ONE_LAUNCH
#define ONE_LAUNCH 1
#endif

#ifndef REP_MASK
#define REP_MASK 0
#endif
#define GEMM1_STAGGER_US 0
#define REP_BAND 1
#define REP_MEM 1
#define REP_PREP 1
#define EXTRA_SYNCS 0
#ifndef PG8_SP2
#define PG8_SP2 1
#endif
#define LAS __attribute__((address_space(3)))
typedef unsigned short bf16_t;
typedef short bf16x8 __attribute__((ext_vector_type(8)));
typedef short s16x4 __attribute__((ext_vector_type(4)));
typedef float f32x4 __attribute__((ext_vector_type(4)));
typedef unsigned u32x4 __attribute__((ext_vector_type(4)));
typedef unsigned u32x2 __attribute__((ext_vector_type(2)));
typedef int i32x8 __attribute__((ext_vector_type(8)));
typedef int i32x4 __attribute__((ext_vector_type(4)));
typedef short s16x16 __attribute__((ext_vector_type(16)));

constexpr int DM = 2048, SEQ = 2048, NB = 16, NTOK = NB * SEQ;
constexpr int PC = 17408;
constexpr int PS = 11264;
constexpr int HT = NTOK / 2;
constexpr int C_Q = 0, C_K = 1536, C_V = 3072, C_ZA = 4608, C_CB = 5120, C_CC = 6144, C_CV = 7168, C_ZC = 8192, C_MQ = 9216, C_ZM = 10240, C_G = 11264;
constexpr int ACTW = 2560;
constexpr int LDP = 2048 + 64;
constexpr float EPSF = 1e-6f;
constexpr int NTHR = 512;
constexpr int LDS_BYTES = 149504;

constexpr size_t WS_WIN = 0;
constexpr size_t WS_WKV = WS_WIN + (size_t)PC * LDP * 2;
constexpr size_t WS_WBR = WS_WKV + (size_t)DM * DM * 2;
constexpr size_t WS_WOUT = WS_WBR + (size_t)DM * ACTW * 2;
constexpr size_t WS_MH = WS_WOUT + (size_t)DM * DM * 2;
constexpr size_t WS_MKV = WS_MH + (size_t)4096 * DM * 2;
constexpr size_t WS_PROJ = WS_MKV + (size_t)4096 * DM * 2;
constexpr size_t WS_OG = WS_PROJ + (size_t)HT * PS * 2;
constexpr size_t WS_LSE = WS_OG + (size_t)HT * 1536 * 2;
constexpr size_t WS_ACT = WS_LSE + (size_t)HT * 12 * 4;
constexpr size_t WS_GF = WS_ACT + (size_t)HT * ACTW * 2;
constexpr size_t WS_MB = WS_GF + (size_t)HT * 6144;
constexpr size_t WS_MB2 = WS_MB + (size_t)HT * DM * 2;
constexpr size_t WS_H = WS_MB2 + (size_t)HT * DM * 2;
constexpr size_t WS_BAR = WS_H + (size_t)NTOK * LDP * 2;
constexpr size_t WS_END = WS_BAR + 16384;
constexpr size_t OUT_H_OFF = (size_t)HT * DM * 4;

__device__ __forceinline__ float bflo(unsigned w) { return __uint_as_float(w << 16); }
__device__ __forceinline__ float bfhi(unsigned w) { return __uint_as_float(w & 0xffff0000u); }
typedef __bf16 bf16x2_t __attribute__((ext_vector_type(2)));
typedef float f32x2_t __attribute__((ext_vector_type(2)));
__device__ __forceinline__ unsigned cvt_pk_bf16(float lo, float hi) { f32x2_t v = {lo, hi}; bf16x2_t b = __builtin_convertvector(v, bf16x2_t); return __builtin_bit_cast(unsigned, b); }
__device__ __forceinline__ float shx(float v, int mask, int lane) { return __int_as_float(__builtin_amdgcn_ds_bpermute(((lane ^ mask) & 63) << 2, __float_as_int(v))); }
__device__ __forceinline__ float sigmoidf_(float x) { return __builtin_amdgcn_rcpf(1.0f + __builtin_amdgcn_exp2f(x * -1.4426950408889634f)); }
__device__ __forceinline__ float siluf_(float x) { return x * __builtin_amdgcn_rcpf(1.0f + __builtin_amdgcn_exp2f(x * -1.4426950408889634f)); }

namespace pg8 {
constexpr int BM = 256, BK = 64, HALF = 128, HTB = HALF * BK * 2, STAGE_BYTES = 8 * HTB, NXCD = 8, WGM = 8;
__host__ __device__ __forceinline__ int lds_byte(int r, int c) { const int st = (r >> 4) * 2 + (c >> 5), rr = r & 15, cc = c & 31, ob = rr * 64 + cc * 2; return st * 1024 + (ob ^ (((ob >> 9) & 1) << 5)); }
__host__ __device__ __forceinline__ void stage_rc(int b, int& R, int& C) { const int st = b / 1024, sb = b % 1024, swz = sb ^ (((sb >> 9) & 1) << 5); R = (st >> 1) * 16 + swz / 64; C = (st & 1) * 32 + (swz % 64) / 2; }
__host__ __device__ __forceinline__ int perm32(int rho) { const int n = rho >> 4, i = rho & 15; return 8 * (i >> 2) + 4 * n + (i & 3); }
struct Unit { int pm, pn; };
struct Gemm { const bf16_t* A; const bf16_t* Bt; int M, N, K, lda, ldb, f8; };
struct StaticOrder {
    int nM, nN, nwg, G, c;
    __device__ void init(int M, int N, int G_, int c_) { nM = M / BM; nN = N / BM; nwg = nM * nN; G = G_; c = c_; }
    __device__ bool next(int i, Unit& u) const {
        const long L = (long)i * G + c; if (L >= nwg) return false;
        int wgid = (int)L; { const int q = nwg / NXCD, r = nwg % NXCD, xcd = wgid % NXCD, off = wgid / NXCD; wgid = (xcd < r ? xcd * (q + 1) : r * (q + 1) + (xcd - r) * q) + off; }
        const int nig = WGM * nN, gid = wgid / nig, fm = gid * WGM, gsz = (nM - fm) < WGM ? (nM - fm) : WGM;
        u.pm = fm + ((wgid % nig) % gsz); u.pn = (wgid % nig) / gsz; return true;
    }
};

struct Epi;
template <bool F8, class Epi, class Sched>
__device__ __forceinline__ void gemm_phase(LAS unsigned char* lds, const Gemm g, const Sched& S, const Epi& E, const int tid) {
    const int wid = __builtin_amdgcn_readfirstlane(tid >> 6), lane = tid & 63, wr = wid >> 2, wc = wid & 3, fr = lane & 15, fq = lane >> 4;
    const int K = g.K, nt = K / BK;
    unsigned voffA[2], voffB[2];
#pragma unroll
    for (int i = 0; i < 2; ++i) { int R, C; stage_rc(tid * 16 + i * 8192, R, C); const int Rb = 2 * (R & ~31) + (E.perm() ? perm32(R & 31) : (R & 31));
        voffA[i] = (unsigned)(R * g.lda + C) * 2u; voffB[i] = (unsigned)(Rb * g.ldb + C) * 2u; }
    const size_t kstep = (size_t)(BK * 2);
    const size_t hstepA = (size_t)HALF * g.lda * 2, hstepB = (size_t)32 * g.ldb * 2;
    const size_t tstepA = 2 * hstepA, tstepB = (size_t)BM * g.ldb * 2;
    const unsigned ldsw = (unsigned)wid * 1024u;
    const int aoff = lds_byte(wr * 64 + fr, fq * 8), boff = lds_byte(wc * 32 + fr, fq * 8);
#define PG8_SA(b, h) (((b) * 2 + (h)) * HTB)
#define PG8_SB(b, h) ((4 + (b) * 2 + (h)) * HTB)
#define PG8_STAGE(bufoff, gbase, voff) do { _Pragma("unroll") for (int _i = 0; _i < 2; ++_i) \
        __builtin_amdgcn_global_load_lds((const unsigned*)((const char*)(gbase) + (voff)[_i]), (LAS unsigned*)(lds + (bufoff) + ldsw + _i * 8192), 16, 0, 0); } while (0)
#define PG8_LD8(p) __builtin_shufflevector(*(const LAS i32x4*)(p), *(const LAS i32x4*)((p) + 1024), 0, 1, 2, 3, 4, 5, 6, 7)
#define PG8_LDA(dst, b, h) do { _Pragma("unroll") for (int m = 0; m < 4; ++m) dst[m] = PG8_LD8(lds + PG8_SA(b, h) + aoff + m * 2048); } while (0)
#define PG8_LDB(dst, b, h) do { _Pragma("unroll") for (int n = 0; n < 2; ++n) dst[n] = PG8_LD8(lds + PG8_SB(b, h) + boff + n * 2048); } while (0)
#define PG8_LO(v) __builtin_bit_cast(bf16x8, __builtin_shufflevector(v, v, 0, 1, 2, 3))
#define PG8_HI(v) __builtin_bit_cast(bf16x8, __builtin_shufflevector(v, v, 4, 5, 6, 7))
#define PG8_MMA(ai, bj, At, Bt) do { __builtin_amdgcn_s_setprio(1); \
        if constexpr (F8) { _Pragma("unroll") for (int m = 0; m < 4; ++m) _Pragma("unroll") for (int n = 0; n < 2; ++n) \
            asm volatile("v_mfma_scale_f32_16x16x128_f8f6f4 %0, %1, %2, %0, %3, %3 op_sel_hi:[0,0,0]" : "+v"(acc[ai][bj][m][n]) : "v"(Bt[n]), "v"(At[m]), "v"(mxs)); } \
        else { _Pragma("unroll") for (int m = 0; m < 4; ++m) _Pragma("unroll") for (int n = 0; n < 2; ++n) { \
            acc[ai][bj][m][n] = __builtin_amdgcn_mfma_f32_16x16x32_bf16(PG8_LO(Bt[n]), PG8_LO(At[m]), acc[ai][bj][m][n], 0, 0, 0); \
            acc[ai][bj][m][n] = __builtin_amdgcn_mfma_f32_16x16x32_bf16(PG8_HI(Bt[n]), PG8_HI(At[m]), acc[ai][bj][m][n], 0, 0, 0); } } \
        __builtin_amdgcn_s_setprio(0); } while (0)
#define PG8_WAIT_V(n) asm volatile("s_waitcnt vmcnt(" #n ")" ::: "memory")
#define PG8_WAIT_L(n) asm volatile("s_waitcnt lgkmcnt(" #n ")" ::: "memory")
#define PG8_BAR __builtin_amdgcn_s_barrier()
#define PG8_SCHED __builtin_amdgcn_sched_barrier(0)
    Unit cur, nxt; int ui = 0;
    if (!S.next(0, cur)) return;
    int mxs = 0x7f7f7f7f; if constexpr (F8) asm volatile("" : "+v"(mxs));
    f32x4 acc[2][2][4][2];
#pragma unroll
    for (int a = 0; a < 2; ++a)
#pragma unroll
        for (int b = 0; b < 2; ++b)
#pragma unroll
            for (int m = 0; m < 4; ++m)
#pragma unroll
                for (int n = 0; n < 2; ++n) acc[a][b][m][n] = (f32x4){0.f, 0.f, 0.f, 0.f};
    i32x8 At[4], B0[2], B1[2];
    const char* cA = (const char*)g.A + (size_t)cur.pm * tstepA; const char* cB = (const char*)g.Bt + (size_t)cur.pn * tstepB;
#if PG8_SP2
    PG8_STAGE(PG8_SB(0, 0), cB, voffB); PG8_STAGE(PG8_SB(0, 1), cB + hstepB, voffB); PG8_STAGE(PG8_SA(0, 0), cA, voffA); PG8_STAGE(PG8_SA(0, 1), cA + hstepA, voffA);
    if (wr == 1) PG8_BAR;
    PG8_WAIT_V(2); PG8_BAR;
    PG8_STAGE(PG8_SB(1, 0), cB + kstep, voffB); PG8_STAGE(PG8_SA(1, 0), cA + kstep, voffA); PG8_STAGE(PG8_SB(1, 1), cB + hstepB + kstep, voffB);
    PG8_WAIT_V(6); PG8_BAR;
#else
    PG8_STAGE(PG8_SB(0, 0), cB, voffB); PG8_STAGE(PG8_SA(0, 0), cA, voffA); PG8_STAGE(PG8_SB(0, 1), cB + hstepB, voffB); PG8_STAGE(PG8_SA(0, 1), cA + hstepA, voffA);
    if (wr == 1) PG8_BAR;
    PG8_WAIT_V(4); PG8_BAR;
    PG8_STAGE(PG8_SB(1, 0), cB + kstep, voffB); PG8_STAGE(PG8_SA(1, 0), cA + kstep, voffA); PG8_STAGE(PG8_SB(1, 1), cB + hstepB + kstep, voffB);
    PG8_WAIT_V(6); PG8_BAR;
#endif
    for (;;) {
        const bool has_next = S.next(ui + 1, nxt);
        const char* nA = has_next ? (const char*)g.A + (size_t)nxt.pm * tstepA : cA; const char* nB = has_next ? (const char*)g.Bt + (size_t)nxt.pn * tstepB : cB;
        for (int t = 0; t < nt; t += 2) {
            const bool last = (t == nt - 2);
            const char* a1 = cA + (size_t)(t + 1) * kstep;
            const char* a2 = last ? nA : cA + (size_t)(t + 2) * kstep; const char* b2 = last ? nB : cB + (size_t)(t + 2) * kstep;
            const char* a3 = a2 + kstep; const char* b3 = b2 + kstep;
            if constexpr (!F8) { if (E.has_mid() && (t == 8 || t == 24)) E.mid(acc, cur, tid, t == 8 ? 0 : 1); }
#if PG8_SP2
            PG8_LDB(B0, 0, 0); PG8_LDB(B1, 0, 1); PG8_SCHED; PG8_LDA(At, 0, 0); PG8_STAGE(PG8_SA(1, 1), a1 + hstepA, voffA);
            PG8_WAIT_V(8); PG8_WAIT_L(0); PG8_BAR; PG8_MMA(0, 0, At, B0); PG8_MMA(0, 1, At, B1); PG8_BAR; PG8_SCHED;
            PG8_LDA(At, 0, 1); PG8_STAGE(PG8_SB(0, 0), b2, voffB); PG8_STAGE(PG8_SB(0, 1), b2 + hstepB, voffB); PG8_STAGE(PG8_SA(0, 0), a2, voffA);
            PG8_WAIT_V(8); PG8_WAIT_L(0); PG8_BAR; PG8_MMA(1, 0, At, B0); PG8_MMA(1, 1, At, B1); PG8_BAR; PG8_SCHED;
            PG8_LDB(B0, 1, 0); PG8_LDB(B1, 1, 1); PG8_SCHED; PG8_LDA(At, 1, 0); PG8_STAGE(PG8_SA(0, 1), a2 + hstepA, voffA);
            PG8_WAIT_V(8); PG8_WAIT_L(0); PG8_BAR; PG8_MMA(0, 0, At, B0); PG8_MMA(0, 1, At, B1); PG8_BAR; PG8_SCHED;
            PG8_LDA(At, 1, 1); PG8_STAGE(PG8_SB(1, 0), b3, voffB); PG8_STAGE(PG8_SB(1, 1), b3 + hstepB, voffB); PG8_STAGE(PG8_SA(1, 0), a3, voffA);
            PG8_WAIT_V(8); PG8_WAIT_L(0); PG8_BAR; PG8_MMA(1, 0, At, B0); PG8_MMA(1, 1, At, B1); PG8_BAR; PG8_SCHED;
#else
            PG8_LDB(B0, 0, 0); PG8_SCHED; PG8_LDA(At, 0, 0); PG8_STAGE(PG8_SA(1, 1), a1 + hstepA, voffA);
            PG8_WAIT_L(8); PG8_BAR; PG8_WAIT_L(0); PG8_MMA(0, 0, At, B0); PG8_BAR; PG8_SCHED;
            PG8_LDB(B1, 0, 1); PG8_STAGE(PG8_SB(0, 0), b2, voffB);
            PG8_BAR; PG8_WAIT_L(0); PG8_MMA(0, 1, At, B1); PG8_BAR;
            PG8_LDA(At, 0, 1); PG8_STAGE(PG8_SA(0, 0), a2, voffA);
            PG8_BAR; PG8_WAIT_L(0); PG8_MMA(1, 0, At, B0); PG8_BAR; PG8_SCHED;
            PG8_STAGE(PG8_SB(0, 1), b2 + hstepB, voffB);
            PG8_WAIT_V(6); PG8_BAR; PG8_MMA(1, 1, At, B1); PG8_BAR;
            PG8_LDB(B0, 1, 0); PG8_SCHED; PG8_LDA(At, 1, 0); PG8_STAGE(PG8_SA(0, 1), a2 + hstepA, voffA);
            PG8_WAIT_L(8); PG8_BAR; PG8_WAIT_L(0); PG8_MMA(0, 0, At, B0); PG8_BAR; PG8_SCHED;
            PG8_LDB(B1, 1, 1); PG8_STAGE(PG8_SB(1, 0), b3, voffB);
            PG8_BAR; PG8_WAIT_L(0); PG8_MMA(0, 1, At, B1); PG8_BAR;
            PG8_LDA(At, 1, 1); PG8_STAGE(PG8_SA(1, 0), a3, voffA);
            PG8_BAR; PG8_WAIT_L(0); PG8_MMA(1, 0, At, B0); PG8_BAR; PG8_SCHED;
            PG8_STAGE(PG8_SB(1, 1), b3 + hstepB, voffB);
            PG8_WAIT_V(6); PG8_BAR; PG8_MMA(1, 1, At, B1); PG8_BAR;
#endif
        }
        if (wr == 0) PG8_BAR;
        if constexpr (F8) {
            asm volatile("s_nop 15\n\ts_nop 15"
                         : "+v"(acc[1][0][0][0]), "+v"(acc[1][0][0][1]), "+v"(acc[1][0][1][0]), "+v"(acc[1][0][1][1]), "+v"(acc[1][0][2][0]), "+v"(acc[1][0][2][1]), "+v"(acc[1][0][3][0]), "+v"(acc[1][0][3][1]),
                           "+v"(acc[1][1][0][0]), "+v"(acc[1][1][0][1]), "+v"(acc[1][1][1][0]), "+v"(acc[1][1][1][1]), "+v"(acc[1][1][2][0]), "+v"(acc[1][1][2][1]), "+v"(acc[1][1][3][0]), "+v"(acc[1][1][3][1]));
            E.k0(acc, cur, wr, wc, fr, fq, tid);
        } else E(acc, cur, wr, wc, fr, fq, tid);
        if (!has_next) break;
#pragma unroll
        for (int a = 0; a < 2; ++a)
#pragma unroll
            for (int b = 0; b < 2; ++b)
#pragma unroll
                for (int m = 0; m < 4; ++m)
#pragma unroll
                    for (int n = 0; n < 2; ++n) acc[a][b][m][n] = (f32x4){0.f, 0.f, 0.f, 0.f};
        cur = nxt; cA = nA; cB = nB; ++ui;
        if (wr == 1) PG8_BAR;
    }
    PG8_WAIT_V(0);
    PG8_BAR;
#undef PG8_SA
#undef PG8_SB
#undef PG8_STAGE
#undef PG8_LDA
#undef PG8_LDB
#undef PG8_MMA
#undef PG8_LD8
#undef PG8_LO
#undef PG8_HI
#undef PG8_WAIT_V
#undef PG8_WAIT_L
#undef PG8_BAR
#undef PG8_SCHED
}

struct Epi {
    int kind; void* p0; const void* p1; void* p2; int ldc, gpn0; float gscale; int split, off0, off1, gpn1, gb0, gb1;
    __device__ __forceinline__ bool perm() const { return kind != 4; }
    __device__ __forceinline__ bool has_mid() const { return kind == 5; }
    __device__ __forceinline__ void mid(f32x4 (&acc)[2][2][4][2], const Unit& u, int tid, int which) const {
        const u32x2* ga = (const u32x2*)p1 + ((size_t)(u.pm * 24 + 8 * which + u.pn) * 16) * 512 + tid; const u32x2* gb = ga + (size_t)8 * 16 * 512;
        u32x2 x[16], y[16];
#pragma unroll
        for (int i = 0; i < 16; ++i) { x[i] = ga[i * 512]; y[i] = gb[i * 512]; }
        asm volatile("s_waitcnt vmcnt(0)" ::: "memory");
#pragma unroll
        for (int i = 0; i < 16; ++i) { const int ai = i >> 3, m = (i >> 1) & 3, bj = i & 1; const u32x2 a = x[i], b = y[i];
#define QR(wa, wb, sh) __builtin_amdgcn_exp2f(((float)(((wb) >> (sh)) & 0xffu) - (float)(((wa) >> (sh)) & 0xffu)) * 0.03125f)
            acc[ai][bj][m][0] *= (f32x4){QR(a.x, b.x, 0), QR(a.x, b.x, 8), QR(a.x, b.x, 16), QR(a.x, b.x, 24)};
            acc[ai][bj][m][1] *= (f32x4){QR(a.y, b.y, 0), QR(a.y, b.y, 8), QR(a.y, b.y, 16), QR(a.y, b.y, 24)};
#undef QR
        }
    }
    __device__ __forceinline__ void gate(const f32x4 (&acc)[2][2][4][2], const Unit& u, int tid) const {
            const int gi = (u.pn < gpn1) ? gb0 + (u.pn - gpn0) : gb1 + (u.pn - gpn1);
            u32x2* gf = (u32x2*)p2 + ((size_t)(u.pm * 24 + gi) * 16) * 512 + tid;
            const float nls = -1.4426950408889634f * gscale;
#pragma unroll
            for (int ai = 0; ai < 2; ++ai)
#pragma unroll
                for (int m = 0; m < 4; ++m)
#pragma unroll
                    for (int bj = 0; bj < 2; ++bj) { const f32x4 v0 = acc[ai][bj][m][0], v1 = acc[ai][bj][m][1];
#define QF(v) (__builtin_amdgcn_logf(1.0f + __builtin_amdgcn_exp2f((v) * nls)) * 32.0f)
#define QP(a, b, c, d) __builtin_amdgcn_cvt_pk_u8_f32(QF(d), 3, __builtin_amdgcn_cvt_pk_u8_f32(QF(c), 2, __builtin_amdgcn_cvt_pk_u8_f32(QF(b), 1, __builtin_amdgcn_cvt_pk_u8_f32(QF(a), 0, 0u))))
                        u32x2 w; w.x = QP(v0[0], v0[1], v0[2], v0[3]); w.y = QP(v1[0], v1[1], v1[2], v1[3]);
#undef QP
#undef QF
                        __builtin_nontemporal_store(w, &gf[((ai * 4 + m) * 2 + bj) * 512]); }
    }
    __device__ __forceinline__ void k0store(const f32x4 (&acc)[2][2][4][2], const Unit& u, int wr, int wc, int fr, int fq) const {
        const bool lo = fr < 8;
        const int row0 = u.pm * BM + wr * 64 + (fr & 7);
        bf16_t* O = (bf16_t*)p0; const int col0 = ((u.pn < split) ? off0 + u.pn * BM : off1 + (u.pn - split) * BM) + wc * 64 + 8 * fq + (lo ? 0 : 32); const float sc = gscale;
#pragma unroll
        for (int ai = 0; ai < 2; ++ai)
#pragma unroll
            for (int m = 0; m < 4; ++m) { bf16_t* rowp = O + (size_t)(row0 + ai * HALF + m * 16) * ldc + col0;
                const f32x4 a0 = acc[ai][0][m][0] * sc, a1 = acc[ai][0][m][1] * sc, b0 = acc[ai][1][m][0] * sc, b1 = acc[ai][1][m][1] * sc;
                u32x4 w0, w1; w0.x = cvt_pk_bf16(a0[0], a0[1]); w0.y = cvt_pk_bf16(a0[2], a0[3]); w0.z = cvt_pk_bf16(a1[0], a1[1]); w0.w = cvt_pk_bf16(a1[2], a1[3]);
                w1.x = cvt_pk_bf16(b0[0], b0[1]); w1.y = cvt_pk_bf16(b0[2], b0[3]); w1.z = cvt_pk_bf16(b1[0], b1[1]); w1.w = cvt_pk_bf16(b1[2], b1[3]);
                const u32x4 snd = lo ? w1 : w0; u32x4 rcv;
                rcv.x = (unsigned)__builtin_amdgcn_mov_dpp((int)snd.x, 0x128, 0xf, 0xf, true); rcv.y = (unsigned)__builtin_amdgcn_mov_dpp((int)snd.y, 0x128, 0xf, 0xf, true);
                rcv.z = (unsigned)__builtin_amdgcn_mov_dpp((int)snd.z, 0x128, 0xf, 0xf, true); rcv.w = (unsigned)__builtin_amdgcn_mov_dpp((int)snd.w, 0x128, 0xf, 0xf, true);
                const u32x4 sa = lo ? w0 : rcv, sb = lo ? rcv : w1;
                __builtin_nontemporal_store(sa, (u32x4*)rowp);
                __builtin_nontemporal_store(sb, (u32x4*)(rowp + (size_t)8 * ldc)); }
    }
    __device__ __forceinline__ void k0(const f32x4 (&acc)[2][2][4][2], const Unit& u, int wr, int wc, int fr, int fq, int tid) const {
        if (u.pn >= gpn0) gate(acc, u, tid); else k0store(acc, u, wr, wc, fr, fq);
    }
    __device__ __forceinline__ void operator()(const f32x4 (&acc)[2][2][4][2], const Unit& u, int wr, int wc, int fr, int fq, int tid) const {
        const int row0 = u.pm * BM + wr * 64 + fr;
        if (kind == 0 && u.pn >= gpn0) {
            gate(acc, u, tid);
        } else if (kind == 0) {
            k0store(acc, u, wr, wc, fr, fq);
        } else if (kind == 4) {
            const float* x = (const float*)p1; float* out = (float*)p0; const int col0 = u.pn * BM + wc * 64 + 4 * fq;
#pragma unroll
            for (int ai = 0; ai < 2; ++ai) {
                f32x4 xv[4][2][2];
#pragma unroll
                for (int m = 0; m < 4; ++m) { const size_t off = (size_t)(row0 + ai * HALF + m * 16) * DM + col0;
#pragma unroll
                    for (int bj = 0; bj < 2; ++bj)
#pragma unroll
                        for (int n = 0; n < 2; ++n) xv[m][bj][n] = *(const f32x4*)(x + off + bj * 32 + n * 16); }
                asm volatile("s_waitcnt vmcnt(0)" ::: "memory");
#pragma unroll
                for (int m = 0; m < 4; ++m) { const size_t off = (size_t)(row0 + ai * HALF + m * 16) * DM + col0;
#pragma unroll
                    for (int bj = 0; bj < 2; ++bj)
#pragma unroll
                        for (int n = 0; n < 2; ++n) *(f32x4*)(out + off + bj * 32 + n * 16) = xv[m][bj][n] + acc[ai][bj][m][n]; }
                asm volatile("" ::: "memory");
            }
        } else if (kind == 5) {
            bf16_t* O = (bf16_t*)p0; const int col0 = u.pn * BM + wc * 64 + 8 * fq;
            const u32x2* gc = (const u32x2*)p1 + ((size_t)(u.pm * 24 + 16 + u.pn) * 16) * 512 + tid;
            u32x2 gy[16];
#pragma unroll
            for (int i = 0; i < 16; ++i) gy[i] = gc[i * 512];
            asm volatile("s_waitcnt vmcnt(0)" ::: "memory");
#pragma unroll
            for (int ai = 0; ai < 2; ++ai)
#pragma unroll
                for (int m = 0; m < 4; ++m) { bf16_t* rowp = O + (size_t)(row0 + ai * HALF + m * 16) * ldc + col0;
#pragma unroll
                    for (int bj = 0; bj < 2; ++bj) { const f32x4 v0 = acc[ai][bj][m][0], v1 = acc[ai][bj][m][1]; const u32x2 y = gy[(ai * 4 + m) * 2 + bj];
#define QS(wv, sh) __builtin_amdgcn_exp2f((float)(((wv) >> (sh)) & 0xffu) * -0.03125f)
                        u32x4 w; w.x = cvt_pk_bf16(v0[0] * QS(y.x, 0), v0[1] * QS(y.x, 8)); w.y = cvt_pk_bf16(v0[2] * QS(y.x, 16), v0[3] * QS(y.x, 24));
                        w.z = cvt_pk_bf16(v1[0] * QS(y.y, 0), v1[1] * QS(y.y, 8)); w.w = cvt_pk_bf16(v1[2] * QS(y.y, 16), v1[3] * QS(y.y, 24));
#undef QS
                        *(u32x4*)(rowp + bj * 32) = w; } }
        }
    }
};
}

__device__ __forceinline__ unsigned pk4_fp8(float a, float b, float c, float d) { int w = __builtin_amdgcn_cvt_pk_fp8_f32(a, b, 0, false); w = __builtin_amdgcn_cvt_pk_fp8_f32(c, d, w, true); return (unsigned)w; }
__device__ __forceinline__ void rmsnorm_rows(const float* __restrict__ x, const float* __restrict__ g, bf16_t* __restrict__ out, int ldo, unsigned char* __restrict__ out8, int nrows, int gw, int nw, int lane) {
    for (int row = gw; row < nrows; row += nw) {
        const float4* xr = (const float4*)(x + (size_t)row * DM);
        float4 v[8]; float ss = 0.f;
#pragma unroll
        for (int i = 0; i < 4; ++i) { const int c = lane + 64 * i; const f32x4 t0 = __builtin_nontemporal_load((const f32x4*)(xr + 2 * c)), t1 = __builtin_nontemporal_load((const f32x4*)(xr + 2 * c + 1)); v[2 * i] = make_float4(t0[0], t0[1], t0[2], t0[3]); v[2 * i + 1] = make_float4(t1[0], t1[1], t1[2], t1[3]); }
#pragma unroll
        for (int i = 0; i < 8; ++i) ss += v[i].x * v[i].x + v[i].y * v[i].y + v[i].z * v[i].z + v[i].w * v[i].w;
#pragma unroll
        for (int o = 32; o >= 1; o >>= 1) ss += shx(ss, o, lane);
        const float rstd = rsqrtf(ss * (1.0f / DM) + EPSF);
#pragma unroll
        for (int i = 0; i < 4; ++i) { const int c = lane + 64 * i; const float4 ga = ((const float4*)g)[2 * c], gb = ((const float4*)g)[2 * c + 1]; const float4 a = v[2 * i], b = v[2 * i + 1];
            u32x4 w; w.x = cvt_pk_bf16(a.x * rstd * ga.x, a.y * rstd * ga.y); w.y = cvt_pk_bf16(a.z * rstd * ga.z, a.w * rstd * ga.w);
            w.z = cvt_pk_bf16(b.x * rstd * gb.x, b.y * rstd * gb.y); w.w = cvt_pk_bf16(b.z * rstd * gb.z, b.w * rstd * gb.w);
            *(u32x4*)(out + (size_t)row * ldo + c * 8) = w;
            if (out8) { u32x2 q; q.x = pk4_fp8(a.x * rstd * ga.x, a.y * rstd * ga.y, a.z * rstd * ga.z, a.w * rstd * ga.w); q.y = pk4_fp8(b.x * rstd * gb.x, b.y * rstd * gb.y, b.z * rstd * gb.z, b.w * rstd * gb.w);
                        *(u32x2*)(out8 + (size_t)row * DM + c * 8) = q; } }
    }
}
struct TJob { const float* src; bf16_t* dst; int C, ld, koff, r0, c0, dc, f8; };
__device__ __forceinline__ void tile_load(float4 (&v)[4], const TJob& J, int tid) {
#pragma unroll
    for (int p = 0; p < 4; ++p) { const int r = p * 16 + (tid >> 5), c4 = (tid & 31) * 4; const f32x4 t = __builtin_nontemporal_load((const f32x4*)(J.src + (size_t)(J.r0 + r) * J.C + J.c0 + c4)); v[p] = make_float4(t[0], t[1], t[2], t[3]); }
}
__device__ __forceinline__ void tile_store(LAS float* t  , const float4 (&v)[4], const TJob& J, int tid) {
#pragma unroll
    for (int p = 0; p < 4; ++p) { const int r = p * 16 + (tid >> 5), c4 = (tid & 31) * 4; LAS float* q = t + r * 129 + c4; q[0] = v[p].x; q[1] = v[p].y; q[2] = v[p].z; q[3] = v[p].w; }
    __syncthreads();
#pragma unroll
    for (int h = 0; h < 2; ++h) { const int c = h * 64 + (tid >> 3), rc = (tid & 7) * 8; float f[8];
#pragma unroll
        for (int j = 0; j < 8; ++j) f[j] = t[(rc + j) * 129 + c];
        if (J.f8) { u32x2 q; q.x = pk4_fp8(f[0] * 64.f, f[1] * 64.f, f[2] * 64.f, f[3] * 64.f); q.y = pk4_fp8(f[4] * 64.f, f[5] * 64.f, f[6] * 64.f, f[7] * 64.f);
                    *(u32x2*)((unsigned char*)J.dst + (size_t)(J.dc + c) * J.ld + J.r0 + rc) = q; }
        else { u32x4 w; w.x = cvt_pk_bf16(f[0], f[1]); w.y = cvt_pk_bf16(f[2], f[3]); w.z = cvt_pk_bf16(f[4], f[5]); w.w = cvt_pk_bf16(f[6], f[7]);
               *(u32x4*)(J.dst + (size_t)(J.dc + c) * J.ld + J.koff + J.r0 + rc) = w; } }
    __syncthreads();
}

struct PrepPtrs { const float* win; const float* wkv; const float* wba; const float* wbc; const float* wbm; const float* wout; bf16_t* WIN; bf16_t* WKV; bf16_t* WBR; bf16_t* WOUT; unsigned char* WG8; };
constexpr int PT0 = 512, PT1 = PT0 + 32 * 136, PT2 = PT1 + 128, PT3 = PT2 + 256, PT4 = PT3 + 256, PT5 = PT4 + 512;
__device__ __forceinline__ TJob prep_job(int t, const PrepPtrs P) {
    TJob J; int ti;
    if (t < PT0) { J.src = P.wkv; J.C = DM; J.dst = P.WKV; J.ld = DM; J.koff = 0; ti = t; }
    else if (t < PT1) { J.src = P.win; J.C = PC; J.dst = P.WIN; J.ld = LDP; J.koff = 0; ti = t - PT0; }
    else if (t < PT2) { J.src = P.wba; J.C = DM; J.dst = P.WBR; J.ld = ACTW; J.koff = 0; ti = t - PT1; }
    else if (t < PT3) { J.src = P.wbc; J.C = DM; J.dst = P.WBR; J.ld = ACTW; J.koff = 512; ti = t - PT2; }
    else if (t < PT4) { J.src = P.wbm; J.C = DM; J.dst = P.WBR; J.ld = ACTW; J.koff = 1536; ti = t - PT3; }
    else { J.src = P.wout; J.C = DM; J.dst = P.WOUT; J.ld = DM; J.koff = 0; ti = t - PT4; }
    const int nct = J.C / 128; J.r0 = (ti / nct) * 64; J.c0 = (ti % nct) * 128; J.dc = J.c0; J.f8 = 0;
    if (t >= PT0 && t < PT1) {
        const int c = J.c0;
        if (c < 5120) { J.f8 = 1; J.dc = c; }
        else if (c < 9216) { J.dc = c - 5120; }
        else if (c < 11264) { J.f8 = 1; J.dc = 5120 + (c - 9216); }
        else if (c < 13312) { J.f8 = 1; J.dc = 7168 + (c - 11264); }
        else if (c < 15360) { J.dc = 4096 + (c - 13312); }
        else { J.f8 = 1; J.dc = 9216 + (c - 15360); }
        if (J.f8) { J.dst = (bf16_t*)P.WG8; J.ld = DM; }
    }
    return J;
}

template <int HD> struct AttnGeo { static constexpr int KSTR = HD * 2 + 16, VSTR = HD * 2 + 32, PPR = HD / 8, NKS = HD / 32, NDT = HD / 16, NPC = 256 * (HD / 8) / NTHR; };

template <int HD> __device__ __forceinline__ void issue_rows(u32x4 (&r)[AttnGeo<HD>::NPC], const bf16_t* __restrict__ p, int stride, int jbase, int tid) {
    typedef AttnGeo<HD> G; constexpr int RS = NTHR / G::PPR;
    const int r0 = tid / G::PPR, pc = tid % G::PPR;
#pragma unroll
    for (int i = 0; i < G::NPC; ++i) { int j = jbase + r0 + i * RS; j = j < 0 ? 0 : j;
        r[i] = *(const u32x4*)(p + ((unsigned)j * (unsigned)stride + (unsigned)(pc * 8))); }
}
template <int HD> __device__ __forceinline__ void issue_q(u32x4 (&q)[AttnGeo<HD>::NKS], const bf16_t* __restrict__ qrow, int g4) {
#pragma unroll
    for (int ks = 0; ks < AttnGeo<HD>::NKS; ++ks) q[ks] = *(const u32x4*)(qrow + ks * 32 + g4 * 8);
}
template <int HD> __device__ __forceinline__ void write_k(LAS unsigned char* kl, const u32x4 (&r)[AttnGeo<HD>::NPC], int jbase, const float* __restrict__ wk, int tid) {
    typedef AttnGeo<HD> G; constexpr int RS = NTHR / G::PPR;
    const int r0 = tid / G::PPR, pc = tid % G::PPR;
    LAS unsigned char* base = kl + r0 * G::KSTR + pc * 16;
    const float4 wa = *(const float4*)(wk + pc * 8), wb = *(const float4*)(wk + pc * 8 + 4);
#pragma unroll
    for (int i = 0; i < G::NPC; ++i) { const u32x4 w = r[i];
        float f[8] = {bflo(w.x), bfhi(w.x), bflo(w.y), bfhi(w.y), bflo(w.z), bfhi(w.z), bflo(w.w), bfhi(w.w)};
        float ss = 0.f;
#pragma unroll
        for (int e = 0; e < 8; ++e) ss += f[e] * f[e];
#pragma unroll
        for (int o = 1; o < G::PPR; o <<= 1) ss += shx(ss, o, tid);
        const float rstd = (jbase + r0 + i * RS >= 0) ? rsqrtf(ss * (1.0f / HD) + EPSF) : 0.f;
        u32x4 o4; o4.x = cvt_pk_bf16(f[0] * rstd * wa.x, f[1] * rstd * wa.y); o4.y = cvt_pk_bf16(f[2] * rstd * wa.z, f[3] * rstd * wa.w);
        o4.z = cvt_pk_bf16(f[4] * rstd * wb.x, f[5] * rstd * wb.y); o4.w = cvt_pk_bf16(f[6] * rstd * wb.z, f[7] * rstd * wb.w);
        *(LAS u32x4*)(base + i * (RS * G::KSTR)) = o4;
        if (G::NPC > 8) __builtin_amdgcn_sched_barrier(0); }
}
template <int HD> __device__ __forceinline__ void write_v(LAS unsigned char* vl, const u32x4 (&r)[AttnGeo<HD>::NPC], int jbase, int tid) {
    typedef AttnGeo<HD> G; constexpr int RS = NTHR / G::PPR;
    const int r0 = tid / G::PPR, pc = tid % G::PPR;
    LAS unsigned char* base = vl + r0 * G::VSTR + pc * 16;
#pragma unroll
    for (int i = 0; i < G::NPC; ++i) { const bool ok = jbase + r0 + i * RS >= 0; u32x4 w = r[i];
        w.x = ok ? w.x : 0u; w.y = ok ? w.y : 0u; w.z = ok ? w.z : 0u; w.w = ok ? w.w : 0u;
        *(LAS u32x4*)(base + i * (RS * G::VSTR)) = w; }
}
template <int HD, bool ISK> __device__ __forceinline__ void stage_rows(LAS unsigned char* dst, const bf16_t* __restrict__ p, int stride, const float* __restrict__ wk, int tid) {
    typedef AttnGeo<HD> G; constexpr int RS = NTHR / G::PPR, STR = ISK ? G::KSTR : G::VSTR, NB = ISK ? 8 : 16;
    const int r0 = tid / G::PPR, pc = tid % G::PPR;
    LAS unsigned char* base = dst + r0 * STR + pc * 16;
    float4 wa = make_float4(1.f, 1.f, 1.f, 1.f), wb = wa;
    if (ISK) { wa = *(const float4*)(wk + pc * 8); wb = *(const float4*)(wk + pc * 8 + 4); }
#pragma unroll 1
    for (int i0 = 0; i0 < G::NPC; i0 += NB) {
        u32x4 r[NB];
        unsigned boff = (unsigned)(r0 + i0 * RS) * (unsigned)stride + (unsigned)(pc * 8); asm volatile("" : "+v"(boff));
#pragma unroll
        for (int i = 0; i < NB; ++i) r[i] = *(const u32x4*)(p + (boff + (unsigned)(i * RS) * (unsigned)stride));
#pragma unroll
        for (int i = 0; i < NB; ++i) { u32x4 w = r[i];
            if (ISK) {
                float f[8] = {bflo(w.x), bfhi(w.x), bflo(w.y), bfhi(w.y), bflo(w.z), bfhi(w.z), bflo(w.w), bfhi(w.w)};
                float ss = 0.f;
#pragma unroll
                for (int e = 0; e < 8; ++e) ss += f[e] * f[e];
#pragma unroll
                for (int o = 1; o < G::PPR; o <<= 1) ss += shx(ss, o, tid);
                const float rstd = rsqrtf(ss * (1.0f / HD) + EPSF);
                w.x = cvt_pk_bf16(f[0] * rstd * wa.x, f[1] * rstd * wa.y); w.y = cvt_pk_bf16(f[2] * rstd * wa.z, f[3] * rstd * wa.w);
                w.z = cvt_pk_bf16(f[4] * rstd * wb.x, f[5] * rstd * wb.y); w.w = cvt_pk_bf16(f[6] * rstd * wb.z, f[7] * rstd * wb.w);
            }
            *(LAS u32x4*)(base + (i0 + i) * (RS * STR)) = w;
            if (ISK) __builtin_amdgcn_sched_barrier(0); }
    }
}
template <int HD> __device__ __forceinline__ void norm_q(bf16x8 (&qf)[AttnGeo<HD>::NKS], const u32x4 (&qw)[AttnGeo<HD>::NKS], const float* __restrict__ wq, float scale, int g4, int lane16) {
    typedef AttnGeo<HD> G;
    float ss = 0.f;
#pragma unroll
    for (int ks = 0; ks < G::NKS; ++ks) { const u32x4 x = qw[ks]; const float a0 = bflo(x.x), a1 = bfhi(x.x), a2 = bflo(x.y), a3 = bfhi(x.y), a4 = bflo(x.z), a5 = bfhi(x.z), a6 = bflo(x.w), a7 = bfhi(x.w);
        ss += a0 * a0 + a1 * a1 + a2 * a2 + a3 * a3 + a4 * a4 + a5 * a5 + a6 * a6 + a7 * a7; }
    ss += shx(ss, 16, lane16); ss += shx(ss, 32, lane16);
    const float sc = rsqrtf(ss * (1.0f / HD) + EPSF) * scale;
#pragma unroll
    for (int ks = 0; ks < G::NKS; ++ks) { const u32x4 x = qw[ks]; const float4 wa = *(const float4*)(wq + ks * 32 + g4 * 8), wb = *(const float4*)(wq + ks * 32 + g4 * 8 + 4);
        u32x4 o; o.x = cvt_pk_bf16(bflo(x.x) * sc * wa.x, bfhi(x.x) * sc * wa.y); o.y = cvt_pk_bf16(bflo(x.y) * sc * wa.z, bfhi(x.y) * sc * wa.w);
        o.z = cvt_pk_bf16(bflo(x.z) * sc * wb.x, bfhi(x.z) * sc * wb.y); o.w = cvt_pk_bf16(bflo(x.w) * sc * wb.z, bfhi(x.w) * sc * wb.w);
        qf[ks] = __builtin_bit_cast(bf16x8, o); }
}

__device__ __forceinline__ int band_item(int bx, int k, int G_) { return (G_ == 256) ? ((k >> 1) * 512 + 64 * (bx & 7) + (bx >> 3) + 32 * (k & 1)) : (bx + k * G_); }
__device__ __forceinline__ int mem_item(int bx, int k, int G_) { return (G_ == 256) ? (64 * (bx & 7) + (bx >> 3) + 32 * k) : (bx + k * G_); }
struct BandItem { const bf16_t* qp; int rstride; int qb, g, h; size_t row0; int d; };
__device__ __forceinline__ BandItem band_decode(int it, const bf16_t* PROJ) {
    BandItem I; const int g = it >> 9, idx = it & 511, dsh = 2 * g, d = 1 << dsh, nqb = 16 >> dsh;
    I.qb = idx % nqb; int rest = idx / nqb; const int r = rest % d; rest /= d; I.h = rest & 3; const int bl = rest >> 2;
    I.g = g; I.d = d; I.row0 = (size_t)bl * SEQ + r; I.qp = PROJ + I.row0 * PS + g * 512 + I.h * 128; I.rstride = d * PS; return I;
}
__device__ __forceinline__ void attn_banded_run(LAS unsigned char* lds, const bf16_t* __restrict__ PROJ, const float* __restrict__ aqn, const float* __restrict__ akn, bf16_t* __restrict__ OG, float* __restrict__ LSE,
                                                int bx, int G_, const int tid) {
    constexpr int HD = 128; typedef AttnGeo<HD> G;
    const int w = __builtin_amdgcn_readfirstlane(tid >> 6), lane = tid & 63, lq = lane & 15, g4 = lane >> 4;
    LAS unsigned char* kl = lds; LAS unsigned char* vl = lds + 256 * G::KSTR;
    const int n = (1536 - bx + G_ - 1) / G_;
    if (n <= 0) return;
    u32x4 rk[G::NPC], rv[G::NPC], rq[G::NKS];
    { const BandItem I = band_decode(band_item(bx, 0, G_), PROJ); const int jb = I.qb * 128 - 128;
      issue_rows<HD>(rk, I.qp + C_K, I.rstride, jb, tid); issue_rows<HD>(rv, I.qp + C_V, I.rstride, jb, tid); issue_q<HD>(rq, I.qp + (unsigned)(I.qb * 128 + 16 * w + lq) * (unsigned)I.rstride, g4); }
    { unsigned zl = 0u; asm volatile("" : "+v"(zl));
      for (int p = tid; p < 16 * G::PPR; p += NTHR) *(LAS u32x4*)(vl + (256 + p / G::PPR) * G::VSTR + (p % G::PPR) * 16) = (u32x4){zl, zl, zl, zl}; }
#pragma unroll 1
    for (int k = 0; k < n; ++k) {
        const BandItem I = band_decode(band_item(bx, k, G_), PROJ);
        const int jbase = I.qb * 128 - 128, qi = I.qb * 128 + 16 * w + lq;
        write_k<HD>(kl, rk, jbase, akn + I.g * 128, tid);
        write_v<HD>(vl, rv, jbase, tid);
        bf16x8 qf[G::NKS];
        norm_q<HD>(qf, rq, aqn + I.g * 128, 0.08838834764831845f * 1.4426950408889634f, g4, lane);
        __syncthreads();
        { const int kn = (k + 1 < n) ? k + 1 : k; const BandItem J = band_decode(band_item(bx, kn, G_), PROJ); const int jb = J.qb * 128 - 128;
          issue_rows<HD>(rk, J.qp + C_K, J.rstride, jb, tid); issue_rows<HD>(rv, J.qp + C_V, J.rstride, jb, tid); issue_q<HD>(rq, J.qp + (unsigned)(J.qb * 128 + 16 * w + lq) * (unsigned)J.rstride, g4); }
        f32x4 S[10];
        float NEG = -__builtin_inff(); asm volatile("" : "+v"(NEG));
#pragma unroll
        for (int t = 0; t < 9; ++t) {
            const int kt = w + t;
            if (jbase + kt * 16 >= 0) {
                f32x4 sv = (f32x4){0.f, 0.f, 0.f, 0.f};
#pragma unroll
                for (int ks = 0; ks < G::NKS; ++ks) { const bf16x8 kf = *(const LAS bf16x8*)(kl + (kt * 16 + lq) * G::KSTR + ks * 64 + g4 * 16); sv = __builtin_amdgcn_mfma_f32_16x16x32_bf16(kf, qf[ks], sv, 0, 0, 0); }
                if (t == 0) {
#pragma unroll
                    for (int r = 0; r < 4; ++r) sv[r] = (4 * g4 + r >= lq) ? sv[r] : NEG; }
                if (t == 8) {
#pragma unroll
                    for (int r = 0; r < 4; ++r) sv[r] = (4 * g4 + r <= lq) ? sv[r] : NEG; }
                S[t] = sv;
            } else S[t] = (f32x4){NEG, NEG, NEG, NEG};
        }
        S[9] = (f32x4){NEG, NEG, NEG, NEG};
        float mx = NEG;
#pragma unroll
        for (int t = 0; t < 9; ++t)
#pragma unroll
            for (int r = 0; r < 4; ++r) mx = fmaxf(mx, S[t][r]);
        mx = fmaxf(mx, shx(mx, 16, lane)); mx = fmaxf(mx, shx(mx, 32, lane));
        float l = 0.f;
#pragma unroll
        for (int t = 0; t < 10; ++t)
#pragma unroll
            for (int r = 0; r < 4; ++r) { const float pv = __builtin_amdgcn_exp2f(S[t][r] - mx); l += pv; S[t][r] = pv; }
        l += shx(l, 16, lane); l += shx(l, 32, lane);
        f32x4 O[G::NDT];
#pragma unroll
        for (int dt = 0; dt < G::NDT; ++dt) O[dt] = (f32x4){0.f, 0.f, 0.f, 0.f};
#pragma unroll
        for (int u = 0; u < 5; ++u) {
            u32x4 pw; pw.x = cvt_pk_bf16(S[2 * u][0], S[2 * u][1]); pw.y = cvt_pk_bf16(S[2 * u][2], S[2 * u][3]); pw.z = cvt_pk_bf16(S[2 * u + 1][0], S[2 * u + 1][1]); pw.w = cvt_pk_bf16(S[2 * u + 1][2], S[2 * u + 1][3]);
            const bf16x8 pb = __builtin_bit_cast(bf16x8, pw);
            const int ka = (w + 2 * u) * 16 + 4 * g4 + (lq >> 2), kb = ka + 16;
            LAS unsigned char* va = vl + ka * G::VSTR + (lane & 3) * 8; LAS unsigned char* vb = vl + kb * G::VSTR + (lane & 3) * 8;
#pragma unroll
            for (int dt = 0; dt < G::NDT; ++dt) {
                const s16x4 x = __builtin_amdgcn_ds_read_tr16_b64_v4i16((LAS s16x4*)(va + dt * 32));
                const s16x4 y = __builtin_amdgcn_ds_read_tr16_b64_v4i16((LAS s16x4*)(vb + dt * 32));
                const bf16x8 av = (bf16x8){x[0], x[1], x[2], x[3], y[0], y[1], y[2], y[3]};
                O[dt] = __builtin_amdgcn_mfma_f32_16x16x32_bf16(av, pb, O[dt], 0, 0, 0);
            }
        }
        const float inv = 1.0f / l;
        const size_t trow = I.row0 + (size_t)qi * I.d;
        bf16_t* orow = OG + trow * 1536 + I.g * 512 + I.h * 128;
#pragma unroll
        for (int dp = 0; dp < G::NDT / 2; ++dp) {
            const unsigned ax = cvt_pk_bf16(O[2 * dp][0] * inv, O[2 * dp][1] * inv), ay = cvt_pk_bf16(O[2 * dp][2] * inv, O[2 * dp][3] * inv);
            const unsigned bx_ = cvt_pk_bf16(O[2 * dp + 1][0] * inv, O[2 * dp + 1][1] * inv), by_ = cvt_pk_bf16(O[2 * dp + 1][2] * inv, O[2 * dp + 1][3] * inv);
            const u32x2 r0 = __builtin_amdgcn_permlane16_swap(ax, bx_, false, false), r1 = __builtin_amdgcn_permlane16_swap(ay, by_, false, false);
            const u32x4 wv = (u32x4){r0[0], r1[0], r0[1], r1[1]};
            *(u32x4*)(orow + ((g4 & 1) ? (2 * dp + 1) * 16 + 4 * (g4 - 1) : (2 * dp) * 16 + 4 * g4)) = wv; }
        if (g4 == 0) LSE[trow * 12 + I.g * 4 + I.h] = (mx + __builtin_amdgcn_logf(l)) * 0.6931471805599453f;
        __syncthreads();
    }
}

__device__ __forceinline__ void attn_mem_run(LAS unsigned char* lds, const bf16_t* __restrict__ PROJ, const bf16_t* __restrict__ MKV, const float* __restrict__ wq, const float* __restrict__ wk, bf16_t* __restrict__ ACT,
                                             int half, int bx, int G_, const int tid) {
    constexpr int HD = 256; typedef AttnGeo<HD> G;
    const int w = __builtin_amdgcn_readfirstlane(tid >> 6), lane = tid & 63, lq = lane & 15, g4 = lane >> 4;
    const int n = (512 - bx + G_ - 1) / G_;
    if (n <= 0) return;
#pragma unroll 1
    for (int k = 0; k < n; ++k) {
        const int idx = mem_item(bx, k, G_), qb = idx & 15, h = (idx >> 4) & 3, bl = idx >> 6, b = half * 8 + bl;
        const size_t trow = (size_t)bl * SEQ + qb * 128 + 16 * w + lq;
        u32x4 rq[G::NKS];
        issue_q<HD>(rq, PROJ + trow * PS + C_MQ + h * 256, g4);
        stage_rows<HD, true>(lds, MKV + (size_t)b * 256 * DM + h * 256, DM, wk, tid);
        bf16x8 qf[G::NKS];
        norm_q<HD>(qf, rq, wq, 0.0625f * 1.4426950408889634f, g4, lane);
        __syncthreads();
        u32x2 P[16]; float l;
        {
            f32x4 S[16];
#pragma unroll
            for (int t = 0; t < 16; ++t) {
                f32x4 sv = (f32x4){0.f, 0.f, 0.f, 0.f};
#pragma unroll
                for (int ks = 0; ks < G::NKS; ++ks) { const bf16x8 kf = *(const LAS bf16x8*)(lds + (t * 16 + lq) * G::KSTR + ks * 64 + g4 * 16); sv = __builtin_amdgcn_mfma_f32_16x16x32_bf16(kf, qf[ks], sv, 0, 0, 0); }
                S[t] = sv;
            }
            float mx = -__builtin_inff(); asm volatile("" : "+v"(mx));
#pragma unroll
            for (int t = 0; t < 16; ++t)
#pragma unroll
                for (int r = 0; r < 4; ++r) mx = fmaxf(mx, S[t][r]);
            mx = fmaxf(mx, shx(mx, 16, lane)); mx = fmaxf(mx, shx(mx, 32, lane));
            l = 0.f;
#pragma unroll
            for (int t = 0; t < 16; ++t) { const float p0 = __builtin_amdgcn_exp2f(S[t][0] - mx), p1 = __builtin_amdgcn_exp2f(S[t][1] - mx), p2 = __builtin_amdgcn_exp2f(S[t][2] - mx), p3 = __builtin_amdgcn_exp2f(S[t][3] - mx);
                l += (p0 + p1) + (p2 + p3); P[t].x = cvt_pk_bf16(p0, p1); P[t].y = cvt_pk_bf16(p2, p3); }
            l += shx(l, 16, lane); l += shx(l, 32, lane);
        }
        __syncthreads();
        stage_rows<HD, false>(lds, MKV + (size_t)b * 256 * DM + 1024 + h * 256, DM, wk, tid);
        __syncthreads();
        f32x4 O[G::NDT];
#pragma unroll
        for (int dt = 0; dt < G::NDT; ++dt) O[dt] = (f32x4){0.f, 0.f, 0.f, 0.f};
#pragma unroll
        for (int u = 0; u < 8; ++u) {
            u32x4 pw; pw.x = P[2 * u].x; pw.y = P[2 * u].y; pw.z = P[2 * u + 1].x; pw.w = P[2 * u + 1].y;
            const bf16x8 pb = __builtin_bit_cast(bf16x8, pw);
            const int ka = (2 * u) * 16 + 4 * g4 + (lq >> 2), kb = ka + 16;
            LAS unsigned char* va = lds + ka * G::VSTR + (lane & 3) * 8; LAS unsigned char* vb = lds + kb * G::VSTR + (lane & 3) * 8;
#pragma unroll
            for (int dt = 0; dt < G::NDT; ++dt) {
                const s16x4 x = __builtin_amdgcn_ds_read_tr16_b64_v4i16((LAS s16x4*)(va + dt * 32));
                const s16x4 y = __builtin_amdgcn_ds_read_tr16_b64_v4i16((LAS s16x4*)(vb + dt * 32));
                const bf16x8 av = (bf16x8){x[0], x[1], x[2], x[3], y[0], y[1], y[2], y[3]};
                O[dt] = __builtin_amdgcn_mfma_f32_16x16x32_bf16(av, pb, O[dt], 0, 0, 0);
            }
        }
        const float inv = 1.0f / l;
        const bf16_t* zrow = PROJ + trow * PS + C_ZM + h * 256; bf16_t* arow = ACT + trow * ACTW + 1536 + h * 256;
#pragma unroll
        for (int dp = 0; dp < G::NDT / 2; ++dp) {
            float va[4], vb[4];
#pragma unroll
            for (int j = 0; j < 4; ++j) { const u32x2 r = __builtin_amdgcn_permlane16_swap(__float_as_uint(O[2 * dp][j]), __float_as_uint(O[2 * dp + 1][j]), false, false); va[j] = __uint_as_float(r[0]); vb[j] = __uint_as_float(r[1]); }
            const int dofs = (g4 & 1) ? (2 * dp + 1) * 16 + 4 * (g4 - 1) : (2 * dp) * 16 + 4 * g4;
            const u32x4 z = *(const u32x4*)(zrow + dofs);
            u32x4 o; o.x = cvt_pk_bf16(va[0] * inv * siluf_(bflo(z.x)), va[1] * inv * siluf_(bfhi(z.x))); o.y = cvt_pk_bf16(va[2] * inv * siluf_(bflo(z.y)), va[3] * inv * siluf_(bfhi(z.y)));
            o.z = cvt_pk_bf16(vb[0] * inv * siluf_(bflo(z.z)), vb[1] * inv * siluf_(bfhi(z.z))); o.w = cvt_pk_bf16(vb[2] * inv * siluf_(bflo(z.w)), vb[3] * inv * siluf_(bfhi(z.w)));
            *(u32x4*)(arow + dofs) = o; }
        __syncthreads();
    }
}

#define XB_TMO      128
#define XB_XCNT(j)  (256  + 64 * (j))
#define XB_XSUB(j)  (1280 + 64 * (j))
#define XB_XGEN(j)  (2304 + 64 * (j))
#define XB_TOP      3328
#define XB_TOPGEN   3392
#define XCD_BAR_WORDS 3456
#define XB_SPIN_CAP (1u << 22)
__device__ __forceinline__ unsigned xb_ld(unsigned* p)              { return __hip_atomic_load(p, __ATOMIC_RELAXED, __HIP_MEMORY_SCOPE_AGENT); }
__device__ __forceinline__ unsigned xb_add(unsigned* p, unsigned v) { return __hip_atomic_fetch_add(p, v, __ATOMIC_RELAXED, __HIP_MEMORY_SCOPE_AGENT); }
__device__ __forceinline__ unsigned xb_xcc_id() { return (unsigned)__builtin_amdgcn_s_getreg((3 << 11) | 20) & 0xFu; }
#define XB_SPIN(cond, bar) do { unsigned _sp = 0; while (cond) { __builtin_amdgcn_s_sleep(1); \
    if ((++_sp & 255u) == 0u) { if (xb_ld(&(bar)[XB_TMO])) break; if (_sp > XB_SPIN_CAP) { atomicAdd(&(bar)[XB_TMO], 1u); break; } } } } while (0)
__device__ __forceinline__ void xcd_barrier_complete(unsigned* bar, unsigned x, unsigned& nloc, unsigned& nx) {
    const unsigned G = gridDim.x;
    unsigned sum, cnt, mine, sp = 0u;
    for (;;) {
        sum = 0u; cnt = 0u; mine = 0u;
#pragma unroll
        for (unsigned j = 0; j < 16; ++j) { const unsigned c = xb_ld(&bar[XB_XCNT(j)]); sum += c; cnt += (c > 0u) ? 1u : 0u; mine = (j == x) ? c : mine; }
        if (sum == G) break;
        __builtin_amdgcn_s_sleep(1);
        if ((++sp & 255u) == 0u) { if (xb_ld(&bar[XB_TMO])) break; if (sp > XB_SPIN_CAP) { atomicAdd(&bar[XB_TMO], 1u); break; } }
    }
    nloc = mine > 0u ? mine : 1u; nx = cnt > 0u ? cnt : 1u;
}
__device__ __forceinline__ void xcd_barrier(unsigned* bar, volatile LAS unsigned* st, bool leader_thread) {
    asm volatile("s_waitcnt vmcnt(0)" ::: "memory");
    __syncthreads();
    if (leader_thread) {
        const unsigned x = xb_xcc_id();
        __builtin_amdgcn_s_waitcnt(0);
        unsigned nloc = st[0], nx = st[1];
        if (nloc == 0u) { xcd_barrier_complete(bar, x, nloc, nx); st[0] = nloc; st[1] = nx; }
        const unsigned old = xb_add(&bar[XB_XSUB(x)], 1u);
        const unsigned gen = old / nloc;
        if (old + 1u == (gen + 1u) * nloc) {
            __builtin_amdgcn_fence(__ATOMIC_RELEASE, "agent");
            asm volatile("s_waitcnt vmcnt(0)" ::: "memory");
            const unsigned og = xb_add(&bar[XB_TOP], 1u);
            const unsigned tg = og / nx;
            if (og + 1u == (tg + 1u) * nx) xb_add(&bar[XB_TOPGEN], 1u);
            else XB_SPIN(xb_ld(&bar[XB_TOPGEN]) == tg, bar);
            __builtin_amdgcn_fence(__ATOMIC_ACQUIRE, "agent");
            xb_add(&bar[XB_XGEN(x)], 1u);
            asm volatile("s_waitcnt vmcnt(0)" ::: "memory");
        } else {
            XB_SPIN(xb_ld(&bar[XB_XGEN(x)]) == gen, bar);
            __builtin_amdgcn_fence(__ATOMIC_ACQUIRE, "agent");
            asm volatile("s_waitcnt vmcnt(0)" ::: "memory");
        }
    }
    __syncthreads();
}

struct Args { const float* in[15]; float* out; unsigned char* ws; int lo, hi; };
enum { I_X = 0, I_MEM, I_NG, I_MNG, I_WIN, I_AQN, I_AKN, I_CW, I_WKV, I_MQN, I_MKN, I_WBA, I_WBC, I_WBM, I_WOUT };
constexpr int NPHASE = 11;

__global__ void __launch_bounds__(NTHR, 2) mega(Args a) {
    extern __shared__ __attribute__((aligned(16))) unsigned char lds_raw[];
    LAS unsigned char* lds = (LAS unsigned char*)lds_raw;
    const int G = gridDim.x, bx = blockIdx.x, wave_s = __builtin_amdgcn_readfirstlane((int)threadIdx.x >> 6);
    typedef const __attribute__((address_space(4))) Args* KArgs;
    const int ph_lo = a.lo, ph_hi = a.hi;
    if (a.lo < 0) cg::this_grid().sync();
    volatile LAS unsigned* xst = (volatile LAS unsigned*)(lds + LDS_BYTES - 16);
    if (ph_hi - ph_lo > 1) {
        if (threadIdx.x == 0) { xst[0] = 0u; xst[1] = 0u; (void)xb_add(&((unsigned*)(a.ws + WS_BAR))[XB_XCNT(xb_xcc_id())], 1u); }
        __syncthreads();
    }
    for (int ph = ph_lo; ph < ph_hi; ++ph) {
        KArgs A = (KArgs)__builtin_amdgcn_kernarg_segment_ptr(); asm volatile("" : "+s"(A));
        unsigned char* ws = A->ws;
        bf16_t* WIN = (bf16_t*)(ws + WS_WIN); bf16_t* WKV = (bf16_t*)(ws + WS_WKV); bf16_t* WBR = (bf16_t*)(ws + WS_WBR); bf16_t* WOUT = (bf16_t*)(ws + WS_WOUT);
        bf16_t* MH = (bf16_t*)(ws + WS_MH); bf16_t* MKV = (bf16_t*)(ws + WS_MKV); bf16_t* PROJ = (bf16_t*)(ws + WS_PROJ); bf16_t* OG = (bf16_t*)(ws + WS_OG);
        float* LSE = (float*)(ws + WS_LSE); bf16_t* ACT = (bf16_t*)(ws + WS_ACT); u32x2* GF = (u32x2*)(ws + WS_GF); bf16_t* MB = (bf16_t*)(ws + WS_MB);
        bf16_t* H = (bf16_t*)(ws + WS_H);
        unsigned char* H8 = (unsigned char*)A->out;
        unsigned char* WG8 = (unsigned char*)WIN + (size_t)6144 * LDP * 2;
#define MAKE_TID(name) unsigned name##_m = ~0u; asm volatile("" : "+s"(name##_m)); int name = wave_s * 64 + (int)__builtin_amdgcn_mbcnt_hi(name##_m, __builtin_amdgcn_mbcnt_lo(name##_m, 0u)); asm volatile("" : "+v"(name))
        if (ph == 1 || ph == 2 || ph == 5 || ph == 6 || ph == 9 || ph == 10) {
            const int nj = (ph == 9 || ph == 2 || ph == 5) ? 2 : 1, njr = ((REP_MASK >> ph) & 1) ? 2 * nj : nj;
#pragma unroll 1
            for (int jr = 0; jr < njr; ++jr) {
                const int j = jr >= nj ? jr - nj : jr;
                bf16_t* MB2 = (bf16_t*)(ws + WS_MB2);
                int what;
                int half;
                const int swp = (bx >> 3) & 1;
                u32x2* GF2 = (u32x2*)((unsigned char*)A->out + OUT_H_OFF);
                if (ph == 1) { what = 0; half = 0; }
                else if (ph == 2) { what = (j == 0) ? 1 : 4; half = 0; }
                else if (ph == 5) { what = ((j == 0) != (swp != 0)) ? 2 : 4; half = (what == 2) ? 0 : 1; }
                else if (ph == 6) { what = 1; half = 1; }
                else if (ph == 9) { what = ((j == 0) != (swp != 0)) ? 3 : 2; half = (what == 3) ? 0 : 1; }
                else { what = 3; half = 1; }
                pg8::Gemm g; pg8::Epi E;
                if (what == 2) {
                    g = pg8::Gemm{ACT, WBR, HT, DM, ACTW, ACTW, ACTW, 0}; E = pg8::Epi{5, half ? MB2 : MB, half ? GF2 : GF, nullptr, DM, 1 << 20, 1.0f, 1 << 20, 0, 0, 1 << 20, 0, 0};
                } else if (what == 0) {
                    g = pg8::Gemm{MH, WKV, 4096, DM, DM, DM, DM, 0}; E = pg8::Epi{0, MKV, nullptr, nullptr, DM, 1 << 20, 1.0f, 1 << 20, 0, 0, 1 << 20, 0, 0};
                } else if (what == 3) {
                    const size_t ro = half ? (size_t)HT * DM : 0;
                    g = pg8::Gemm{half ? MB2 : MB, WOUT, HT, DM, DM, DM, DM, 0}; E = pg8::Epi{4, A->out + ro, A->in[I_X] + ro, nullptr, DM, 1 << 20, 1.0f, 1 << 20, 0, 0, 1 << 20, 0, 0};
                } else if (what == 1) {
                    g = pg8::Gemm{H + (size_t)half * HT * LDP, WIN, HT, 6144, DM, LDP, LDP, 0};
                    E = pg8::Epi{0, PROJ, nullptr, half ? GF2 : GF, PS, 16, 1.0f, 1 << 20, C_CB, 0, 1 << 20, 8, 0};
                } else {
                    g = pg8::Gemm{(const bf16_t*)(H8 + (size_t)half * HT * DM), (const bf16_t*)WG8, HT, PS, DM / 2, DM / 2, DM / 2, 1};
                    E = pg8::Epi{0, PROJ, nullptr, half ? GF2 : GF, PS, 28, 1.0f / 64.0f, 20, 0, C_MQ, 36, 0, 16};
                }
                if (GEMM1_STAGGER_US > 0 && g.N == PS) {
                    const unsigned long long t0 = __builtin_amdgcn_s_memrealtime(), dl = (unsigned long long)(((bx >> 3) & 3) * GEMM1_STAGGER_US * 100);
                    while (__builtin_amdgcn_s_memrealtime() - t0 < dl) __builtin_amdgcn_s_sleep(8);
                }
                pg8::StaticOrder S; S.init(g.M, g.N, G, bx);
                unsigned ones2 = ~0u; asm volatile("" : "+s"(ones2));
                int tidj = wave_s * 64 + (int)__builtin_amdgcn_mbcnt_hi(ones2, __builtin_amdgcn_mbcnt_lo(ones2, 0u)); asm volatile("" : "+v"(tidj));
                if (g.f8) pg8::gemm_phase<true>(lds, g, S, E, tidj); else pg8::gemm_phase<false>(lds, g, S, E, tidj);
            }
        }
        if (ph == 0 || ph == 1) {
            MAKE_TID(tid);
            const int lane = tid & 63, wave = tid >> 6;
            if (ph == 0) rmsnorm_rows(A->in[I_MEM], A->in[I_MNG], MH, DM, nullptr, 4096, bx * 8 + wave, G * 8, lane);
            else rmsnorm_rows(A->in[I_X], A->in[I_NG], H, LDP, H8, NTOK, bx * 8 + wave, G * 8, lane);
            const PrepPtrs PP{A->in[I_WIN], A->in[I_WKV], A->in[I_WBA], A->in[I_WBC], A->in[I_WBM], A->in[I_WOUT], WIN, WKV, WBR, WOUT, WG8};
            constexpr int T0 = PT0, T5 = PT5;
            const int tb = (ph == 0) ? 0 : T0, te = (ph == 0) ? T0 : T5;
            if (tb + bx < te) {
                float4 v[4]; TJob J = prep_job(tb + bx, PP); tile_load(v, J, tid);
#pragma unroll 1
                for (int t = tb + bx; t < te; t += G) {
                    float4 vn[4]; const int tn = (t + G < te) ? t + G : t; const TJob Jn = prep_job(tn, PP); tile_load(vn, Jn, tid);
                    tile_store((LAS float*)lds, v, J, tid);
                    J = Jn;
#pragma unroll
                    for (int p = 0; p < 4; ++p) v[p] = vn[p];
                }
            }
        } else if (ph == 3 || ph == 7) {
            const int half = (ph == 3) ? 0 : 1;
            MAKE_TID(tid);
#pragma unroll 1
            for (int rep = 0; rep < REP_BAND; ++rep)
            attn_banded_run(lds, PROJ, A->in[I_AQN], A->in[I_AKN], OG, LSE, bx, G, tid);
#pragma unroll 1
            for (int rep = 0; rep < REP_MEM; ++rep)
            attn_mem_run(lds, PROJ, MKV, A->in[I_MQN], A->in[I_MKN], ACT, half, bx, G, tid);
        } else if (ph == 4 || ph == 8) {
            MAKE_TID(tid);
            const int gt = bx * NTHR + tid, nth = G * NTHR;
            for (int idx = gt; idx < HT * 64; idx += nth) {
                const int row = idx >> 6, c8 = (idx & 63) * 8, h = c8 >> 7;
                const float l0 = LSE[(size_t)row * 12 + h], l1 = LSE[(size_t)row * 12 + 4 + h], l2 = LSE[(size_t)row * 12 + 8 + h];
                const float m = fmaxf(l0, fmaxf(l1, l2)); float w0 = __expf(l0 - m), w1 = __expf(l1 - m), w2 = __expf(l2 - m); const float inv = 1.0f / (w0 + w1 + w2); w0 *= inv; w1 *= inv; w2 *= inv;
                const u32x4 o0 = *(const u32x4*)(OG + (size_t)row * 1536 + c8), o1 = *(const u32x4*)(OG + (size_t)row * 1536 + 512 + c8), o2 = *(const u32x4*)(OG + (size_t)row * 1536 + 1024 + c8);
                const u32x4 z = *(const u32x4*)(PROJ + (size_t)row * PS + C_ZA + c8);
                u32x4 o;
#define CMB(k) o.k = cvt_pk_bf16((w0 * bflo(o0.k) + w1 * bflo(o1.k) + w2 * bflo(o2.k)) * siluf_(bflo(z.k)), (w0 * bfhi(o0.k) + w1 * bfhi(o1.k) + w2 * bfhi(o2.k)) * siluf_(bfhi(z.k)))
                CMB(x); CMB(y); CMB(z); CMB(w);
#undef CMB
                *(u32x4*)(ACT + (size_t)row * ACTW + c8) = o;
            }
            const float* cw = A->in[I_CW];
            for (int idx = gt; idx < HT * 128; idx += nth) {
                const int row = idx >> 7, c8 = (idx & 127) * 8, t = row & (SEQ - 1);
                const bf16_t* pr = PROJ + (size_t)row * PS;
                unsigned zl = 0u; asm volatile("" : "+v"(zl)); const u32x4 z4 = (u32x4){zl, zl, zl, zl};
                const u32x4 c0 = *(const u32x4*)(pr + C_CC + c8), v0 = *(const u32x4*)(pr + C_CV + c8);
                const u32x4 c1 = t >= 1 ? *(const u32x4*)(pr - PS + C_CC + c8) : z4, v1 = t >= 1 ? *(const u32x4*)(pr - PS + C_CV + c8) : z4;
                const u32x4 c2 = t >= 2 ? *(const u32x4*)(pr - 2 * PS + C_CC + c8) : z4, v2 = t >= 2 ? *(const u32x4*)(pr - 2 * PS + C_CV + c8) : z4;
                const u32x4 bb = *(const u32x4*)(pr + C_CB + c8), zz = *(const u32x4*)(pr + C_ZC + c8);
                const float4 wa0 = *(const float4*)(cw + c8), wb0 = *(const float4*)(cw + c8 + 4), wa1 = *(const float4*)(cw + 1024 + c8), wb1 = *(const float4*)(cw + 1024 + c8 + 4), wa2 = *(const float4*)(cw + 2048 + c8), wb2 = *(const float4*)(cw + 2048 + c8 + 4);
                u32x4 o;
#define CV1(f, k, W0, W1, W2) ((W0 * (f(c0.k) * f(v0.k)) + W1 * (f(c1.k) * f(v1.k)) + W2 * (f(c2.k) * f(v2.k))) * f(bb.k) * siluf_(f(zz.k)))
                o.x = cvt_pk_bf16(CV1(bflo, x, wa0.x, wa1.x, wa2.x), CV1(bfhi, x, wa0.y, wa1.y, wa2.y));
                o.y = cvt_pk_bf16(CV1(bflo, y, wa0.z, wa1.z, wa2.z), CV1(bfhi, y, wa0.w, wa1.w, wa2.w));
                o.z = cvt_pk_bf16(CV1(bflo, z, wb0.x, wb1.x, wb2.x), CV1(bfhi, z, wb0.y, wb1.y, wb2.y));
                o.w = cvt_pk_bf16(CV1(bflo, w, wb0.z, wb1.z, wb2.z), CV1(bfhi, w, wb0.w, wb1.w, wb2.w));
#undef CV1
                *(u32x4*)(ACT + (size_t)row * ACTW + 512 + c8) = o;
            }
        }
        if (ph + 1 < ph_hi) {
            { MAKE_TID(tb_); xcd_barrier((unsigned*)(A->ws + WS_BAR), xst, tb_ == 0); }
        }
        if (ph == 0 && ph_hi - ph_lo > 1) { for (int e = 0; e < EXTRA_SYNCS; ++e) cg::this_grid().sync(); }
    }
}

extern "C" void kernel_launch(void* const* d_in, const int* in_sizes, int n_in, void* d_out, int out_size, void* d_ws, size_t ws_size, hipStream_t stream) {
    static int grid = 0;
    if (grid == 0) {
        if (n_in != 15 || ws_size < WS_END) { fprintf(stderr, "kernel_launch: unexpected inputs (n_in %d, ws %zu < %zu)\n", n_in, ws_size, (size_t)WS_END); grid = -1; return; }
        int dev = 0, cus = 0, per_cu = 0;
        hipGetDevice(&dev); hipDeviceGetAttribute(&cus, hipDeviceAttributeMultiprocessorCount, dev);
        if (hipFuncSetAttribute((const void*)mega, hipFuncAttributeMaxDynamicSharedMemorySize, LDS_BYTES) != hipSuccess) { fprintf(stderr, "kernel_launch: hipFuncSetAttribute failed\n"); grid = -1; return; }
        hipOccupancyMaxActiveBlocksPerMultiprocessor(&per_cu, (const void*)mega, NTHR, LDS_BYTES);
        if (per_cu < 1) per_cu = 1;
        grid = cus * 1;
        (void)hipGetLastError();
    }
    if (grid < 0) return;
    Args a{};
    for (int i = 0; i < 15; ++i) a.in[i] = (const float*)d_in[i];
    a.out = (float*)d_out; a.ws = (unsigned char*)d_ws;
#if ONE_LAUNCH
    (void)hipMemsetAsync((unsigned char*)d_ws + WS_BAR, 0, 16384, stream);
    a.lo = 0; a.hi = NPHASE;
    void* args[] = {&a};
    hipError_t e = hipLaunchCooperativeKernel((const void*)mega, dim3(grid), dim3(NTHR), args, LDS_BYTES, stream);
    if (e != hipSuccess) fprintf(stderr, "cooperative launch failed: %s (grid %d)\n", hipGetErrorString(e), grid);
#else
    for (int ph = 0; ph < NPHASE; ++ph) { a.lo = ph; a.hi = ph + 1; hipLaunchKernelGGL(mega, dim3(grid), dim3(NTHR), LDS_BYTES, stream, a); }
#endif
}
```
